# Optimizing an MI355X kernel written in HIP

```python
import jax
import jax.numpy as jnp
from jax import lax
import numpy as np

D_MODEL = 1024
BATCH = 4
SEQ = 8192
DEPTH = 1

MEM_TOKENS = 256
RWKV_HEADS = 8
RWKV_HEAD_DIM = 64
RWKV_WIDTH = RWKV_HEADS * RWKV_HEAD_DIM
DECAY_RANK = 64
AAA_RANK = 64
GATE_RANK = 128
RWKV_SPLITS = [RWKV_WIDTH, 2 * RWKV_WIDTH, 3 * RWKV_WIDTH, 3 * RWKV_WIDTH + DECAY_RANK, 3 * RWKV_WIDTH + DECAY_RANK + AAA_RANK]
RWKV_COLS = 3 * RWKV_WIDTH + DECAY_RANK + AAA_RANK + GATE_RANK
SWA_Q_HEADS = 8
SWA_KV_HEADS = 2
SWA_HEAD_DIM = 64
SWA_GROUP = SWA_Q_HEADS // SWA_KV_HEADS
SWA_WIDTH = SWA_Q_HEADS * SWA_HEAD_DIM
SWA_KV_WIDTH = SWA_KV_HEADS * SWA_HEAD_DIM
SWA_COLS = SWA_WIDTH + 2 * SWA_KV_WIDTH
IN_COLS = RWKV_COLS + SWA_COLS
MIX_WIDTH = RWKV_WIDTH + SWA_WIDTH
WINDOW = 128
ROPE_THETA = 10000.0
MEM_HEADS = 4
MEM_HEAD_DIM = D_MODEL // MEM_HEADS
N_EXPERTS = 256
TOP_K = 8
N_GROUPS = 8
TOPK_GROUPS = 4
EXPERT_DIM = D_MODEL // 4
SHARED_DIM = EXPERT_DIM
ROUTED_SCALE = 2.5
MOE_BLOCK = 128
LN_EPS = 1e-5
GN_EPS = 64e-5
NEG_INF = -1e30
DEEPNORM_ALPHA = (2 * DEPTH) ** 0.25
DEEPNORM_BETA = (8 * DEPTH) ** -0.25

kernel_name = "hybrid_rwkv7_swa_sink_memxattn_moe_deepnorm"


def layer_norm(x, g, b):
    xf = x.astype(jnp.float32)
    mu = xf.mean(-1, keepdims=True)
    var = jnp.square(xf - mu).mean(-1, keepdims=True)
    return ((xf - mu) * lax.rsqrt(var + LN_EPS) * g + b).astype(x.dtype)


def rope(x, positions):
    hd = x.shape[-1]
    inv_freq = ROPE_THETA ** (-jnp.arange(0, hd, 2, dtype=jnp.float32) / hd)
    ang = positions.astype(jnp.float32)[..., None] * inv_freq
    cos = jnp.cos(ang)[:, :, None, :]
    sin = jnp.sin(ang)[:, :, None, :]
    x1, x2 = jnp.split(x.astype(jnp.float32), 2, axis=-1)
    return jnp.concatenate([x1 * cos - x2 * sin, x2 * cos + x1 * sin], axis=-1).astype(x.dtype)


def wkv7_scan(r, w, k, v, a, b):
    B, S, H, N = r.shape

    def step(state, inp):
        r_t, w_t, k_t, v_t, a_t, b_t = inp
        sa = jnp.einsum('bhvk,bhk->bhv', state, a_t)
        state = state * w_t[:, :, None, :] + sa[..., None] * b_t[:, :, None, :] + v_t[..., None] * k_t[:, :, None, :]
        return state, jnp.einsum('bhvk,bhk->bhv', state, r_t)

    xs = tuple(jnp.moveaxis(t, 1, 0) for t in (r, w, k, v, a, b))
    _, y = lax.scan(step, jnp.zeros((B, H, N, N), jnp.float32), xs)
    return jnp.moveaxis(y, 0, 1)


def rwkv7_group(u, mu_shift, w_decay_up, w0, a_up, a0, g_up, k_k, k_a, r_k, lnx_g, lnx_b):
    B, S, _ = u.shape
    f32 = jnp.float32
    prev = jnp.pad(u, ((0, 0), (1, 0), (0, 0)))[:, :-1]
    u = u + (prev - u) * mu_shift
    r, k, v, wd, ad, gd = jnp.split(u, RWKV_SPLITS, axis=-1)
    logw = -jax.nn.softplus(-(w0 + jnp.tanh(wd) @ w_decay_up).astype(f32)) - 0.5
    decay = jnp.exp(-jnp.exp(logw))
    a = jax.nn.sigmoid((a0 + ad @ a_up).astype(f32))
    g = jax.nn.sigmoid(gd) @ g_up

    def heads(t):
        return t.astype(f32).reshape(B, S, RWKV_HEADS, RWKV_HEAD_DIM)

    kk = heads(k * k_k)
    kk = kk / jnp.maximum(jnp.sqrt(jnp.sum(kk * kk, -1, keepdims=True)), 1e-12)
    k_mod = k.astype(f32) * (1.0 + (a - 1.0) * k_a)
    rh, kh, vh, ah = heads(r), heads(k_mod), heads(v), heads(a)
    y = wkv7_scan(rh, heads(decay), kh, vh, -kk, kk * ah)
    mu = y.mean(-1, keepdims=True)
    var = jnp.square(y - mu).mean(-1, keepdims=True)
    yn = ((y - mu) * lax.rsqrt(var + GN_EPS)).reshape(B, S, RWKV_WIDTH) * lnx_g + lnx_b
    bonus = jnp.sum(rh * kh * r_k, -1, keepdims=True) * vh
    y = yn + bonus.reshape(B, S, RWKV_WIDTH)
    return (y * g).astype(u.dtype)


def swa_group(u, positions, sinks):
    B, S, _ = u.shape
    q, k, v = jnp.split(u, [SWA_WIDTH, SWA_WIDTH + SWA_KV_WIDTH], axis=-1)
    q = rope(q.reshape(B, S, SWA_Q_HEADS, SWA_HEAD_DIM), positions)
    k = rope(k.reshape(B, S, SWA_KV_HEADS, SWA_HEAD_DIM), positions)
    v = v.reshape(B, S, SWA_KV_HEADS, SWA_HEAD_DIM)
    nb = S // WINDOW
    qb = q.reshape(B, nb, WINDOW, SWA_KV_HEADS, SWA_GROUP, SWA_HEAD_DIM)
    kb = k.reshape(B, nb, WINDOW, SWA_KV_HEADS, SWA_HEAD_DIM)
    vb = v.reshape(B, nb, WINDOW, SWA_KV_HEADS, SWA_HEAD_DIM)
    pad = ((0, 0), (1, 0), (0, 0), (0, 0), (0, 0))
    kw = jnp.concatenate([jnp.pad(kb, pad)[:, :-1], kb], axis=2)
    vw = jnp.concatenate([jnp.pad(vb, pad)[:, :-1], vb], axis=2)
    s = jnp.einsum('bnqhgd,bnkhd->bnhgqk', qb, kw).astype(jnp.float32) * (SWA_HEAD_DIM ** -0.5)
    qi = jnp.arange(WINDOW)[:, None]
    kj = jnp.arange(2 * WINDOW)[None, :]
    rel = qi + WINDOW - kj
    band = (rel >= 0) & (rel < WINDOW)
    valid = (jnp.arange(nb)[:, None, None] * WINDOW + kj[None] - WINDOW) >= 0
    mask = band[None] & valid
    s = jnp.where(mask[None, :, None, None], s, NEG_INF)
    sink = jnp.broadcast_to(sinks.astype(jnp.float32).reshape(1, 1, SWA_KV_HEADS, SWA_GROUP, 1, 1),
                            s.shape[:-1] + (1,))
    p = jax.nn.softmax(jnp.concatenate([s, sink], axis=-1), axis=-1)[..., :-1]
    o = jnp.einsum('bnhgqk,bnkhd->bnqhgd', p.astype(v.dtype), vw)
    return o.reshape(B, S, SWA_WIDTH)


def hybrid_mixer(h, positions, w_in, mu_shift, w_decay_up, w0, a_up, a0, g_up, k_k, k_a, r_k,
                 lnx_g, lnx_b, sinks, w_o):
    u = h @ w_in
    y_rwkv = rwkv7_group(u[..., :RWKV_COLS], mu_shift, w_decay_up, w0, a_up, a0, g_up,
                         k_k, k_a, r_k, lnx_g, lnx_b)
    y_swa = swa_group(u[..., RWKV_COLS:], positions, sinks)
    return jnp.concatenate([y_rwkv, y_swa], axis=-1) @ w_o


def memory_cross_attention(h, mem, wm_q, wm_kv, wm_o):
    B, S, D = h.shape
    q = (h @ wm_q).reshape(B, S, MEM_HEADS, MEM_HEAD_DIM)
    k, v = jnp.split(mem @ wm_kv, 2, axis=-1)
    k = k.reshape(B, -1, MEM_HEADS, MEM_HEAD_DIM)
    v = v.reshape(B, -1, MEM_HEADS, MEM_HEAD_DIM)
    s = jnp.einsum('bshd,bmhd->bhsm', q, k).astype(jnp.float32) * (MEM_HEAD_DIM ** -0.5)
    p = jax.nn.softmax(s, axis=-1)
    o = jnp.einsum('bhsm,bmhd->bshd', p.astype(v.dtype), v)
    return o.reshape(B, S, D) @ wm_o


def moe_ffn(h, w_router, router_bias, we_gate, we_up, we_down, ws_gate, ws_up, ws_down):
    B, S, D = h.shape
    xt = h.reshape(-1, D)
    N = xt.shape[0]
    scores = jax.nn.sigmoid((xt @ w_router).astype(jnp.float32))
    biased = scores + router_bias.astype(jnp.float32)
    grp = biased.reshape(N, N_GROUPS, N_EXPERTS // N_GROUPS)
    gscore = lax.top_k(grp, 2)[0].sum(-1)
    _, gidx = lax.top_k(gscore, TOPK_GROUPS)
    gmask = jax.nn.one_hot(gidx, N_GROUPS, dtype=jnp.float32).sum(1) > 0
    emask = jnp.repeat(gmask, N_EXPERTS // N_GROUPS, axis=1)
    _, eidx = lax.top_k(jnp.where(emask, biased, NEG_INF), TOP_K)
    sel = jnp.take_along_axis(scores, eidx, axis=1)
    gates = sel / jnp.sum(sel, -1, keepdims=True) * ROUTED_SCALE
    NK = N * TOP_K
    e_flat = eidx.reshape(-1).astype(jnp.int32)
    tok_flat = jnp.repeat(jnp.arange(N, dtype=jnp.int32), TOP_K)
    g_flat = gates.reshape(-1)
    order = jnp.argsort(e_flat)
    e_sorted = e_flat[order]
    counts = jnp.bincount(e_flat, length=N_EXPERTS)
    starts = jnp.cumsum(counts) - counts
    padded = ((counts + MOE_BLOCK - 1) // MOE_BLOCK) * MOE_BLOCK
    pad_ends = jnp.cumsum(padded)
    pad_starts = pad_ends - padded
    dest = pad_starts[e_sorted] + (jnp.arange(NK, dtype=jnp.int32) - starts[e_sorted])
    n_blocks = (NK + MOE_BLOCK - 1) // MOE_BLOCK + N_EXPERTS
    P = n_blocks * MOE_BLOCK
    tok_pad = jnp.full((P,), N, jnp.int32).at[dest].set(tok_flat[order])
    gate_pad = jnp.zeros((P,), jnp.float32).at[dest].set(g_flat[order])
    block_expert = jnp.minimum(
        jnp.searchsorted(pad_ends, jnp.arange(n_blocks, dtype=jnp.int32) * MOE_BLOCK, side='right'),
        N_EXPERTS - 1).astype(jnp.int32)
    x_ext = jnp.concatenate([xt, jnp.zeros((1, D), xt.dtype)], axis=0)

    def block(acc, inp):
        idx, g, e = inp
        xb = x_ext[idx]
        hb = jax.nn.silu(xb @ we_gate[e]) * (xb @ we_up[e])
        yb = (hb @ we_down[e]) * g[:, None].astype(xb.dtype)
        return acc.at[idx].add(yb), None

    acc, _ = lax.scan(block, jnp.zeros((N + 1, D), xt.dtype),
                      (tok_pad.reshape(n_blocks, MOE_BLOCK), gate_pad.reshape(n_blocks, MOE_BLOCK), block_expert))
    shared = (jax.nn.silu(xt @ ws_gate) * (xt @ ws_up)) @ ws_down
    return (acc[:N] + shared).reshape(B, S, D)


def setup_inputs(seed: int = 0) -> dict:
    key = jax.random.key(seed)
    ks = list(jax.random.split(key, 40))
    ctr = [0]

    def nk():
        ctr[0] += 1
        return ks[ctr[0] - 1]

    def nrm(shape, scale):
        return jax.random.normal(nk(), shape, jnp.float32) * scale

    def uni(shape, lo, hi):
        return jax.random.uniform(nk(), shape, jnp.float32, lo, hi)

    L, D = DEPTH, D_MODEL
    x = nrm((BATCH, SEQ, D), 1.0)
    mem = nrm((BATCH, MEM_TOKENS, D), 1.0)
    offset = jax.random.randint(nk(), (BATCH, 1), 0, 1024, jnp.int32)
    positions = offset + jnp.arange(SEQ, dtype=jnp.int32)[None, :]
    return {
        "x": x,
        "mem": mem,
        "positions": positions,
        "w_in": nrm((L, D, IN_COLS), D ** -0.5),
        "mu_shift": uni((L, RWKV_COLS), 0.0, 1.0),
        "w_decay_up": nrm((L, DECAY_RANK, RWKV_WIDTH), 0.5 * DECAY_RANK ** -0.5),
        "w0": uni((L, RWKV_WIDTH), -6.0, -1.0),
        "a_up": nrm((L, AAA_RANK, RWKV_WIDTH), AAA_RANK ** -0.5),
        "a0": nrm((L, RWKV_WIDTH), 0.1),
        "g_up": nrm((L, GATE_RANK, RWKV_WIDTH), GATE_RANK ** -0.5),
        "k_k": 0.85 + nrm((L, RWKV_WIDTH), 0.05),
        "k_a": 1.0 + nrm((L, RWKV_WIDTH), 0.05),
        "r_k": nrm((L, RWKV_HEADS, RWKV_HEAD_DIM), 0.1),
        "lnx_g": 1.0 + nrm((L, RWKV_WIDTH), 0.05),
        "lnx_b": nrm((L, RWKV_WIDTH), 0.01),
        "sinks": nrm((L, SWA_Q_HEADS), 0.5),
        "w_o": nrm((L, MIX_WIDTH, D), DEEPNORM_BETA * MIX_WIDTH ** -0.5),
        "ln1_g": 1.0 + nrm((L, D), 0.05),
        "ln1_b": nrm((L, D), 0.01),
        "wm_q": nrm((L, D, D), D ** -0.5),
        "wm_kv": nrm((L, D, 2 * D), D ** -0.5),
        "wm_o": nrm((L, D, D), DEEPNORM_BETA * D ** -0.5),
        "ln2_g": 1.0 + nrm((L, D), 0.05),
        "ln2_b": nrm((L, D), 0.01),
        "w_router": nrm((L, D, N_EXPERTS), D ** -0.5),
        "router_bias": nrm((L, N_EXPERTS), 0.01),
        "we_gate": nrm((L, N_EXPERTS, D, EXPERT_DIM), D ** -0.5),
        "we_up": nrm((L, N_EXPERTS, D, EXPERT_DIM), D ** -0.5),
        "we_down": nrm((L, N_EXPERTS, EXPERT_DIM, D), DEEPNORM_BETA * EXPERT_DIM ** -0.5),
        "ws_gate": nrm((L, D, SHARED_DIM), D ** -0.5),
        "ws_up": nrm((L, D, SHARED_DIM), D ** -0.5),
        "ws_down": nrm((L, SHARED_DIM, D), DEEPNORM_BETA * SHARED_DIM ** -0.5),
        "ln3_g": 1.0 + nrm((L, D), 0.05),
        "ln3_b": nrm((L, D), 0.01),
    }


def reference(x, mem, positions, w_in, mu_shift, w_decay_up, w0, a_up, a0, g_up, k_k, k_a, r_k,
              lnx_g, lnx_b, sinks, w_o, ln1_g, ln1_b, wm_q, wm_kv, wm_o, ln2_g, ln2_b,
              w_router, router_bias, we_gate, we_up, we_down, ws_gate, ws_up, ws_down, ln3_g, ln3_b):
    for l in range(DEPTH):
        mix = hybrid_mixer(x, positions, w_in[l], mu_shift[l], w_decay_up[l], w0[l], a_up[l], a0[l],
                           g_up[l], k_k[l], k_a[l], r_k[l], lnx_g[l], lnx_b[l], sinks[l], w_o[l])
        x = layer_norm(DEEPNORM_ALPHA * x + mix, ln1_g[l], ln1_b[l])
        xa = memory_cross_attention(x, mem, wm_q[l], wm_kv[l], wm_o[l])
        x = layer_norm(DEEPNORM_ALPHA * x + xa, ln2_g[l], ln2_b[l])
        ff = moe_ffn(x, w_router[l], router_bias[l], we_gate[l], we_up[l], we_down[l],
                     ws_gate[l], ws_up[l], ws_down[l])
        x = layer_norm(DEEPNORM_ALPHA * x + ff, ln3_g[l], ln3_b[l])
    return x
```

```cpp
#include <hip/hip_runtime.h>
#include <cstdio>
#include <cstdint>

constexpr int D = 1024, BATCH = 4, SEQ = 8192, NTOK = BATCH * SEQ;
constexpr int MEMT = 256;
constexpr int RW = 512, RCOLS = 1792, INCOLS = 2560;
constexpr int C_R = 0, C_K = 512, C_V = 1024, C_WD = 1536, C_AD = 1600, C_GD = 1664, C_Q = 1792, C_KS = 2304, C_VS = 2432;
constexpr int NEXP = 256, TOPK = 8, EDIM = 256;
constexpr int NK = NTOK * TOPK;
constexpr int MOE_TR = 128;
constexpr int PMAX = NK + NEXP * MOE_TR;
constexpr float LN_EPS = 1e-5f, GN_EPS = 64e-5f;
constexpr float ALPHA = 1.189207115002721f;

constexpr size_t MiB = 1u << 20;
constexpr size_t WS_CTL = 0, CTL_ZERO_BYTES = 64 * 1024;
constexpr size_t WS_TEXP = 512 * 1024;
constexpr size_t WS_ROPE = 1 * MiB;
constexpr size_t WS_U = 16 * MiB;
constexpr size_t WS_LR = 336 * MiB;
constexpr size_t WS_DW = 368 * MiB, WS_DA = 432 * MiB, WS_G = 496 * MiB;
constexpr size_t WS_MIX = 560 * MiB;
constexpr size_t WS_X1 = 688 * MiB;
constexpr size_t WS_QM = 16 * MiB;
constexpr size_t WS_KVM = 144 * MiB;
constexpr size_t WS_SC = 152 * MiB;
constexpr size_t WS_OM = 280 * MiB;
constexpr size_t WS_X2 = 408 * MiB;
constexpr size_t WS_LOG = 536 * MiB;
constexpr size_t WS_EIDX = 568 * MiB, WS_GATE = 569 * MiB, WS_POS = 570 * MiB;
constexpr size_t WS_STOK = 572 * MiB, WS_SGATE = 574 * MiB;
constexpr size_t WS_HG = 576 * MiB;
constexpr size_t WS_HS = 864 * MiB;
constexpr size_t WS_END = 896 * MiB;
constexpr int CW_CNT = 0, CW_OFF = 512, CW_NT = 1024, CW_BAR = 4096;

constexpr int NTHREADS = 512, NWAVES = 8;
constexpr int LDS_BYTES = 147456;
constexpr int MISC_OFF = 140 * 1024;

#define LAS __attribute__((address_space(3)))
typedef float f32x4 __attribute__((ext_vector_type(4)));
typedef float f32x16 __attribute__((ext_vector_type(16)));

#define XB_TMO      128
#define XB_XCNT(j)  (256  + 64 * (j))
#define XB_XSUB(j)  (1280 + 64 * (j))
#define XB_XGEN(j)  (2304 + 64 * (j))
#define XB_TOP      3328
#define XB_TOPGEN   3392
#define XCD_BAR_WORDS 3456
#define XB_SPIN_CAP (1u << 18)
__device__ __forceinline__ unsigned xb_ld(unsigned* p)              { return __hip_atomic_load(p, __ATOMIC_RELAXED, __HIP_MEMORY_SCOPE_AGENT); }
__device__ __forceinline__ unsigned xb_add(unsigned* p, unsigned v) { return __hip_atomic_fetch_add(p, v, __ATOMIC_RELAXED, __HIP_MEMORY_SCOPE_AGENT); }
__device__ __forceinline__ unsigned xb_xcc_id() { return (unsigned)__builtin_amdgcn_s_getreg((3 << 11) | 20) & 0xFu; }
#define XB_SPIN(cond, bar) do { unsigned _sp = 0; while (cond) { __builtin_amdgcn_s_sleep(1); \
    if ((++_sp & 255u) == 0u) { if (xb_ld(&(bar)[XB_TMO])) break; if (_sp > XB_SPIN_CAP) { atomicAdd(&(bar)[XB_TMO], 1u); break; } } } } while (0)
struct XcdBarrier { unsigned* bar; unsigned x; volatile LAS unsigned* st; };
__device__ __forceinline__ XcdBarrier xcd_barrier_post(unsigned* bar, volatile LAS unsigned* st) {
    XcdBarrier b; b.bar = bar; b.x = xb_xcc_id(); b.st = st;
    if (threadIdx.x == 0) (void)xb_add(&bar[XB_XCNT(b.x)], 1u);
    return b;
}
__device__ __forceinline__ void xcd_barrier_complete(unsigned* bar, unsigned x, unsigned& nloc, unsigned& nx) {
    const unsigned G = gridDim.x * gridDim.y * gridDim.z;
    unsigned sum, cnt, mine, sp = 0u;
    for (;;) {
        sum = 0u; cnt = 0u; mine = 0u;
#pragma unroll
        for (unsigned j = 0; j < 16; ++j) { const unsigned c = xb_ld(&bar[XB_XCNT(j)]); sum += c; cnt += (c > 0u) ? 1u : 0u; mine = (j == x) ? c : mine; }
        if (sum == G) break;
        __builtin_amdgcn_s_sleep(1);
        if ((++sp & 255u) == 0u) { if (xb_ld(&bar[XB_TMO])) break; if (sp > XB_SPIN_CAP) { atomicAdd(&bar[XB_TMO], 1u); break; } }
    }
    nloc = mine > 0u ? mine : 1u; nx = cnt > 0u ? cnt : 1u;
}
__device__ __forceinline__ void xcd_barrier(const XcdBarrier& b) {
    asm volatile("s_waitcnt vmcnt(0)" ::: "memory");
    __syncthreads();
    if (threadIdx.x == 0) {
        unsigned* bar = b.bar;
        __builtin_amdgcn_s_waitcnt(0);
        unsigned nloc = b.st[0], nx = b.st[1];
        if (nloc == 0u) { xcd_barrier_complete(bar, b.x, nloc, nx); b.st[0] = nloc; b.st[1] = nx; }
        const unsigned old = xb_add(&bar[XB_XSUB(b.x)], 1u);
        const unsigned gen = old / nloc;
        if (old + 1u == (gen + 1u) * nloc) {
            __builtin_amdgcn_fence(__ATOMIC_RELEASE, "agent");
            asm volatile("s_waitcnt vmcnt(0)" ::: "memory");
            const unsigned og = xb_add(&bar[XB_TOP], 1u);
            const unsigned tg = og / nx;
            if (og + 1u == (tg + 1u) * nx) xb_add(&bar[XB_TOPGEN], 1u);
            else XB_SPIN(xb_ld(&bar[XB_TOPGEN]) == tg, bar);
            __builtin_amdgcn_fence(__ATOMIC_ACQUIRE, "agent");
            xb_add(&bar[XB_XGEN(b.x)], 1u);
            asm volatile("s_waitcnt vmcnt(0)" ::: "memory");
        } else {
            XB_SPIN(xb_ld(&bar[XB_XGEN(b.x)]) == gen, bar);
            __builtin_amdgcn_fence(__ATOMIC_ACQUIRE, "agent");
            asm volatile("s_waitcnt vmcnt(0)" ::: "memory");
        }
    }
    __syncthreads();
}

__device__ __forceinline__ float wave_sum(float v) {
#pragma unroll
    for (int o = 1; o < 64; o <<= 1) v += __shfl_xor(v, o);
    return v;
}
__device__ __forceinline__ float sigmoidf_(float x) { return 1.0f / (1.0f + expf(-x)); }

struct Args {
    const float* in[34]; float* out; unsigned char* ws;
    int ph_lo, ph_hi;
};

struct GF {
    const float* A; long lda; const int* arow; int arow_lim;
    const float* B; long ldb; int bmode;
    int K;
};
template <class Epi>
__device__ __forceinline__ void gemm_f32_tile(float* lds, const GF& g, int row0, int col0, Epi&& epi) {
    float* As = lds;
    float* Bs = lds + 16 * 132;
    const int tid = threadIdx.x, lane = tid & 63, w = tid >> 6, wm = w >> 1, wn = w & 1;
    f32x16 acc0, acc1;
#pragma unroll
    for (int i = 0; i < 16; ++i) { acc0[i] = 0.f; acc1[i] = 0.f; }
    const int ar = tid >> 2, ak = (tid & 3) * 4;
    long arow_idx = row0 + ar; bool avalid = true;
    if (g.arow) { const int t = g.arow[row0 + ar]; avalid = t < g.arow_lim; arow_idx = avalid ? t : 0; }
    const float* ap = g.A + arow_idx * g.lda + ak;
    const float* bp; int bk, bn;
    if (g.bmode == 0) { bk = tid >> 5; bn = (tid & 31) * 4; bp = g.B + (long)bk * g.ldb + col0 + bn; }
    else { bn = tid >> 2; bk = (tid & 3) * 4; bp = g.B + (long)(col0 + bn) * g.ldb + bk; }
    const int hl = lane >> 5, l31 = lane & 31;
    for (int k0 = 0; k0 < g.K; k0 += 16) {
        f32x4 av = (f32x4){0.f, 0.f, 0.f, 0.f};
        if (avalid) av = *(const f32x4*)(ap + k0);
        const f32x4 bv = g.bmode == 0 ? *(const f32x4*)(bp + (long)k0 * g.ldb) : *(const f32x4*)(bp + k0);
        __syncthreads();
        As[(ak + 0) * 132 + ar] = av[0]; As[(ak + 1) * 132 + ar] = av[1]; As[(ak + 2) * 132 + ar] = av[2]; As[(ak + 3) * 132 + ar] = av[3];
        if (g.bmode == 0) *(f32x4*)&Bs[bk * 132 + bn] = bv;
        else { Bs[(bk + 0) * 132 + bn] = bv[0]; Bs[(bk + 1) * 132 + bn] = bv[1]; Bs[(bk + 2) * 132 + bn] = bv[2]; Bs[(bk + 3) * 132 + bn] = bv[3]; }
        __syncthreads();
#pragma unroll
        for (int kk = 0; kk < 16; kk += 2) {
            const float a = As[(kk + hl) * 132 + wm * 32 + l31];
            const float b0 = Bs[(kk + hl) * 132 + wn * 64 + l31];
            const float b1 = Bs[(kk + hl) * 132 + wn * 64 + 32 + l31];
            acc0 = __builtin_amdgcn_mfma_f32_32x32x2f32(a, b0, acc0, 0, 0, 0);
            acc1 = __builtin_amdgcn_mfma_f32_32x32x2f32(a, b1, acc1, 0, 0, 0);
        }
    }
#pragma unroll
    for (int r = 0; r < 16; ++r) {
        const int row = row0 + wm * 32 + (r & 3) + 8 * (r >> 2) + 4 * hl;
        const int col = col0 + wn * 64 + l31;
        epi(row, col, acc0[r]);
        epi(row, col + 32, acc1[r]);
    }
    __syncthreads();
}

__device__ __forceinline__ void ln_row(const float* a, float alpha, const float* b, float* out, const float* gam, const float* bet, int lane) {
    f32x4 v[4]; float s = 0.f;
#pragma unroll
    for (int j = 0; j < 4; ++j) {
        v[j] = *(const f32x4*)(a + 4 * lane + 256 * j) * alpha;
        if (b) v[j] += *(const f32x4*)(b + 4 * lane + 256 * j);
        s += (v[j][0] + v[j][1]) + (v[j][2] + v[j][3]);
    }
    const float mean = wave_sum(s) * (1.f / D); float s2 = 0.f;
#pragma unroll
    for (int j = 0; j < 4; ++j) { v[j] = v[j] - mean; s2 += (v[j][0] * v[j][0] + v[j][1] * v[j][1]) + (v[j][2] * v[j][2] + v[j][3] * v[j][3]); }
    const float rstd = 1.f / sqrtf(wave_sum(s2) * (1.f / D) + LN_EPS);
#pragma unroll
    for (int j = 0; j < 4; ++j) {
        const f32x4 gg = *(const f32x4*)(gam + 4 * lane + 256 * j), bb = *(const f32x4*)(bet + 4 * lane + 256 * j);
        *(f32x4*)(out + 4 * lane + 256 * j) = v[j] * rstd * gg + bb;
    }
}

constexpr int NPHASES = 22;

__global__ void __launch_bounds__(NTHREADS, 2) mega(Args args) {
    extern __shared__ __attribute__((aligned(16))) unsigned char lds_raw[];
    float* ldsf = (float*)lds_raw;
    const int tid = threadIdx.x, lane = tid & 63, wave = tid >> 6;
    const int G = gridDim.x, bx = blockIdx.x;
    const int gw = bx * NWAVES + wave, NGW = G * NWAVES;
    unsigned char* ws = args.ws;
    unsigned* ctl = (unsigned*)(ws + WS_CTL);
    volatile LAS unsigned* misc = (volatile LAS unsigned*)((LAS unsigned char*)lds_raw + MISC_OFF);
    if (tid < 4) misc[tid] = 0u;
    __syncthreads();
    const int lo = args.ph_lo, hi = args.ph_hi;
    const bool multi = (hi - lo) > 1;
    XcdBarrier bar; bar.bar = ctl + CW_BAR; bar.x = 0; bar.st = nullptr;
    if (multi) bar = xcd_barrier_post(ctl + CW_BAR, misc);
#define IN(k) (lo <= (k) && (k) < hi)
#define SEAM(k) do { if (IN(k) && IN((k) + 1)) xcd_barrier(bar); } while (0)

    const float* x = args.in[0]; const float* mem = args.in[1]; const int* positions = (const int*)args.in[2];
    const float* w_in = args.in[3]; const float* mu_shift = args.in[4]; const float* w_decay_up = args.in[5]; const float* w0 = args.in[6];
    const float* a_up = args.in[7]; const float* a0 = args.in[8]; const float* g_up = args.in[9]; const float* k_k = args.in[10]; const float* k_a = args.in[11];
    const float* r_k = args.in[12]; const float* lnx_g = args.in[13]; const float* lnx_b = args.in[14]; const float* sinks = args.in[15];
    const float* w_o = args.in[16]; const float* ln1_g = args.in[17]; const float* ln1_b = args.in[18];
    const float* wm_q = args.in[19]; const float* wm_kv = args.in[20]; const float* wm_o = args.in[21]; const float* ln2_g = args.in[22]; const float* ln2_b = args.in[23];
    const float* w_router = args.in[24]; const float* router_bias = args.in[25];
    const float* we_gate = args.in[26]; const float* we_up = args.in[27]; const float* we_down = args.in[28];
    const float* ws_gate = args.in[29]; const float* ws_up = args.in[30]; const float* ws_down = args.in[31];
    const float* ln3_g = args.in[32]; const float* ln3_b = args.in[33];
    float* out = args.out;

    float* ROPE_C = (float*)(ws + WS_ROPE); float* ROPE_S = ROPE_C + (size_t)NTOK * 32;
    float* U = (float*)(ws + WS_U); float* LR = (float*)(ws + WS_LR);
    float* DW = (float*)(ws + WS_DW); float* DA = (float*)(ws + WS_DA); float* GG = (float*)(ws + WS_G);
    float* MIX = (float*)(ws + WS_MIX); float* X1 = (float*)(ws + WS_X1);
    float* QM = (float*)(ws + WS_QM); float* KVM = (float*)(ws + WS_KVM); float* SC = (float*)(ws + WS_SC); float* OM = (float*)(ws + WS_OM);
    float* X2 = (float*)(ws + WS_X2); float* LOG = (float*)(ws + WS_LOG);
    int* EIDX = (int*)(ws + WS_EIDX); float* GATE = (float*)(ws + WS_GATE); int* POS = (int*)(ws + WS_POS);
    int* STOK = (int*)(ws + WS_STOK); float* SGATE = (float*)(ws + WS_SGATE);
    float* HG = (float*)(ws + WS_HG); float* HS = (float*)(ws + WS_HS);
    int* TEXP = (int*)(ws + WS_TEXP);

    if (IN(0)) {
        for (int i = bx * NTHREADS + tid; i < NTOK * 32; i += G * NTHREADS) {
            const int n = i >> 5, f = i & 31;
            const double inv = exp(-(double)(2 * f) / 64.0 * 9.210340371976184);
            const double ang = (double)positions[n] * inv;
            ROPE_C[i] = (float)cos(ang); ROPE_S[i] = (float)sin(ang);
        }
    }
    SEAM(0);
    if (IN(1)) {
        GF g{x, D, nullptr, 0, w_in, INCOLS, 0, D};
        const int nm = NTOK / 128, nn = INCOLS / 128;
        for (int t = bx; t < nm * nn; t += G) {
            const int tm = t / nn, tn = t % nn;
            gemm_f32_tile(ldsf, g, tm * 128, tn * 128, [&](int r, int c, float v) { U[(size_t)r * INCOLS + c] = v; });
        }
    }
    SEAM(1);
    if (IN(2)) {
        for (size_t i = (size_t)bx * NTHREADS + tid; i < (size_t)NTOK * 256; i += (size_t)G * NTHREADS) {
            const int n = (int)(i >> 8), c = (int)(i & 255), col = C_WD + c;
            const float u = U[(size_t)n * INCOLS + col];
            const float p = (n % SEQ) ? U[(size_t)(n - 1) * INCOLS + col] : 0.f;
            const float v = u + (p - u) * mu_shift[col];
            LR[i] = c < 64 ? tanhf(v) : (c < 128 ? v : sigmoidf_(v));
        }
    }
    SEAM(2);
    if (IN(3)) {
        const int nm = NTOK / 128, nn = RW / 128;
        for (int t = bx; t < 3 * nm * nn; t += G) {
            const int which = t / (nm * nn), tt = t % (nm * nn), tm = tt / nn, tn = tt % nn;
            if (which == 0) { GF g{LR, 256, nullptr, 0, w_decay_up, RW, 0, 64};
                gemm_f32_tile(ldsf, g, tm * 128, tn * 128, [&](int r, int c, float v) { DW[(size_t)r * RW + c] = v; }); }
            else if (which == 1) { GF g{LR + 64, 256, nullptr, 0, a_up, RW, 0, 64};
                gemm_f32_tile(ldsf, g, tm * 128, tn * 128, [&](int r, int c, float v) { DA[(size_t)r * RW + c] = v; }); }
            else { GF g{LR + 128, 256, nullptr, 0, g_up, RW, 0, 128};
                gemm_f32_tile(ldsf, g, tm * 128, tn * 128, [&](int r, int c, float v) { GG[(size_t)r * RW + c] = v; }); }
        }
    }
    SEAM(3);
    if (IN(4)) {
        if (wave == 0) {
            for (int unit = bx; unit < BATCH * 8; unit += G) {
                const int b = unit >> 3, h = unit & 7, j = lane, hc = h * 64 + j;
                float S[64];
#pragma unroll
                for (int k = 0; k < 64; ++k) S[k] = 0.f;
                float pr = 0.f, pk = 0.f, pv = 0.f;
                const float mur = mu_shift[C_R + hc], muk = mu_shift[C_K + hc], muv = mu_shift[C_V + hc];
                const float w0j = w0[hc], a0j = a0[hc], kkj = k_k[hc], kaj = k_a[hc], rkj = r_k[hc], lgj = lnx_g[hc], lbj = lnx_b[hc];
                float* vec = ldsf;
                for (int t = 0; t < SEQ; ++t) {
                    const size_t n = (size_t)b * SEQ + t;
                    const float r0 = U[n * INCOLS + C_R + hc], k0 = U[n * INCOLS + C_K + hc], v0 = U[n * INCOLS + C_V + hc];
                    const float r = r0 + (pr - r0) * mur, k = k0 + (pk - k0) * muk, v = v0 + (pv - v0) * muv;
                    pr = r0; pk = k0; pv = v0;
                    const float dw = DW[n * RW + hc], da = DA[n * RW + hc], gg = GG[n * RW + hc];
                    const float xx = -(w0j + dw);
                    const float sp = fmaxf(xx, 0.f) + log1pf(expf(-fabsf(xx)));
                    const float logw = -sp - 0.5f;
                    const float wdec = expf(-expf(logw));
                    const float a = sigmoidf_(a0j + da);
                    const float kkv = k * kkj;
                    const float nrm = sqrtf(wave_sum(kkv * kkv));
                    const float kkn = kkv / fmaxf(nrm, 1e-12f);
                    const float kmod = k * (1.f + (a - 1.f) * kaj);
                    const float bonus = wave_sum(r * kmod * rkj);
                    vec[0 * 64 + j] = wdec; vec[1 * 64 + j] = -kkn; vec[2 * 64 + j] = kkn * a; vec[3 * 64 + j] = kmod; vec[4 * 64 + j] = r;
                    __builtin_amdgcn_s_waitcnt(0xC07F);
                    __builtin_amdgcn_wave_barrier();
                    float sa = 0.f;
#pragma unroll
                    for (int kq = 0; kq < 16; ++kq) { const f32x4 av = *(const f32x4*)&vec[64 + 4 * kq];
                        sa += S[4 * kq] * av[0] + S[4 * kq + 1] * av[1] + S[4 * kq + 2] * av[2] + S[4 * kq + 3] * av[3]; }
                    float y = 0.f;
#pragma unroll
                    for (int kq = 0; kq < 16; ++kq) {
                        const f32x4 wv = *(const f32x4*)&vec[4 * kq], bv = *(const f32x4*)&vec[128 + 4 * kq], kv = *(const f32x4*)&vec[192 + 4 * kq], rv = *(const f32x4*)&vec[256 + 4 * kq];
#pragma unroll
                        for (int q = 0; q < 4; ++q) { const float s = S[4 * kq + q] * wv[q] + sa * bv[q] + v * kv[q]; S[4 * kq + q] = s; y += s * rv[q]; }
                    }
                    __builtin_amdgcn_wave_barrier();
                    const float mu = wave_sum(y) * (1.f / 64.f);
                    const float dd = y - mu;
                    const float var = wave_sum(dd * dd) * (1.f / 64.f);
                    const float yn = dd * (1.f / sqrtf(var + GN_EPS)) * lgj + lbj;
                    MIX[n * D + hc] = (yn + bonus * v) * gg;
                }
            }
        }
    }
    SEAM(4);
    if (IN(5)) {
        float* Kt = ldsf; float* Vt = ldsf + 255 * 64;
        for (int unit = bx; unit < BATCH * 64 * 2; unit += G) {
            const int b = unit >> 7, blk = (unit & 127) >> 1, hk = unit & 1;
            const int base_s = blk * 128 - 127;
            __syncthreads();
            for (int i = tid; i < 255 * 64; i += NTHREADS) {
                const int jj = i >> 6, d = i & 63, s = base_s + jj;
                Vt[i] = s >= 0 ? U[((size_t)b * SEQ + s) * INCOLS + C_VS + hk * 64 + d] : 0.f;
            }
            for (int i = tid; i < 255 * 32; i += NTHREADS) {
                const int jj = i >> 5, f = i & 31, s = base_s + jj;
                float o1 = 0.f, o2 = 0.f;
                if (s >= 0) { const size_t n = (size_t)b * SEQ + s; const float k1 = U[n * INCOLS + C_KS + hk * 64 + f], k2 = U[n * INCOLS + C_KS + hk * 64 + 32 + f];
                    const float c = ROPE_C[n * 32 + f], sn = ROPE_S[n * 32 + f]; o1 = k1 * c - k2 * sn; o2 = k2 * c + k1 * sn; }
                Kt[jj * 64 + f] = o1; Kt[jj * 64 + 32 + f] = o2;
            }
            __syncthreads();
            const int i = tid & 127, g = tid >> 7, hq = hk * 4 + g;
            const size_t n = (size_t)b * SEQ + blk * 128 + i;
            float q[64], o[64];
#pragma unroll
            for (int f = 0; f < 32; ++f) { const float q1 = U[n * INCOLS + C_Q + hq * 64 + f], q2 = U[n * INCOLS + C_Q + hq * 64 + 32 + f];
                const float c = ROPE_C[n * 32 + f], sn = ROPE_S[n * 32 + f]; q[f] = (q1 * c - q2 * sn) * 0.125f; q[f + 32] = (q2 * c + q1 * sn) * 0.125f; }
#pragma unroll
            for (int d = 0; d < 64; ++d) o[d] = 0.f;
            float m = sinks[hq], l = 1.f;
            for (int jj = 0; jj < 255; ++jj) {
                const int s = base_s + jj;
                const bool valid = (jj >= i) && (jj <= i + 127) && (s >= 0);
                float sc = 0.f;
#pragma unroll
                for (int dq = 0; dq < 16; ++dq) { const f32x4 kv = *(const f32x4*)&Kt[jj * 64 + 4 * dq];
                    sc += q[4 * dq] * kv[0] + q[4 * dq + 1] * kv[1] + q[4 * dq + 2] * kv[2] + q[4 * dq + 3] * kv[3]; }
                if (valid) {
                    const float mn = fmaxf(m, sc), scale = expf(m - mn), p = expf(sc - mn);
                    l = l * scale + p; m = mn;
#pragma unroll
                    for (int dq = 0; dq < 16; ++dq) { const f32x4 vv = *(const f32x4*)&Vt[jj * 64 + 4 * dq];
#pragma unroll
                        for (int qd = 0; qd < 4; ++qd) o[4 * dq + qd] = o[4 * dq + qd] * scale + p * vv[qd]; }
                }
            }
            const float il = 1.f / l;
#pragma unroll
            for (int d = 0; d < 64; ++d) MIX[n * D + RW + hq * 64 + d] = o[d] * il;
        }
    }
    SEAM(5);
    if (IN(6)) {
        GF g{MIX, D, nullptr, 0, w_o, D, 0, D};
        const int nm = NTOK / 128, nn = D / 128;
        for (int t = bx; t < nm * nn; t += G) {
            const int tm = t / nn, tn = t % nn;
            gemm_f32_tile(ldsf, g, tm * 128, tn * 128, [&](int r, int c, float v) { X1[(size_t)r * D + c] = ALPHA * x[(size_t)r * D + c] + v; });
        }
    }
    SEAM(6);
    if (IN(7)) { for (int n = gw; n < NTOK; n += NGW) ln_row(X1 + (size_t)n * D, 1.f, nullptr, X1 + (size_t)n * D, ln1_g, ln1_b, lane); }
    SEAM(7);
    if (IN(8)) {
        const int nm = NTOK / 128, nn = D / 128, n1 = nm * nn, nm2 = (BATCH * MEMT) / 128, nn2 = 2048 / 128;
        for (int t = bx; t < n1 + nm2 * nn2; t += G) {
            if (t < n1) { const int tm = t / nn, tn = t % nn; GF g{X1, D, nullptr, 0, wm_q, D, 0, D};
                gemm_f32_tile(ldsf, g, tm * 128, tn * 128, [&](int r, int c, float v) { QM[(size_t)r * D + c] = v; }); }
            else { const int tt = t - n1, tm = tt / nn2, tn = tt % nn2; GF g{mem, D, nullptr, 0, wm_kv, 2048, 0, D};
                gemm_f32_tile(ldsf, g, tm * 128, tn * 128, [&](int r, int c, float v) { KVM[(size_t)r * 2048 + c] = v; }); }
        }
    }
    SEAM(8);
    if (IN(9)) {
        const int per = (SEQ / 128) * 2;
        for (int t = bx; t < BATCH * 4 * per; t += G) {
            const int bh = t / per, tt = t % per, b = bh >> 2, h = bh & 3, tm = tt >> 1, tn = tt & 1;
            GF g{QM + (size_t)b * SEQ * D + h * 256, D, nullptr, 0, KVM + (size_t)b * MEMT * 2048 + h * 256, 2048, 1, 256};
            float* dst = SC + (size_t)b * SEQ * 1024 + h * 256;
            gemm_f32_tile(ldsf, g, tm * 128, tn * 128, [&](int r, int c, float v) { dst[(size_t)r * 1024 + c] = v * 0.0625f; });
        }
    }
    SEAM(9);
    if (IN(10)) {
        for (int row = gw; row < NTOK * 4; row += NGW) {
            float* p = SC + (size_t)row * 256 + 4 * lane;
            f32x4 v = *(const f32x4*)p;
            float m = fmaxf(fmaxf(v[0], v[1]), fmaxf(v[2], v[3]));
#pragma unroll
            for (int o = 1; o < 64; o <<= 1) m = fmaxf(m, __shfl_xor(m, o));
            v[0] = expf(v[0] - m); v[1] = expf(v[1] - m); v[2] = expf(v[2] - m); v[3] = expf(v[3] - m);
            const float s = wave_sum((v[0] + v[1]) + (v[2] + v[3]));
            *(f32x4*)p = v * (1.f / s);
        }
    }
    SEAM(10);
    if (IN(11)) {
        const int per = (SEQ / 128) * 2;
        for (int t = bx; t < BATCH * 4 * per; t += G) {
            const int bh = t / per, tt = t % per, b = bh >> 2, h = bh & 3, tm = tt >> 1, tn = tt & 1;
            GF g{SC + (size_t)b * SEQ * 1024 + h * 256, 1024, nullptr, 0, KVM + (size_t)b * MEMT * 2048 + 1024 + h * 256, 2048, 0, 256};
            float* dst = OM + (size_t)b * SEQ * D + h * 256;
            gemm_f32_tile(ldsf, g, tm * 128, tn * 128, [&](int r, int c, float v) { dst[(size_t)r * D + c] = v; });
        }
    }
    SEAM(11);
    if (IN(12)) {
        GF g{OM, D, nullptr, 0, wm_o, D, 0, D};
        const int nm = NTOK / 128, nn = D / 128;
        for (int t = bx; t < nm * nn; t += G) {
            const int tm = t / nn, tn = t % nn;
            gemm_f32_tile(ldsf, g, tm * 128, tn * 128, [&](int r, int c, float v) { X2[(size_t)r * D + c] = ALPHA * X1[(size_t)r * D + c] + v; });
        }
    }
    SEAM(12);
    if (IN(13)) { for (int n = gw; n < NTOK; n += NGW) ln_row(X2 + (size_t)n * D, 1.f, nullptr, X2 + (size_t)n * D, ln2_g, ln2_b, lane); }
    SEAM(13);
    if (IN(14)) {
        GF g{X2, D, nullptr, 0, w_router, NEXP, 0, D};
        const int nm = NTOK / 128, nn = NEXP / 128;
        for (int t = bx; t < nm * nn; t += G) {
            const int tm = t / nn, tn = t % nn;
            gemm_f32_tile(ldsf, g, tm * 128, tn * 128, [&](int r, int c, float v) { LOG[(size_t)r * NEXP + c] = v; });
        }
    }
    SEAM(14);
    if (IN(15)) {
        const int hl = lane >> 5;
        for (int i = bx * NTHREADS + tid; i < PMAX; i += G * NTHREADS) { STOK[i] = NTOK; SGATE[i] = 0.f; }
        for (int n = gw; n < NTOK; n += NGW) {
            float sc[4], bi[4], gso[4];
#pragma unroll
            for (int j = 0; j < 4; ++j) { const int e = lane + 64 * j; sc[j] = sigmoidf_(LOG[(size_t)n * NEXP + e]); bi[j] = sc[j] + router_bias[e]; }
#pragma unroll
            for (int j = 0; j < 4; ++j) {
                float m1 = bi[j], m2 = -INFINITY;
#pragma unroll
                for (int o = 1; o < 32; o <<= 1) { const float o1 = __shfl_xor(m1, o), o2 = __shfl_xor(m2, o);
                    const float n1 = fmaxf(m1, o1), n2 = fmaxf(fminf(m1, o1), fmaxf(m2, o2)); m1 = n1; m2 = n2; }
                gso[j] = m1 + m2;
            }
            float g8[8];
#pragma unroll
            for (int j = 0; j < 4; ++j) { const float oth = __shfl_xor(gso[j], 32); g8[2 * j] = hl ? oth : gso[j]; g8[2 * j + 1] = hl ? gso[j] : oth; }
            bool gsel[8];
#pragma unroll
            for (int a = 0; a < 8; ++a) { int rank = 0;
#pragma unroll
                for (int c = 0; c < 8; ++c) rank += ((g8[c] > g8[a]) || (g8[c] == g8[a] && c < a)) ? 1 : 0;
                gsel[a] = rank < 4; }
            float cand[4];
#pragma unroll
            for (int j = 0; j < 4; ++j) { const bool s = hl ? gsel[2 * j + 1] : gsel[2 * j]; cand[j] = s ? bi[j] : -1e30f; }
            int eidx[8]; float sel[8]; float ssum = 0.f;
#pragma unroll
            for (int k = 0; k < 8; ++k) {
                float bv = cand[0]; int be = lane;
#pragma unroll
                for (int j = 1; j < 4; ++j) if (cand[j] > bv) { bv = cand[j]; be = lane + 64 * j; }
#pragma unroll
                for (int o = 1; o < 64; o <<= 1) { const float ov = __shfl_xor(bv, o); const int oe = __shfl_xor(be, o);
                    if (ov > bv || (ov == bv && oe < be)) { bv = ov; be = oe; } }
                eidx[k] = be;
                const int jw = be >> 6, lw = be & 63;
                const float mys = jw == 0 ? sc[0] : (jw == 1 ? sc[1] : (jw == 2 ? sc[2] : sc[3]));
                sel[k] = __shfl(mys, lw); ssum += sel[k];
#pragma unroll
                for (int j = 0; j < 4; ++j) if (lane == lw && j == jw) cand[j] = -INFINITY;
            }
#pragma unroll
            for (int k = 0; k < 8; ++k) {
                if (lane == k) {
                    const int e = eidx[k];
                    const int pos = (int)atomicAdd(&ctl[CW_CNT + e], 1u);
                    EIDX[n * 8 + k] = e; GATE[n * 8 + k] = sel[k] / ssum * 2.5f; POS[n * 8 + k] = pos;
                }
            }
        }
    }
    SEAM(15);
    if (IN(16)) {
        if (bx == 0) {
            int* soff = (int*)ldsf;
            if (tid == 0) { int acc = 0; for (int e = 0; e < NEXP; ++e) { soff[e] = acc; const int c = (int)ctl[CW_CNT + e]; acc += ((c + MOE_TR - 1) / MOE_TR) * MOE_TR; } soff[NEXP] = acc; }
            __syncthreads();
            if (tid <= NEXP) ctl[CW_OFF + tid] = (unsigned)soff[tid];
            if (tid == 0) ctl[CW_NT] = (unsigned)(soff[NEXP] / MOE_TR);
            if (tid < NEXP) { for (int t = soff[tid] / MOE_TR; t < soff[tid + 1] / MOE_TR; ++t) TEXP[t] = tid; }
        }
    }
    SEAM(16);
    if (IN(17)) {
        for (int i = bx * NTHREADS + tid; i < NK; i += G * NTHREADS) {
            const int e = EIDX[i], p = (int)ctl[CW_OFF + e] + POS[i];
            STOK[p] = i >> 3; SGATE[p] = GATE[i];
        }
    }
    SEAM(17);
    if (IN(18)) {
        const int ntm = (int)ctl[CW_NT], n1 = ntm * 2, n2 = (NTOK / 128) * 2;
        for (int t = bx; t < n1 + n2; t += G) {
            if (t < n1) { const int tm = t >> 1, tn = t & 1, e = TEXP[tm];
                GF g{X2, D, STOK, NTOK, we_gate + (size_t)e * D * EDIM, EDIM, 0, D};
                gemm_f32_tile(ldsf, g, tm * 128, tn * 128, [&](int r, int c, float v) { HG[(size_t)r * EDIM + c] = v; }); }
            else { const int tt = t - n1, tm = tt >> 1, tn = tt & 1;
                GF g{X2, D, nullptr, 0, ws_gate, EDIM, 0, D};
                gemm_f32_tile(ldsf, g, tm * 128, tn * 128, [&](int r, int c, float v) { HS[(size_t)r * EDIM + c] = v; }); }
        }
    }
    SEAM(18);
    if (IN(19)) {
        const int ntm = (int)ctl[CW_NT], n1 = ntm * 2, n2 = (NTOK / 128) * 2;
        for (int t = bx; t < n1 + n2; t += G) {
            if (t < n1) { const int tm = t >> 1, tn = t & 1, e = TEXP[tm];
                GF g{X2, D, STOK, NTOK, we_up + (size_t)e * D * EDIM, EDIM, 0, D};
                gemm_f32_tile(ldsf, g, tm * 128, tn * 128, [&](int r, int c, float v) { float* p = &HG[(size_t)r * EDIM + c]; const float gv = *p; *p = gv * sigmoidf_(gv) * v; }); }
            else { const int tt = t - n1, tm = tt >> 1, tn = tt & 1;
                GF g{X2, D, nullptr, 0, ws_up, EDIM, 0, D};
                gemm_f32_tile(ldsf, g, tm * 128, tn * 128, [&](int r, int c, float v) { float* p = &HS[(size_t)r * EDIM + c]; const float gv = *p; *p = gv * sigmoidf_(gv) * v; }); }
        }
    }
    SEAM(19);
    if (IN(20)) {
        const int ntm = (int)ctl[CW_NT], n1 = ntm * 8, n2 = (NTOK / 128) * 8;
        for (int t = bx; t < n1 + n2; t += G) {
            if (t < n1) { const int tm = t >> 3, tn = t & 7, e = TEXP[tm];
                GF g{HG, EDIM, nullptr, 0, we_down + (size_t)e * EDIM * D, D, 0, EDIM};
                gemm_f32_tile(ldsf, g, tm * 128, tn * 128, [&](int r, int c, float v) { const int tok = STOK[r]; if (tok < NTOK) atomicAdd(&out[(size_t)tok * D + c], v * SGATE[r]); }); }
            else { const int tt = t - n1, tm = tt >> 3, tn = tt & 7;
                GF g{HS, EDIM, nullptr, 0, ws_down, D, 0, EDIM};
                gemm_f32_tile(ldsf, g, tm * 128, tn * 128, [&](int r, int c, float v) { atomicAdd(&out[(size_t)r * D + c], v); }); }
        }
    }
    SEAM(20);
    if (IN(21)) { for (int n = gw; n < NTOK; n += NGW) ln_row(X2 + (size_t)n * D, ALPHA, out + (size_t)n * D, out + (size_t)n * D, ln3_g, ln3_b, lane); }
#undef IN
#undef SEAM
}

#ifndef PHASE_MASK
#define PHASE_MASK 0x3FFFFFu
#endif
#ifndef ONE_LAUNCH
#define ONE_LAUNCH 0
#endif

extern "C" void kernel_launch(void* const* d_in, const int* in_sizes, int n_in, void* d_out, int out_size, void* d_ws, size_t ws_size, hipStream_t stream) {
    static int grid = 0;
    if (grid == 0) {
        if (n_in != 34 || out_size != NTOK * D || ws_size < WS_END) { fprintf(stderr, "kernel_launch: unexpected shapes (n_in %d out %d ws %zu)\n", n_in, out_size, ws_size); grid = -1; return; }
        int dev = 0, cus = 0;
        if (hipGetDevice(&dev) != hipSuccess || hipDeviceGetAttribute(&cus, hipDeviceAttributeMultiprocessorCount, dev) != hipSuccess) { grid = -1; return; }
        if (hipFuncSetAttribute((const void*)mega, hipFuncAttributeMaxDynamicSharedMemorySize, LDS_BYTES) != hipSuccess) { fprintf(stderr, "kernel_launch: hipFuncSetAttribute failed\n"); grid = -1; return; }
        (void)hipGetLastError();
        grid = cus;
    }
    if (grid < 0) return;
    (void)hipMemsetAsync((char*)d_ws + WS_CTL, 0, CTL_ZERO_BYTES, stream);
    (void)hipMemsetAsync(d_out, 0, (size_t)NTOK * D * sizeof(float), stream);
    Args a{};
    for (int i = 0; i < 34; ++i) a.in[i] = (const float*)d_in[i];
    a.out = (float*)d_out; a.ws = (unsigned char*)d_ws;
#if ONE_LAUNCH
    a.ph_lo = 0; a.ph_hi = NPHASES;
    hipLaunchKernelGGL(mega, dim3(grid), dim3(NTHREADS), LDS_BYTES, stream, a);
#else
    for (int p = 0; p < NPHASES; ++p) { if (!((PHASE_MASK >> p) & 1)) continue; a.ph_lo = p; a.ph_hi = p + 1; hipLaunchKernelGGL(mega, dim3(grid), dim3(NTHREADS), LDS_BYTES, stream, a); }
#endif
}
```

```cpp
#include <hip/hip_runtime.h>
#include <cstdio>
#include <cstdint>

constexpr int D = 1024, BATCH = 4, SEQ = 8192, NTOK = BATCH * SEQ;
constexpr int MEMT = 256;
constexpr int RW = 512, RCOLS = 1792, INCOLS = 2560;
constexpr int C_R = 0, C_K = 512, C_V = 1024, C_WD = 1536, C_AD = 1600, C_GD = 1664, C_Q = 1792, C_KS = 2304, C_VS = 2432;
constexpr int NEXP = 256, TOPK = 8, EDIM = 256;
constexpr int NK = NTOK * TOPK;
constexpr int MOE_TR = 128;
constexpr int PMAX = NK + NEXP * MOE_TR;
constexpr float LN_EPS = 1e-5f, GN_EPS = 64e-5f;
constexpr float ALPHA = 1.189207115002721f;

constexpr size_t MiB = 1u << 20;
constexpr size_t WS_CTL = 0, CTL_ZERO_BYTES = 64 * 1024;
constexpr size_t WS_TEXP = 512 * 1024;
constexpr size_t WS_ROPE = 1 * MiB;
constexpr size_t WS_U = 16 * MiB;
constexpr size_t WS_LR = 336 * MiB;
constexpr size_t WS_DW = 368 * MiB, WS_DA = 432 * MiB, WS_G = 496 * MiB;
constexpr size_t WS_MIX = 560 * MiB;
constexpr size_t WS_X1 = 688 * MiB;
constexpr size_t WS_QM = 16 * MiB;
constexpr size_t WS_KVM = 144 * MiB;
constexpr size_t WS_SC = 152 * MiB;
constexpr size_t WS_OM = 280 * MiB;
constexpr size_t WS_X2 = 408 * MiB;
constexpr size_t WS_LOG = 536 * MiB;
constexpr size_t WS_EIDX = 568 * MiB, WS_GATE = 569 * MiB, WS_POS = 570 * MiB;
constexpr size_t WS_STOK = 572 * MiB, WS_SGATE = 574 * MiB;
constexpr size_t WS_HG = 576 * MiB;
constexpr size_t WS_HS = 864 * MiB;
constexpr size_t WS_END = 896 * MiB;
constexpr int CW_CNT = 0, CW_OFF = 512, CW_NT = 1024, CW_BAR = 4096;

constexpr int NTHREADS = 512, NWAVES = 8;
constexpr int LDS_BYTES = 147456;
constexpr int MISC_OFF = 140 * 1024;

#define LAS __attribute__((address_space(3)))
typedef float f32x4 __attribute__((ext_vector_type(4)));
typedef float f32x16 __attribute__((ext_vector_type(16)));

#define XB_TMO      128
#define XB_XCNT(j)  (256  + 64 * (j))
#define XB_XSUB(j)  (1280 + 64 * (j))
#define XB_XGEN(j)  (2304 + 64 * (j))
#define XB_TOP      3328
#define XB_TOPGEN   3392
#define XCD_BAR_WORDS 3456
#define XB_SPIN_CAP (1u << 18)
__device__ __forceinline__ unsigned xb_ld(unsigned* p)              { return __hip_atomic_load(p, __ATOMIC_RELAXED, __HIP_MEMORY_SCOPE_AGENT); }
__device__ __forceinline__ unsigned xb_add(unsigned* p, unsigned v) { return __hip_atomic_fetch_add(p, v, __ATOMIC_RELAXED, __HIP_MEMORY_SCOPE_AGENT); }
__device__ __forceinline__ unsigned xb_xcc_id() { return (unsigned)__builtin_amdgcn_s_getreg((3 << 11) | 20) & 0xFu; }
#define XB_SPIN(cond, bar) do { unsigned _sp = 0; while (cond) { __builtin_amdgcn_s_sleep(1); \
    if ((++_sp & 255u) == 0u) { if (xb_ld(&(bar)[XB_TMO])) break; if (_sp > XB_SPIN_CAP) { atomicAdd(&(bar)[XB_TMO], 1u); break; } } } } while (0)
struct XcdBarrier { unsigned* bar; unsigned x; volatile LAS unsigned* st; };
__device__ __forceinline__ XcdBarrier xcd_barrier_post(unsigned* bar, volatile LAS unsigned* st) {
    XcdBarrier b; b.bar = bar; b.x = xb_xcc_id(); b.st = st;
    if (threadIdx.x == 0) (void)xb_add(&bar[XB_XCNT(b.x)], 1u);
    return b;
}
__device__ __forceinline__ void xcd_barrier_complete(unsigned* bar, unsigned x, unsigned& nloc, unsigned& nx) {
    const unsigned G = gridDim.x * gridDim.y * gridDim.z;
    unsigned sum, cnt, mine, sp = 0u;
    for (;;) {
        sum = 0u; cnt = 0u; mine = 0u;
#pragma unroll
        for (unsigned j = 0; j < 16; ++j) { const unsigned c = xb_ld(&bar[XB_XCNT(j)]); sum += c; cnt += (c > 0u) ? 1u : 0u; mine = (j == x) ? c : mine; }
        if (sum == G) break;
        __builtin_amdgcn_s_sleep(1);
        if ((++sp & 255u) == 0u) { if (xb_ld(&bar[XB_TMO])) break; if (sp > XB_SPIN_CAP) { atomicAdd(&bar[XB_TMO], 1u); break; } }
    }
    nloc = mine > 0u ? mine : 1u; nx = cnt > 0u ? cnt : 1u;
}
__device__ __forceinline__ void xcd_barrier(const XcdBarrier& b) {
    asm volatile("s_waitcnt vmcnt(0)" ::: "memory");
    __syncthreads();
    if (threadIdx.x == 0) {
        unsigned* bar = b.bar;
        __builtin_amdgcn_s_waitcnt(0);
        unsigned nloc = b.st[0], nx = b.st[1];
        if (nloc == 0u) { xcd_barrier_complete(bar, b.x, nloc, nx); b.st[0] = nloc; b.st[1] = nx; }
        const unsigned old = xb_add(&bar[XB_XSUB(b.x)], 1u);
        const unsigned gen = old / nloc;
        if (old + 1u == (gen + 1u) * nloc) {
            __builtin_amdgcn_fence(__ATOMIC_RELEASE, "agent");
            asm volatile("s_waitcnt vmcnt(0)" ::: "memory");
            const unsigned og = xb_add(&bar[XB_TOP], 1u);
            const unsigned tg = og / nx;
            if (og + 1u == (tg + 1u) * nx) xb_add(&bar[XB_TOPGEN], 1u);
            else XB_SPIN(xb_ld(&bar[XB_TOPGEN]) == tg, bar);
            __builtin_amdgcn_fence(__ATOMIC_ACQUIRE, "agent");
            xb_add(&bar[XB_XGEN(b.x)], 1u);
            asm volatile("s_waitcnt vmcnt(0)" ::: "memory");
        } else {
            XB_SPIN(xb_ld(&bar[XB_XGEN(b.x)]) == gen, bar);
            __builtin_amdgcn_fence(__ATOMIC_ACQUIRE, "agent");
            asm volatile("s_waitcnt vmcnt(0)" ::: "memory");
        }
    }
    __syncthreads();
}

__device__ __forceinline__ float wave_sum(float v) {
#pragma unroll
    for (int o = 1; o < 64; o <<= 1) v += __shfl_xor(v, o);
    return v;
}
__device__ __forceinline__ float sigmoidf_(float x) { return 1.0f / (1.0f + expf(-x)); }

struct Args {
    const float* in[34]; float* out; unsigned char* ws;
    int ph_lo, ph_hi;
};

struct GF {
    const float* A; long lda; const int* arow; int arow_lim;
    const float* B; long ldb; int bmode;
    int K;
};
template <class Epi>
__device__ __forceinline__ void gemm_f32_tile(float* lds, const GF& g, int row0, int col0, Epi&& epi) {
    float* As = lds;
    float* Bs = lds + 16 * 132;
    const int tid = threadIdx.x, lane = tid & 63, w = tid >> 6, wm = w >> 1, wn = w & 1;
    f32x16 acc0, acc1;
#pragma unroll
    for (int i = 0; i < 16; ++i) { acc0[i] = 0.f; acc1[i] = 0.f; }
    const int ar = tid >> 2, ak = (tid & 3) * 4;
    long arow_idx = row0 + ar; bool avalid = true;
    if (g.arow) { const int t = g.arow[row0 + ar]; avalid = t < g.arow_lim; arow_idx = avalid ? t : 0; }
    const float* ap = g.A + arow_idx * g.lda + ak;
    const float* bp; int bk, bn;
    if (g.bmode == 0) { bk = tid >> 5; bn = (tid & 31) * 4; bp = g.B + (long)bk * g.ldb + col0 + bn; }
    else { bn = tid >> 2; bk = (tid & 3) * 4; bp = g.B + (long)(col0 + bn) * g.ldb + bk; }
    const int hl = lane >> 5, l31 = lane & 31;
    for (int k0 = 0; k0 < g.K; k0 += 16) {
        f32x4 av = (f32x4){0.f, 0.f, 0.f, 0.f};
        if (avalid) av = *(const f32x4*)(ap + k0);
        const f32x4 bv = g.bmode == 0 ? *(const f32x4*)(bp + (long)k0 * g.ldb) : *(const f32x4*)(bp + k0);
        __syncthreads();
        As[(ak + 0) * 132 + ar] = av[0]; As[(ak + 1) * 132 + ar] = av[1]; As[(ak + 2) * 132 + ar] = av[2]; As[(ak + 3) * 132 + ar] = av[3];
        if (g.bmode == 0) *(f32x4*)&Bs[bk * 132 + bn] = bv;
        else { Bs[(bk + 0) * 132 + bn] = bv[0]; Bs[(bk + 1) * 132 + bn] = bv[1]; Bs[(bk + 2) * 132 + bn] = bv[2]; Bs[(bk + 3) * 132 + bn] = bv[3]; }
        __syncthreads();
#pragma unroll
        for (int kk = 0; kk < 16; kk += 2) {
            const float a = As[(kk + hl) * 132 + wm * 32 + l31];
            const float b0 = Bs[(kk + hl) * 132 + wn * 64 + l31];
            const float b1 = Bs[(kk + hl) * 132 + wn * 64 + 32 + l31];
            acc0 = __builtin_amdgcn_mfma_f32_32x32x2f32(a, b0, acc0, 0, 0, 0);
            acc1 = __builtin_amdgcn_mfma_f32_32x32x2f32(a, b1, acc1, 0, 0, 0);
        }
    }
#pragma unroll
    for (int r = 0; r < 16; ++r) {
        const int row = row0 + wm * 32 + (r & 3) + 8 * (r >> 2) + 4 * hl;
        const int col = col0 + wn * 64 + l31;
        epi(row, col, acc0[r]);
        epi(row, col + 32, acc1[r]);
    }
    __syncthreads();
}

__device__ __forceinline__ void ln_row(const float* a, float alpha, const float* b, float* out, const float* gam, const float* bet, int lane) {
    f32x4 v[4]; float s = 0.f;
#pragma unroll
    for (int j = 0; j < 4; ++j) {
        v[j] = *(const f32x4*)(a + 4 * lane + 256 * j) * alpha;
        if (b) v[j] += *(const f32x4*)(b + 4 * lane + 256 * j);
        s += (v[j][0] + v[j][1]) + (v[j][2] + v[j][3]);
    }
    const float mean = wave_sum(s) * (1.f / D); float s2 = 0.f;
#pragma unroll
    for (int j = 0; j < 4; ++j) { v[j] = v[j] - mean; s2 += (v[j][0] * v[j][0] + v[j][1] * v[j][1]) + (v[j][2] * v[j][2] + v[j][3] * v[j][3]); }
    const float rstd = 1.f / sqrtf(wave_sum(s2) * (1.f / D) + LN_EPS);
#pragma unroll
    for (int j = 0; j < 4; ++j) {
        const f32x4 gg = *(const f32x4*)(gam + 4 * lane + 256 * j), bb = *(const f32x4*)(bet + 4 * lane + 256 * j);
        *(f32x4*)(out + 4 * lane + 256 * j) = v[j] * rstd * gg + bb;
    }
}

constexpr int NPHASES = 22;

__global__ void __launch_bounds__(NTHREADS, 2) mega(Args args) {
    extern __shared__ __attribute__((aligned(16))) unsigned char lds_raw[];
    float* ldsf = (float*)lds_raw;
    const int tid = threadIdx.x, lane = tid & 63, wave = tid >> 6;
    const int G = gridDim.x, bx = blockIdx.x;
    const int gw = bx * NWAVES + wave, NGW = G * NWAVES;
    unsigned char* ws = args.ws;
    unsigned* ctl = (unsigned*)(ws + WS_CTL);
    volatile LAS unsigned* misc = (volatile LAS unsigned*)((LAS unsigned char*)lds_raw + MISC_OFF);
    if (tid < 4) misc[tid] = 0u;
    __syncthreads();
    const int lo = args.ph_lo, hi = args.ph_hi;
    const bool multi = (hi - lo) > 1;
    XcdBarrier bar; bar.bar = ctl + CW_BAR; bar.x = 0; bar.st = nullptr;
    if (multi) bar = xcd_barrier_post(ctl + CW_BAR, misc);
#define IN(k) (lo <= (k) && (k) < hi)
#define SEAM(k) do { if (IN(k) && IN((k) + 1)) xcd_barrier(bar); } while (0)

    const float* x = args.in[0]; const float* mem = args.in[1]; const int* positions = (const int*)args.in[2];
    const float* w_in = args.in[3]; const float* mu_shift = args.in[4]; const float* w_decay_up = args.in[5]; const float* w0 = args.in[6];
    const float* a_up = args.in[7]; const float* a0 = args.in[8]; const float* g_up = args.in[9]; const float* k_k = args.in[10]; const float* k_a = args.in[11];
    const float* r_k = args.in[12]; const float* lnx_g = args.in[13]; const float* lnx_b = args.in[14]; const float* sinks = args.in[15];
    const float* w_o = args.in[16]; const float* ln1_g = args.in[17]; const float* ln1_b = args.in[18];
    const float* wm_q = args.in[19]; const float* wm_kv = args.in[20]; const float* wm_o = args.in[21]; const float* ln2_g = args.in[22]; const float* ln2_b = args.in[23];
    const float* w_router = args.in[24]; const float* router_bias = args.in[25];
    const float* we_gate = args.in[26]; const float* we_up = args.in[27]; const float* we_down = args.in[28];
    const float* ws_gate = args.in[29]; const float* ws_up = args.in[30]; const float* ws_down = args.in[31];
    const float* ln3_g = args.in[32]; const float* ln3_b = args.in[33];
    float* out = args.out;

    float* ROPE_C = (float*)(ws + WS_ROPE); float* ROPE_S = ROPE_C + (size_t)NTOK * 32;
    float* U = (float*)(ws + WS_U); float* LR = (float*)(ws + WS_LR);
    float* DW = (float*)(ws + WS_DW); float* DA = (float*)(ws + WS_DA); float* GG = (float*)(ws + WS_G);
    float* MIX = (float*)(ws + WS_MIX); float* X1 = (float*)(ws + WS_X1);
    float* QM = (float*)(ws + WS_QM); float* KVM = (float*)(ws + WS_KVM); float* SC = (float*)(ws + WS_SC); float* OM = (float*)(ws + WS_OM);
    float* X2 = (float*)(ws + WS_X2); float* LOG = (float*)(ws + WS_LOG);
    int* EIDX = (int*)(ws + WS_EIDX); float* GATE = (float*)(ws + WS_GATE); int* POS = (int*)(ws + WS_POS);
    int* STOK = (int*)(ws + WS_STOK); float* SGATE = (float*)(ws + WS_SGATE);
    float* HG = (float*)(ws + WS_HG); float* HS = (float*)(ws + WS_HS);
    int* TEXP = (int*)(ws + WS_TEXP);

    if (IN(0)) {
        for (int i = bx * NTHREADS + tid; i < NTOK * 32; i += G * NTHREADS) {
            const int n = i >> 5, f = i & 31;
            const double inv = exp(-(double)(2 * f) / 64.0 * 9.210340371976184);
            const double ang = (double)positions[n] * inv;
            ROPE_C[i] = (float)cos(ang); ROPE_S[i] = (float)sin(ang);
        }
    }
    SEAM(0);
    if (IN(1)) {
        GF g{x, D, nullptr, 0, w_in, INCOLS, 0, D};
        const int nm = NTOK / 128, nn = INCOLS / 128;
        for (int t = bx; t < nm * nn; t += G) {
            const int tm = t / nn, tn = t % nn;
            gemm_f32_tile(ldsf, g, tm * 128, tn * 128, [&](int r, int c, float v) { U[(size_t)r * INCOLS + c] = v; });
        }
    }
    SEAM(1);
    if (IN(2)) {
        for (size_t i = (size_t)bx * NTHREADS + tid; i < (size_t)NTOK * 256; i += (size_t)G * NTHREADS) {
            const int n = (int)(i >> 8), c = (int)(i & 255), col = C_WD + c;
            const float u = U[(size_t)n * INCOLS + col];
            const float p = (n % SEQ) ? U[(size_t)(n - 1) * INCOLS + col] : 0.f;
            const float v = u + (p - u) * mu_shift[col];
            LR[i] = c < 64 ? tanhf(v) : (c < 128 ? v : sigmoidf_(v));
        }
    }
    SEAM(2);
    if (IN(3)) {
        const int nm = NTOK / 128, nn = RW / 128;
        for (int t = bx; t < 3 * nm * nn; t += G) {
            const int which = t / (nm * nn), tt = t % (nm * nn), tm = tt / nn, tn = tt % nn;
            if (which == 0) { GF g{LR, 256, nullptr, 0, w_decay_up, RW, 0, 64};
                gemm_f32_tile(ldsf, g, tm * 128, tn * 128, [&](int r, int c, float v) { DW[(size_t)r * RW + c] = v; }); }
            else if (which == 1) { GF g{LR + 64, 256, nullptr, 0, a_up, RW, 0, 64};
                gemm_f32_tile(ldsf, g, tm * 128, tn * 128, [&](int r, int c, float v) { DA[(size_t)r * RW + c] = v; }); }
            else { GF g{LR + 128, 256, nullptr, 0, g_up, RW, 0, 128};
                gemm_f32_tile(ldsf, g, tm * 128, tn * 128, [&](int r, int c, float v) { GG[(size_t)r * RW + c] = v; }); }
        }
    }
    SEAM(3);
    if (IN(4)) {
        if (wave == 0) {
            for (int unit = bx; unit < BATCH * 8; unit += G) {
                const int b = unit >> 3, h = unit & 7, j = lane, hc = h * 64 + j;
                float S[64];
#pragma unroll
                for (int k = 0; k < 64; ++k) S[k] = 0.f;
                float pr = 0.f, pk = 0.f, pv = 0.f;
                const float mur = mu_shift[C_R + hc], muk = mu_shift[C_K + hc], muv = mu_shift[C_V + hc];
                const float w0j = w0[hc], a0j = a0[hc], kkj = k_k[hc], kaj = k_a[hc], rkj = r_k[hc], lgj = lnx_g[hc], lbj = lnx_b[hc];
                float* vec = ldsf;
                for (int t = 0; t < SEQ; ++t) {
                    const size_t n = (size_t)b * SEQ + t;
                    const float r0 = U[n * INCOLS + C_R + hc], k0 = U[n * INCOLS + C_K + hc], v0 = U[n * INCOLS + C_V + hc];
                    const float r = r0 + (pr - r0) * mur, k = k0 + (pk - k0) * muk, v = v0 + (pv - v0) * muv;
                    pr = r0; pk = k0; pv = v0;
                    const float dw = DW[n * RW + hc], da = DA[n * RW + hc], gg = GG[n * RW + hc];
                    const float xx = -(w0j + dw);
                    const float sp = fmaxf(xx, 0.f) + log1pf(expf(-fabsf(xx)));
                    const float logw = -sp - 0.5f;
                    const float wdec = expf(-expf(logw));
                    const float a = sigmoidf_(a0j + da);
                    const float kkv = k * kkj;
                    const float nrm = sqrtf(wave_sum(kkv * kkv));
                    const float kkn = kkv / fmaxf(nrm, 1e-12f);
                    const float kmod = k * (1.f + (a - 1.f) * kaj);
                    const float bonus = wave_sum(r * kmod * rkj);
                    vec[0 * 64 + j] = wdec; vec[1 * 64 + j] = -kkn; vec[2 * 64 + j] = kkn * a; vec[3 * 64 + j] = kmod; vec[4 * 64 + j] = r;
                    __builtin_amdgcn_s_waitcnt(0xC07F);
                    __builtin_amdgcn_wave_barrier();
                    float sa = 0.f;
#pragma unroll
                    for (int kq = 0; kq < 16; ++kq) { const f32x4 av = *(const f32x4*)&vec[64 + 4 * kq];
                        sa += S[4 * kq] * av[0] + S[4 * kq + 1] * av[1] + S[4 * kq + 2] * av[2] + S[4 * kq + 3] * av[3]; }
                    float y = 0.f;
#pragma unroll
                    for (int kq = 0; kq < 16; ++kq) {
                        const f32x4 wv = *(const f32x4*)&vec[4 * kq], bv = *(const f32x4*)&vec[128 + 4 * kq], kv = *(const f32x4*)&vec[192 + 4 * kq], rv = *(const f32x4*)&vec[256 + 4 * kq];
#pragma unroll
                        for (int q = 0; q < 4; ++q) { const float s = S[4 * kq + q] * wv[q] + sa * bv[q] + v * kv[q]; S[4 * kq + q] = s; y += s * rv[q]; }
                    }
                    __builtin_amdgcn_wave_barrier();
                    const float mu = wave_sum(y) * (1.f / 64.f);
                    const float dd = y - mu;
                    const float var = wave_sum(dd * dd) * (1.f / 64.f);
                    const float yn = dd * (1.f / sqrtf(var + GN_EPS)) * lgj + lbj;
                    MIX[n * D + hc] = (yn + bonus * v) * gg;
                }
            }
        }
    }
    SEAM(4);
    if (IN(5)) {
        float* Kt = ldsf; float* Vt = ldsf + 255 * 64;
        for (int unit = bx; unit < BATCH * 64 * 2; unit += G) {
            const int b = unit >> 7, blk = (unit & 127) >> 1, hk = unit & 1;
            const int base_s = blk * 128 - 127;
            __syncthreads();
            for (int i = tid; i < 255 * 64; i += NTHREADS) {
                const int jj = i >> 6, d = i & 63, s = base_s + jj;
                Vt[i] = s >= 0 ? U[((size_t)b * SEQ + s) * INCOLS + C_VS + hk * 64 + d] : 0.f;
            }
            for (int i = tid; i < 255 * 32; i += NTHREADS) {
                const int jj = i >> 5, f = i & 31, s = base_s + jj;
                float o1 = 0.f, o2 = 0.f;
                if (s >= 0) { const size_t n = (size_t)b * SEQ + s; const float k1 = U[n * INCOLS + C_KS + hk * 64 + f], k2 = U[n * INCOLS + C_KS + hk * 64 + 32 + f];
                    const float c = ROPE_C[n * 32 + f], sn = ROPE_S[n * 32 + f]; o1 = k1 * c - k2 * sn; o2 = k2 * c + k1 * sn; }
                Kt[jj * 64 + f] = o1; Kt[jj * 64 + 32 + f] = o2;
            }
            __syncthreads();
            const int i = tid & 127, g = tid >> 7, hq = hk * 4 + g;
            const size_t n = (size_t)b * SEQ + blk * 128 + i;
            float q[64], o[64];
#pragma unroll
            for (int f = 0; f < 32; ++f) { const float q1 = U[n * INCOLS + C_Q + hq * 64 + f], q2 = U[n * INCOLS + C_Q + hq * 64 + 32 + f];
                const float c = ROPE_C[n * 32 + f], sn = ROPE_S[n * 32 + f]; q[f] = (q1 * c - q2 * sn) * 0.125f; q[f + 32] = (q2 * c + q1 * sn) * 0.125f; }
#pragma unroll
            for (int d = 0; d < 64; ++d) o[d] = 0.f;
            float m = sinks[hq], l = 1.f;
            for (int jj = 0; jj < 255; ++jj) {
                const int s = base_s + jj;
                const bool valid = (jj >= i) && (jj <= i + 127) && (s >= 0);
                float sc = 0.f;
#pragma unroll
                for (int dq = 0; dq < 16; ++dq) { const f32x4 kv = *(const f32x4*)&Kt[jj * 64 + 4 * dq];
                    sc += q[4 * dq] * kv[0] + q[4 * dq + 1] * kv[1] + q[4 * dq + 2] * kv[2] + q[4 * dq + 3] * kv[3]; }
                if (valid) {
                    const float mn = fmaxf(m, sc), scale = expf(m - mn), p = expf(sc - mn);
                    l = l * scale + p; m = mn;
#pragma unroll
                    for (int dq = 0; dq < 16; ++dq) { const f32x4 vv = *(const f32x4*)&Vt[jj * 64 + 4 * dq];
#pragma unroll
                        for (int qd = 0; qd < 4; ++qd) o[4 * dq + qd] = o[4 * dq + qd] * scale + p * vv[qd]; }
                }
            }
            const float il = 1.f / l;
#pragma unroll
            for (int d = 0; d < 64; ++d) MIX[n * D + RW + hq * 64 + d] = o[d] * il;
        }
    }
    SEAM(5);
    if (IN(6)) {
        GF g{MIX, D, nullptr, 0, w_o, D, 0, D};
        const int nm = NTOK / 128, nn = D / 128;
        for (int t = bx; t < nm * nn; t += G) {
            const int tm = t / nn, tn = t % nn;
            gemm_f32_tile(ldsf, g, tm * 128, tn * 128, [&](int r, int c, float v) { X1[(size_t)r * D + c] = ALPHA * x[(size_t)r * D + c] + v; });
        }
    }
    SEAM(6);
    if (IN(7)) { for (int n = gw; n < NTOK; n += NGW) ln_row(X1 + (size_t)n * D, 1.f, nullptr, X1 + (size_t)n * D, ln1_g, ln1_b, lane); }
    SEAM(7);
    if (IN(8)) {
        const int nm = NTOK / 128, nn = D / 128, n1 = nm * nn, nm2 = (BATCH * MEMT) / 128, nn2 = 2048 / 128;
        for (int t = bx; t < n1 + nm2 * nn2; t += G) {
            if (t < n1) { const int tm = t / nn, tn = t % nn; GF g{X1, D, nullptr, 0, wm_q, D, 0, D};
                gemm_f32_tile(ldsf, g, tm * 128, tn * 128, [&](int r, int c, float v) { QM[(size_t)r * D + c] = v; }); }
            else { const int tt = t - n1, tm = tt / nn2, tn = tt % nn2; GF g{mem, D, nullptr, 0, wm_kv, 2048, 0, D};
                gemm_f32_tile(ldsf, g, tm * 128, tn * 128, [&](int r, int c, float v) { KVM[(size_t)r * 2048 + c] = v; }); }
        }
    }
    SEAM(8);
    if (IN(9)) {
        const int per = (SEQ / 128) * 2;
        for (int t = bx; t < BATCH * 4 * per; t += G) {
            const int bh = t / per, tt = t % per, b = bh >> 2, h = bh & 3, tm = tt >> 1, tn = tt & 1;
            GF g{QM + (size_t)b * SEQ * D + h * 256, D, nullptr, 0, KVM + (size_t)b * MEMT * 2048 + h * 256, 2048, 1, 256};
            float* dst = SC + (size_t)b * SEQ * 1024 + h * 256;
            gemm_f32_tile(ldsf, g, tm * 128, tn * 128, [&](int r, int c, float v) { dst[(size_t)r * 1024 + c] = v * 0.0625f; });
        }
    }
    SEAM(9);
    if (IN(10)) {
        for (int row = gw; row < NTOK * 4; row += NGW) {
            float* p = SC + (size_t)row * 256 + 4 * lane;
            f32x4 v = *(const f32x4*)p;
            float m = fmaxf(fmaxf(v[0], v[1]), fmaxf(v[2], v[3]));
#pragma unroll
            for (int o = 1; o < 64; o <<= 1) m = fmaxf(m, __shfl_xor(m, o));
            v[0] = expf(v[0] - m); v[1] = expf(v[1] - m); v[2] = expf(v[2] - m); v[3] = expf(v[3] - m);
            const float s = wave_sum((v[0] + v[1]) + (v[2] + v[3]));
            *(f32x4*)p = v * (1.f / s);
        }
    }
    SEAM(10);
    if (IN(11)) {
        const int per = (SEQ / 128) * 2;
        for (int t = bx; t < BATCH * 4 * per; t += G) {
            const int bh = t / per, tt = t % per, b = bh >> 2, h = bh & 3, tm = tt >> 1, tn = tt & 1;
            GF g{SC + (size_t)b * SEQ * 1024 + h * 256, 1024, nullptr, 0, KVM + (size_t)b * MEMT * 2048 + 1024 + h * 256, 2048, 0, 256};
            float* dst = OM + (size_t)b * SEQ * D + h * 256;
            gemm_f32_tile(ldsf, g, tm * 128, tn * 128, [&](int r, int c, float v) { dst[(size_t)r * D + c] = v; });
        }
    }
    SEAM(11);
    if (IN(12)) {
        GF g{OM, D, nullptr, 0, wm_o, D, 0, D};
        const int nm = NTOK / 128, nn = D / 128;
        for (int t = bx; t < nm * nn; t += G) {
            const int tm = t / nn, tn = t % nn;
            gemm_f32_tile(ldsf, g, tm * 128, tn * 128, [&](int r, int c, float v) { X2[(size_t)r * D + c] = ALPHA * X1[(size_t)r * D + c] + v; });
        }
    }
    SEAM(12);
    if (IN(13)) { for (int n = gw; n < NTOK; n += NGW) ln_row(X2 + (size_t)n * D, 1.f, nullptr, X2 + (size_t)n * D, ln2_g, ln2_b, lane); }
    SEAM(13);
    if (IN(14)) {
        GF g{X2, D, nullptr, 0, w_router, NEXP, 0, D};
        const int nm = NTOK / 128, nn = NEXP / 128;
        for (int t = bx; t < nm * nn; t += G) {
            const int tm = t / nn, tn = t % nn;
            gemm_f32_tile(ldsf, g, tm * 128, tn * 128, [&](int r, int c, float v) { LOG[(size_t)r * NEXP + c] = v; });
        }
    }
    SEAM(14);
    if (IN(15)) {
        const int hl = lane >> 5;
        for (int i = bx * NTHREADS + tid; i < PMAX; i += G * NTHREADS) { STOK[i] = NTOK; SGATE[i] = 0.f; }
        for (int n = gw; n < NTOK; n += NGW) {
            float sc[4], bi[4], gso[4];
#pragma unroll
            for (int j = 0; j < 4; ++j) { const int e = lane + 64 * j; sc[j] = sigmoidf_(LOG[(size_t)n * NEXP + e]); bi[j] = sc[j] + router_bias[e]; }
#pragma unroll
            for (int j = 0; j < 4; ++j) {
                float m1 = bi[j], m2 = -INFINITY;
#pragma unroll
                for (int o = 1; o < 32; o <<= 1) { const float o1 = __shfl_xor(m1, o), o2 = __shfl_xor(m2, o);
                    const float n1 = fmaxf(m1, o1), n2 = fmaxf(fminf(m1, o1), fmaxf(m2, o2)); m1 = n1; m2 = n2; }
                gso[j] = m1 + m2;
            }
            float g8[8];
#pragma unroll
            for (int j = 0; j < 4; ++j) { const float oth = __shfl_xor(gso[j], 32); g8[2 * j] = hl ? oth : gso[j]; g8[2 * j + 1] = hl ? gso[j] : oth; }
            bool gsel[8];
#pragma unroll
            for (int a = 0; a < 8; ++a) { int rank = 0;
#pragma unroll
                for (int c = 0; c < 8; ++c) rank += ((g8[c] > g8[a]) || (g8[c] == g8[a] && c < a)) ? 1 : 0;
                gsel[a] = rank < 4; }
            float cand[4];
#pragma unroll
            for (int j = 0; j < 4; ++j) { const bool s = hl ? gsel[2 * j + 1] : gsel[2 * j]; cand[j] = s ? bi[j] : -1e30f; }
            int eidx[8]; float sel[8]; float ssum = 0.f;
#pragma unroll
            for (int k = 0; k < 8; ++k) {
                float bv = cand[0]; int be = lane;
#pragma unroll
                for (int j = 1; j < 4; ++j) if (cand[j] > bv) { bv = cand[j]; be = lane + 64 * j; }
#pragma unroll
                for (int o = 1; o < 64; o <<= 1) { const float ov = __shfl_xor(bv, o); const int oe = __shfl_xor(be, o);
                    if (ov > bv || (ov == bv && oe < be)) { bv = ov; be = oe; } }
                eidx[k] = be;
                const int jw = be >> 6, lw = be & 63;
                const float mys = jw == 0 ? sc[0] : (jw == 1 ? sc[1] : (jw == 2 ? sc[2] : sc[3]));
                sel[k] = __shfl(mys, lw); ssum += sel[k];
#pragma unroll
                for (int j = 0; j < 4; ++j) if (lane == lw && j == jw) cand[j] = -INFINITY;
            }
#pragma unroll
            for (int k = 0; k < 8; ++k) {
                if (lane == k) {
                    const int e = eidx[k];
                    const int pos = (int)atomicAdd(&ctl[CW_CNT + e], 1u);
                    EIDX[n * 8 + k] = e; GATE[n * 8 + k] = sel[k] / ssum * 2.5f; POS[n * 8 + k] = pos;
                }
            }
        }
    }
    SEAM(15);
    if (IN(16)) {
        if (bx == 0) {
            int* soff = (int*)ldsf;
            if (tid == 0) { int acc = 0; for (int e = 0; e < NEXP; ++e) { soff[e] = acc; const int c = (int)ctl[CW_CNT + e]; acc += ((c + MOE_TR - 1) / MOE_TR) * MOE_TR; } soff[NEXP] = acc; }
            __syncthreads();
            if (tid <= NEXP) ctl[CW_OFF + tid] = (unsigned)soff[tid];
            if (tid == 0) ctl[CW_NT] = (unsigned)(soff[NEXP] / MOE_TR);
            if (tid < NEXP) { for (int t = soff[tid] / MOE_TR; t < soff[tid + 1] / MOE_TR; ++t) TEXP[t] = tid; }
        }
    }
    SEAM(16);
    if (IN(17)) {
        for (int i = bx * NTHREADS + tid; i < NK; i += G * NTHREADS) {
            const int e = EIDX[i], p = (int)ctl[CW_OFF + e] + POS[i];
            STOK[p] = i >> 3; SGATE[p] = GATE[i];
        }
    }
    SEAM(17);
    if (IN(18)) {
        const int ntm = (int)ctl[CW_NT], n1 = ntm * 2, n2 = (NTOK / 128) * 2;
        for (int t = bx; t < n1 + n2; t += G) {
            if (t < n1) { const int tm = t >> 1, tn = t & 1, e = TEXP[tm];
                GF g{X2, D, STOK, NTOK, we_gate + (size_t)e * D * EDIM, EDIM, 0, D};
                gemm_f32_tile(ldsf, g, tm * 128, tn * 128, [&](int r, int c, float v) { HG[(size_t)r * EDIM + c] = v; }); }
            else { const int tt = t - n1, tm = tt >> 1, tn = tt & 1;
                GF g{X2, D, nullptr, 0, ws_gate, EDIM, 0, D};
                gemm_f32_tile(ldsf, g, tm * 128, tn * 128, [&](int r, int c, float v) { HS[(size_t)r * EDIM + c] = v; }); }
        }
    }
    SEAM(18);
    if (IN(19)) {
        const int ntm = (int)ctl[CW_NT], n1 = ntm * 2, n2 = (NTOK / 128) * 2;
        for (int t = bx; t < n1 + n2; t += G) {
            if (t < n1) { const int tm = t >> 1, tn = t & 1, e = TEXP[tm];
                GF g{X2, D, STOK, NTOK, we_up + (size_t)e * D * EDIM, EDIM, 0, D};
                gemm_f32_tile(ldsf, g, tm * 128, tn * 128, [&](int r, int c, float v) { float* p = &HG[(size_t)r * EDIM + c]; const float gv = *p; *p = gv * sigmoidf_(gv) * v; }); }
            else { const int tt = t - n1, tm = tt >> 1, tn = tt & 1;
                GF g{X2, D, nullptr, 0, ws_up, EDIM, 0, D};
                gemm_f32_tile(ldsf, g, tm * 128, tn * 128, [&](int r, int c, float v) { float* p = &HS[(size_t)r * EDIM + c]; const float gv = *p; *p = gv * sigmoidf_(gv) * v; }); }
        }
    }
    SEAM(19);
    if (IN(20)) {
        const int ntm = (int)ctl[CW_NT], n1 = ntm * 8, n2 = (NTOK / 128) * 8;
        for (int t = bx; t < n1 + n2; t += G) {
            if (t < n1) { const int tm = t >> 3, tn = t & 7, e = TEXP[tm];
                GF g{HG, EDIM, nullptr, 0, we_down + (size_t)e * EDIM * D, D, 0, EDIM};
                gemm_f32_tile(ldsf, g, tm * 128, tn * 128, [&](int r, int c, float v) { const int tok = STOK[r]; if (tok < NTOK) atomicAdd(&out[(size_t)tok * D + c], v * SGATE[r]); }); }
            else { const int tt = t - n1, tm = tt >> 3, tn = tt & 7;
                GF g{HS, EDIM, nullptr, 0, ws_down, D, 0, EDIM};
                gemm_f32_tile(ldsf, g, tm * 128, tn * 128, [&](int r, int c, float v) { atomicAdd(&out[(size_t)r * D + c], v); }); }
        }
    }
    SEAM(20);
    if (IN(21)) { for (int n = gw; n < NTOK; n += NGW) ln_row(X2 + (size_t)n * D, ALPHA, out + (size_t)n * D, out + (size_t)n * D, ln3_g, ln3_b, lane); }
#undef IN
#undef SEAM
}

#ifndef PHASE_MASK
#define PHASE_MASK 0x3FFFFFu
#endif
#ifndef ONE_LAUNCH
#define ONE_LAUNCH 1
#endif

extern "C" void kernel_launch(void* const* d_in, const int* in_sizes, int n_in, void* d_out, int out_size, void* d_ws, size_t ws_size, hipStream_t stream) {
    static int grid = 0;
    if (grid == 0) {
        if (n_in != 34 || out_size != NTOK * D || ws_size < WS_END) { fprintf(stderr, "kernel_launch: unexpected shapes (n_in %d out %d ws %zu)\n", n_in, out_size, ws_size); grid = -1; return; }
        int dev = 0, cus = 0;
        if (hipGetDevice(&dev) != hipSuccess || hipDeviceGetAttribute(&cus, hipDeviceAttributeMultiprocessorCount, dev) != hipSuccess) { grid = -1; return; }
        if (hipFuncSetAttribute((const void*)mega, hipFuncAttributeMaxDynamicSharedMemorySize, LDS_BYTES) != hipSuccess) { fprintf(stderr, "kernel_launch: hipFuncSetAttribute failed\n"); grid = -1; return; }
        (void)hipGetLastError();
        grid = cus;
    }
    if (grid < 0) return;
    (void)hipMemsetAsync((char*)d_ws + WS_CTL, 0, CTL_ZERO_BYTES, stream);
    (void)hipMemsetAsync(d_out, 0, (size_t)NTOK * D * sizeof(float), stream);
    Args a{};
    for (int i = 0; i < 34; ++i) a.in[i] = (const float*)d_in[i];
    a.out = (float*)d_out; a.ws = (unsigned char*)d_ws;
#if ONE_LAUNCH
    a.ph_lo = 0; a.ph_hi = NPHASES;
    hipLaunchKernelGGL(mega, dim3(grid), dim3(NTHREADS), LDS_BYTES, stream, a);
#else
    for (int p = 0; p < NPHASES; ++p) { if (!((PHASE_MASK >> p) & 1)) continue; a.ph_lo = p; a.ph_hi = p + 1; hipLaunchKernelGGL(mega, dim3(grid), dim3(NTHREADS), LDS_BYTES, stream, a); }
#endif
}
```

```cpp
#include <hip/hip_runtime.h>
#include <cstdio>
#include <cstdint>

constexpr int D = 1024, BATCH = 4, SEQ = 8192, NTOK = BATCH * SEQ;
constexpr int MEMT = 256;
constexpr int RW = 512, RCOLS = 1792, INCOLS = 2560;
constexpr int C_R = 0, C_K = 512, C_V = 1024, C_WD = 1536, C_AD = 1600, C_GD = 1664, C_Q = 1792, C_KS = 2304, C_VS = 2432;
constexpr int NEXP = 256, TOPK = 8, EDIM = 256;
constexpr int NK = NTOK * TOPK;
constexpr int MOE_TR = 128;
constexpr int PMAX = NK + NEXP * MOE_TR;
constexpr float LN_EPS = 1e-5f, GN_EPS = 64e-5f;
constexpr float ALPHA = 1.189207115002721f;

constexpr size_t MiB = 1u << 20;
constexpr size_t WS_CTL = 0, CTL_ZERO_BYTES = 64 * 1024;
constexpr size_t WS_TEXP = 512 * 1024;
constexpr size_t WS_ROPE = 1 * MiB;
constexpr size_t WS_WIN = 16 * MiB, WS_WO = 21 * MiB, WS_WMQ = 23 * MiB, WS_WMKV = 25 * MiB, WS_WMO = 29 * MiB;
constexpr size_t WS_XB = 40 * MiB;
constexpr size_t WS_MEMB = 104 * MiB;
constexpr size_t WS_U = 106 * MiB;
constexpr size_t WS_LR = 266 * MiB;
constexpr size_t WS_DW = 298 * MiB, WS_DA = 362 * MiB, WS_G = 426 * MiB;
constexpr size_t WS_MIX = 490 * MiB;
constexpr size_t WS_X1 = 554 * MiB;
constexpr size_t WS_X1B = 682 * MiB;
constexpr size_t WS_QM = 106 * MiB;
constexpr size_t WS_KVM = 234 * MiB;
constexpr size_t WS_SC = 242 * MiB;
constexpr size_t WS_OM = 370 * MiB;
constexpr size_t WS_X2 = 746 * MiB;
constexpr size_t WS_LOG = 562 * MiB;
constexpr size_t WS_EIDX = 594 * MiB, WS_GATE = 595 * MiB, WS_POS = 596 * MiB;
constexpr size_t WS_STOK = 597 * MiB, WS_SGATE = 598 * MiB + 512 * 1024;
constexpr size_t WS_HG = 106 * MiB;
constexpr size_t WS_HS = 394 * MiB;
constexpr size_t WS_END = 874 * MiB;
constexpr int CW_CNT = 0, CW_OFF = 512, CW_NT = 1024, CW_BAR = 4096;

constexpr int NTHREADS = 512, NWAVES = 8;
constexpr int LDS_BYTES = 147456;
constexpr int MISC_OFF = 140 * 1024;

#define LAS __attribute__((address_space(3)))
typedef float f32x4 __attribute__((ext_vector_type(4)));
typedef float f32x16 __attribute__((ext_vector_type(16)));

#define XB_TMO      128
#define XB_XCNT(j)  (256  + 64 * (j))
#define XB_XSUB(j)  (1280 + 64 * (j))
#define XB_XGEN(j)  (2304 + 64 * (j))
#define XB_TOP      3328
#define XB_TOPGEN   3392
#define XCD_BAR_WORDS 3456
#define XB_SPIN_CAP (1u << 18)
__device__ __forceinline__ unsigned xb_ld(unsigned* p)              { return __hip_atomic_load(p, __ATOMIC_RELAXED, __HIP_MEMORY_SCOPE_AGENT); }
__device__ __forceinline__ unsigned xb_add(unsigned* p, unsigned v) { return __hip_atomic_fetch_add(p, v, __ATOMIC_RELAXED, __HIP_MEMORY_SCOPE_AGENT); }
__device__ __forceinline__ unsigned xb_xcc_id() { return (unsigned)__builtin_amdgcn_s_getreg((3 << 11) | 20) & 0xFu; }
#define XB_SPIN(cond, bar) do { unsigned _sp = 0; while (cond) { __builtin_amdgcn_s_sleep(1); \
    if ((++_sp & 255u) == 0u) { if (xb_ld(&(bar)[XB_TMO])) break; if (_sp > XB_SPIN_CAP) { atomicAdd(&(bar)[XB_TMO], 1u); break; } } } } while (0)
struct XcdBarrier { unsigned* bar; unsigned x; volatile LAS unsigned* st; };
__device__ __forceinline__ XcdBarrier xcd_barrier_post(unsigned* bar, volatile LAS unsigned* st) {
    XcdBarrier b; b.bar = bar; b.x = xb_xcc_id(); b.st = st;
    if (threadIdx.x == 0) (void)xb_add(&bar[XB_XCNT(b.x)], 1u);
    return b;
}
__device__ __forceinline__ void xcd_barrier_complete(unsigned* bar, unsigned x, unsigned& nloc, unsigned& nx) {
    const unsigned G = gridDim.x * gridDim.y * gridDim.z;
    unsigned sum, cnt, mine, sp = 0u;
    for (;;) {
        sum = 0u; cnt = 0u; mine = 0u;
#pragma unroll
        for (unsigned j = 0; j < 16; ++j) { const unsigned c = xb_ld(&bar[XB_XCNT(j)]); sum += c; cnt += (c > 0u) ? 1u : 0u; mine = (j == x) ? c : mine; }
        if (sum == G) break;
        __builtin_amdgcn_s_sleep(1);
        if ((++sp & 255u) == 0u) { if (xb_ld(&bar[XB_TMO])) break; if (sp > XB_SPIN_CAP) { atomicAdd(&bar[XB_TMO], 1u); break; } }
    }
    nloc = mine > 0u ? mine : 1u; nx = cnt > 0u ? cnt : 1u;
}
__device__ __forceinline__ void xcd_barrier(const XcdBarrier& b) {
    asm volatile("s_waitcnt vmcnt(0)" ::: "memory");
    __syncthreads();
    if (threadIdx.x == 0) {
        unsigned* bar = b.bar;
        __builtin_amdgcn_s_waitcnt(0);
        unsigned nloc = b.st[0], nx = b.st[1];
        if (nloc == 0u) { xcd_barrier_complete(bar, b.x, nloc, nx); b.st[0] = nloc; b.st[1] = nx; }
        const unsigned old = xb_add(&bar[XB_XSUB(b.x)], 1u);
        const unsigned gen = old / nloc;
        if (old + 1u == (gen + 1u) * nloc) {
            __builtin_amdgcn_fence(__ATOMIC_RELEASE, "agent");
            asm volatile("s_waitcnt vmcnt(0)" ::: "memory");
            const unsigned og = xb_add(&bar[XB_TOP], 1u);
            const unsigned tg = og / nx;
            if (og + 1u == (tg + 1u) * nx) xb_add(&bar[XB_TOPGEN], 1u);
            else XB_SPIN(xb_ld(&bar[XB_TOPGEN]) == tg, bar);
            __builtin_amdgcn_fence(__ATOMIC_ACQUIRE, "agent");
            xb_add(&bar[XB_XGEN(b.x)], 1u);
            asm volatile("s_waitcnt vmcnt(0)" ::: "memory");
        } else {
            XB_SPIN(xb_ld(&bar[XB_XGEN(b.x)]) == gen, bar);
            __builtin_amdgcn_fence(__ATOMIC_ACQUIRE, "agent");
            asm volatile("s_waitcnt vmcnt(0)" ::: "memory");
        }
    }
    __syncthreads();
}

namespace pg8 {
#define PG8_LAS __attribute__((address_space(3)))
typedef unsigned short bf16_t;
typedef short bf16x8 __attribute__((ext_vector_type(8)));
typedef float f32x4 __attribute__((ext_vector_type(4)));
typedef float f32x2 __attribute__((ext_vector_type(2)));
typedef unsigned u32x4 __attribute__((ext_vector_type(4)));
constexpr int BM = 256, BK = 64, HALF = 128, HTB = HALF * BK * 2, STAGE_BYTES = 8 * HTB, NXCD = 8, WGM = 8;
__host__ __device__ __forceinline__ int lds_byte(int r, int c) { const int st = (r >> 4) * 2 + (c >> 5), rr = r & 15, cc = c & 31, ob = rr * 64 + cc * 2; return st * 1024 + (ob ^ (((ob >> 9) & 1) << 5)); }
__host__ __device__ __forceinline__ void stage_rc(int b, int& R, int& C) { const int st = b / 1024, sb = b % 1024, swz = sb ^ (((sb >> 9) & 1) << 5); R = (st >> 1) * 16 + swz / 64; C = (st & 1) * 32 + (swz % 64) / 2; }
__host__ __device__ __forceinline__ int perm32(int rho) { const int n = rho >> 4, i = rho & 15; return 8 * (i >> 2) + 4 * n + (i & 3); }
__device__ __forceinline__ unsigned cvt_pk_bf16(float lo, float hi) { unsigned r; asm volatile("v_cvt_pk_bf16_f32 %0, %1, %2" : "=v"(r) : "v"(lo), "v"(hi)); return r; }

struct Unit { int pm, pn, e; };
struct StaticOrder {
    int nM, nN, nwg, G, c;
    __host__ __device__ void init(int M, int N, int G_, int c_) { nM = M / BM; nN = N / BM; nwg = nM * nN; G = G_; c = c_; }
    __host__ __device__ bool next(int i, Unit& u) const {
        const long L = (long)i * G + c; if (L >= nwg) return false;
        int wgid = (int)L; { const int q = nwg / NXCD, r = nwg % NXCD, xcd = wgid % NXCD, off = wgid / NXCD; wgid = (xcd < r ? xcd * (q + 1) : r * (q + 1) + (xcd - r) * q) + off; }
        const int nig = WGM * nN, gid = wgid / nig, fm = gid * WGM, gsz = (nM - fm) < WGM ? (nM - fm) : WGM;
        u.pm = fm + ((wgid % nig) % gsz); u.pn = (wgid % nig) / gsz; u.e = 0; return true;
    }
};
struct DenseProb {
    const bf16_t* A; const bf16_t* Bt; int K; StaticOrder ord;
    __device__ __forceinline__ bool next(int i, Unit& u) const { return ord.next(i, u); }
    __device__ __forceinline__ const char* a_base(const Unit& u) const { return (const char*)A + (size_t)u.pm * BM * K * 2; }
    __device__ __forceinline__ const char* b_base(const Unit& u) const { return (const char*)Bt + (size_t)u.pn * BM * K * 2; }
    __device__ __forceinline__ void a_offs(const Unit&, unsigned (&v)[2][2], const int (&R)[2], const int (&C)[2]) const {
#pragma unroll
        for (int h = 0; h < 2; ++h)
#pragma unroll
            for (int i = 0; i < 2; ++i) v[h][i] = (unsigned)((h * HALF + R[i]) * K + C[i]) * 2u;
    }
};
struct GatherProb {
    const bf16_t* X; const int* stok; const bf16_t* Bt; const int* texp; int K, nN, nunits, G, c; size_t estride;
    __device__ __forceinline__ bool next(int i, Unit& u) const {
        const long L = (long)i * G + c; if (L >= nunits) return false;
        u.pm = (int)(L / nN); u.pn = (int)(L % nN); u.e = texp[u.pm]; return true;
    }
    __device__ __forceinline__ const char* a_base(const Unit&) const { return (const char*)X; }
    __device__ __forceinline__ const char* b_base(const Unit& u) const { return (const char*)Bt + (size_t)u.e * estride + (size_t)u.pn * BM * K * 2; }
    __device__ __forceinline__ void a_offs(const Unit& u, unsigned (&v)[2][2], const int (&R)[2], const int (&C)[2]) const {
#pragma unroll
        for (int h = 0; h < 2; ++h)
#pragma unroll
            for (int i = 0; i < 2; ++i) { const int tok = stok[u.pm * BM + h * HALF + R[i]]; v[h][i] = (unsigned)(tok * K + C[i]) * 2u; }
    }
};
struct GroupedProb {
    const bf16_t* A; const bf16_t* Bt; const int* texp; int K, nN, nunits, G, c; size_t estride;
    __device__ __forceinline__ bool next(int i, Unit& u) const {
        const long L = (long)i * G + c; if (L >= nunits) return false;
        u.pm = (int)(L / nN); u.pn = (int)(L % nN); u.e = texp[u.pm]; return true;
    }
    __device__ __forceinline__ const char* a_base(const Unit& u) const { return (const char*)A + (size_t)u.pm * BM * K * 2; }
    __device__ __forceinline__ const char* b_base(const Unit& u) const { return (const char*)Bt + (size_t)u.e * estride + (size_t)u.pn * BM * K * 2; }
    __device__ __forceinline__ void a_offs(const Unit&, unsigned (&v)[2][2], const int (&R)[2], const int (&C)[2]) const {
#pragma unroll
        for (int h = 0; h < 2; ++h)
#pragma unroll
            for (int i = 0; i < 2; ++i) v[h][i] = (unsigned)((h * HALF + R[i]) * K + C[i]) * 2u;
    }
};

struct EpiBf16 {
    static constexpr bool PERM = true;
    bf16_t* O; int ldc;
    __device__ __forceinline__ void operator()(const f32x4 (&acc)[2][2][4][2], const Unit& u, int wr, int wc, int fr, int fq) const {
        const int row0 = u.pm * BM + wr * 64 + fr, col0 = u.pn * BM + wc * 32 + 8 * fq;
#pragma unroll
        for (int ai = 0; ai < 2; ++ai)
#pragma unroll
            for (int m = 0; m < 4; ++m) { bf16_t* rowp = O + (size_t)(row0 + ai * HALF + m * 16) * ldc + col0;
#pragma unroll
                for (int bj = 0; bj < 2; ++bj) { const f32x4 v0 = acc[ai][bj][m][0], v1 = acc[ai][bj][m][1];
                    u32x4 w; w.x = cvt_pk_bf16(v0[0], v0[1]); w.y = cvt_pk_bf16(v0[2], v0[3]); w.z = cvt_pk_bf16(v1[0], v1[1]); w.w = cvt_pk_bf16(v1[2], v1[3]);
                    *(u32x4*)(rowp + bj * HALF) = w; } }
    }
};
struct EpiF32Res {
    static constexpr bool PERM = false;
    float* C; int ldc; const float* base; float alpha;
    __device__ __forceinline__ void operator()(const f32x4 (&acc)[2][2][4][2], const Unit& u, int wr, int wc, int fr, int fq) const {
        const int row0 = u.pm * BM + wr * 64 + fr, col0 = u.pn * BM + wc * 32 + 4 * fq;
#pragma unroll
        for (int ai = 0; ai < 2; ++ai)
#pragma unroll
            for (int m = 0; m < 4; ++m) { const size_t off = (size_t)(row0 + ai * HALF + m * 16) * ldc + col0;
#pragma unroll
                for (int bj = 0; bj < 2; ++bj)
#pragma unroll
                    for (int n = 0; n < 2; ++n) { f32x4 o = acc[ai][bj][m][n];
                        if (base) o += *(const f32x4*)(base + off + bj * HALF + n * 16) * alpha;
                        *(f32x4*)(C + off + bj * HALF + n * 16) = o; } }
    }
};

template <class Epi, class Prob>
__device__ __forceinline__ void gemm_phase(PG8_LAS unsigned char* lds, const Prob& S, const Epi& E) {
    const int tid = threadIdx.x, wid = __builtin_amdgcn_readfirstlane(tid >> 6), lane = tid & 63, wr = wid >> 2, wc = wid & 3, fr = lane & 15, fq = lane >> 4;
    const int K = S.K, nt = K / BK;
    int Rr[2], Cc[2]; unsigned voffB[2];
#pragma unroll
    for (int i = 0; i < 2; ++i) { int R, C; stage_rc(tid * 16 + i * 8192, R, C); const int Rb = Epi::PERM ? ((R & ~31) + perm32(R & 31)) : R;
        Rr[i] = R; Cc[i] = C; voffB[i] = (unsigned)(Rb * K + C) * 2u; }
    const size_t kstep = (size_t)(BK * 2);
    const size_t hstep = (size_t)HALF * K * 2;
    const unsigned ldsw = (unsigned)wid * 1024u;
    const int aoff = lds_byte(wr * 64 + fr, fq * 8), boff = lds_byte(wc * 32 + fr, fq * 8);
#define PG8_SA(b, h) (((b) * 2 + (h)) * HTB)
#define PG8_SB(b, h) ((4 + (b) * 2 + (h)) * HTB)
#define PG8_STAGE(bufoff, gbase, voff) do { _Pragma("unroll") for (int _i = 0; _i < 2; ++_i) \
        __builtin_amdgcn_global_load_lds((const unsigned*)((const char*)(gbase) + (voff)[_i]), (PG8_LAS unsigned*)(lds + (bufoff) + ldsw + _i * 8192), 16, 0, 0); } while (0)
#define PG8_LDA(dst, b, h) do { _Pragma("unroll") for (int m = 0; m < 4; ++m) _Pragma("unroll") for (int k = 0; k < 2; ++k) dst[m][k] = *(const PG8_LAS bf16x8*)(lds + PG8_SA(b, h) + aoff + m * 2048 + k * 1024); } while (0)
#define PG8_LDB(dst, b, h) do { _Pragma("unroll") for (int n = 0; n < 2; ++n) _Pragma("unroll") for (int k = 0; k < 2; ++k) dst[n][k] = *(const PG8_LAS bf16x8*)(lds + PG8_SB(b, h) + boff + n * 2048 + k * 1024); } while (0)
#define PG8_MMA(ai, bj, At, Bt) do { __builtin_amdgcn_s_setprio(1); _Pragma("unroll") for (int m = 0; m < 4; ++m) _Pragma("unroll") for (int n = 0; n < 2; ++n) _Pragma("unroll") for (int k = 0; k < 2; ++k) \
        acc[ai][bj][m][n] = __builtin_amdgcn_mfma_f32_16x16x32_bf16(Bt[n][k], At[m][k], acc[ai][bj][m][n], 0, 0, 0); __builtin_amdgcn_s_setprio(0); } while (0)
#define PG8_WAIT_V(n) asm volatile("s_waitcnt vmcnt(" #n ")" ::: "memory")
#define PG8_WAIT_L(n) asm volatile("s_waitcnt lgkmcnt(" #n ")" ::: "memory")
#define PG8_BAR __builtin_amdgcn_s_barrier()
#define PG8_SCHED __builtin_amdgcn_sched_barrier(0)
    Unit cur, nxt; int ui = 0;
    if (!S.next(0, cur)) return;
    f32x4 acc[2][2][4][2];
#pragma unroll
    for (int a = 0; a < 2; ++a)
#pragma unroll
        for (int b = 0; b < 2; ++b)
#pragma unroll
            for (int m = 0; m < 4; ++m)
#pragma unroll
                for (int n = 0; n < 2; ++n) acc[a][b][m][n] = (f32x4){0.f, 0.f, 0.f, 0.f};
    bf16x8 At[4][2], B0[2][2], B1[2][2];
    const char* cA = S.a_base(cur); const char* cB = S.b_base(cur);
    unsigned vA[2][2], nvA[2][2];
    S.a_offs(cur, vA, Rr, Cc);
    PG8_STAGE(PG8_SB(0, 0), cB, voffB); PG8_STAGE(PG8_SA(0, 0), cA, vA[0]); PG8_STAGE(PG8_SB(0, 1), cB + hstep, voffB); PG8_STAGE(PG8_SA(0, 1), cA, vA[1]);
    if (wr == 1) PG8_BAR;
    PG8_WAIT_V(4); PG8_BAR;
    PG8_STAGE(PG8_SB(1, 0), cB + kstep, voffB); PG8_STAGE(PG8_SA(1, 0), cA + kstep, vA[0]); PG8_STAGE(PG8_SB(1, 1), cB + hstep + kstep, voffB);
    PG8_WAIT_V(6); PG8_BAR;
    for (;;) {
        const bool has_next = S.next(ui + 1, nxt);
        const char* nA = has_next ? S.a_base(nxt) : cA; const char* nB = has_next ? S.b_base(nxt) : cB;
        if (has_next) S.a_offs(nxt, nvA, Rr, Cc);
        else {
#pragma unroll
            for (int h = 0; h < 2; ++h)
#pragma unroll
                for (int i = 0; i < 2; ++i) nvA[h][i] = vA[h][i];
        }
        for (int t = 0; t < nt; t += 2) {
            const bool last = (t == nt - 2);
            const char* a1 = cA + (size_t)(t + 1) * kstep;
            const char* a2 = last ? nA : cA + (size_t)(t + 2) * kstep; const char* b2 = last ? nB : cB + (size_t)(t + 2) * kstep;
            const char* a3 = a2 + kstep; const char* b3 = b2 + kstep;
            unsigned v2[2][2];
#pragma unroll
            for (int h = 0; h < 2; ++h)
#pragma unroll
                for (int i = 0; i < 2; ++i) v2[h][i] = last ? nvA[h][i] : vA[h][i];
            PG8_LDB(B0, 0, 0); PG8_SCHED; PG8_LDA(At, 0, 0); PG8_STAGE(PG8_SA(1, 1), a1, vA[1]);
            PG8_WAIT_L(8); PG8_BAR; PG8_WAIT_L(0); PG8_MMA(0, 0, At, B0); PG8_BAR; PG8_SCHED;
            PG8_LDB(B1, 0, 1); PG8_STAGE(PG8_SB(0, 0), b2, voffB);
            PG8_BAR; PG8_WAIT_L(0); PG8_MMA(0, 1, At, B1); PG8_BAR;
            PG8_LDA(At, 0, 1); PG8_STAGE(PG8_SA(0, 0), a2, v2[0]);
            PG8_BAR; PG8_WAIT_L(0); PG8_MMA(1, 0, At, B0); PG8_BAR; PG8_SCHED;
            PG8_STAGE(PG8_SB(0, 1), b2 + hstep, voffB);
            PG8_WAIT_V(6); PG8_BAR; PG8_MMA(1, 1, At, B1); PG8_BAR;
            PG8_LDB(B0, 1, 0); PG8_SCHED; PG8_LDA(At, 1, 0); PG8_STAGE(PG8_SA(0, 1), a2, v2[1]);
            PG8_WAIT_L(8); PG8_BAR; PG8_WAIT_L(0); PG8_MMA(0, 0, At, B0); PG8_BAR; PG8_SCHED;
            PG8_LDB(B1, 1, 1); PG8_STAGE(PG8_SB(1, 0), b3, voffB);
            PG8_BAR; PG8_WAIT_L(0); PG8_MMA(0, 1, At, B1); PG8_BAR;
            PG8_LDA(At, 1, 1); PG8_STAGE(PG8_SA(1, 0), a3, v2[0]);
            PG8_BAR; PG8_WAIT_L(0); PG8_MMA(1, 0, At, B0); PG8_BAR; PG8_SCHED;
            PG8_STAGE(PG8_SB(1, 1), b3 + hstep, voffB);
            PG8_WAIT_V(6); PG8_BAR; PG8_MMA(1, 1, At, B1); PG8_BAR;
        }
        E(acc, cur, wr, wc, fr, fq);
        if (!has_next) break;
#pragma unroll
        for (int a = 0; a < 2; ++a)
#pragma unroll
            for (int b = 0; b < 2; ++b)
#pragma unroll
                for (int m = 0; m < 4; ++m)
#pragma unroll
                    for (int n = 0; n < 2; ++n) acc[a][b][m][n] = (f32x4){0.f, 0.f, 0.f, 0.f};
        cur = nxt; cA = nA; cB = nB; ++ui;
#pragma unroll
        for (int h = 0; h < 2; ++h)
#pragma unroll
            for (int i = 0; i < 2; ++i) vA[h][i] = nvA[h][i];
    }
    PG8_WAIT_V(0);
    if (wr == 0) PG8_BAR;
    PG8_BAR;
#undef PG8_SA
#undef PG8_SB
#undef PG8_STAGE
#undef PG8_LDA
#undef PG8_LDB
#undef PG8_MMA
#undef PG8_WAIT_V
#undef PG8_WAIT_L
#undef PG8_BAR
#undef PG8_SCHED
}
}

__device__ __forceinline__ float wave_sum(float v) {
#pragma unroll
    for (int o = 1; o < 64; o <<= 1) v += __shfl_xor(v, o);
    return v;
}
__device__ __forceinline__ float sigmoidf_(float x) { return 1.0f / (1.0f + expf(-x)); }

typedef unsigned short bf16_t;
typedef unsigned u32x4 __attribute__((ext_vector_type(4)));
typedef unsigned u32x2 __attribute__((ext_vector_type(2)));
__device__ __forceinline__ float bf2f(bf16_t b) { return __builtin_bit_cast(float, (unsigned)b << 16); }
__device__ __forceinline__ bf16_t f2bf(float f) { return (bf16_t)(pg8::cvt_pk_bf16(f, 0.f) & 0xffffu); }
__device__ __forceinline__ void transpose_item(const float* W, int K, int N, bf16_t* WT, int k0, int n0, int drow0, float* scr, int lane) {
#pragma unroll 8
    for (int i = 0; i < 32; ++i) { const int kk = 2 * i + (lane >> 5); scr[kk * 33 + (lane & 31)] = W[(size_t)(k0 + kk) * N + n0 + (lane & 31)]; }
    __builtin_amdgcn_wave_barrier();
    const int c = lane & 7;
#pragma unroll
    for (int j = 0; j < 4; ++j) { const int n = (lane >> 3) + 8 * j; const float* s = scr + (8 * c) * 33 + n;
        u32x4 o; o.x = pg8::cvt_pk_bf16(s[0 * 33], s[1 * 33]); o.y = pg8::cvt_pk_bf16(s[2 * 33], s[3 * 33]); o.z = pg8::cvt_pk_bf16(s[4 * 33], s[5 * 33]); o.w = pg8::cvt_pk_bf16(s[6 * 33], s[7 * 33]);
        *(u32x4*)(WT + (size_t)(drow0 + n) * K + k0 + 8 * c) = o; }
    __builtin_amdgcn_wave_barrier();
}
struct Args {
    const float* in[34]; float* out; unsigned char* ws;
    int ph_lo, ph_hi;
};

struct GF {
    const float* A; long lda; const int* arow; int arow_lim;
    const float* B; long ldb; int bmode;
    int K;
};
template <class Epi>
__device__ __forceinline__ void gemm_f32_tile(float* lds, const GF& g, int row0, int col0, Epi&& epi) {
    float* As = lds;
    float* Bs = lds + 16 * 132;
    const int tid = threadIdx.x, lane = tid & 63, w = tid >> 6, wm = w >> 1, wn = w & 1;
    f32x16 acc0, acc1;
#pragma unroll
    for (int i = 0; i < 16; ++i) { acc0[i] = 0.f; acc1[i] = 0.f; }
    const int ar = tid >> 2, ak = (tid & 3) * 4;
    long arow_idx = row0 + ar; bool avalid = true;
    if (g.arow) { const int t = g.arow[row0 + ar]; avalid = t < g.arow_lim; arow_idx = avalid ? t : 0; }
    const float* ap = g.A + arow_idx * g.lda + ak;
    const float* bp; int bk, bn;
    if (g.bmode == 0) { bk = tid >> 5; bn = (tid & 31) * 4; bp = g.B + (long)bk * g.ldb + col0 + bn; }
    else { bn = tid >> 2; bk = (tid & 3) * 4; bp = g.B + (long)(col0 + bn) * g.ldb + bk; }
    const int hl = lane >> 5, l31 = lane & 31;
    for (int k0 = 0; k0 < g.K; k0 += 16) {
        f32x4 av = (f32x4){0.f, 0.f, 0.f, 0.f};
        if (avalid) av = *(const f32x4*)(ap + k0);
        const f32x4 bv = g.bmode == 0 ? *(const f32x4*)(bp + (long)k0 * g.ldb) : *(const f32x4*)(bp + k0);
        __syncthreads();
        As[(ak + 0) * 132 + ar] = av[0]; As[(ak + 1) * 132 + ar] = av[1]; As[(ak + 2) * 132 + ar] = av[2]; As[(ak + 3) * 132 + ar] = av[3];
        if (g.bmode == 0) *(f32x4*)&Bs[bk * 132 + bn] = bv;
        else { Bs[(bk + 0) * 132 + bn] = bv[0]; Bs[(bk + 1) * 132 + bn] = bv[1]; Bs[(bk + 2) * 132 + bn] = bv[2]; Bs[(bk + 3) * 132 + bn] = bv[3]; }
        __syncthreads();
#pragma unroll
        for (int kk = 0; kk < 16; kk += 2) {
            const float a = As[(kk + hl) * 132 + wm * 32 + l31];
            const float b0 = Bs[(kk + hl) * 132 + wn * 64 + l31];
            const float b1 = Bs[(kk + hl) * 132 + wn * 64 + 32 + l31];
            acc0 = __builtin_amdgcn_mfma_f32_32x32x2f32(a, b0, acc0, 0, 0, 0);
            acc1 = __builtin_amdgcn_mfma_f32_32x32x2f32(a, b1, acc1, 0, 0, 0);
        }
    }
#pragma unroll
    for (int r = 0; r < 16; ++r) {
        const int row = row0 + wm * 32 + (r & 3) + 8 * (r >> 2) + 4 * hl;
        const int col = col0 + wn * 64 + l31;
        epi(row, col, acc0[r]);
        epi(row, col + 32, acc1[r]);
    }
    __syncthreads();
}

__device__ __forceinline__ void ln_row(const float* a, float alpha, const float* b, float* out, const float* gam, const float* bet, int lane, bf16_t* outb = nullptr) {
    f32x4 v[4]; float s = 0.f;
#pragma unroll
    for (int j = 0; j < 4; ++j) {
        v[j] = *(const f32x4*)(a + 4 * lane + 256 * j) * alpha;
        if (b) v[j] += *(const f32x4*)(b + 4 * lane + 256 * j);
        s += (v[j][0] + v[j][1]) + (v[j][2] + v[j][3]);
    }
    const float mean = wave_sum(s) * (1.f / D); float s2 = 0.f;
#pragma unroll
    for (int j = 0; j < 4; ++j) { v[j] = v[j] - mean; s2 += (v[j][0] * v[j][0] + v[j][1] * v[j][1]) + (v[j][2] * v[j][2] + v[j][3] * v[j][3]); }
    const float rstd = 1.f / sqrtf(wave_sum(s2) * (1.f / D) + LN_EPS);
#pragma unroll
    for (int j = 0; j < 4; ++j) {
        const f32x4 gg = *(const f32x4*)(gam + 4 * lane + 256 * j), bb = *(const f32x4*)(bet + 4 * lane + 256 * j);
        const f32x4 o = v[j] * rstd * gg + bb;
        *(f32x4*)(out + 4 * lane + 256 * j) = o;
        if (outb) { u32x2 w; w.x = pg8::cvt_pk_bf16(o[0], o[1]); w.y = pg8::cvt_pk_bf16(o[2], o[3]); *(u32x2*)(outb + 4 * lane + 256 * j) = w; }
    }
}

constexpr int NPHASES = 22;

__global__ void __launch_bounds__(NTHREADS, 2) mega(Args args) {
    extern __shared__ __attribute__((aligned(16))) unsigned char lds_raw[];
    float* ldsf = (float*)lds_raw;
    const int tid = threadIdx.x, lane = tid & 63, wave = tid >> 6;
    const int G = gridDim.x, bx = blockIdx.x;
    const int gw = bx * NWAVES + wave, NGW = G * NWAVES;
    unsigned char* ws = args.ws;
    unsigned* ctl = (unsigned*)(ws + WS_CTL);
    volatile LAS unsigned* misc = (volatile LAS unsigned*)((LAS unsigned char*)lds_raw + MISC_OFF);
    if (tid < 4) misc[tid] = 0u;
    __syncthreads();
    const int lo = args.ph_lo, hi = args.ph_hi;
    const bool multi = (hi - lo) > 1;
    XcdBarrier bar; bar.bar = ctl + CW_BAR; bar.x = 0; bar.st = nullptr;
    if (multi) bar = xcd_barrier_post(ctl + CW_BAR, misc);
#define IN(k) (lo <= (k) && (k) < hi)
#define SEAM(k) do { if (IN(k) && IN((k) + 1)) xcd_barrier(bar); } while (0)

    const float* x = args.in[0]; const float* mem = args.in[1]; const int* positions = (const int*)args.in[2];
    const float* w_in = args.in[3]; const float* mu_shift = args.in[4]; const float* w_decay_up = args.in[5]; const float* w0 = args.in[6];
    const float* a_up = args.in[7]; const float* a0 = args.in[8]; const float* g_up = args.in[9]; const float* k_k = args.in[10]; const float* k_a = args.in[11];
    const float* r_k = args.in[12]; const float* lnx_g = args.in[13]; const float* lnx_b = args.in[14]; const float* sinks = args.in[15];
    const float* w_o = args.in[16]; const float* ln1_g = args.in[17]; const float* ln1_b = args.in[18];
    const float* wm_q = args.in[19]; const float* wm_kv = args.in[20]; const float* wm_o = args.in[21]; const float* ln2_g = args.in[22]; const float* ln2_b = args.in[23];
    const float* w_router = args.in[24]; const float* router_bias = args.in[25];
    const float* we_gate = args.in[26]; const float* we_up = args.in[27]; const float* we_down = args.in[28];
    const float* ws_gate = args.in[29]; const float* ws_up = args.in[30]; const float* ws_down = args.in[31];
    const float* ln3_g = args.in[32]; const float* ln3_b = args.in[33];
    float* out = args.out;

    float* ROPE_C = (float*)(ws + WS_ROPE); float* ROPE_S = ROPE_C + (size_t)NTOK * 32;
    bf16_t* W_IN_T = (bf16_t*)(ws + WS_WIN); bf16_t* W_O_T = (bf16_t*)(ws + WS_WO); bf16_t* WM_Q_T = (bf16_t*)(ws + WS_WMQ); bf16_t* WM_KV_T = (bf16_t*)(ws + WS_WMKV); bf16_t* WM_O_T = (bf16_t*)(ws + WS_WMO);
    bf16_t* XB = (bf16_t*)(ws + WS_XB); bf16_t* MEMB = (bf16_t*)(ws + WS_MEMB);
    bf16_t* U = (bf16_t*)(ws + WS_U); float* LR = (float*)(ws + WS_LR);
    float* DW = (float*)(ws + WS_DW); float* DA = (float*)(ws + WS_DA); float* GG = (float*)(ws + WS_G);
    bf16_t* MIX = (bf16_t*)(ws + WS_MIX); float* X1 = (float*)(ws + WS_X1); bf16_t* X1B = (bf16_t*)(ws + WS_X1B);
    float* QM = (float*)(ws + WS_QM); float* KVM = (float*)(ws + WS_KVM); float* SC = (float*)(ws + WS_SC); bf16_t* OM = (bf16_t*)(ws + WS_OM);
    float* X2 = (float*)(ws + WS_X2); float* LOG = (float*)(ws + WS_LOG);
    int* EIDX = (int*)(ws + WS_EIDX); float* GATE = (float*)(ws + WS_GATE); int* POS = (int*)(ws + WS_POS);
    int* STOK = (int*)(ws + WS_STOK); float* SGATE = (float*)(ws + WS_SGATE);
    float* HG = (float*)(ws + WS_HG); float* HS = (float*)(ws + WS_HS);
    int* TEXP = (int*)(ws + WS_TEXP);
    PG8_LAS unsigned char* ldsl = (PG8_LAS unsigned char*)lds_raw;

    if (IN(0)) {
        for (int i = bx * NTHREADS + tid; i < NTOK * 32; i += G * NTHREADS) {
            const int n = i >> 5, f = i & 31;
            const double inv = exp(-(double)(2 * f) / 64.0 * 9.210340371976184);
            const double ang = (double)positions[n] * inv;
            ROPE_C[i] = (float)cos(ang); ROPE_S[i] = (float)sin(ang);
        }
        {
            float* scr = ldsf + wave * 4096;
            constexpr int I_IN = 16 * (INCOLS / 32), I_SQ = 16 * (D / 32), I_KV = 16 * (2048 / 32);
            constexpr int NIT = I_IN + 3 * I_SQ + I_KV;
            for (int it = gw; it < NIT; it += NGW) {
                int r = it;
                if (r < I_IN) { const int nb = INCOLS / 32; transpose_item(w_in, D, INCOLS, W_IN_T, 64 * (r / nb), 32 * (r % nb), 32 * (r % nb), scr, lane); continue; } r -= I_IN;
                if (r < I_SQ) { const int nb = D / 32; transpose_item(w_o, D, D, W_O_T, 64 * (r / nb), 32 * (r % nb), 32 * (r % nb), scr, lane); continue; } r -= I_SQ;
                if (r < I_SQ) { const int nb = D / 32; transpose_item(wm_q, D, D, WM_Q_T, 64 * (r / nb), 32 * (r % nb), 32 * (r % nb), scr, lane); continue; } r -= I_SQ;
                if (r < I_SQ) { const int nb = D / 32; transpose_item(wm_o, D, D, WM_O_T, 64 * (r / nb), 32 * (r % nb), 32 * (r % nb), scr, lane); continue; } r -= I_SQ;
                { const int nb = 2048 / 32; transpose_item(wm_kv, D, 2048, WM_KV_T, 64 * (r / nb), 32 * (r % nb), 32 * (r % nb), scr, lane); }
            }
        }
        for (size_t i = (size_t)bx * NTHREADS + tid; i < (size_t)NTOK * D / 8; i += (size_t)G * NTHREADS) {
            const f32x4 a = *(const f32x4*)(x + i * 8), b = *(const f32x4*)(x + i * 8 + 4);
            u32x4 o; o.x = pg8::cvt_pk_bf16(a[0], a[1]); o.y = pg8::cvt_pk_bf16(a[2], a[3]); o.z = pg8::cvt_pk_bf16(b[0], b[1]); o.w = pg8::cvt_pk_bf16(b[2], b[3]);
            *(u32x4*)(XB + i * 8) = o;
        }
        for (size_t i = (size_t)bx * NTHREADS + tid; i < (size_t)BATCH * MEMT * D / 8; i += (size_t)G * NTHREADS) {
            const f32x4 a = *(const f32x4*)(mem + i * 8), b = *(const f32x4*)(mem + i * 8 + 4);
            u32x4 o; o.x = pg8::cvt_pk_bf16(a[0], a[1]); o.y = pg8::cvt_pk_bf16(a[2], a[3]); o.z = pg8::cvt_pk_bf16(b[0], b[1]); o.w = pg8::cvt_pk_bf16(b[2], b[3]);
            *(u32x4*)(MEMB + i * 8) = o;
        }
    }
    SEAM(0);
    if (IN(1)) {
        pg8::DenseProb S{XB, W_IN_T, D, {}}; S.ord.init(NTOK, INCOLS, G, bx);
        pg8::EpiBf16 E{U, INCOLS};
        pg8::gemm_phase(ldsl, S, E);
    }
    SEAM(1);
    if (IN(2)) {
        for (size_t i = (size_t)bx * NTHREADS + tid; i < (size_t)NTOK * 256; i += (size_t)G * NTHREADS) {
            const int n = (int)(i >> 8), c = (int)(i & 255), col = C_WD + c;
            const float u = bf2f(U[(size_t)n * INCOLS + col]);
            const float p = (n % SEQ) ? bf2f(U[(size_t)(n - 1) * INCOLS + col]) : 0.f;
            const float v = u + (p - u) * mu_shift[col];
            LR[i] = c < 64 ? tanhf(v) : (c < 128 ? v : sigmoidf_(v));
        }
    }
    SEAM(2);
    if (IN(3)) {
        const int nm = NTOK / 128, nn = RW / 128;
        for (int t = bx; t < 3 * nm * nn; t += G) {
            const int which = t / (nm * nn), tt = t % (nm * nn), tm = tt / nn, tn = tt % nn;
            if (which == 0) { GF g{LR, 256, nullptr, 0, w_decay_up, RW, 0, 64};
                gemm_f32_tile(ldsf, g, tm * 128, tn * 128, [&](int r, int c, float v) { DW[(size_t)r * RW + c] = v; }); }
            else if (which == 1) { GF g{LR + 64, 256, nullptr, 0, a_up, RW, 0, 64};
                gemm_f32_tile(ldsf, g, tm * 128, tn * 128, [&](int r, int c, float v) { DA[(size_t)r * RW + c] = v; }); }
            else { GF g{LR + 128, 256, nullptr, 0, g_up, RW, 0, 128};
                gemm_f32_tile(ldsf, g, tm * 128, tn * 128, [&](int r, int c, float v) { GG[(size_t)r * RW + c] = v; }); }
        }
    }
    SEAM(3);
    if (IN(4)) {
        if (wave == 0) {
            for (int unit = bx; unit < BATCH * 8; unit += G) {
                const int b = unit >> 3, h = unit & 7, j = lane, hc = h * 64 + j;
                float S[64];
#pragma unroll
                for (int k = 0; k < 64; ++k) S[k] = 0.f;
                float pr = 0.f, pk = 0.f, pv = 0.f;
                const float mur = mu_shift[C_R + hc], muk = mu_shift[C_K + hc], muv = mu_shift[C_V + hc];
                const float w0j = w0[hc], a0j = a0[hc], kkj = k_k[hc], kaj = k_a[hc], rkj = r_k[hc], lgj = lnx_g[hc], lbj = lnx_b[hc];
                float* vec = ldsf;
                for (int t = 0; t < SEQ; ++t) {
                    const size_t n = (size_t)b * SEQ + t;
                    const float r0 = bf2f(U[n * INCOLS + C_R + hc]), k0 = bf2f(U[n * INCOLS + C_K + hc]), v0 = bf2f(U[n * INCOLS + C_V + hc]);
                    const float r = r0 + (pr - r0) * mur, k = k0 + (pk - k0) * muk, v = v0 + (pv - v0) * muv;
                    pr = r0; pk = k0; pv = v0;
                    const float dw = DW[n * RW + hc], da = DA[n * RW + hc], gg = GG[n * RW + hc];
                    const float xx = -(w0j + dw);
                    const float sp = fmaxf(xx, 0.f) + log1pf(expf(-fabsf(xx)));
                    const float logw = -sp - 0.5f;
                    const float wdec = expf(-expf(logw));
                    const float a = sigmoidf_(a0j + da);
                    const float kkv = k * kkj;
                    const float nrm = sqrtf(wave_sum(kkv * kkv));
                    const float kkn = kkv / fmaxf(nrm, 1e-12f);
                    const float kmod = k * (1.f + (a - 1.f) * kaj);
                    const float bonus = wave_sum(r * kmod * rkj);
                    vec[0 * 64 + j] = wdec; vec[1 * 64 + j] = -kkn; vec[2 * 64 + j] = kkn * a; vec[3 * 64 + j] = kmod; vec[4 * 64 + j] = r;
                    __builtin_amdgcn_s_waitcnt(0xC07F);
                    __builtin_amdgcn_wave_barrier();
                    float sa = 0.f;
#pragma unroll
                    for (int kq = 0; kq < 16; ++kq) { const f32x4 av = *(const f32x4*)&vec[64 + 4 * kq];
                        sa += S[4 * kq] * av[0] + S[4 * kq + 1] * av[1] + S[4 * kq + 2] * av[2] + S[4 * kq + 3] * av[3]; }
                    float y = 0.f;
#pragma unroll
                    for (int kq = 0; kq < 16; ++kq) {
                        const f32x4 wv = *(const f32x4*)&vec[4 * kq], bv = *(const f32x4*)&vec[128 + 4 * kq], kv = *(const f32x4*)&vec[192 + 4 * kq], rv = *(const f32x4*)&vec[256 + 4 * kq];
#pragma unroll
                        for (int q = 0; q < 4; ++q) { const float s = S[4 * kq + q] * wv[q] + sa * bv[q] + v * kv[q]; S[4 * kq + q] = s; y += s * rv[q]; }
                    }
                    __builtin_amdgcn_wave_barrier();
                    const float mu = wave_sum(y) * (1.f / 64.f);
                    const float dd = y - mu;
                    const float var = wave_sum(dd * dd) * (1.f / 64.f);
                    const float yn = dd * (1.f / sqrtf(var + GN_EPS)) * lgj + lbj;
                    MIX[n * D + hc] = f2bf((yn + bonus * v) * gg);
                }
            }
        }
    }
    SEAM(4);
    if (IN(5)) {
        float* Kt = ldsf; float* Vt = ldsf + 255 * 64;
        for (int unit = bx; unit < BATCH * 64 * 2; unit += G) {
            const int b = unit >> 7, blk = (unit & 127) >> 1, hk = unit & 1;
            const int base_s = blk * 128 - 127;
            __syncthreads();
            for (int i = tid; i < 255 * 64; i += NTHREADS) {
                const int jj = i >> 6, d = i & 63, s = base_s + jj;
                Vt[i] = s >= 0 ? bf2f(U[((size_t)b * SEQ + s) * INCOLS + C_VS + hk * 64 + d]) : 0.f;
            }
            for (int i = tid; i < 255 * 32; i += NTHREADS) {
                const int jj = i >> 5, f = i & 31, s = base_s + jj;
                float o1 = 0.f, o2 = 0.f;
                if (s >= 0) { const size_t n = (size_t)b * SEQ + s; const float k1 = bf2f(U[n * INCOLS + C_KS + hk * 64 + f]), k2 = bf2f(U[n * INCOLS + C_KS + hk * 64 + 32 + f]);
                    const float c = ROPE_C[n * 32 + f], sn = ROPE_S[n * 32 + f]; o1 = k1 * c - k2 * sn; o2 = k2 * c + k1 * sn; }
                Kt[jj * 64 + f] = o1; Kt[jj * 64 + 32 + f] = o2;
            }
            __syncthreads();
            const int i = tid & 127, g = tid >> 7, hq = hk * 4 + g;
            const size_t n = (size_t)b * SEQ + blk * 128 + i;
            float q[64], o[64];
#pragma unroll
            for (int f = 0; f < 32; ++f) { const float q1 = bf2f(U[n * INCOLS + C_Q + hq * 64 + f]), q2 = bf2f(U[n * INCOLS + C_Q + hq * 64 + 32 + f]);
                const float c = ROPE_C[n * 32 + f], sn = ROPE_S[n * 32 + f]; q[f] = (q1 * c - q2 * sn) * 0.125f; q[f + 32] = (q2 * c + q1 * sn) * 0.125f; }
#pragma unroll
            for (int d = 0; d < 64; ++d) o[d] = 0.f;
            float m = sinks[hq], l = 1.f;
            for (int jj = 0; jj < 255; ++jj) {
                const int s = base_s + jj;
                const bool valid = (jj >= i) && (jj <= i + 127) && (s >= 0);
                float sc = 0.f;
#pragma unroll
                for (int dq = 0; dq < 16; ++dq) { const f32x4 kv = *(const f32x4*)&Kt[jj * 64 + 4 * dq];
                    sc += q[4 * dq] * kv[0] + q[4 * dq + 1] * kv[1] + q[4 * dq + 2] * kv[2] + q[4 * dq + 3] * kv[3]; }
                if (valid) {
                    const float mn = fmaxf(m, sc), scale = expf(m - mn), p = expf(sc - mn);
                    l = l * scale + p; m = mn;
#pragma unroll
                    for (int dq = 0; dq < 16; ++dq) { const f32x4 vv = *(const f32x4*)&Vt[jj * 64 + 4 * dq];
#pragma unroll
                        for (int qd = 0; qd < 4; ++qd) o[4 * dq + qd] = o[4 * dq + qd] * scale + p * vv[qd]; }
                }
            }
            const float il = 1.f / l;
#pragma unroll
            for (int d = 0; d < 64; ++d) MIX[n * D + RW + hq * 64 + d] = f2bf(o[d] * il);
        }
    }
    SEAM(5);
    if (IN(6)) {
        pg8::DenseProb S{MIX, W_O_T, D, {}}; S.ord.init(NTOK, D, G, bx);
        pg8::EpiF32Res E{X1, D, x, ALPHA};
        pg8::gemm_phase(ldsl, S, E);
    }
    SEAM(6);
    if (IN(7)) { for (int n = gw; n < NTOK; n += NGW) ln_row(X1 + (size_t)n * D, 1.f, nullptr, X1 + (size_t)n * D, ln1_g, ln1_b, lane, X1B + (size_t)n * D); }
    SEAM(7);
    if (IN(8)) {
        { pg8::DenseProb S{X1B, WM_Q_T, D, {}}; S.ord.init(NTOK, D, G, bx); pg8::EpiF32Res E{QM, D, nullptr, 0.f}; pg8::gemm_phase(ldsl, S, E); }
        { pg8::DenseProb S{MEMB, WM_KV_T, D, {}}; S.ord.init(BATCH * MEMT, 2048, G, bx); pg8::EpiF32Res E{KVM, 2048, nullptr, 0.f}; pg8::gemm_phase(ldsl, S, E); }
    }
    SEAM(8);
    if (IN(9)) {
        const int per = (SEQ / 128) * 2;
        for (int t = bx; t < BATCH * 4 * per; t += G) {
            const int bh = t / per, tt = t % per, b = bh >> 2, h = bh & 3, tm = tt >> 1, tn = tt & 1;
            GF g{QM + (size_t)b * SEQ * D + h * 256, D, nullptr, 0, KVM + (size_t)b * MEMT * 2048 + h * 256, 2048, 1, 256};
            float* dst = SC + (size_t)b * SEQ * 1024 + h * 256;
            gemm_f32_tile(ldsf, g, tm * 128, tn * 128, [&](int r, int c, float v) { dst[(size_t)r * 1024 + c] = v * 0.0625f; });
        }
    }
    SEAM(9);
    if (IN(10)) {
        for (int row = gw; row < NTOK * 4; row += NGW) {
            float* p = SC + (size_t)row * 256 + 4 * lane;
            f32x4 v = *(const f32x4*)p;
            float m = fmaxf(fmaxf(v[0], v[1]), fmaxf(v[2], v[3]));
#pragma unroll
            for (int o = 1; o < 64; o <<= 1) m = fmaxf(m, __shfl_xor(m, o));
            v[0] = expf(v[0] - m); v[1] = expf(v[1] - m); v[2] = expf(v[2] - m); v[3] = expf(v[3] - m);
            const float s = wave_sum((v[0] + v[1]) + (v[2] + v[3]));
            *(f32x4*)p = v * (1.f / s);
        }
    }
    SEAM(10);
    if (IN(11)) {
        const int per = (SEQ / 128) * 2;
        for (int t = bx; t < BATCH * 4 * per; t += G) {
            const int bh = t / per, tt = t % per, b = bh >> 2, h = bh & 3, tm = tt >> 1, tn = tt & 1;
            GF g{SC + (size_t)b * SEQ * 1024 + h * 256, 1024, nullptr, 0, KVM + (size_t)b * MEMT * 2048 + 1024 + h * 256, 2048, 0, 256};
            bf16_t* dst = OM + (size_t)b * SEQ * D + h * 256;
            gemm_f32_tile(ldsf, g, tm * 128, tn * 128, [&](int r, int c, float v) { dst[(size_t)r * D + c] = f2bf(v); });
        }
    }
    SEAM(11);
    if (IN(12)) {
        pg8::DenseProb S{OM, WM_O_T, D, {}}; S.ord.init(NTOK, D, G, bx);
        pg8::EpiF32Res E{X2, D, X1, ALPHA};
        pg8::gemm_phase(ldsl, S, E);
    }
    SEAM(12);
    if (IN(13)) { for (int n = gw; n < NTOK; n += NGW) ln_row(X2 + (size_t)n * D, 1.f, nullptr, X2 + (size_t)n * D, ln2_g, ln2_b, lane); }
    SEAM(13);
    if (IN(14)) {
        GF g{X2, D, nullptr, 0, w_router, NEXP, 0, D};
        const int nm = NTOK / 128, nn = NEXP / 128;
        for (int t = bx; t < nm * nn; t += G) {
            const int tm = t / nn, tn = t % nn;
            gemm_f32_tile(ldsf, g, tm * 128, tn * 128, [&](int r, int c, float v) { LOG[(size_t)r * NEXP + c] = v; });
        }
    }
    SEAM(14);
    if (IN(15)) {
        const int hl = lane >> 5;
        for (int i = bx * NTHREADS + tid; i < PMAX; i += G * NTHREADS) { STOK[i] = NTOK; SGATE[i] = 0.f; }
        for (int n = gw; n < NTOK; n += NGW) {
            float sc[4], bi[4], gso[4];
#pragma unroll
            for (int j = 0; j < 4; ++j) { const int e = lane + 64 * j; sc[j] = sigmoidf_(LOG[(size_t)n * NEXP + e]); bi[j] = sc[j] + router_bias[e]; }
#pragma unroll
            for (int j = 0; j < 4; ++j) {
                float m1 = bi[j], m2 = -INFINITY;
#pragma unroll
                for (int o = 1; o < 32; o <<= 1) { const float o1 = __shfl_xor(m1, o), o2 = __shfl_xor(m2, o);
                    const float n1 = fmaxf(m1, o1), n2 = fmaxf(fminf(m1, o1), fmaxf(m2, o2)); m1 = n1; m2 = n2; }
                gso[j] = m1 + m2;
            }
            float g8[8];
#pragma unroll
            for (int j = 0; j < 4; ++j) { const float oth = __shfl_xor(gso[j], 32); g8[2 * j] = hl ? oth : gso[j]; g8[2 * j + 1] = hl ? gso[j] : oth; }
            bool gsel[8];
#pragma unroll
            for (int a = 0; a < 8; ++a) { int rank = 0;
#pragma unroll
                for (int c = 0; c < 8; ++c) rank += ((g8[c] > g8[a]) || (g8[c] == g8[a] && c < a)) ? 1 : 0;
                gsel[a] = rank < 4; }
            float cand[4];
#pragma unroll
            for (int j = 0; j < 4; ++j) { const bool s = hl ? gsel[2 * j + 1] : gsel[2 * j]; cand[j] = s ? bi[j] : -1e30f; }
            int eidx[8]; float sel[8]; float ssum = 0.f;
#pragma unroll
            for (int k = 0; k < 8; ++k) {
                float bv = cand[0]; int be = lane;
#pragma unroll
                for (int j = 1; j < 4; ++j) if (cand[j] > bv) { bv = cand[j]; be = lane + 64 * j; }
#pragma unroll
                for (int o = 1; o < 64; o <<= 1) { const float ov = __shfl_xor(bv, o); const int oe = __shfl_xor(be, o);
                    if (ov > bv || (ov == bv && oe < be)) { bv = ov; be = oe; } }
                eidx[k] = be;
                const int jw = be >> 6, lw = be & 63;
                const float mys = jw == 0 ? sc[0] : (jw == 1 ? sc[1] : (jw == 2 ? sc[2] : sc[3]));
                sel[k] = __shfl(mys, lw); ssum += sel[k];
#pragma unroll
                for (int j = 0; j < 4; ++j) if (lane == lw && j == jw) cand[j] = -INFINITY;
            }
#pragma unroll
            for (int k = 0; k < 8; ++k) {
                if (lane == k) {
                    const int e = eidx[k];
                    const int pos = (int)atomicAdd(&ctl[CW_CNT + e], 1u);
                    EIDX[n * 8 + k] = e; GATE[n * 8 + k] = sel[k] / ssum * 2.5f; POS[n * 8 + k] = pos;
                }
            }
        }
    }
    SEAM(15);
    if (IN(16)) {
        if (bx == 0) {
            int* soff = (int*)ldsf;
            if (tid == 0) { int acc = 0; for (int e = 0; e < NEXP; ++e) { soff[e] = acc; const int c = (int)ctl[CW_CNT + e]; acc += ((c + MOE_TR - 1) / MOE_TR) * MOE_TR; } soff[NEXP] = acc; }
            __syncthreads();
            if (tid <= NEXP) ctl[CW_OFF + tid] = (unsigned)soff[tid];
            if (tid == 0) ctl[CW_NT] = (unsigned)(soff[NEXP] / MOE_TR);
            if (tid < NEXP) { for (int t = soff[tid] / MOE_TR; t < soff[tid + 1] / MOE_TR; ++t) TEXP[t] = tid; }
        }
    }
    SEAM(16);
    if (IN(17)) {
        for (int i = bx * NTHREADS + tid; i < NK; i += G * NTHREADS) {
            const int e = EIDX[i], p = (int)ctl[CW_OFF + e] + POS[i];
            STOK[p] = i >> 3; SGATE[p] = GATE[i];
        }
    }
    SEAM(17);
    if (IN(18)) {
        const int ntm = (int)ctl[CW_NT], n1 = ntm * 2, n2 = (NTOK / 128) * 2;
        for (int t = bx; t < n1 + n2; t += G) {
            if (t < n1) { const int tm = t >> 1, tn = t & 1, e = TEXP[tm];
                GF g{X2, D, STOK, NTOK, we_gate + (size_t)e * D * EDIM, EDIM, 0, D};
                gemm_f32_tile(ldsf, g, tm * 128, tn * 128, [&](int r, int c, float v) { HG[(size_t)r * EDIM + c] = v; }); }
            else { const int tt = t - n1, tm = tt >> 1, tn = tt & 1;
                GF g{X2, D, nullptr, 0, ws_gate, EDIM, 0, D};
                gemm_f32_tile(ldsf, g, tm * 128, tn * 128, [&](int r, int c, float v) { HS[(size_t)r * EDIM + c] = v; }); }
        }
    }
    SEAM(18);
    if (IN(19)) {
        const int ntm = (int)ctl[CW_NT], n1 = ntm * 2, n2 = (NTOK / 128) * 2;
        for (int t = bx; t < n1 + n2; t += G) {
            if (t < n1) { const int tm = t >> 1, tn = t & 1, e = TEXP[tm];
                GF g{X2, D, STOK, NTOK, we_up + (size_t)e * D * EDIM, EDIM, 0, D};
                gemm_f32_tile(ldsf, g, tm * 128, tn * 128, [&](int r, int c, float v) { float* p = &HG[(size_t)r * EDIM + c]; const float gv = *p; *p = gv * sigmoidf_(gv) * v; }); }
            else { const int tt = t - n1, tm = tt >> 1, tn = tt & 1;
                GF g{X2, D, nullptr, 0, ws_up, EDIM, 0, D};
                gemm_f32_tile(ldsf, g, tm * 128, tn * 128, [&](int r, int c, float v) { float* p = &HS[(size_t)r * EDIM + c]; const float gv = *p; *p = gv * sigmoidf_(gv) * v; }); }
        }
    }
    SEAM(19);
    if (IN(20)) {
        const int ntm = (int)ctl[CW_NT], n1 = ntm * 8, n2 = (NTOK / 128) * 8;
        for (int t = bx; t < n1 + n2; t += G) {
            if (t < n1) { const int tm = t >> 3, tn = t & 7, e = TEXP[tm];
                GF g{HG, EDIM, nullptr, 0, we_down + (size_t)e * EDIM * D, D, 0, EDIM};
                gemm_f32_tile(ldsf, g, tm * 128, tn * 128, [&](int r, int c, float v) { const int tok = STOK[r]; if (tok < NTOK) atomicAdd(&out[(size_t)tok * D + c], v * SGATE[r]); }); }
            else { const int tt = t - n1, tm = tt >> 3, tn = tt & 7;
                GF g{HS, EDIM, nullptr, 0, ws_down, D, 0, EDIM};
                gemm_f32_tile(ldsf, g, tm * 128, tn * 128, [&](int r, int c, float v) { atomicAdd(&out[(size_t)r * D + c], v); }); }
        }
    }
    SEAM(20);
    if (IN(21)) { for (int n = gw; n < NTOK; n += NGW) ln_row(X2 + (size_t)n * D, ALPHA, out + (size_t)n * D, out + (size_t)n * D, ln3_g, ln3_b, lane); }
#undef IN
#undef SEAM
}

#ifndef PHASE_MASK
#define PHASE_MASK 0x3FFFFFu
#endif
#ifndef ONE_LAUNCH
#define ONE_LAUNCH 1
#endif

extern "C" void kernel_launch(void* const* d_in, const int* in_sizes, int n_in, void* d_out, int out_size, void* d_ws, size_t ws_size, hipStream_t stream) {
    static int grid = 0;
    if (grid == 0) {
        if (n_in != 34 || out_size != NTOK * D || ws_size < WS_END) { fprintf(stderr, "kernel_launch: unexpected shapes (n_in %d out %d ws %zu)\n", n_in, out_size, ws_size); grid = -1; return; }
        int dev = 0, cus = 0;
        if (hipGetDevice(&dev) != hipSuccess || hipDeviceGetAttribute(&cus, hipDeviceAttributeMultiprocessorCount, dev) != hipSuccess) { grid = -1; return; }
        if (hipFuncSetAttribute((const void*)mega, hipFuncAttributeMaxDynamicSharedMemorySize, LDS_BYTES) != hipSuccess) { fprintf(stderr, "kernel_launch: hipFuncSetAttribute failed\n"); grid = -1; return; }
        (void)hipGetLastError();
        grid = cus;
    }
    if (grid < 0) return;
    (void)hipMemsetAsync((char*)d_ws + WS_CTL, 0, CTL_ZERO_BYTES, stream);
    (void)hipMemsetAsync(d_out, 0, (size_t)NTOK * D * sizeof(float), stream);
    Args a{};
    for (int i = 0; i < 34; ++i) a.in[i] = (const float*)d_in[i];
    a.out = (float*)d_out; a.ws = (unsigned char*)d_ws;
#if ONE_LAUNCH
    a.ph_lo = 0; a.ph_hi = NPHASES;
    hipLaunchKernelGGL(mega, dim3(grid), dim3(NTHREADS), LDS_BYTES, stream, a);
#else
    for (int p = 0; p < NPHASES; ++p) { if (!((PHASE_MASK >> p) & 1)) continue; a.ph_lo = p; a.ph_hi = p + 1; hipLaunchKernelGGL(mega, dim3(grid), dim3(NTHREADS), LDS_BYTES, stream, a); }
#endif
}
```

```cpp
#include <hip/hip_runtime.h>
#include <cstdio>
#include <cstdint>

constexpr int D = 1024, BATCH = 4, SEQ = 8192, NTOK = BATCH * SEQ;
constexpr int MEMT = 256;
constexpr int RW = 512, RCOLS = 1792, INCOLS = 2560;
constexpr int C_R = 0, C_K = 512, C_V = 1024, C_WD = 1536, C_AD = 1600, C_GD = 1664, C_Q = 1792, C_KS = 2304, C_VS = 2432;
constexpr int NEXP = 256, TOPK = 8, EDIM = 256;
constexpr int NK = NTOK * TOPK;
constexpr int MOE_TR = 256;
constexpr int PMAX = NK + NEXP * MOE_TR;
constexpr float LN_EPS = 1e-5f, GN_EPS = 64e-5f;
constexpr float ALPHA = 1.189207115002721f;

constexpr size_t MiB = 1u << 20;
constexpr size_t WS_CTL = 0, CTL_ZERO_BYTES = 64 * 1024;
constexpr size_t WS_TEXP = 512 * 1024;
constexpr size_t WS_ROPE = 1 * MiB;
constexpr size_t WS_EIDX = 9 * MiB, WS_GATE = 10 * MiB, WS_POS = 11 * MiB, WS_YROW = 12 * MiB;
constexpr size_t WS_STOK = 13 * MiB, WS_SGATE = 14 * MiB + 512 * 1024;
constexpr size_t WS_WIN = 16 * MiB, WS_WO = 21 * MiB, WS_WMQ = 23 * MiB, WS_WMKV = 25 * MiB, WS_WMO = 29 * MiB, WS_WSGU = 31 * MiB, WS_WSD = 32 * MiB;
constexpr size_t WS_MEMB = 36 * MiB;
constexpr size_t WS_WED = 40 * MiB;
constexpr size_t WS_WEGU = 168 * MiB;
constexpr size_t WS_XB = 424 * MiB;
constexpr size_t WS_U = 490 * MiB;
constexpr size_t WS_LR = 650 * MiB;
constexpr size_t WS_DW = 682 * MiB, WS_DA = 746 * MiB, WS_G = 810 * MiB;
constexpr size_t WS_MIX = 874 * MiB;
constexpr size_t WS_X1 = 424 * MiB;
constexpr size_t WS_X1B = 552 * MiB;
constexpr size_t WS_QM = 616 * MiB;
constexpr size_t WS_KVM = 744 * MiB;
constexpr size_t WS_SC = 752 * MiB;
constexpr size_t WS_OM = 880 * MiB;
constexpr size_t WS_X2B = 424 * MiB;
constexpr size_t WS_LOG = 490 * MiB;
constexpr size_t WS_H = 768 * MiB;
constexpr size_t WS_HS = 928 * MiB;
constexpr size_t WS_Y = 168 * MiB;
constexpr size_t WS_END = 944 * MiB;
constexpr int CW_CNT = 0, CW_OFF = 512, CW_NT = 1024, CW_CST = 1280, CW_BAR = 4096;

constexpr int NTHREADS = 512, NWAVES = 8;
constexpr int LDS_BYTES = 147456;
constexpr int MISC_OFF = 140 * 1024;

#define LAS __attribute__((address_space(3)))
typedef float f32x4 __attribute__((ext_vector_type(4)));
typedef float f32x16 __attribute__((ext_vector_type(16)));

#define XB_TMO      128
#define XB_XCNT(j)  (256  + 64 * (j))
#define XB_XSUB(j)  (1280 + 64 * (j))
#define XB_XGEN(j)  (2304 + 64 * (j))
#define XB_TOP      3328
#define XB_TOPGEN   3392
#define XCD_BAR_WORDS 3456
#define XB_SPIN_CAP (1u << 18)
__device__ __forceinline__ unsigned xb_ld(unsigned* p)              { return __hip_atomic_load(p, __ATOMIC_RELAXED, __HIP_MEMORY_SCOPE_AGENT); }
__device__ __forceinline__ unsigned xb_add(unsigned* p, unsigned v) { return __hip_atomic_fetch_add(p, v, __ATOMIC_RELAXED, __HIP_MEMORY_SCOPE_AGENT); }
__device__ __forceinline__ unsigned xb_xcc_id() { return (unsigned)__builtin_amdgcn_s_getreg((3 << 11) | 20) & 0xFu; }
#define XB_SPIN(cond, bar) do { unsigned _sp = 0; while (cond) { __builtin_amdgcn_s_sleep(1); \
    if ((++_sp & 255u) == 0u) { if (xb_ld(&(bar)[XB_TMO])) break; if (_sp > XB_SPIN_CAP) { atomicAdd(&(bar)[XB_TMO], 1u); break; } } } } while (0)
struct XcdBarrier { unsigned* bar; unsigned x; volatile LAS unsigned* st; };
__device__ __forceinline__ XcdBarrier xcd_barrier_post(unsigned* bar, volatile LAS unsigned* st) {
    XcdBarrier b; b.bar = bar; b.x = xb_xcc_id(); b.st = st;
    if (threadIdx.x == 0) (void)xb_add(&bar[XB_XCNT(b.x)], 1u);
    return b;
}
__device__ __forceinline__ void xcd_barrier_complete(unsigned* bar, unsigned x, unsigned& nloc, unsigned& nx) {
    const unsigned G = gridDim.x * gridDim.y * gridDim.z;
    unsigned sum, cnt, mine, sp = 0u;
    for (;;) {
        sum = 0u; cnt = 0u; mine = 0u;
#pragma unroll
        for (unsigned j = 0; j < 16; ++j) { const unsigned c = xb_ld(&bar[XB_XCNT(j)]); sum += c; cnt += (c > 0u) ? 1u : 0u; mine = (j == x) ? c : mine; }
        if (sum == G) break;
        __builtin_amdgcn_s_sleep(1);
        if ((++sp & 255u) == 0u) { if (xb_ld(&bar[XB_TMO])) break; if (sp > XB_SPIN_CAP) { atomicAdd(&bar[XB_TMO], 1u); break; } }
    }
    nloc = mine > 0u ? mine : 1u; nx = cnt > 0u ? cnt : 1u;
}
__device__ __forceinline__ void xcd_barrier(const XcdBarrier& b) {
    asm volatile("s_waitcnt vmcnt(0)" ::: "memory");
    __syncthreads();
    if (threadIdx.x == 0) {
        unsigned* bar = b.bar;
        __builtin_amdgcn_s_waitcnt(0);
        unsigned nloc = b.st[0], nx = b.st[1];
        if (nloc == 0u) { xcd_barrier_complete(bar, b.x, nloc, nx); b.st[0] = nloc; b.st[1] = nx; }
        const unsigned old = xb_add(&bar[XB_XSUB(b.x)], 1u);
        const unsigned gen = old / nloc;
        if (old + 1u == (gen + 1u) * nloc) {
            __builtin_amdgcn_fence(__ATOMIC_RELEASE, "agent");
            asm volatile("s_waitcnt vmcnt(0)" ::: "memory");
            const unsigned og = xb_add(&bar[XB_TOP], 1u);
            const unsigned tg = og / nx;
            if (og + 1u == (tg + 1u) * nx) xb_add(&bar[XB_TOPGEN], 1u);
            else XB_SPIN(xb_ld(&bar[XB_TOPGEN]) == tg, bar);
            __builtin_amdgcn_fence(__ATOMIC_ACQUIRE, "agent");
            xb_add(&bar[XB_XGEN(b.x)], 1u);
            asm volatile("s_waitcnt vmcnt(0)" ::: "memory");
        } else {
            XB_SPIN(xb_ld(&bar[XB_XGEN(b.x)]) == gen, bar);
            __builtin_amdgcn_fence(__ATOMIC_ACQUIRE, "agent");
            asm volatile("s_waitcnt vmcnt(0)" ::: "memory");
        }
    }
    __syncthreads();
}

namespace pg8 {
#define PG8_LAS __attribute__((address_space(3)))
typedef unsigned short bf16_t;
typedef short bf16x8 __attribute__((ext_vector_type(8)));
typedef float f32x4 __attribute__((ext_vector_type(4)));
typedef float f32x2 __attribute__((ext_vector_type(2)));
typedef unsigned u32x4 __attribute__((ext_vector_type(4)));
constexpr int BM = 256, BK = 64, HALF = 128, HTB = HALF * BK * 2, STAGE_BYTES = 8 * HTB, NXCD = 8, WGM = 8;
__host__ __device__ __forceinline__ int lds_byte(int r, int c) { const int st = (r >> 4) * 2 + (c >> 5), rr = r & 15, cc = c & 31, ob = rr * 64 + cc * 2; return st * 1024 + (ob ^ (((ob >> 9) & 1) << 5)); }
__host__ __device__ __forceinline__ void stage_rc(int b, int& R, int& C) { const int st = b / 1024, sb = b % 1024, swz = sb ^ (((sb >> 9) & 1) << 5); R = (st >> 1) * 16 + swz / 64; C = (st & 1) * 32 + (swz % 64) / 2; }
__host__ __device__ __forceinline__ int perm32(int rho) { const int n = rho >> 4, i = rho & 15; return 8 * (i >> 2) + 4 * n + (i & 3); }
__device__ __forceinline__ unsigned cvt_pk_bf16(float lo, float hi) { unsigned r; asm volatile("v_cvt_pk_bf16_f32 %0, %1, %2" : "=v"(r) : "v"(lo), "v"(hi)); return r; }

struct Unit { int pm, pn, e; };
struct StaticOrder {
    int nM, nN, nwg, G, c;
    __host__ __device__ void init(int M, int N, int G_, int c_) { nM = M / BM; nN = N / BM; nwg = nM * nN; G = G_; c = c_; }
    __host__ __device__ bool next(int i, Unit& u) const {
        const long L = (long)i * G + c; if (L >= nwg) return false;
        int wgid = (int)L; { const int q = nwg / NXCD, r = nwg % NXCD, xcd = wgid % NXCD, off = wgid / NXCD; wgid = (xcd < r ? xcd * (q + 1) : r * (q + 1) + (xcd - r) * q) + off; }
        const int nig = WGM * nN, gid = wgid / nig, fm = gid * WGM, gsz = (nM - fm) < WGM ? (nM - fm) : WGM;
        u.pm = fm + ((wgid % nig) % gsz); u.pn = (wgid % nig) / gsz; u.e = 0; return true;
    }
};
struct DenseProb {
    const bf16_t* A; const bf16_t* Bt; int K; StaticOrder ord;
    __device__ __forceinline__ bool next(int i, Unit& u) const { return ord.next(i, u); }
    __device__ __forceinline__ const char* a_base(const Unit& u) const { return (const char*)A + (size_t)u.pm * BM * K * 2; }
    __device__ __forceinline__ const char* b_base(const Unit& u) const { return (const char*)Bt + (size_t)u.pn * BM * K * 2; }
    __device__ __forceinline__ void a_offs(const Unit&, unsigned (&v)[2][2], const int (&R)[2], const int (&C)[2]) const {
#pragma unroll
        for (int h = 0; h < 2; ++h)
#pragma unroll
            for (int i = 0; i < 2; ++i) v[h][i] = (unsigned)((h * HALF + R[i]) * K + C[i]) * 2u;
    }
};
struct GatherProb {
    const bf16_t* X; const int* stok; const bf16_t* Bt; const int* texp; int K, nN, nunits, G, c; size_t estride;
    __device__ __forceinline__ bool next(int i, Unit& u) const {
        const long L = (long)i * G + c; if (L >= nunits) return false;
        u.pm = (int)(L / nN); u.pn = (int)(L % nN); u.e = texp[u.pm]; return true;
    }
    __device__ __forceinline__ const char* a_base(const Unit&) const { return (const char*)X; }
    __device__ __forceinline__ const char* b_base(const Unit& u) const { return (const char*)Bt + (size_t)u.e * estride + (size_t)u.pn * BM * K * 2; }
    __device__ __forceinline__ void a_offs(const Unit& u, unsigned (&v)[2][2], const int (&R)[2], const int (&C)[2]) const {
#pragma unroll
        for (int h = 0; h < 2; ++h)
#pragma unroll
            for (int i = 0; i < 2; ++i) { const int tok = stok[u.pm * BM + h * HALF + R[i]]; v[h][i] = (unsigned)(tok * K + C[i]) * 2u; }
    }
};
struct GroupedProb {
    const bf16_t* A; const bf16_t* Bt; const int* texp; int K, nN, nunits, G, c; size_t estride;
    __device__ __forceinline__ bool next(int i, Unit& u) const {
        const long L = (long)i * G + c; if (L >= nunits) return false;
        u.pm = (int)(L / nN); u.pn = (int)(L % nN); u.e = texp[u.pm]; return true;
    }
    __device__ __forceinline__ const char* a_base(const Unit& u) const { return (const char*)A + (size_t)u.pm * BM * K * 2; }
    __device__ __forceinline__ const char* b_base(const Unit& u) const { return (const char*)Bt + (size_t)u.e * estride + (size_t)u.pn * BM * K * 2; }
    __device__ __forceinline__ void a_offs(const Unit&, unsigned (&v)[2][2], const int (&R)[2], const int (&C)[2]) const {
#pragma unroll
        for (int h = 0; h < 2; ++h)
#pragma unroll
            for (int i = 0; i < 2; ++i) v[h][i] = (unsigned)((h * HALF + R[i]) * K + C[i]) * 2u;
    }
};

struct EpiBf16 {
    static constexpr bool PERM = true;
    bf16_t* O; int ldc;
    __device__ __forceinline__ void operator()(const f32x4 (&acc)[2][2][4][2], const Unit& u, int wr, int wc, int fr, int fq) const {
        const int row0 = u.pm * BM + wr * 64 + fr, col0 = u.pn * BM + wc * 32 + 8 * fq;
#pragma unroll
        for (int ai = 0; ai < 2; ++ai)
#pragma unroll
            for (int m = 0; m < 4; ++m) { bf16_t* rowp = O + (size_t)(row0 + ai * HALF + m * 16) * ldc + col0;
#pragma unroll
                for (int bj = 0; bj < 2; ++bj) { const f32x4 v0 = acc[ai][bj][m][0], v1 = acc[ai][bj][m][1];
                    u32x4 w; w.x = cvt_pk_bf16(v0[0], v0[1]); w.y = cvt_pk_bf16(v0[2], v0[3]); w.z = cvt_pk_bf16(v1[0], v1[1]); w.w = cvt_pk_bf16(v1[2], v1[3]);
                    *(u32x4*)(rowp + bj * HALF) = w; } }
    }
};
struct EpiF32Res {
    static constexpr bool PERM = false;
    float* C; int ldc; const float* base; float alpha;
    __device__ __forceinline__ void operator()(const f32x4 (&acc)[2][2][4][2], const Unit& u, int wr, int wc, int fr, int fq) const {
        const int row0 = u.pm * BM + wr * 64 + fr, col0 = u.pn * BM + wc * 32 + 4 * fq;
#pragma unroll
        for (int ai = 0; ai < 2; ++ai)
#pragma unroll
            for (int m = 0; m < 4; ++m) { const size_t off = (size_t)(row0 + ai * HALF + m * 16) * ldc + col0;
#pragma unroll
                for (int bj = 0; bj < 2; ++bj)
#pragma unroll
                    for (int n = 0; n < 2; ++n) { f32x4 o = acc[ai][bj][m][n];
                        if (base) o += *(const f32x4*)(base + off + bj * HALF + n * 16) * alpha;
                        *(f32x4*)(C + off + bj * HALF + n * 16) = o; } }
    }
};

struct EpiSwiGLU {
    static constexpr bool PERM = true;
    bf16_t* O; int ldc;
    __device__ __forceinline__ void operator()(const f32x4 (&acc)[2][2][4][2], const Unit& u, int wr, int wc, int fr, int fq) const {
        const int row0 = u.pm * BM + wr * 64 + fr, col0 = u.pn * HALF + wc * 32 + 8 * fq;
#pragma unroll
        for (int ai = 0; ai < 2; ++ai)
#pragma unroll
            for (int m = 0; m < 4; ++m) { bf16_t* rowp = O + (size_t)(row0 + ai * HALF + m * 16) * ldc + col0;
                float h[8];
#pragma unroll
                for (int n = 0; n < 2; ++n)
#pragma unroll
                    for (int q = 0; q < 4; ++q) { const float g = acc[ai][0][m][n][q], up = acc[ai][1][m][n][q]; h[4 * n + q] = g * __builtin_amdgcn_rcpf(1.f + __expf(-g)) * up; }
                u32x4 w; w.x = cvt_pk_bf16(h[0], h[1]); w.y = cvt_pk_bf16(h[2], h[3]); w.z = cvt_pk_bf16(h[4], h[5]); w.w = cvt_pk_bf16(h[6], h[7]);
                *(u32x4*)rowp = w; }
    }
};
struct EpiScaleY {
    static constexpr bool PERM = true;
    bf16_t* Y; const float* sgate; const unsigned* off; const unsigned* cnt; const unsigned* cst;
    __device__ __forceinline__ void operator()(const f32x4 (&acc)[2][2][4][2], const Unit& u, int wr, int wc, int fr, int fq) const {
        const int o0 = (int)off[u.e], nreal = (int)cnt[u.e], c0 = (int)cst[u.e];
        const int row0 = u.pm * BM + wr * 64 + fr, col0 = u.pn * BM + wc * 32 + 8 * fq;
#pragma unroll
        for (int ai = 0; ai < 2; ++ai)
#pragma unroll
            for (int m = 0; m < 4; ++m) { const int p = row0 + ai * HALF + m * 16, rel = p - o0;
                if (rel < nreal) { const float gs = sgate[p]; bf16_t* rowp = Y + (size_t)(c0 + rel) * 1024 + col0;
#pragma unroll
                    for (int bj = 0; bj < 2; ++bj) { const f32x4 v0 = acc[ai][bj][m][0] * gs, v1 = acc[ai][bj][m][1] * gs;
                        u32x4 w; w.x = cvt_pk_bf16(v0[0], v0[1]); w.y = cvt_pk_bf16(v0[2], v0[3]); w.z = cvt_pk_bf16(v1[0], v1[1]); w.w = cvt_pk_bf16(v1[2], v1[3]);
                        *(u32x4*)(rowp + bj * HALF) = w; } } }
    }
};

template <class Epi, class Prob>
__device__ __forceinline__ void gemm_phase(PG8_LAS unsigned char* lds, const Prob& S, const Epi& E) {
    const int tid = threadIdx.x, wid = __builtin_amdgcn_readfirstlane(tid >> 6), lane = tid & 63, wr = wid >> 2, wc = wid & 3, fr = lane & 15, fq = lane >> 4;
    const int K = S.K, nt = K / BK;
    int Rr[2], Cc[2]; unsigned voffB[2];
#pragma unroll
    for (int i = 0; i < 2; ++i) { int R, C; stage_rc(tid * 16 + i * 8192, R, C); const int Rb = Epi::PERM ? ((R & ~31) + perm32(R & 31)) : R;
        Rr[i] = R; Cc[i] = C; voffB[i] = (unsigned)(Rb * K + C) * 2u; }
    const size_t kstep = (size_t)(BK * 2);
    const size_t hstep = (size_t)HALF * K * 2;
    const unsigned ldsw = (unsigned)wid * 1024u;
    const int aoff = lds_byte(wr * 64 + fr, fq * 8), boff = lds_byte(wc * 32 + fr, fq * 8);
#define PG8_SA(b, h) (((b) * 2 + (h)) * HTB)
#define PG8_SB(b, h) ((4 + (b) * 2 + (h)) * HTB)
#define PG8_STAGE(bufoff, gbase, voff) do { _Pragma("unroll") for (int _i = 0; _i < 2; ++_i) \
        __builtin_amdgcn_global_load_lds((const unsigned*)((const char*)(gbase) + (voff)[_i]), (PG8_LAS unsigned*)(lds + (bufoff) + ldsw + _i * 8192), 16, 0, 0); } while (0)
#define PG8_LDA(dst, b, h) do { _Pragma("unroll") for (int m = 0; m < 4; ++m) _Pragma("unroll") for (int k = 0; k < 2; ++k) dst[m][k] = *(const PG8_LAS bf16x8*)(lds + PG8_SA(b, h) + aoff + m * 2048 + k * 1024); } while (0)
#define PG8_LDB(dst, b, h) do { _Pragma("unroll") for (int n = 0; n < 2; ++n) _Pragma("unroll") for (int k = 0; k < 2; ++k) dst[n][k] = *(const PG8_LAS bf16x8*)(lds + PG8_SB(b, h) + boff + n * 2048 + k * 1024); } while (0)
#define PG8_MMA(ai, bj, At, Bt) do { __builtin_amdgcn_s_setprio(1); _Pragma("unroll") for (int m = 0; m < 4; ++m) _Pragma("unroll") for (int n = 0; n < 2; ++n) _Pragma("unroll") for (int k = 0; k < 2; ++k) \
        acc[ai][bj][m][n] = __builtin_amdgcn_mfma_f32_16x16x32_bf16(Bt[n][k], At[m][k], acc[ai][bj][m][n], 0, 0, 0); __builtin_amdgcn_s_setprio(0); } while (0)
#define PG8_WAIT_V(n) asm volatile("s_waitcnt vmcnt(" #n ")" ::: "memory")
#define PG8_WAIT_L(n) asm volatile("s_waitcnt lgkmcnt(" #n ")" ::: "memory")
#define PG8_BAR __builtin_amdgcn_s_barrier()
#define PG8_SCHED __builtin_amdgcn_sched_barrier(0)
    Unit cur, nxt; int ui = 0;
    if (!S.next(0, cur)) return;
    f32x4 acc[2][2][4][2];
#pragma unroll
    for (int a = 0; a < 2; ++a)
#pragma unroll
        for (int b = 0; b < 2; ++b)
#pragma unroll
            for (int m = 0; m < 4; ++m)
#pragma unroll
                for (int n = 0; n < 2; ++n) acc[a][b][m][n] = (f32x4){0.f, 0.f, 0.f, 0.f};
    bf16x8 At[4][2], B0[2][2], B1[2][2];
    const char* cA = S.a_base(cur); const char* cB = S.b_base(cur);
    unsigned vA[2][2], nvA[2][2];
    S.a_offs(cur, vA, Rr, Cc);
    PG8_STAGE(PG8_SB(0, 0), cB, voffB); PG8_STAGE(PG8_SA(0, 0), cA, vA[0]); PG8_STAGE(PG8_SB(0, 1), cB + hstep, voffB); PG8_STAGE(PG8_SA(0, 1), cA, vA[1]);
    if (wr == 1) PG8_BAR;
    PG8_WAIT_V(4); PG8_BAR;
    PG8_STAGE(PG8_SB(1, 0), cB + kstep, voffB); PG8_STAGE(PG8_SA(1, 0), cA + kstep, vA[0]); PG8_STAGE(PG8_SB(1, 1), cB + hstep + kstep, voffB);
    PG8_WAIT_V(6); PG8_BAR;
    for (;;) {
        const bool has_next = S.next(ui + 1, nxt);
        const char* nA = has_next ? S.a_base(nxt) : cA; const char* nB = has_next ? S.b_base(nxt) : cB;
        if (has_next) S.a_offs(nxt, nvA, Rr, Cc);
        else {
#pragma unroll
            for (int h = 0; h < 2; ++h)
#pragma unroll
                for (int i = 0; i < 2; ++i) nvA[h][i] = vA[h][i];
        }
        for (int t = 0; t < nt; t += 2) {
            const bool last = (t == nt - 2);
            const char* a1 = cA + (size_t)(t + 1) * kstep;
            const char* a2 = last ? nA : cA + (size_t)(t + 2) * kstep; const char* b2 = last ? nB : cB + (size_t)(t + 2) * kstep;
            const char* a3 = a2 + kstep; const char* b3 = b2 + kstep;
            unsigned v2[2][2];
#pragma unroll
            for (int h = 0; h < 2; ++h)
#pragma unroll
                for (int i = 0; i < 2; ++i) v2[h][i] = last ? nvA[h][i] : vA[h][i];
            PG8_LDB(B0, 0, 0); PG8_SCHED; PG8_LDA(At, 0, 0); PG8_STAGE(PG8_SA(1, 1), a1, vA[1]);
            PG8_WAIT_L(8); PG8_BAR; PG8_WAIT_L(0); PG8_MMA(0, 0, At, B0); PG8_BAR; PG8_SCHED;
            PG8_LDB(B1, 0, 1); PG8_STAGE(PG8_SB(0, 0), b2, voffB);
            PG8_BAR; PG8_WAIT_L(0); PG8_MMA(0, 1, At, B1); PG8_BAR;
            PG8_LDA(At, 0, 1); PG8_STAGE(PG8_SA(0, 0), a2, v2[0]);
            PG8_BAR; PG8_WAIT_L(0); PG8_MMA(1, 0, At, B0); PG8_BAR; PG8_SCHED;
            PG8_STAGE(PG8_SB(0, 1), b2 + hstep, voffB);
            PG8_WAIT_V(6); PG8_BAR; PG8_MMA(1, 1, At, B1); PG8_BAR;
            PG8_LDB(B0, 1, 0); PG8_SCHED; PG8_LDA(At, 1, 0); PG8_STAGE(PG8_SA(0, 1), a2, v2[1]);
            PG8_WAIT_L(8); PG8_BAR; PG8_WAIT_L(0); PG8_MMA(0, 0, At, B0); PG8_BAR; PG8_SCHED;
            PG8_LDB(B1, 1, 1); PG8_STAGE(PG8_SB(1, 0), b3, voffB);
            PG8_BAR; PG8_WAIT_L(0); PG8_MMA(0, 1, At, B1); PG8_BAR;
            PG8_LDA(At, 1, 1); PG8_STAGE(PG8_SA(1, 0), a3, v2[0]);
            PG8_BAR; PG8_WAIT_L(0); PG8_MMA(1, 0, At, B0); PG8_BAR; PG8_SCHED;
            PG8_STAGE(PG8_SB(1, 1), b3 + hstep, voffB);
            PG8_WAIT_V(6); PG8_BAR; PG8_MMA(1, 1, At, B1); PG8_BAR;
        }
        E(acc, cur, wr, wc, fr, fq);
        if (!has_next) break;
#pragma unroll
        for (int a = 0; a < 2; ++a)
#pragma unroll
            for (int b = 0; b < 2; ++b)
#pragma unroll
                for (int m = 0; m < 4; ++m)
#pragma unroll
                    for (int n = 0; n < 2; ++n) acc[a][b][m][n] = (f32x4){0.f, 0.f, 0.f, 0.f};
        cur = nxt; cA = nA; cB = nB; ++ui;
#pragma unroll
        for (int h = 0; h < 2; ++h)
#pragma unroll
            for (int i = 0; i < 2; ++i) vA[h][i] = nvA[h][i];
    }
    PG8_WAIT_V(0);
    if (wr == 0) PG8_BAR;
    PG8_BAR;
#undef PG8_SA
#undef PG8_SB
#undef PG8_STAGE
#undef PG8_LDA
#undef PG8_LDB
#undef PG8_MMA
#undef PG8_WAIT_V
#undef PG8_WAIT_L
#undef PG8_BAR
#undef PG8_SCHED
}
}

__device__ __forceinline__ float wave_sum(float v) {
#pragma unroll
    for (int o = 1; o < 64; o <<= 1) v += __shfl_xor(v, o);
    return v;
}
__device__ __forceinline__ float sigmoidf_(float x) { return 1.0f / (1.0f + expf(-x)); }

typedef unsigned short bf16_t;
typedef unsigned u32x4 __attribute__((ext_vector_type(4)));
typedef unsigned u32x2 __attribute__((ext_vector_type(2)));
__device__ __forceinline__ float bf2f(bf16_t b) { return __builtin_bit_cast(float, (unsigned)b << 16); }
__device__ __forceinline__ bf16_t f2bf(float f) { return (bf16_t)(pg8::cvt_pk_bf16(f, 0.f) & 0xffffu); }
__device__ __forceinline__ void transpose_item(const float* W, int K, int N, bf16_t* WT, int k0, int n0, int drow0, float* scr, int lane) {
#pragma unroll 8
    for (int i = 0; i < 32; ++i) { const int kk = 2 * i + (lane >> 5); scr[kk * 33 + (lane & 31)] = W[(size_t)(k0 + kk) * N + n0 + (lane & 31)]; }
    __builtin_amdgcn_wave_barrier();
    const int c = lane & 7;
#pragma unroll
    for (int j = 0; j < 4; ++j) { const int n = (lane >> 3) + 8 * j; const float* s = scr + (8 * c) * 33 + n;
        u32x4 o; o.x = pg8::cvt_pk_bf16(s[0 * 33], s[1 * 33]); o.y = pg8::cvt_pk_bf16(s[2 * 33], s[3 * 33]); o.z = pg8::cvt_pk_bf16(s[4 * 33], s[5 * 33]); o.w = pg8::cvt_pk_bf16(s[6 * 33], s[7 * 33]);
        *(u32x4*)(WT + (size_t)(drow0 + n) * K + k0 + 8 * c) = o; }
    __builtin_amdgcn_wave_barrier();
}
struct Args {
    const float* in[34]; float* out; unsigned char* ws;
    int ph_lo, ph_hi;
};

struct GF {
    const float* A; long lda; const int* arow; int arow_lim;
    const float* B; long ldb; int bmode;
    int K;
};
template <class Epi>
__device__ __forceinline__ void gemm_f32_tile(float* lds, const GF& g, int row0, int col0, Epi&& epi) {
    float* As = lds;
    float* Bs = lds + 16 * 132;
    const int tid = threadIdx.x, lane = tid & 63, w = tid >> 6, wm = w >> 1, wn = w & 1;
    f32x16 acc0, acc1;
#pragma unroll
    for (int i = 0; i < 16; ++i) { acc0[i] = 0.f; acc1[i] = 0.f; }
    const int ar = tid >> 2, ak = (tid & 3) * 4;
    long arow_idx = row0 + ar; bool avalid = true;
    if (g.arow) { const int t = g.arow[row0 + ar]; avalid = t < g.arow_lim; arow_idx = avalid ? t : 0; }
    const float* ap = g.A + arow_idx * g.lda + ak;
    const float* bp; int bk, bn;
    if (g.bmode == 0) { bk = tid >> 5; bn = (tid & 31) * 4; bp = g.B + (long)bk * g.ldb + col0 + bn; }
    else { bn = tid >> 2; bk = (tid & 3) * 4; bp = g.B + (long)(col0 + bn) * g.ldb + bk; }
    const int hl = lane >> 5, l31 = lane & 31;
    for (int k0 = 0; k0 < g.K; k0 += 16) {
        f32x4 av = (f32x4){0.f, 0.f, 0.f, 0.f};
        if (avalid) av = *(const f32x4*)(ap + k0);
        const f32x4 bv = g.bmode == 0 ? *(const f32x4*)(bp + (long)k0 * g.ldb) : *(const f32x4*)(bp + k0);
        __syncthreads();
        As[(ak + 0) * 132 + ar] = av[0]; As[(ak + 1) * 132 + ar] = av[1]; As[(ak + 2) * 132 + ar] = av[2]; As[(ak + 3) * 132 + ar] = av[3];
        if (g.bmode == 0) *(f32x4*)&Bs[bk * 132 + bn] = bv;
        else { Bs[(bk + 0) * 132 + bn] = bv[0]; Bs[(bk + 1) * 132 + bn] = bv[1]; Bs[(bk + 2) * 132 + bn] = bv[2]; Bs[(bk + 3) * 132 + bn] = bv[3]; }
        __syncthreads();
#pragma unroll
        for (int kk = 0; kk < 16; kk += 2) {
            const float a = As[(kk + hl) * 132 + wm * 32 + l31];
            const float b0 = Bs[(kk + hl) * 132 + wn * 64 + l31];
            const float b1 = Bs[(kk + hl) * 132 + wn * 64 + 32 + l31];
            acc0 = __builtin_amdgcn_mfma_f32_32x32x2f32(a, b0, acc0, 0, 0, 0);
            acc1 = __builtin_amdgcn_mfma_f32_32x32x2f32(a, b1, acc1, 0, 0, 0);
        }
    }
#pragma unroll
    for (int r = 0; r < 16; ++r) {
        const int row = row0 + wm * 32 + (r & 3) + 8 * (r >> 2) + 4 * hl;
        const int col = col0 + wn * 64 + l31;
        epi(row, col, acc0[r]);
        epi(row, col + 32, acc1[r]);
    }
    __syncthreads();
}

__device__ __forceinline__ void ln_row(const float* a, float alpha, const float* b, float* out, const float* gam, const float* bet, int lane, bf16_t* outb = nullptr) {
    f32x4 v[4]; float s = 0.f;
#pragma unroll
    for (int j = 0; j < 4; ++j) {
        v[j] = *(const f32x4*)(a + 4 * lane + 256 * j) * alpha;
        if (b) v[j] += *(const f32x4*)(b + 4 * lane + 256 * j);
        s += (v[j][0] + v[j][1]) + (v[j][2] + v[j][3]);
    }
    const float mean = wave_sum(s) * (1.f / D); float s2 = 0.f;
#pragma unroll
    for (int j = 0; j < 4; ++j) { v[j] = v[j] - mean; s2 += (v[j][0] * v[j][0] + v[j][1] * v[j][1]) + (v[j][2] * v[j][2] + v[j][3] * v[j][3]); }
    const float rstd = 1.f / sqrtf(wave_sum(s2) * (1.f / D) + LN_EPS);
#pragma unroll
    for (int j = 0; j < 4; ++j) {
        const f32x4 gg = *(const f32x4*)(gam + 4 * lane + 256 * j), bb = *(const f32x4*)(bet + 4 * lane + 256 * j);
        const f32x4 o = v[j] * rstd * gg + bb;
        *(f32x4*)(out + 4 * lane + 256 * j) = o;
        if (outb) { u32x2 w; w.x = pg8::cvt_pk_bf16(o[0], o[1]); w.y = pg8::cvt_pk_bf16(o[2], o[3]); *(u32x2*)(outb + 4 * lane + 256 * j) = w; }
    }
}

constexpr int NPHASES = 21;

__global__ void __launch_bounds__(NTHREADS, 2) mega(Args args) {
    extern __shared__ __attribute__((aligned(16))) unsigned char lds_raw[];
    float* ldsf = (float*)lds_raw;
    const int tid = threadIdx.x, lane = tid & 63, wave = tid >> 6;
    const int G = gridDim.x, bx = blockIdx.x;
    const int gw = bx * NWAVES + wave, NGW = G * NWAVES;
    unsigned char* ws = args.ws;
    unsigned* ctl = (unsigned*)(ws + WS_CTL);
    volatile LAS unsigned* misc = (volatile LAS unsigned*)((LAS unsigned char*)lds_raw + MISC_OFF);
    if (tid < 4) misc[tid] = 0u;
    __syncthreads();
    const int lo = args.ph_lo, hi = args.ph_hi;
    const bool multi = (hi - lo) > 1;
    XcdBarrier bar; bar.bar = ctl + CW_BAR; bar.x = 0; bar.st = nullptr;
    if (multi) bar = xcd_barrier_post(ctl + CW_BAR, misc);
#define IN(k) (lo <= (k) && (k) < hi)
#define SEAM(k) do { if (IN(k) && IN((k) + 1)) xcd_barrier(bar); } while (0)

    const float* x = args.in[0]; const float* mem = args.in[1]; const int* positions = (const int*)args.in[2];
    const float* w_in = args.in[3]; const float* mu_shift = args.in[4]; const float* w_decay_up = args.in[5]; const float* w0 = args.in[6];
    const float* a_up = args.in[7]; const float* a0 = args.in[8]; const float* g_up = args.in[9]; const float* k_k = args.in[10]; const float* k_a = args.in[11];
    const float* r_k = args.in[12]; const float* lnx_g = args.in[13]; const float* lnx_b = args.in[14]; const float* sinks = args.in[15];
    const float* w_o = args.in[16]; const float* ln1_g = args.in[17]; const float* ln1_b = args.in[18];
    const float* wm_q = args.in[19]; const float* wm_kv = args.in[20]; const float* wm_o = args.in[21]; const float* ln2_g = args.in[22]; const float* ln2_b = args.in[23];
    const float* w_router = args.in[24]; const float* router_bias = args.in[25];
    const float* we_gate = args.in[26]; const float* we_up = args.in[27]; const float* we_down = args.in[28];
    const float* ws_gate = args.in[29]; const float* ws_up = args.in[30]; const float* ws_down = args.in[31];
    const float* ln3_g = args.in[32]; const float* ln3_b = args.in[33];
    float* out = args.out;

    float* ROPE_C = (float*)(ws + WS_ROPE); float* ROPE_S = ROPE_C + (size_t)NTOK * 32;
    bf16_t* W_IN_T = (bf16_t*)(ws + WS_WIN); bf16_t* W_O_T = (bf16_t*)(ws + WS_WO); bf16_t* WM_Q_T = (bf16_t*)(ws + WS_WMQ); bf16_t* WM_KV_T = (bf16_t*)(ws + WS_WMKV); bf16_t* WM_O_T = (bf16_t*)(ws + WS_WMO);
    bf16_t* XB = (bf16_t*)(ws + WS_XB); bf16_t* MEMB = (bf16_t*)(ws + WS_MEMB);
    bf16_t* U = (bf16_t*)(ws + WS_U); float* LR = (float*)(ws + WS_LR);
    float* DW = (float*)(ws + WS_DW); float* DA = (float*)(ws + WS_DA); float* GG = (float*)(ws + WS_G);
    bf16_t* MIX = (bf16_t*)(ws + WS_MIX); float* X1 = (float*)(ws + WS_X1); bf16_t* X1B = (bf16_t*)(ws + WS_X1B);
    float* QM = (float*)(ws + WS_QM); float* KVM = (float*)(ws + WS_KVM); float* SC = (float*)(ws + WS_SC); bf16_t* OM = (bf16_t*)(ws + WS_OM);
    float* X2 = out; bf16_t* X2B = (bf16_t*)(ws + WS_X2B); float* LOG = (float*)(ws + WS_LOG);
    int* EIDX = (int*)(ws + WS_EIDX); float* GATE = (float*)(ws + WS_GATE); int* POS = (int*)(ws + WS_POS); int* YROW = (int*)(ws + WS_YROW);
    int* STOK = (int*)(ws + WS_STOK); float* SGATE = (float*)(ws + WS_SGATE);
    bf16_t* HH = (bf16_t*)(ws + WS_H); bf16_t* HS = (bf16_t*)(ws + WS_HS); bf16_t* YY = (bf16_t*)(ws + WS_Y);
    bf16_t* WS_GU_T = (bf16_t*)(ws + WS_WSGU); bf16_t* WS_D_T = (bf16_t*)(ws + WS_WSD); bf16_t* WE_GU_T = (bf16_t*)(ws + WS_WEGU); bf16_t* WE_D_T = (bf16_t*)(ws + WS_WED);
    int* TEXP = (int*)(ws + WS_TEXP);
    PG8_LAS unsigned char* ldsl = (PG8_LAS unsigned char*)lds_raw;

    if (IN(0)) {
        for (int i = bx * NTHREADS + tid; i < NTOK * 32; i += G * NTHREADS) {
            const int n = i >> 5, f = i & 31;
            const double inv = exp(-(double)(2 * f) / 64.0 * 9.210340371976184);
            const double ang = (double)positions[n] * inv;
            ROPE_C[i] = (float)cos(ang); ROPE_S[i] = (float)sin(ang);
        }
        {
            float* scr = ldsf + wave * 4096;
            constexpr int I_IN = 16 * (INCOLS / 32), I_SQ = 16 * (D / 32), I_KV = 16 * (2048 / 32);
            constexpr int NIT = I_IN + 3 * I_SQ + I_KV;
            for (int it = gw; it < NIT; it += NGW) {
                int r = it;
                if (r < I_IN) { const int nb = INCOLS / 32; transpose_item(w_in, D, INCOLS, W_IN_T, 64 * (r / nb), 32 * (r % nb), 32 * (r % nb), scr, lane); continue; } r -= I_IN;
                if (r < I_SQ) { const int nb = D / 32; transpose_item(w_o, D, D, W_O_T, 64 * (r / nb), 32 * (r % nb), 32 * (r % nb), scr, lane); continue; } r -= I_SQ;
                if (r < I_SQ) { const int nb = D / 32; transpose_item(wm_q, D, D, WM_Q_T, 64 * (r / nb), 32 * (r % nb), 32 * (r % nb), scr, lane); continue; } r -= I_SQ;
                if (r < I_SQ) { const int nb = D / 32; transpose_item(wm_o, D, D, WM_O_T, 64 * (r / nb), 32 * (r % nb), 32 * (r % nb), scr, lane); continue; } r -= I_SQ;
                { const int nb = 2048 / 32; transpose_item(wm_kv, D, 2048, WM_KV_T, 64 * (r / nb), 32 * (r % nb), 32 * (r % nb), scr, lane); }
            }
        }
        {
            float* scr = ldsf + wave * 4096;
            const int NITE = (NEXP + 1) * 384;
            for (int it = gw; it < NITE; it += NGW) {
                const int e = it / 384, r = it % 384;
                const float* wg = e < NEXP ? we_gate + (size_t)e * D * EDIM : ws_gate; const float* wu = e < NEXP ? we_up + (size_t)e * D * EDIM : ws_up;
                const float* wd = e < NEXP ? we_down + (size_t)e * EDIM * D : ws_down;
                bf16_t* gu = e < NEXP ? WE_GU_T + (size_t)e * 512 * D : WS_GU_T; bf16_t* dt = e < NEXP ? WE_D_T + (size_t)e * D * EDIM : WS_D_T;
                if (r < 256) { const int isup = r >> 7, rr = r & 127, kb = rr >> 3, nb = rr & 7, n0 = 32 * nb;
                    transpose_item(isup ? wu : wg, D, EDIM, gu, 64 * kb, n0, (n0 >> 7) * 256 + isup * 128 + (n0 & 127), scr, lane); }
                else { const int rr = r - 256, kb = rr >> 5, nb = rr & 31;
                    transpose_item(wd, EDIM, D, dt, 64 * kb, 32 * nb, 32 * nb, scr, lane); }
            }
        }
        for (size_t i = (size_t)bx * NTHREADS + tid; i < (size_t)NTOK * D / 8; i += (size_t)G * NTHREADS) {
            const f32x4 a = *(const f32x4*)(x + i * 8), b = *(const f32x4*)(x + i * 8 + 4);
            u32x4 o; o.x = pg8::cvt_pk_bf16(a[0], a[1]); o.y = pg8::cvt_pk_bf16(a[2], a[3]); o.z = pg8::cvt_pk_bf16(b[0], b[1]); o.w = pg8::cvt_pk_bf16(b[2], b[3]);
            *(u32x4*)(XB + i * 8) = o;
        }
        for (size_t i = (size_t)bx * NTHREADS + tid; i < (size_t)BATCH * MEMT * D / 8; i += (size_t)G * NTHREADS) {
            const f32x4 a = *(const f32x4*)(mem + i * 8), b = *(const f32x4*)(mem + i * 8 + 4);
            u32x4 o; o.x = pg8::cvt_pk_bf16(a[0], a[1]); o.y = pg8::cvt_pk_bf16(a[2], a[3]); o.z = pg8::cvt_pk_bf16(b[0], b[1]); o.w = pg8::cvt_pk_bf16(b[2], b[3]);
            *(u32x4*)(MEMB + i * 8) = o;
        }
    }
    SEAM(0);
    if (IN(1)) {
        pg8::DenseProb S{XB, W_IN_T, D, {}}; S.ord.init(NTOK, INCOLS, G, bx);
        pg8::EpiBf16 E{U, INCOLS};
        pg8::gemm_phase(ldsl, S, E);
    }
    SEAM(1);
    if (IN(2)) {
        for (size_t i = (size_t)bx * NTHREADS + tid; i < (size_t)NTOK * 256; i += (size_t)G * NTHREADS) {
            const int n = (int)(i >> 8), c = (int)(i & 255), col = C_WD + c;
            const float u = bf2f(U[(size_t)n * INCOLS + col]);
            const float p = (n % SEQ) ? bf2f(U[(size_t)(n - 1) * INCOLS + col]) : 0.f;
            const float v = u + (p - u) * mu_shift[col];
            LR[i] = c < 64 ? tanhf(v) : (c < 128 ? v : sigmoidf_(v));
        }
    }
    SEAM(2);
    if (IN(3)) {
        const int nm = NTOK / 128, nn = RW / 128;
        for (int t = bx; t < 3 * nm * nn; t += G) {
            const int which = t / (nm * nn), tt = t % (nm * nn), tm = tt / nn, tn = tt % nn;
            if (which == 0) { GF g{LR, 256, nullptr, 0, w_decay_up, RW, 0, 64};
                gemm_f32_tile(ldsf, g, tm * 128, tn * 128, [&](int r, int c, float v) { DW[(size_t)r * RW + c] = v; }); }
            else if (which == 1) { GF g{LR + 64, 256, nullptr, 0, a_up, RW, 0, 64};
                gemm_f32_tile(ldsf, g, tm * 128, tn * 128, [&](int r, int c, float v) { DA[(size_t)r * RW + c] = v; }); }
            else { GF g{LR + 128, 256, nullptr, 0, g_up, RW, 0, 128};
                gemm_f32_tile(ldsf, g, tm * 128, tn * 128, [&](int r, int c, float v) { GG[(size_t)r * RW + c] = v; }); }
        }
    }
    SEAM(3);
    if (IN(4)) {
        if (wave == 0) {
            for (int unit = bx; unit < BATCH * 8; unit += G) {
                const int b = unit >> 3, h = unit & 7, j = lane, hc = h * 64 + j;
                float S[64];
#pragma unroll
                for (int k = 0; k < 64; ++k) S[k] = 0.f;
                float pr = 0.f, pk = 0.f, pv = 0.f;
                const float mur = mu_shift[C_R + hc], muk = mu_shift[C_K + hc], muv = mu_shift[C_V + hc];
                const float w0j = w0[hc], a0j = a0[hc], kkj = k_k[hc], kaj = k_a[hc], rkj = r_k[hc], lgj = lnx_g[hc], lbj = lnx_b[hc];
                float* vec = ldsf;
                for (int t = 0; t < SEQ; ++t) {
                    const size_t n = (size_t)b * SEQ + t;
                    const float r0 = bf2f(U[n * INCOLS + C_R + hc]), k0 = bf2f(U[n * INCOLS + C_K + hc]), v0 = bf2f(U[n * INCOLS + C_V + hc]);
                    const float r = r0 + (pr - r0) * mur, k = k0 + (pk - k0) * muk, v = v0 + (pv - v0) * muv;
                    pr = r0; pk = k0; pv = v0;
                    const float dw = DW[n * RW + hc], da = DA[n * RW + hc], gg = GG[n * RW + hc];
                    const float xx = -(w0j + dw);
                    const float sp = fmaxf(xx, 0.f) + log1pf(expf(-fabsf(xx)));
                    const float logw = -sp - 0.5f;
                    const float wdec = expf(-expf(logw));
                    const float a = sigmoidf_(a0j + da);
                    const float kkv = k * kkj;
                    const float nrm = sqrtf(wave_sum(kkv * kkv));
                    const float kkn = kkv / fmaxf(nrm, 1e-12f);
                    const float kmod = k * (1.f + (a - 1.f) * kaj);
                    const float bonus = wave_sum(r * kmod * rkj);
                    vec[0 * 64 + j] = wdec; vec[1 * 64 + j] = -kkn; vec[2 * 64 + j] = kkn * a; vec[3 * 64 + j] = kmod; vec[4 * 64 + j] = r;
                    __builtin_amdgcn_s_waitcnt(0xC07F);
                    __builtin_amdgcn_wave_barrier();
                    float sa = 0.f;
#pragma unroll
                    for (int kq = 0; kq < 16; ++kq) { const f32x4 av = *(const f32x4*)&vec[64 + 4 * kq];
                        sa += S[4 * kq] * av[0] + S[4 * kq + 1] * av[1] + S[4 * kq + 2] * av[2] + S[4 * kq + 3] * av[3]; }
                    float y = 0.f;
#pragma unroll
                    for (int kq = 0; kq < 16; ++kq) {
                        const f32x4 wv = *(const f32x4*)&vec[4 * kq], bv = *(const f32x4*)&vec[128 + 4 * kq], kv = *(const f32x4*)&vec[192 + 4 * kq], rv = *(const f32x4*)&vec[256 + 4 * kq];
#pragma unroll
                        for (int q = 0; q < 4; ++q) { const float s = S[4 * kq + q] * wv[q] + sa * bv[q] + v * kv[q]; S[4 * kq + q] = s; y += s * rv[q]; }
                    }
                    __builtin_amdgcn_wave_barrier();
                    const float mu = wave_sum(y) * (1.f / 64.f);
                    const float dd = y - mu;
                    const float var = wave_sum(dd * dd) * (1.f / 64.f);
                    const float yn = dd * (1.f / sqrtf(var + GN_EPS)) * lgj + lbj;
                    MIX[n * D + hc] = f2bf((yn + bonus * v) * gg);
                }
            }
        }
    }
    SEAM(4);
    if (IN(5)) {
        float* Kt = ldsf; float* Vt = ldsf + 255 * 64;
        for (int unit = bx; unit < BATCH * 64 * 2; unit += G) {
            const int b = unit >> 7, blk = (unit & 127) >> 1, hk = unit & 1;
            const int base_s = blk * 128 - 127;
            __syncthreads();
            for (int i = tid; i < 255 * 64; i += NTHREADS) {
                const int jj = i >> 6, d = i & 63, s = base_s + jj;
                Vt[i] = s >= 0 ? bf2f(U[((size_t)b * SEQ + s) * INCOLS + C_VS + hk * 64 + d]) : 0.f;
            }
            for (int i = tid; i < 255 * 32; i += NTHREADS) {
                const int jj = i >> 5, f = i & 31, s = base_s + jj;
                float o1 = 0.f, o2 = 0.f;
                if (s >= 0) { const size_t n = (size_t)b * SEQ + s; const float k1 = bf2f(U[n * INCOLS + C_KS + hk * 64 + f]), k2 = bf2f(U[n * INCOLS + C_KS + hk * 64 + 32 + f]);
                    const float c = ROPE_C[n * 32 + f], sn = ROPE_S[n * 32 + f]; o1 = k1 * c - k2 * sn; o2 = k2 * c + k1 * sn; }
                Kt[jj * 64 + f] = o1; Kt[jj * 64 + 32 + f] = o2;
            }
            __syncthreads();
            const int i = tid & 127, g = tid >> 7, hq = hk * 4 + g;
            const size_t n = (size_t)b * SEQ + blk * 128 + i;
            float q[64], o[64];
#pragma unroll
            for (int f = 0; f < 32; ++f) { const float q1 = bf2f(U[n * INCOLS + C_Q + hq * 64 + f]), q2 = bf2f(U[n * INCOLS + C_Q + hq * 64 + 32 + f]);
                const float c = ROPE_C[n * 32 + f], sn = ROPE_S[n * 32 + f]; q[f] = (q1 * c - q2 * sn) * 0.125f; q[f + 32] = (q2 * c + q1 * sn) * 0.125f; }
#pragma unroll
            for (int d = 0; d < 64; ++d) o[d] = 0.f;
            float m = sinks[hq], l = 1.f;
            for (int jj = 0; jj < 255; ++jj) {
                const int s = base_s + jj;
                const bool valid = (jj >= i) && (jj <= i + 127) && (s >= 0);
                float sc = 0.f;
#pragma unroll
                for (int dq = 0; dq < 16; ++dq) { const f32x4 kv = *(const f32x4*)&Kt[jj * 64 + 4 * dq];
                    sc += q[4 * dq] * kv[0] + q[4 * dq + 1] * kv[1] + q[4 * dq + 2] * kv[2] + q[4 * dq + 3] * kv[3]; }
                if (valid) {
                    const float mn = fmaxf(m, sc), scale = expf(m - mn), p = expf(sc - mn);
                    l = l * scale + p; m = mn;
#pragma unroll
                    for (int dq = 0; dq < 16; ++dq) { const f32x4 vv = *(const f32x4*)&Vt[jj * 64 + 4 * dq];
#pragma unroll
                        for (int qd = 0; qd < 4; ++qd) o[4 * dq + qd] = o[4 * dq + qd] * scale + p * vv[qd]; }
                }
            }
            const float il = 1.f / l;
#pragma unroll
            for (int d = 0; d < 64; ++d) MIX[n * D + RW + hq * 64 + d] = f2bf(o[d] * il);
        }
    }
    SEAM(5);
    if (IN(6)) {
        pg8::DenseProb S{MIX, W_O_T, D, {}}; S.ord.init(NTOK, D, G, bx);
        pg8::EpiF32Res E{X1, D, x, ALPHA};
        pg8::gemm_phase(ldsl, S, E);
    }
    SEAM(6);
    if (IN(7)) { for (int n = gw; n < NTOK; n += NGW) ln_row(X1 + (size_t)n * D, 1.f, nullptr, X1 + (size_t)n * D, ln1_g, ln1_b, lane, X1B + (size_t)n * D); }
    SEAM(7);
    if (IN(8)) {
        { pg8::DenseProb S{X1B, WM_Q_T, D, {}}; S.ord.init(NTOK, D, G, bx); pg8::EpiF32Res E{QM, D, nullptr, 0.f}; pg8::gemm_phase(ldsl, S, E); }
        { pg8::DenseProb S{MEMB, WM_KV_T, D, {}}; S.ord.init(BATCH * MEMT, 2048, G, bx); pg8::EpiF32Res E{KVM, 2048, nullptr, 0.f}; pg8::gemm_phase(ldsl, S, E); }
    }
    SEAM(8);
    if (IN(9)) {
        const int per = (SEQ / 128) * 2;
        for (int t = bx; t < BATCH * 4 * per; t += G) {
            const int bh = t / per, tt = t % per, b = bh >> 2, h = bh & 3, tm = tt >> 1, tn = tt & 1;
            GF g{QM + (size_t)b * SEQ * D + h * 256, D, nullptr, 0, KVM + (size_t)b * MEMT * 2048 + h * 256, 2048, 1, 256};
            float* dst = SC + (size_t)b * SEQ * 1024 + h * 256;
            gemm_f32_tile(ldsf, g, tm * 128, tn * 128, [&](int r, int c, float v) { dst[(size_t)r * 1024 + c] = v * 0.0625f; });
        }
    }
    SEAM(9);
    if (IN(10)) {
        for (int row = gw; row < NTOK * 4; row += NGW) {
            float* p = SC + (size_t)row * 256 + 4 * lane;
            f32x4 v = *(const f32x4*)p;
            float m = fmaxf(fmaxf(v[0], v[1]), fmaxf(v[2], v[3]));
#pragma unroll
            for (int o = 1; o < 64; o <<= 1) m = fmaxf(m, __shfl_xor(m, o));
            v[0] = expf(v[0] - m); v[1] = expf(v[1] - m); v[2] = expf(v[2] - m); v[3] = expf(v[3] - m);
            const float s = wave_sum((v[0] + v[1]) + (v[2] + v[3]));
            *(f32x4*)p = v * (1.f / s);
        }
    }
    SEAM(10);
    if (IN(11)) {
        const int per = (SEQ / 128) * 2;
        for (int t = bx; t < BATCH * 4 * per; t += G) {
            const int bh = t / per, tt = t % per, b = bh >> 2, h = bh & 3, tm = tt >> 1, tn = tt & 1;
            GF g{SC + (size_t)b * SEQ * 1024 + h * 256, 1024, nullptr, 0, KVM + (size_t)b * MEMT * 2048 + 1024 + h * 256, 2048, 0, 256};
            bf16_t* dst = OM + (size_t)b * SEQ * D + h * 256;
            gemm_f32_tile(ldsf, g, tm * 128, tn * 128, [&](int r, int c, float v) { dst[(size_t)r * D + c] = f2bf(v); });
        }
    }
    SEAM(11);
    if (IN(12)) {
        pg8::DenseProb S{OM, WM_O_T, D, {}}; S.ord.init(NTOK, D, G, bx);
        pg8::EpiF32Res E{X2, D, X1, ALPHA};
        pg8::gemm_phase(ldsl, S, E);
    }
    SEAM(12);
    if (IN(13)) {
        for (int n = gw; n < NTOK; n += NGW) ln_row(X2 + (size_t)n * D, 1.f, nullptr, X2 + (size_t)n * D, ln2_g, ln2_b, lane, X2B + (size_t)n * D);
        if (bx == 0 && tid < 128) *(u32x4*)(X2B + (size_t)NTOK * D + tid * 8) = (u32x4){0u, 0u, 0u, 0u};
    }
    SEAM(13);
    if (IN(14)) {
        GF g{X2, D, nullptr, 0, w_router, NEXP, 0, D};
        const int nm = NTOK / 128, nn = NEXP / 128;
        for (int t = bx; t < nm * nn; t += G) {
            const int tm = t / nn, tn = t % nn;
            gemm_f32_tile(ldsf, g, tm * 128, tn * 128, [&](int r, int c, float v) { LOG[(size_t)r * NEXP + c] = v; });
        }
    }
    SEAM(14);
    if (IN(15)) {
        const int hl = lane >> 5;
        for (int i = bx * NTHREADS + tid; i < PMAX; i += G * NTHREADS) { STOK[i] = NTOK; SGATE[i] = 0.f; }
        for (int n = gw; n < NTOK; n += NGW) {
            float sc[4], bi[4], gso[4];
#pragma unroll
            for (int j = 0; j < 4; ++j) { const int e = lane + 64 * j; sc[j] = sigmoidf_(LOG[(size_t)n * NEXP + e]); bi[j] = sc[j] + router_bias[e]; }
#pragma unroll
            for (int j = 0; j < 4; ++j) {
                float m1 = bi[j], m2 = -INFINITY;
#pragma unroll
                for (int o = 1; o < 32; o <<= 1) { const float o1 = __shfl_xor(m1, o), o2 = __shfl_xor(m2, o);
                    const float n1 = fmaxf(m1, o1), n2 = fmaxf(fminf(m1, o1), fmaxf(m2, o2)); m1 = n1; m2 = n2; }
                gso[j] = m1 + m2;
            }
            float g8[8];
#pragma unroll
            for (int j = 0; j < 4; ++j) { const float oth = __shfl_xor(gso[j], 32); g8[2 * j] = hl ? oth : gso[j]; g8[2 * j + 1] = hl ? gso[j] : oth; }
            bool gsel[8];
#pragma unroll
            for (int a = 0; a < 8; ++a) { int rank = 0;
#pragma unroll
                for (int c = 0; c < 8; ++c) rank += ((g8[c] > g8[a]) || (g8[c] == g8[a] && c < a)) ? 1 : 0;
                gsel[a] = rank < 4; }
            float cand[4];
#pragma unroll
            for (int j = 0; j < 4; ++j) { const bool s = hl ? gsel[2 * j + 1] : gsel[2 * j]; cand[j] = s ? bi[j] : -1e30f; }
            int eidx[8]; float sel[8]; float ssum = 0.f;
#pragma unroll
            for (int k = 0; k < 8; ++k) {
                float bv = cand[0]; int be = lane;
#pragma unroll
                for (int j = 1; j < 4; ++j) if (cand[j] > bv) { bv = cand[j]; be = lane + 64 * j; }
#pragma unroll
                for (int o = 1; o < 64; o <<= 1) { const float ov = __shfl_xor(bv, o); const int oe = __shfl_xor(be, o);
                    if (ov > bv || (ov == bv && oe < be)) { bv = ov; be = oe; } }
                eidx[k] = be;
                const int jw = be >> 6, lw = be & 63;
                const float mys = jw == 0 ? sc[0] : (jw == 1 ? sc[1] : (jw == 2 ? sc[2] : sc[3]));
                sel[k] = __shfl(mys, lw); ssum += sel[k];
#pragma unroll
                for (int j = 0; j < 4; ++j) if (lane == lw && j == jw) cand[j] = -INFINITY;
            }
#pragma unroll
            for (int k = 0; k < 8; ++k) {
                if (lane == k) {
                    const int e = eidx[k];
                    const int pos = (int)atomicAdd(&ctl[CW_CNT + e], 1u);
                    EIDX[n * 8 + k] = e; GATE[n * 8 + k] = sel[k] / ssum * 2.5f; POS[n * 8 + k] = pos;
                }
            }
        }
    }
    SEAM(15);
    if (IN(16)) {
        if (bx == 0) {
            int* soff = (int*)ldsf;
            if (tid == 0) { int acc = 0, cacc = 0; for (int e = 0; e < NEXP; ++e) { soff[e] = acc; soff[512 + e] = cacc; const int c = (int)ctl[CW_CNT + e]; acc += ((c + MOE_TR - 1) / MOE_TR) * MOE_TR; cacc += c; } soff[NEXP] = acc; }
            __syncthreads();
            if (tid <= NEXP) ctl[CW_OFF + tid] = (unsigned)soff[tid];
            if (tid < NEXP) ctl[CW_CST + tid] = (unsigned)soff[512 + tid];
            if (tid == 0) ctl[CW_NT] = (unsigned)(soff[NEXP] / MOE_TR);
            if (tid < NEXP) { for (int t = soff[tid] / MOE_TR; t < soff[tid + 1] / MOE_TR; ++t) TEXP[t] = tid; }
        }
    }
    SEAM(16);
    if (IN(17)) {
        for (int i = bx * NTHREADS + tid; i < NK; i += G * NTHREADS) {
            const int e = EIDX[i], p = (int)ctl[CW_OFF + e] + POS[i];
            STOK[p] = i >> 3; SGATE[p] = GATE[i]; YROW[i] = (int)ctl[CW_CST + e] + POS[i];
        }
    }
    SEAM(17);
    if (IN(18)) {
        const int ntm = (int)ctl[CW_NT];
        { pg8::GatherProb S{X2B, STOK, WE_GU_T, TEXP, D, 2, ntm * 2, G, bx, (size_t)512 * D * 2}; pg8::EpiSwiGLU E{HH, EDIM}; pg8::gemm_phase(ldsl, S, E); }
        { pg8::DenseProb S{X2B, WS_GU_T, D, {}}; S.ord.init(NTOK, 512, G, bx); pg8::EpiSwiGLU E{HS, EDIM}; pg8::gemm_phase(ldsl, S, E); }
    }
    SEAM(18);
    if (IN(19)) {
        const int ntm = (int)ctl[CW_NT];
        { pg8::GroupedProb S{HH, WE_D_T, TEXP, EDIM, 4, ntm * 4, G, bx, (size_t)D * EDIM * 2}; pg8::EpiScaleY E{YY, SGATE, ctl + CW_OFF, ctl + CW_CNT, ctl + CW_CST}; pg8::gemm_phase(ldsl, S, E); }
        { pg8::DenseProb S{HS, WS_D_T, EDIM, {}}; S.ord.init(NTOK, D, G, bx); pg8::EpiF32Res E{out, D, X2, ALPHA}; pg8::gemm_phase(ldsl, S, E); }
    }
    SEAM(19);
    if (IN(20)) {
        for (int n = gw; n < NTOK; n += NGW) {
            float v[16];
            float* orow = out + (size_t)n * D;
#pragma unroll
            for (int j = 0; j < 2; ++j) { const f32x4 a = *(const f32x4*)(orow + 512 * j + 8 * lane), b = *(const f32x4*)(orow + 512 * j + 8 * lane + 4);
#pragma unroll
                for (int q = 0; q < 4; ++q) { v[8 * j + q] = a[q]; v[8 * j + 4 + q] = b[q]; } }
            int yr[8];
#pragma unroll
            for (int k = 0; k < 8; ++k) yr[k] = YROW[n * 8 + k];
#pragma unroll
            for (int k = 0; k < 8; ++k) {
                const bf16_t* yrow = YY + (size_t)yr[k] * D;
#pragma unroll
                for (int j = 0; j < 2; ++j) { const u32x4 w = *(const u32x4*)(yrow + 512 * j + 8 * lane);
#pragma unroll
                    for (int q = 0; q < 4; ++q) { v[8 * j + 2 * q] += __builtin_bit_cast(float, w[q] << 16); v[8 * j + 2 * q + 1] += __builtin_bit_cast(float, w[q] & 0xffff0000u); } }
            }
            float s = 0.f;
#pragma unroll
            for (int i = 0; i < 16; ++i) s += v[i];
            const float mean = wave_sum(s) * (1.f / D); float s2 = 0.f;
#pragma unroll
            for (int i = 0; i < 16; ++i) { v[i] -= mean; s2 += v[i] * v[i]; }
            const float rstd = 1.f / sqrtf(wave_sum(s2) * (1.f / D) + LN_EPS);
#pragma unroll
            for (int j = 0; j < 2; ++j) {
                const f32x4 g0 = *(const f32x4*)(ln3_g + 512 * j + 8 * lane), g1 = *(const f32x4*)(ln3_g + 512 * j + 8 * lane + 4);
                const f32x4 b0 = *(const f32x4*)(ln3_b + 512 * j + 8 * lane), b1 = *(const f32x4*)(ln3_b + 512 * j + 8 * lane + 4);
                f32x4 o0, o1;
#pragma unroll
                for (int q = 0; q < 4; ++q) { o0[q] = v[8 * j + q] * rstd * g0[q] + b0[q]; o1[q] = v[8 * j + 4 + q] * rstd * g1[q] + b1[q]; }
                *(f32x4*)(orow + 512 * j + 8 * lane) = o0; *(f32x4*)(orow + 512 * j + 8 * lane + 4) = o1;
            }
        }
    }
#undef IN
#undef SEAM
}

#ifndef PHASE_MASK
#define PHASE_MASK 0x1FFFFFu
#endif
#ifndef ONE_LAUNCH
#define ONE_LAUNCH 1
#endif

extern "C" void kernel_launch(void* const* d_in, const int* in_sizes, int n_in, void* d_out, int out_size, void* d_ws, size_t ws_size, hipStream_t stream) {
    static int grid = 0;
    if (grid == 0) {
        if (n_in != 34 || out_size != NTOK * D || ws_size < WS_END) { fprintf(stderr, "kernel_launch: unexpected shapes (n_in %d out %d ws %zu)\n", n_in, out_size, ws_size); grid = -1; return; }
        int dev = 0, cus = 0;
        if (hipGetDevice(&dev) != hipSuccess || hipDeviceGetAttribute(&cus, hipDeviceAttributeMultiprocessorCount, dev) != hipSuccess) { grid = -1; return; }
        if (hipFuncSetAttribute((const void*)mega, hipFuncAttributeMaxDynamicSharedMemorySize, LDS_BYTES) != hipSuccess) { fprintf(stderr, "kernel_launch: hipFuncSetAttribute failed\n"); grid = -1; return; }
        (void)hipGetLastError();
        grid = cus;
    }
    if (grid < 0) return;
    (void)hipMemsetAsync((char*)d_ws + WS_CTL, 0, CTL_ZERO_BYTES, stream);
    Args a{};
    for (int i = 0; i < 34; ++i) a.in[i] = (const float*)d_in[i];
    a.out = (float*)d_out; a.ws = (unsigned char*)d_ws;
#if ONE_LAUNCH
    a.ph_lo = 0; a.ph_hi = NPHASES;
    hipLaunchKernelGGL(mega, dim3(grid), dim3(NTHREADS), LDS_BYTES, stream, a);
#else
    for (int p = 0; p < NPHASES; ++p) { if (!((PHASE_MASK >> p) & 1)) continue; a.ph_lo = p; a.ph_hi = p + 1; hipLaunchKernelGGL(mega, dim3(grid), dim3(NTHREADS), LDS_BYTES, stream, a); }
#endif
}
```

```cpp
#include <hip/hip_runtime.h>
#include <cstdio>
#include <cstdint>

constexpr int D = 1024, BATCH = 4, SEQ = 8192, NTOK = BATCH * SEQ;
constexpr int MEMT = 256;
constexpr int RW = 512, RCOLS = 1792, INCOLS = 2560;
constexpr int C_R = 0, C_K = 512, C_V = 1024, C_WD = 1536, C_AD = 1600, C_GD = 1664, C_Q = 1792, C_KS = 2304, C_VS = 2432;
constexpr int NEXP = 256, TOPK = 8, EDIM = 256;
constexpr int NK = NTOK * TOPK;
constexpr int CH = 128, NCH = SEQ / CH;
constexpr int MOE_TR = 256;
constexpr int PMAX = NK + NEXP * MOE_TR;
constexpr float LN_EPS = 1e-5f, GN_EPS = 64e-5f;
constexpr float ALPHA = 1.189207115002721f;

constexpr size_t MiB = 1u << 20;
constexpr size_t WS_CTL = 0, CTL_ZERO_BYTES = 64 * 1024;
constexpr size_t WS_TEXP = 512 * 1024;
constexpr size_t WS_ROPE = 1 * MiB;
constexpr size_t WS_EIDX = 9 * MiB, WS_GATE = 10 * MiB, WS_POS = 11 * MiB, WS_YROW = 12 * MiB;
constexpr size_t WS_STOK = 13 * MiB, WS_SGATE = 14 * MiB + 512 * 1024;
constexpr size_t WS_WIN = 16 * MiB, WS_WO = 21 * MiB, WS_WMQ = 23 * MiB, WS_WMKV = 25 * MiB, WS_WMO = 29 * MiB, WS_WSGU = 31 * MiB, WS_WSD = 32 * MiB;
constexpr size_t WS_MEMB = 36 * MiB;
constexpr size_t WS_WED = 40 * MiB;
constexpr size_t WS_WEGU = 168 * MiB;
constexpr size_t WS_XB = 424 * MiB;
constexpr size_t WS_U = 490 * MiB;
constexpr size_t WS_LRB = 650 * MiB;
constexpr size_t WS_DWAG = 666 * MiB;
constexpr size_t WS_YLOC = 762 * MiB;
constexpr size_t WS_ZB = 826 * MiB;
constexpr size_t WS_PT = 858 * MiB;
constexpr size_t WS_SLT = 424 * MiB;
constexpr size_t WS_SIN = 456 * MiB;
constexpr size_t WS_BONUS = 472 * MiB;
constexpr size_t WS_WLR = 33 * MiB;
constexpr size_t WS_MIX = 874 * MiB;
constexpr size_t WS_X1 = 424 * MiB;
constexpr size_t WS_X1B = 552 * MiB;
constexpr size_t WS_QM = 616 * MiB;
constexpr size_t WS_KVM = 744 * MiB;
constexpr size_t WS_SC = 752 * MiB;
constexpr size_t WS_OM = 880 * MiB;
constexpr size_t WS_X2B = 424 * MiB;
constexpr size_t WS_LOG = 490 * MiB;
constexpr size_t WS_H = 768 * MiB;
constexpr size_t WS_HS = 928 * MiB;
constexpr size_t WS_Y = 168 * MiB;
constexpr size_t WS_END = 944 * MiB;
constexpr int CW_CNT = 0, CW_OFF = 512, CW_NT = 1024, CW_CST = 1280, CW_BAR = 4096;

constexpr int NTHREADS = 512, NWAVES = 8;
constexpr int LDS_BYTES = 147456;
constexpr int MISC_OFF = 140 * 1024;

#define LAS __attribute__((address_space(3)))
typedef float f32x4 __attribute__((ext_vector_type(4)));
typedef float f32x16 __attribute__((ext_vector_type(16)));

#define XB_TMO      128
#define XB_XCNT(j)  (256  + 64 * (j))
#define XB_XSUB(j)  (1280 + 64 * (j))
#define XB_XGEN(j)  (2304 + 64 * (j))
#define XB_TOP      3328
#define XB_TOPGEN   3392
#define XCD_BAR_WORDS 3456
#define XB_SPIN_CAP (1u << 18)
__device__ __forceinline__ unsigned xb_ld(unsigned* p)              { return __hip_atomic_load(p, __ATOMIC_RELAXED, __HIP_MEMORY_SCOPE_AGENT); }
__device__ __forceinline__ unsigned xb_add(unsigned* p, unsigned v) { return __hip_atomic_fetch_add(p, v, __ATOMIC_RELAXED, __HIP_MEMORY_SCOPE_AGENT); }
__device__ __forceinline__ unsigned xb_xcc_id() { return (unsigned)__builtin_amdgcn_s_getreg((3 << 11) | 20) & 0xFu; }
#define XB_SPIN(cond, bar) do { unsigned _sp = 0; while (cond) { __builtin_amdgcn_s_sleep(1); \
    if ((++_sp & 255u) == 0u) { if (xb_ld(&(bar)[XB_TMO])) break; if (_sp > XB_SPIN_CAP) { atomicAdd(&(bar)[XB_TMO], 1u); break; } } } } while (0)
struct XcdBarrier { unsigned* bar; unsigned x; volatile LAS unsigned* st; };
__device__ __forceinline__ XcdBarrier xcd_barrier_post(unsigned* bar, volatile LAS unsigned* st) {
    XcdBarrier b; b.bar = bar; b.x = xb_xcc_id(); b.st = st;
    if (threadIdx.x == 0) (void)xb_add(&bar[XB_XCNT(b.x)], 1u);
    return b;
}
__device__ __forceinline__ void xcd_barrier_complete(unsigned* bar, unsigned x, unsigned& nloc, unsigned& nx) {
    const unsigned G = gridDim.x * gridDim.y * gridDim.z;
    unsigned sum, cnt, mine, sp = 0u;
    for (;;) {
        sum = 0u; cnt = 0u; mine = 0u;
#pragma unroll
        for (unsigned j = 0; j < 16; ++j) { const unsigned c = xb_ld(&bar[XB_XCNT(j)]); sum += c; cnt += (c > 0u) ? 1u : 0u; mine = (j == x) ? c : mine; }
        if (sum == G) break;
        __builtin_amdgcn_s_sleep(1);
        if ((++sp & 255u) == 0u) { if (xb_ld(&bar[XB_TMO])) break; if (sp > XB_SPIN_CAP) { atomicAdd(&bar[XB_TMO], 1u); break; } }
    }
    nloc = mine > 0u ? mine : 1u; nx = cnt > 0u ? cnt : 1u;
}
__device__ __forceinline__ void xcd_barrier(const XcdBarrier& b) {
    asm volatile("s_waitcnt vmcnt(0)" ::: "memory");
    __syncthreads();
    if (threadIdx.x == 0) {
        unsigned* bar = b.bar;
        __builtin_amdgcn_s_waitcnt(0);
        unsigned nloc = b.st[0], nx = b.st[1];
        if (nloc == 0u) { xcd_barrier_complete(bar, b.x, nloc, nx); b.st[0] = nloc; b.st[1] = nx; }
        const unsigned old = xb_add(&bar[XB_XSUB(b.x)], 1u);
        const unsigned gen = old / nloc;
        if (old + 1u == (gen + 1u) * nloc) {
            __builtin_amdgcn_fence(__ATOMIC_RELEASE, "agent");
            asm volatile("s_waitcnt vmcnt(0)" ::: "memory");
            const unsigned og = xb_add(&bar[XB_TOP], 1u);
            const unsigned tg = og / nx;
            if (og + 1u == (tg + 1u) * nx) xb_add(&bar[XB_TOPGEN], 1u);
            else XB_SPIN(xb_ld(&bar[XB_TOPGEN]) == tg, bar);
            __builtin_amdgcn_fence(__ATOMIC_ACQUIRE, "agent");
            xb_add(&bar[XB_XGEN(b.x)], 1u);
            asm volatile("s_waitcnt vmcnt(0)" ::: "memory");
        } else {
            XB_SPIN(xb_ld(&bar[XB_XGEN(b.x)]) == gen, bar);
            __builtin_amdgcn_fence(__ATOMIC_ACQUIRE, "agent");
            asm volatile("s_waitcnt vmcnt(0)" ::: "memory");
        }
    }
    __syncthreads();
}

namespace pg8 {
#define PG8_LAS __attribute__((address_space(3)))
typedef unsigned short bf16_t;
typedef short bf16x8 __attribute__((ext_vector_type(8)));
typedef float f32x4 __attribute__((ext_vector_type(4)));
typedef float f32x2 __attribute__((ext_vector_type(2)));
typedef unsigned u32x4 __attribute__((ext_vector_type(4)));
constexpr int BM = 256, BK = 64, HALF = 128, HTB = HALF * BK * 2, STAGE_BYTES = 8 * HTB, NXCD = 8, WGM = 8;
__host__ __device__ __forceinline__ int lds_byte(int r, int c) { const int st = (r >> 4) * 2 + (c >> 5), rr = r & 15, cc = c & 31, ob = rr * 64 + cc * 2; return st * 1024 + (ob ^ (((ob >> 9) & 1) << 5)); }
__host__ __device__ __forceinline__ void stage_rc(int b, int& R, int& C) { const int st = b / 1024, sb = b % 1024, swz = sb ^ (((sb >> 9) & 1) << 5); R = (st >> 1) * 16 + swz / 64; C = (st & 1) * 32 + (swz % 64) / 2; }
__host__ __device__ __forceinline__ int perm32(int rho) { const int n = rho >> 4, i = rho & 15; return 8 * (i >> 2) + 4 * n + (i & 3); }
__device__ __forceinline__ unsigned cvt_pk_bf16(float lo, float hi) { unsigned r; asm volatile("v_cvt_pk_bf16_f32 %0, %1, %2" : "=v"(r) : "v"(lo), "v"(hi)); return r; }

struct Unit { int pm, pn, e; };
struct StaticOrder {
    int nM, nN, nwg, G, c;
    __host__ __device__ void init(int M, int N, int G_, int c_) { nM = M / BM; nN = N / BM; nwg = nM * nN; G = G_; c = c_; }
    __host__ __device__ bool next(int i, Unit& u) const {
        const long L = (long)i * G + c; if (L >= nwg) return false;
        int wgid = (int)L; { const int q = nwg / NXCD, r = nwg % NXCD, xcd = wgid % NXCD, off = wgid / NXCD; wgid = (xcd < r ? xcd * (q + 1) : r * (q + 1) + (xcd - r) * q) + off; }
        const int nig = WGM * nN, gid = wgid / nig, fm = gid * WGM, gsz = (nM - fm) < WGM ? (nM - fm) : WGM;
        u.pm = fm + ((wgid % nig) % gsz); u.pn = (wgid % nig) / gsz; u.e = 0; return true;
    }
};
struct DenseProb {
    const bf16_t* A; const bf16_t* Bt; int K; StaticOrder ord;
    __device__ __forceinline__ bool next(int i, Unit& u) const { return ord.next(i, u); }
    __device__ __forceinline__ const char* a_base(const Unit& u) const { return (const char*)A + (size_t)u.pm * BM * K * 2; }
    __device__ __forceinline__ const char* b_base(const Unit& u) const { return (const char*)Bt + (size_t)u.pn * BM * K * 2; }
    __device__ __forceinline__ void a_offs(const Unit&, unsigned (&v)[2][2], const int (&R)[2], const int (&C)[2]) const {
#pragma unroll
        for (int h = 0; h < 2; ++h)
#pragma unroll
            for (int i = 0; i < 2; ++i) v[h][i] = (unsigned)((h * HALF + R[i]) * K + C[i]) * 2u;
    }
};
struct GatherProb {
    const bf16_t* X; const int* stok; const bf16_t* Bt; const int* texp; int K, nN, nunits, G, c; size_t estride;
    __device__ __forceinline__ bool next(int i, Unit& u) const {
        const long L = (long)i * G + c; if (L >= nunits) return false;
        u.pm = (int)(L / nN); u.pn = (int)(L % nN); u.e = texp[u.pm]; return true;
    }
    __device__ __forceinline__ const char* a_base(const Unit&) const { return (const char*)X; }
    __device__ __forceinline__ const char* b_base(const Unit& u) const { return (const char*)Bt + (size_t)u.e * estride + (size_t)u.pn * BM * K * 2; }
    __device__ __forceinline__ void a_offs(const Unit& u, unsigned (&v)[2][2], const int (&R)[2], const int (&C)[2]) const {
#pragma unroll
        for (int h = 0; h < 2; ++h)
#pragma unroll
            for (int i = 0; i < 2; ++i) { const int tok = stok[u.pm * BM + h * HALF + R[i]]; v[h][i] = (unsigned)(tok * K + C[i]) * 2u; }
    }
};
struct GroupedProb {
    const bf16_t* A; const bf16_t* Bt; const int* texp; int K, nN, nunits, G, c; size_t estride;
    __device__ __forceinline__ bool next(int i, Unit& u) const {
        const long L = (long)i * G + c; if (L >= nunits) return false;
        u.pm = (int)(L / nN); u.pn = (int)(L % nN); u.e = texp[u.pm]; return true;
    }
    __device__ __forceinline__ const char* a_base(const Unit& u) const { return (const char*)A + (size_t)u.pm * BM * K * 2; }
    __device__ __forceinline__ const char* b_base(const Unit& u) const { return (const char*)Bt + (size_t)u.e * estride + (size_t)u.pn * BM * K * 2; }
    __device__ __forceinline__ void a_offs(const Unit&, unsigned (&v)[2][2], const int (&R)[2], const int (&C)[2]) const {
#pragma unroll
        for (int h = 0; h < 2; ++h)
#pragma unroll
            for (int i = 0; i < 2; ++i) v[h][i] = (unsigned)((h * HALF + R[i]) * K + C[i]) * 2u;
    }
};

struct EpiBf16 {
    static constexpr bool PERM = true;
    bf16_t* O; int ldc;
    __device__ __forceinline__ void operator()(const f32x4 (&acc)[2][2][4][2], const Unit& u, int wr, int wc, int fr, int fq) const {
        const int row0 = u.pm * BM + wr * 64 + fr, col0 = u.pn * BM + wc * 32 + 8 * fq;
#pragma unroll
        for (int ai = 0; ai < 2; ++ai)
#pragma unroll
            for (int m = 0; m < 4; ++m) { bf16_t* rowp = O + (size_t)(row0 + ai * HALF + m * 16) * ldc + col0;
#pragma unroll
                for (int bj = 0; bj < 2; ++bj) { const f32x4 v0 = acc[ai][bj][m][0], v1 = acc[ai][bj][m][1];
                    u32x4 w; w.x = cvt_pk_bf16(v0[0], v0[1]); w.y = cvt_pk_bf16(v0[2], v0[3]); w.z = cvt_pk_bf16(v1[0], v1[1]); w.w = cvt_pk_bf16(v1[2], v1[3]);
                    *(u32x4*)(rowp + bj * HALF) = w; } }
    }
};
struct EpiF32Res {
    static constexpr bool PERM = false;
    float* C; int ldc; const float* base; float alpha;
    __device__ __forceinline__ void operator()(const f32x4 (&acc)[2][2][4][2], const Unit& u, int wr, int wc, int fr, int fq) const {
        const int row0 = u.pm * BM + wr * 64 + fr, col0 = u.pn * BM + wc * 32 + 4 * fq;
#pragma unroll
        for (int ai = 0; ai < 2; ++ai)
#pragma unroll
            for (int m = 0; m < 4; ++m) { const size_t off = (size_t)(row0 + ai * HALF + m * 16) * ldc + col0;
#pragma unroll
                for (int bj = 0; bj < 2; ++bj)
#pragma unroll
                    for (int n = 0; n < 2; ++n) { f32x4 o = acc[ai][bj][m][n];
                        if (base) o += *(const f32x4*)(base + off + bj * HALF + n * 16) * alpha;
                        *(f32x4*)(C + off + bj * HALF + n * 16) = o; } }
    }
};

struct EpiSwiGLU {
    static constexpr bool PERM = true;
    bf16_t* O; int ldc;
    __device__ __forceinline__ void operator()(const f32x4 (&acc)[2][2][4][2], const Unit& u, int wr, int wc, int fr, int fq) const {
        const int row0 = u.pm * BM + wr * 64 + fr, col0 = u.pn * HALF + wc * 32 + 8 * fq;
#pragma unroll
        for (int ai = 0; ai < 2; ++ai)
#pragma unroll
            for (int m = 0; m < 4; ++m) { bf16_t* rowp = O + (size_t)(row0 + ai * HALF + m * 16) * ldc + col0;
                float h[8];
#pragma unroll
                for (int n = 0; n < 2; ++n)
#pragma unroll
                    for (int q = 0; q < 4; ++q) { const float g = acc[ai][0][m][n][q], up = acc[ai][1][m][n][q]; h[4 * n + q] = g * __builtin_amdgcn_rcpf(1.f + __expf(-g)) * up; }
                u32x4 w; w.x = cvt_pk_bf16(h[0], h[1]); w.y = cvt_pk_bf16(h[2], h[3]); w.z = cvt_pk_bf16(h[4], h[5]); w.w = cvt_pk_bf16(h[6], h[7]);
                *(u32x4*)rowp = w; }
    }
};
struct EpiScaleY {
    static constexpr bool PERM = true;
    bf16_t* Y; const float* sgate; const unsigned* off; const unsigned* cnt; const unsigned* cst;
    __device__ __forceinline__ void operator()(const f32x4 (&acc)[2][2][4][2], const Unit& u, int wr, int wc, int fr, int fq) const {
        const int o0 = (int)off[u.e], nreal = (int)cnt[u.e], c0 = (int)cst[u.e];
        const int row0 = u.pm * BM + wr * 64 + fr, col0 = u.pn * BM + wc * 32 + 8 * fq;
#pragma unroll
        for (int ai = 0; ai < 2; ++ai)
#pragma unroll
            for (int m = 0; m < 4; ++m) { const int p = row0 + ai * HALF + m * 16, rel = p - o0;
                if (rel < nreal) { const float gs = sgate[p]; bf16_t* rowp = Y + (size_t)(c0 + rel) * 1024 + col0;
#pragma unroll
                    for (int bj = 0; bj < 2; ++bj) { const f32x4 v0 = acc[ai][bj][m][0] * gs, v1 = acc[ai][bj][m][1] * gs;
                        u32x4 w; w.x = cvt_pk_bf16(v0[0], v0[1]); w.y = cvt_pk_bf16(v0[2], v0[3]); w.z = cvt_pk_bf16(v1[0], v1[1]); w.w = cvt_pk_bf16(v1[2], v1[3]);
                        *(u32x4*)(rowp + bj * HALF) = w; } } }
    }
};

template <class Epi, class Prob>
__device__ __forceinline__ void gemm_phase(PG8_LAS unsigned char* lds, const Prob& S, const Epi& E) {
    const int tid = threadIdx.x, wid = __builtin_amdgcn_readfirstlane(tid >> 6), lane = tid & 63, wr = wid >> 2, wc = wid & 3, fr = lane & 15, fq = lane >> 4;
    const int K = S.K, nt = K / BK;
    int Rr[2], Cc[2]; unsigned voffB[2];
#pragma unroll
    for (int i = 0; i < 2; ++i) { int R, C; stage_rc(tid * 16 + i * 8192, R, C); const int Rb = Epi::PERM ? ((R & ~31) + perm32(R & 31)) : R;
        Rr[i] = R; Cc[i] = C; voffB[i] = (unsigned)(Rb * K + C) * 2u; }
    const size_t kstep = (size_t)(BK * 2);
    const size_t hstep = (size_t)HALF * K * 2;
    const unsigned ldsw = (unsigned)wid * 1024u;
    const int aoff = lds_byte(wr * 64 + fr, fq * 8), boff = lds_byte(wc * 32 + fr, fq * 8);
#define PG8_SA(b, h) (((b) * 2 + (h)) * HTB)
#define PG8_SB(b, h) ((4 + (b) * 2 + (h)) * HTB)
#define PG8_STAGE(bufoff, gbase, voff) do { _Pragma("unroll") for (int _i = 0; _i < 2; ++_i) \
        __builtin_amdgcn_global_load_lds((const unsigned*)((const char*)(gbase) + (voff)[_i]), (PG8_LAS unsigned*)(lds + (bufoff) + ldsw + _i * 8192), 16, 0, 0); } while (0)
#define PG8_LDA(dst, b, h) do { _Pragma("unroll") for (int m = 0; m < 4; ++m) _Pragma("unroll") for (int k = 0; k < 2; ++k) dst[m][k] = *(const PG8_LAS bf16x8*)(lds + PG8_SA(b, h) + aoff + m * 2048 + k * 1024); } while (0)
#define PG8_LDB(dst, b, h) do { _Pragma("unroll") for (int n = 0; n < 2; ++n) _Pragma("unroll") for (int k = 0; k < 2; ++k) dst[n][k] = *(const PG8_LAS bf16x8*)(lds + PG8_SB(b, h) + boff + n * 2048 + k * 1024); } while (0)
#define PG8_MMA(ai, bj, At, Bt) do { __builtin_amdgcn_s_setprio(1); _Pragma("unroll") for (int m = 0; m < 4; ++m) _Pragma("unroll") for (int n = 0; n < 2; ++n) _Pragma("unroll") for (int k = 0; k < 2; ++k) \
        acc[ai][bj][m][n] = __builtin_amdgcn_mfma_f32_16x16x32_bf16(Bt[n][k], At[m][k], acc[ai][bj][m][n], 0, 0, 0); __builtin_amdgcn_s_setprio(0); } while (0)
#define PG8_WAIT_V(n) asm volatile("s_waitcnt vmcnt(" #n ")" ::: "memory")
#define PG8_WAIT_L(n) asm volatile("s_waitcnt lgkmcnt(" #n ")" ::: "memory")
#define PG8_BAR __builtin_amdgcn_s_barrier()
#define PG8_SCHED __builtin_amdgcn_sched_barrier(0)
    Unit cur, nxt; int ui = 0;
    if (!S.next(0, cur)) return;
    f32x4 acc[2][2][4][2];
#pragma unroll
    for (int a = 0; a < 2; ++a)
#pragma unroll
        for (int b = 0; b < 2; ++b)
#pragma unroll
            for (int m = 0; m < 4; ++m)
#pragma unroll
                for (int n = 0; n < 2; ++n) acc[a][b][m][n] = (f32x4){0.f, 0.f, 0.f, 0.f};
    bf16x8 At[4][2], B0[2][2], B1[2][2];
    const char* cA = S.a_base(cur); const char* cB = S.b_base(cur);
    unsigned vA[2][2], nvA[2][2];
    S.a_offs(cur, vA, Rr, Cc);
    PG8_STAGE(PG8_SB(0, 0), cB, voffB); PG8_STAGE(PG8_SA(0, 0), cA, vA[0]); PG8_STAGE(PG8_SB(0, 1), cB + hstep, voffB); PG8_STAGE(PG8_SA(0, 1), cA, vA[1]);
    if (wr == 1) PG8_BAR;
    PG8_WAIT_V(4); PG8_BAR;
    PG8_STAGE(PG8_SB(1, 0), cB + kstep, voffB); PG8_STAGE(PG8_SA(1, 0), cA + kstep, vA[0]); PG8_STAGE(PG8_SB(1, 1), cB + hstep + kstep, voffB);
    PG8_WAIT_V(6); PG8_BAR;
    for (;;) {
        const bool has_next = S.next(ui + 1, nxt);
        const char* nA = has_next ? S.a_base(nxt) : cA; const char* nB = has_next ? S.b_base(nxt) : cB;
        if (has_next) S.a_offs(nxt, nvA, Rr, Cc);
        else {
#pragma unroll
            for (int h = 0; h < 2; ++h)
#pragma unroll
                for (int i = 0; i < 2; ++i) nvA[h][i] = vA[h][i];
        }
        for (int t = 0; t < nt; t += 2) {
            const bool last = (t == nt - 2);
            const char* a1 = cA + (size_t)(t + 1) * kstep;
            const char* a2 = last ? nA : cA + (size_t)(t + 2) * kstep; const char* b2 = last ? nB : cB + (size_t)(t + 2) * kstep;
            const char* a3 = a2 + kstep; const char* b3 = b2 + kstep;
            unsigned v2[2][2];
#pragma unroll
            for (int h = 0; h < 2; ++h)
#pragma unroll
                for (int i = 0; i < 2; ++i) v2[h][i] = last ? nvA[h][i] : vA[h][i];
            PG8_LDB(B0, 0, 0); PG8_SCHED; PG8_LDA(At, 0, 0); PG8_STAGE(PG8_SA(1, 1), a1, vA[1]);
            PG8_WAIT_L(8); PG8_BAR; PG8_WAIT_L(0); PG8_MMA(0, 0, At, B0); PG8_BAR; PG8_SCHED;
            PG8_LDB(B1, 0, 1); PG8_STAGE(PG8_SB(0, 0), b2, voffB);
            PG8_BAR; PG8_WAIT_L(0); PG8_MMA(0, 1, At, B1); PG8_BAR;
            PG8_LDA(At, 0, 1); PG8_STAGE(PG8_SA(0, 0), a2, v2[0]);
            PG8_BAR; PG8_WAIT_L(0); PG8_MMA(1, 0, At, B0); PG8_BAR; PG8_SCHED;
            PG8_STAGE(PG8_SB(0, 1), b2 + hstep, voffB);
            PG8_WAIT_V(6); PG8_BAR; PG8_MMA(1, 1, At, B1); PG8_BAR;
            PG8_LDB(B0, 1, 0); PG8_SCHED; PG8_LDA(At, 1, 0); PG8_STAGE(PG8_SA(0, 1), a2, v2[1]);
            PG8_WAIT_L(8); PG8_BAR; PG8_WAIT_L(0); PG8_MMA(0, 0, At, B0); PG8_BAR; PG8_SCHED;
            PG8_LDB(B1, 1, 1); PG8_STAGE(PG8_SB(1, 0), b3, voffB);
            PG8_BAR; PG8_WAIT_L(0); PG8_MMA(0, 1, At, B1); PG8_BAR;
            PG8_LDA(At, 1, 1); PG8_STAGE(PG8_SA(1, 0), a3, v2[0]);
            PG8_BAR; PG8_WAIT_L(0); PG8_MMA(1, 0, At, B0); PG8_BAR; PG8_SCHED;
            PG8_STAGE(PG8_SB(1, 1), b3 + hstep, voffB);
            PG8_WAIT_V(6); PG8_BAR; PG8_MMA(1, 1, At, B1); PG8_BAR;
        }
        E(acc, cur, wr, wc, fr, fq);
        if (!has_next) break;
#pragma unroll
        for (int a = 0; a < 2; ++a)
#pragma unroll
            for (int b = 0; b < 2; ++b)
#pragma unroll
                for (int m = 0; m < 4; ++m)
#pragma unroll
                    for (int n = 0; n < 2; ++n) acc[a][b][m][n] = (f32x4){0.f, 0.f, 0.f, 0.f};
        cur = nxt; cA = nA; cB = nB; ++ui;
#pragma unroll
        for (int h = 0; h < 2; ++h)
#pragma unroll
            for (int i = 0; i < 2; ++i) vA[h][i] = nvA[h][i];
    }
    PG8_WAIT_V(0);
    if (wr == 0) PG8_BAR;
    PG8_BAR;
#undef PG8_SA
#undef PG8_SB
#undef PG8_STAGE
#undef PG8_LDA
#undef PG8_LDB
#undef PG8_MMA
#undef PG8_WAIT_V
#undef PG8_WAIT_L
#undef PG8_BAR
#undef PG8_SCHED
}
}

__device__ __forceinline__ float wave_sum(float v) {
#pragma unroll
    for (int o = 1; o < 64; o <<= 1) v += __shfl_xor(v, o);
    return v;
}
__device__ __forceinline__ float sigmoidf_(float x) { return 1.0f / (1.0f + expf(-x)); }

typedef unsigned short bf16_t;
typedef unsigned u32x4 __attribute__((ext_vector_type(4)));
typedef unsigned u32x2 __attribute__((ext_vector_type(2)));
__device__ __forceinline__ float bf2f(bf16_t b) { return __builtin_bit_cast(float, (unsigned)b << 16); }
__device__ __forceinline__ bf16_t f2bf(float f) { return (bf16_t)(pg8::cvt_pk_bf16(f, 0.f) & 0xffffu); }
__device__ __forceinline__ void transpose_item(const float* W, int K, int N, bf16_t* WT, int k0, int n0, int drow0, float* scr, int lane) {
#pragma unroll 8
    for (int i = 0; i < 32; ++i) { const int kk = 2 * i + (lane >> 5); scr[kk * 33 + (lane & 31)] = W[(size_t)(k0 + kk) * N + n0 + (lane & 31)]; }
    __builtin_amdgcn_wave_barrier();
    const int c = lane & 7;
#pragma unroll
    for (int j = 0; j < 4; ++j) { const int n = (lane >> 3) + 8 * j; const float* s = scr + (8 * c) * 33 + n;
        u32x4 o; o.x = pg8::cvt_pk_bf16(s[0 * 33], s[1 * 33]); o.y = pg8::cvt_pk_bf16(s[2 * 33], s[3 * 33]); o.z = pg8::cvt_pk_bf16(s[4 * 33], s[5 * 33]); o.w = pg8::cvt_pk_bf16(s[6 * 33], s[7 * 33]);
        *(u32x4*)(WT + (size_t)(drow0 + n) * K + k0 + 8 * c) = o; }
    __builtin_amdgcn_wave_barrier();
}
struct Args {
    const float* in[34]; float* out; unsigned char* ws;
    int ph_lo, ph_hi;
};

struct GF {
    const float* A; long lda; const int* arow; int arow_lim;
    const float* B; long ldb; int bmode;
    int K;
};
template <class Epi>
__device__ __forceinline__ void gemm_f32_tile(float* lds, const GF& g, int row0, int col0, Epi&& epi) {
    float* As = lds;
    float* Bs = lds + 16 * 132;
    const int tid = threadIdx.x, lane = tid & 63, w = tid >> 6, wm = w >> 1, wn = w & 1;
    f32x16 acc0, acc1;
#pragma unroll
    for (int i = 0; i < 16; ++i) { acc0[i] = 0.f; acc1[i] = 0.f; }
    const int ar = tid >> 2, ak = (tid & 3) * 4;
    long arow_idx = row0 + ar; bool avalid = true;
    if (g.arow) { const int t = g.arow[row0 + ar]; avalid = t < g.arow_lim; arow_idx = avalid ? t : 0; }
    const float* ap = g.A + arow_idx * g.lda + ak;
    const float* bp; int bk, bn;
    if (g.bmode == 0) { bk = tid >> 5; bn = (tid & 31) * 4; bp = g.B + (long)bk * g.ldb + col0 + bn; }
    else { bn = tid >> 2; bk = (tid & 3) * 4; bp = g.B + (long)(col0 + bn) * g.ldb + bk; }
    const int hl = lane >> 5, l31 = lane & 31;
    for (int k0 = 0; k0 < g.K; k0 += 16) {
        f32x4 av = (f32x4){0.f, 0.f, 0.f, 0.f};
        if (avalid) av = *(const f32x4*)(ap + k0);
        const f32x4 bv = g.bmode == 0 ? *(const f32x4*)(bp + (long)k0 * g.ldb) : *(const f32x4*)(bp + k0);
        __syncthreads();
        As[(ak + 0) * 132 + ar] = av[0]; As[(ak + 1) * 132 + ar] = av[1]; As[(ak + 2) * 132 + ar] = av[2]; As[(ak + 3) * 132 + ar] = av[3];
        if (g.bmode == 0) *(f32x4*)&Bs[bk * 132 + bn] = bv;
        else { Bs[(bk + 0) * 132 + bn] = bv[0]; Bs[(bk + 1) * 132 + bn] = bv[1]; Bs[(bk + 2) * 132 + bn] = bv[2]; Bs[(bk + 3) * 132 + bn] = bv[3]; }
        __syncthreads();
#pragma unroll
        for (int kk = 0; kk < 16; kk += 2) {
            const float a = As[(kk + hl) * 132 + wm * 32 + l31];
            const float b0 = Bs[(kk + hl) * 132 + wn * 64 + l31];
            const float b1 = Bs[(kk + hl) * 132 + wn * 64 + 32 + l31];
            acc0 = __builtin_amdgcn_mfma_f32_32x32x2f32(a, b0, acc0, 0, 0, 0);
            acc1 = __builtin_amdgcn_mfma_f32_32x32x2f32(a, b1, acc1, 0, 0, 0);
        }
    }
#pragma unroll
    for (int r = 0; r < 16; ++r) {
        const int row = row0 + wm * 32 + (r & 3) + 8 * (r >> 2) + 4 * hl;
        const int col = col0 + wn * 64 + l31;
        epi(row, col, acc0[r]);
        epi(row, col + 32, acc1[r]);
    }
    __syncthreads();
}

__device__ __forceinline__ void ln_row(const float* a, float alpha, const float* b, float* out, const float* gam, const float* bet, int lane, bf16_t* outb = nullptr) {
    f32x4 v[4]; float s = 0.f;
#pragma unroll
    for (int j = 0; j < 4; ++j) {
        v[j] = *(const f32x4*)(a + 4 * lane + 256 * j) * alpha;
        if (b) v[j] += *(const f32x4*)(b + 4 * lane + 256 * j);
        s += (v[j][0] + v[j][1]) + (v[j][2] + v[j][3]);
    }
    const float mean = wave_sum(s) * (1.f / D); float s2 = 0.f;
#pragma unroll
    for (int j = 0; j < 4; ++j) { v[j] = v[j] - mean; s2 += (v[j][0] * v[j][0] + v[j][1] * v[j][1]) + (v[j][2] * v[j][2] + v[j][3] * v[j][3]); }
    const float rstd = 1.f / sqrtf(wave_sum(s2) * (1.f / D) + LN_EPS);
#pragma unroll
    for (int j = 0; j < 4; ++j) {
        const f32x4 gg = *(const f32x4*)(gam + 4 * lane + 256 * j), bb = *(const f32x4*)(bet + 4 * lane + 256 * j);
        const f32x4 o = v[j] * rstd * gg + bb;
        *(f32x4*)(out + 4 * lane + 256 * j) = o;
        if (outb) { u32x2 w; w.x = pg8::cvt_pk_bf16(o[0], o[1]); w.y = pg8::cvt_pk_bf16(o[2], o[3]); *(u32x2*)(outb + 4 * lane + 256 * j) = w; }
    }
}

constexpr int NPHASES = 23;

__global__ void __launch_bounds__(NTHREADS, 2) mega(Args args) {
    extern __shared__ __attribute__((aligned(16))) unsigned char lds_raw[];
    float* ldsf = (float*)lds_raw;
    const int tid = threadIdx.x, lane = tid & 63, wave = tid >> 6;
    const int G = gridDim.x, bx = blockIdx.x;
    const int gw = bx * NWAVES + wave, NGW = G * NWAVES;
    unsigned char* ws = args.ws;
    unsigned* ctl = (unsigned*)(ws + WS_CTL);
    volatile LAS unsigned* misc = (volatile LAS unsigned*)((LAS unsigned char*)lds_raw + MISC_OFF);
    if (tid < 4) misc[tid] = 0u;
    __syncthreads();
    const int lo = args.ph_lo, hi = args.ph_hi;
    const bool multi = (hi - lo) > 1;
    XcdBarrier bar; bar.bar = ctl + CW_BAR; bar.x = 0; bar.st = nullptr;
    if (multi) bar = xcd_barrier_post(ctl + CW_BAR, misc);
#define IN(k) (lo <= (k) && (k) < hi)
#define SEAM(k) do { if (IN(k) && IN((k) + 1)) xcd_barrier(bar); } while (0)

    const float* x = args.in[0]; const float* mem = args.in[1]; const int* positions = (const int*)args.in[2];
    const float* w_in = args.in[3]; const float* mu_shift = args.in[4]; const float* w_decay_up = args.in[5]; const float* w0 = args.in[6];
    const float* a_up = args.in[7]; const float* a0 = args.in[8]; const float* g_up = args.in[9]; const float* k_k = args.in[10]; const float* k_a = args.in[11];
    const float* r_k = args.in[12]; const float* lnx_g = args.in[13]; const float* lnx_b = args.in[14]; const float* sinks = args.in[15];
    const float* w_o = args.in[16]; const float* ln1_g = args.in[17]; const float* ln1_b = args.in[18];
    const float* wm_q = args.in[19]; const float* wm_kv = args.in[20]; const float* wm_o = args.in[21]; const float* ln2_g = args.in[22]; const float* ln2_b = args.in[23];
    const float* w_router = args.in[24]; const float* router_bias = args.in[25];
    const float* we_gate = args.in[26]; const float* we_up = args.in[27]; const float* we_down = args.in[28];
    const float* ws_gate = args.in[29]; const float* ws_up = args.in[30]; const float* ws_down = args.in[31];
    const float* ln3_g = args.in[32]; const float* ln3_b = args.in[33];
    float* out = args.out;

    float* ROPE_C = (float*)(ws + WS_ROPE); float* ROPE_S = ROPE_C + (size_t)NTOK * 32;
    bf16_t* W_IN_T = (bf16_t*)(ws + WS_WIN); bf16_t* W_O_T = (bf16_t*)(ws + WS_WO); bf16_t* WM_Q_T = (bf16_t*)(ws + WS_WMQ); bf16_t* WM_KV_T = (bf16_t*)(ws + WS_WMKV); bf16_t* WM_O_T = (bf16_t*)(ws + WS_WMO);
    bf16_t* XB = (bf16_t*)(ws + WS_XB); bf16_t* MEMB = (bf16_t*)(ws + WS_MEMB);
    bf16_t* U = (bf16_t*)(ws + WS_U); bf16_t* LRB = (bf16_t*)(ws + WS_LRB); bf16_t* DWAG = (bf16_t*)(ws + WS_DWAG);
    float* YLOC = (float*)(ws + WS_YLOC); bf16_t* ZB = (bf16_t*)(ws + WS_ZB); bf16_t* PT = (bf16_t*)(ws + WS_PT); float* SLT = (float*)(ws + WS_SLT); bf16_t* SIN = (bf16_t*)(ws + WS_SIN);
    float* BONUS = (float*)(ws + WS_BONUS); bf16_t* WLR_T = (bf16_t*)(ws + WS_WLR);
    bf16_t* MIX = (bf16_t*)(ws + WS_MIX); float* X1 = (float*)(ws + WS_X1); bf16_t* X1B = (bf16_t*)(ws + WS_X1B);
    float* QM = (float*)(ws + WS_QM); float* KVM = (float*)(ws + WS_KVM); float* SC = (float*)(ws + WS_SC); bf16_t* OM = (bf16_t*)(ws + WS_OM);
    float* X2 = out; bf16_t* X2B = (bf16_t*)(ws + WS_X2B); float* LOG = (float*)(ws + WS_LOG);
    int* EIDX = (int*)(ws + WS_EIDX); float* GATE = (float*)(ws + WS_GATE); int* POS = (int*)(ws + WS_POS); int* YROW = (int*)(ws + WS_YROW);
    int* STOK = (int*)(ws + WS_STOK); float* SGATE = (float*)(ws + WS_SGATE);
    bf16_t* HH = (bf16_t*)(ws + WS_H); bf16_t* HS = (bf16_t*)(ws + WS_HS); bf16_t* YY = (bf16_t*)(ws + WS_Y);
    bf16_t* WS_GU_T = (bf16_t*)(ws + WS_WSGU); bf16_t* WS_D_T = (bf16_t*)(ws + WS_WSD); bf16_t* WE_GU_T = (bf16_t*)(ws + WS_WEGU); bf16_t* WE_D_T = (bf16_t*)(ws + WS_WED);
    int* TEXP = (int*)(ws + WS_TEXP);
    PG8_LAS unsigned char* ldsl = (PG8_LAS unsigned char*)lds_raw;

    if (IN(0)) {
        for (int i = bx * NTHREADS + tid; i < NTOK * 32; i += G * NTHREADS) {
            const int n = i >> 5, f = i & 31;
            const double inv = exp(-(double)(2 * f) / 64.0 * 9.210340371976184);
            const double ang = (double)positions[n] * inv;
            ROPE_C[i] = (float)cos(ang); ROPE_S[i] = (float)sin(ang);
        }
        {
            float* scr = ldsf + wave * 4096;
            constexpr int I_IN = 16 * (INCOLS / 32), I_SQ = 16 * (D / 32), I_KV = 16 * (2048 / 32);
            constexpr int NIT = I_IN + 3 * I_SQ + I_KV;
            for (int it = gw; it < NIT; it += NGW) {
                int r = it;
                if (r < I_IN) { const int nb = INCOLS / 32; transpose_item(w_in, D, INCOLS, W_IN_T, 64 * (r / nb), 32 * (r % nb), 32 * (r % nb), scr, lane); continue; } r -= I_IN;
                if (r < I_SQ) { const int nb = D / 32; transpose_item(w_o, D, D, W_O_T, 64 * (r / nb), 32 * (r % nb), 32 * (r % nb), scr, lane); continue; } r -= I_SQ;
                if (r < I_SQ) { const int nb = D / 32; transpose_item(wm_q, D, D, WM_Q_T, 64 * (r / nb), 32 * (r % nb), 32 * (r % nb), scr, lane); continue; } r -= I_SQ;
                if (r < I_SQ) { const int nb = D / 32; transpose_item(wm_o, D, D, WM_O_T, 64 * (r / nb), 32 * (r % nb), 32 * (r % nb), scr, lane); continue; } r -= I_SQ;
                { const int nb = 2048 / 32; transpose_item(wm_kv, D, 2048, WM_KV_T, 64 * (r / nb), 32 * (r % nb), 32 * (r % nb), scr, lane); }
            }
        }
        for (int i = bx * NTHREADS + tid; i < 1536 * 256; i += G * NTHREADS) {
            const int n = i >> 8, k = i & 255; float v = 0.f;
            if (n < 512) { if (k < 64) v = w_decay_up[k * RW + n]; }
            else if (n < 1024) { if (k >= 64 && k < 128) v = a_up[(k - 64) * RW + (n - 512)]; }
            else { if (k >= 128) v = g_up[(k - 128) * RW + (n - 1024)]; }
            WLR_T[i] = f2bf(v);
        }
        {
            float* scr = ldsf + wave * 4096;
            const int NITE = (NEXP + 1) * 384;
            for (int it = gw; it < NITE; it += NGW) {
                const int e = it / 384, r = it % 384;
                const float* wg = e < NEXP ? we_gate + (size_t)e * D * EDIM : ws_gate; const float* wu = e < NEXP ? we_up + (size_t)e * D * EDIM : ws_up;
                const float* wd = e < NEXP ? we_down + (size_t)e * EDIM * D : ws_down;
                bf16_t* gu = e < NEXP ? WE_GU_T + (size_t)e * 512 * D : WS_GU_T; bf16_t* dt = e < NEXP ? WE_D_T + (size_t)e * D * EDIM : WS_D_T;
                if (r < 256) { const int isup = r >> 7, rr = r & 127, kb = rr >> 3, nb = rr & 7, n0 = 32 * nb;
                    transpose_item(isup ? wu : wg, D, EDIM, gu, 64 * kb, n0, (n0 >> 7) * 256 + isup * 128 + (n0 & 127), scr, lane); }
                else { const int rr = r - 256, kb = rr >> 5, nb = rr & 31;
                    transpose_item(wd, EDIM, D, dt, 64 * kb, 32 * nb, 32 * nb, scr, lane); }
            }
        }
        for (size_t i = (size_t)bx * NTHREADS + tid; i < (size_t)NTOK * D / 8; i += (size_t)G * NTHREADS) {
            const f32x4 a = *(const f32x4*)(x + i * 8), b = *(const f32x4*)(x + i * 8 + 4);
            u32x4 o; o.x = pg8::cvt_pk_bf16(a[0], a[1]); o.y = pg8::cvt_pk_bf16(a[2], a[3]); o.z = pg8::cvt_pk_bf16(b[0], b[1]); o.w = pg8::cvt_pk_bf16(b[2], b[3]);
            *(u32x4*)(XB + i * 8) = o;
        }
        for (size_t i = (size_t)bx * NTHREADS + tid; i < (size_t)BATCH * MEMT * D / 8; i += (size_t)G * NTHREADS) {
            const f32x4 a = *(const f32x4*)(mem + i * 8), b = *(const f32x4*)(mem + i * 8 + 4);
            u32x4 o; o.x = pg8::cvt_pk_bf16(a[0], a[1]); o.y = pg8::cvt_pk_bf16(a[2], a[3]); o.z = pg8::cvt_pk_bf16(b[0], b[1]); o.w = pg8::cvt_pk_bf16(b[2], b[3]);
            *(u32x4*)(MEMB + i * 8) = o;
        }
    }
    SEAM(0);
    if (IN(1)) {
        pg8::DenseProb S{XB, W_IN_T, D, {}}; S.ord.init(NTOK, INCOLS, G, bx);
        pg8::EpiBf16 E{U, INCOLS};
        pg8::gemm_phase(ldsl, S, E);
    }
    SEAM(1);
    if (IN(2)) {
        for (size_t i = (size_t)bx * NTHREADS + tid; i < (size_t)NTOK * 256; i += (size_t)G * NTHREADS) {
            const int n = (int)(i >> 8), c = (int)(i & 255), col = C_WD + c;
            const float u = bf2f(U[(size_t)n * INCOLS + col]);
            const float p = (n % SEQ) ? bf2f(U[(size_t)(n - 1) * INCOLS + col]) : 0.f;
            const float v = u + (p - u) * mu_shift[col];
            LRB[i] = f2bf(c < 64 ? tanhf(v) : (c < 128 ? v : sigmoidf_(v)));
        }
    }
    SEAM(2);
    if (IN(3)) {
        pg8::DenseProb S{LRB, WLR_T, 256, {}}; S.ord.init(NTOK, 1536, G, bx);
        pg8::EpiBf16 E{DWAG, 1536};
        pg8::gemm_phase(ldsl, S, E);
    }
    SEAM(3);
    if (IN(4)) {
        const int ul = wave >> 1, role = wave & 1, j = lane;
        for (int u0 = bx * 4; u0 < BATCH * NCH * 8; u0 += G * 4) {
            const int unit = u0 + ul, b = unit / (NCH * 8), c = (unit % (NCH * 8)) >> 3, h = unit & 7, hc = h * 64 + j;
            float S[64];
#pragma unroll
            for (int k = 0; k < 64; ++k) S[k] = (role && k == j) ? 1.f : 0.f;
            const float mur = mu_shift[C_R + hc], muk = mu_shift[C_K + hc], muv = mu_shift[C_V + hc];
            const float w0j = w0[hc], a0j = a0[hc], kkj = k_k[hc], kaj = k_a[hc], rkj = r_k[hc];
            float* vbase = ldsf + ul * (2 * 8 * 320);
            __syncthreads();
            for (int blk = 0; blk < CH / 8; ++blk) {
                float* vb = vbase + (blk & 1) * (8 * 320);
#pragma unroll
                for (int i = 0; i < 4; ++i) {
                    const int tt = role + 2 * i, t = c * CH + blk * 8 + tt; const size_t n = (size_t)b * SEQ + t;
                    const float r0 = bf2f(U[n * INCOLS + C_R + hc]), k0 = bf2f(U[n * INCOLS + C_K + hc]);
                    const float pr = t ? bf2f(U[(n - 1) * INCOLS + C_R + hc]) : 0.f, pk = t ? bf2f(U[(n - 1) * INCOLS + C_K + hc]) : 0.f;
                    const float r = r0 + (pr - r0) * mur, k = k0 + (pk - k0) * muk;
                    const float dw = bf2f(DWAG[n * 1536 + hc]), da = bf2f(DWAG[n * 1536 + 512 + hc]);
                    const float xx = -(w0j + dw);
                    const float sp = fmaxf(xx, 0.f) + log1pf(expf(-fabsf(xx)));
                    const float wdec = expf(-expf(-sp - 0.5f));
                    const float a = sigmoidf_(a0j + da);
                    const float kkv = k * kkj;
                    const float nrm = sqrtf(wave_sum(kkv * kkv));
                    const float kkn = kkv / fmaxf(nrm, 1e-12f);
                    const float kmod = k * (1.f + (a - 1.f) * kaj);
                    const float bonus = wave_sum(r * kmod * rkj);
                    float* vt = vb + tt * 320;
                    vt[j] = wdec; vt[64 + j] = -kkn; vt[128 + j] = kkn * a; vt[192 + j] = kmod; vt[256 + j] = r;
                    if (lane == 0) BONUS[n * 8 + h] = bonus;
                }
                __syncthreads();
                for (int tt = 0; tt < 8; ++tt) {
                    const int t = c * CH + blk * 8 + tt; const size_t n = (size_t)b * SEQ + t;
                    float vv = 0.f;
                    if (role == 0) { const float v0 = bf2f(U[n * INCOLS + C_V + hc]); const float pv = t ? bf2f(U[(n - 1) * INCOLS + C_V + hc]) : 0.f; vv = v0 + (pv - v0) * muv; }
                    const float* vt = vb + tt * 320;
                    float sa = 0.f;
#pragma unroll
                    for (int kq = 0; kq < 16; ++kq) { const f32x4 av = *(const f32x4*)&vt[64 + 4 * kq];
                        sa += S[4 * kq] * av[0] + S[4 * kq + 1] * av[1] + S[4 * kq + 2] * av[2] + S[4 * kq + 3] * av[3]; }
                    float y = 0.f;
#pragma unroll
                    for (int kq = 0; kq < 16; ++kq) {
                        const f32x4 wv = *(const f32x4*)&vt[4 * kq], bv = *(const f32x4*)&vt[128 + 4 * kq], kv = *(const f32x4*)&vt[192 + 4 * kq], rv = *(const f32x4*)&vt[256 + 4 * kq];
#pragma unroll
                        for (int q = 0; q < 4; ++q) { const float s = S[4 * kq + q] * wv[q] + (sa * bv[q] + vv * kv[q]); S[4 * kq + q] = s; y += s * rv[q]; }
                    }
                    if (role == 0) YLOC[n * RW + hc] = y; else ZB[n * RW + hc] = f2bf(y);
                }
            }
            if (role == 0) { float* dst = SLT + (size_t)unit * 4096 + j;
#pragma unroll
                for (int k = 0; k < 64; ++k) dst[k * 64] = S[k]; }
            else { bf16_t* dst = PT + (size_t)unit * 4096 + j;
#pragma unroll
                for (int k = 0; k < 64; ++k) dst[k * 64] = f2bf(S[k]); }
        }
    }
    SEAM(4);
    if (IN(5)) {
        if (wave == 0 && bx < 64) {
            const int bh = bx >> 1, vs = bx & 1, b = bh >> 3, h = bh & 7, col = lane & 31, hh = lane >> 5;
            f32x16 acc[2];
#pragma unroll
            for (int i = 0; i < 16; ++i) { acc[0][i] = 0.f; acc[1][i] = 0.f; }
            for (int c = 0; c < NCH; ++c) {
                const int unit = (b * NCH + c) * 8 + h;
                bf16_t* sdst = SIN + (size_t)unit * 4096 + (size_t)(32 * vs + col) * 64;
                pg8::bf16x8 Bf[2][2];
#pragma unroll
                for (int jb = 0; jb < 2; ++jb) {
                    unsigned pk[8];
#pragma unroll
                    for (int q = 0; q < 8; ++q) pk[q] = pg8::cvt_pk_bf16(acc[jb][2 * q], acc[jb][2 * q + 1]);
#pragma unroll
                    for (int q = 0; q < 4; ++q) { u32x2 w; w.x = pk[2 * q]; w.y = pk[2 * q + 1]; *(u32x2*)(sdst + 32 * jb + 8 * q + 4 * hh) = w; }
#pragma unroll
                    for (int s = 0; s < 2; ++s) { u32x4 w; w.x = pk[4 * s]; w.y = pk[4 * s + 1]; w.z = pk[4 * s + 2]; w.w = pk[4 * s + 3]; Bf[jb][s] = __builtin_bit_cast(pg8::bf16x8, w); }
                }
                if (c == NCH - 1) break;
                const bf16_t* pt = PT + (size_t)unit * 4096; const float* sl = SLT + (size_t)unit * 4096;
                f32x16 nacc[2];
#pragma unroll
                for (int jo = 0; jo < 2; ++jo) {
#pragma unroll
                    for (int r = 0; r < 16; ++r) nacc[jo][r] = sl[(size_t)(32 * jo + (r & 3) + 8 * (r >> 2) + 4 * hh) * 64 + 32 * vs + col];
#pragma unroll
                    for (int jb = 0; jb < 2; ++jb)
#pragma unroll
                        for (int s = 0; s < 2; ++s) {
                            const bf16_t* ap = pt + (size_t)(32 * jo + col) * 64 + 32 * jb + 16 * s + 4 * hh;
                            const u32x2 a0 = *(const u32x2*)ap, a1 = *(const u32x2*)(ap + 8);
                            u32x4 aw; aw.x = a0.x; aw.y = a0.y; aw.z = a1.x; aw.w = a1.y;
                            nacc[jo] = __builtin_amdgcn_mfma_f32_32x32x16_bf16(__builtin_bit_cast(pg8::bf16x8, aw), Bf[jb][s], nacc[jo], 0, 0, 0);
                        }
                }
                acc[0] = nacc[0]; acc[1] = nacc[1];
            }
        }
    }
    SEAM(5);
    if (IN(6)) {
        const int col = lane & 31, hh = lane >> 5;
        for (int unit = gw; unit < BATCH * NCH * 8; unit += NGW) {
            const int b = unit / (NCH * 8), c = (unit % (NCH * 8)) >> 3, h = unit & 7;
            const bf16_t* sin = SIN + (size_t)unit * 4096;
            pg8::bf16x8 Bf[2][4];
#pragma unroll
            for (int ct = 0; ct < 2; ++ct)
#pragma unroll
                for (int s = 0; s < 4; ++s) Bf[ct][s] = *(const pg8::bf16x8*)(sin + (size_t)(32 * ct + col) * 64 + 16 * s + 8 * hh);
            float lg[2], lb[2], muv[2];
#pragma unroll
            for (int ct = 0; ct < 2; ++ct) { lg[ct] = lnx_g[h * 64 + 32 * ct + col]; lb[ct] = lnx_b[h * 64 + 32 * ct + col]; muv[ct] = mu_shift[C_V + h * 64 + 32 * ct + col]; }
            for (int rt = 0; rt < CH / 32; ++rt) {
                const size_t n0 = (size_t)b * SEQ + c * CH + rt * 32;
                f32x16 acc[2];
#pragma unroll
                for (int i = 0; i < 16; ++i) { acc[0][i] = 0.f; acc[1][i] = 0.f; }
#pragma unroll
                for (int s = 0; s < 4; ++s) {
                    const pg8::bf16x8 Af = *(const pg8::bf16x8*)(ZB + (n0 + col) * RW + h * 64 + 16 * s + 8 * hh);
                    acc[0] = __builtin_amdgcn_mfma_f32_32x32x16_bf16(Af, Bf[0][s], acc[0], 0, 0, 0);
                    acc[1] = __builtin_amdgcn_mfma_f32_32x32x16_bf16(Af, Bf[1][s], acc[1], 0, 0, 0);
                }
#pragma unroll
                for (int r = 0; r < 16; ++r) {
                    const int trow = (r & 3) + 8 * (r >> 2) + 4 * hh; const size_t n = n0 + trow; const int t = c * CH + rt * 32 + trow;
                    float y0 = acc[0][r] + YLOC[n * RW + h * 64 + col], y1 = acc[1][r] + YLOC[n * RW + h * 64 + 32 + col];
                    float sm = y0 + y1, sq = y0 * y0 + y1 * y1;
#pragma unroll
                    for (int o = 1; o < 32; o <<= 1) { sm += __shfl_xor(sm, o); sq += __shfl_xor(sq, o); }
                    const float mu = sm * (1.f / 64.f), var = fmaxf(sq * (1.f / 64.f) - mu * mu, 0.f), rs = 1.f / sqrtf(var + GN_EPS);
                    const float bon = BONUS[n * 8 + h];
#pragma unroll
                    for (int ct = 0; ct < 2; ++ct) {
                        const int hc = h * 64 + 32 * ct + col;
                        const float v0 = bf2f(U[n * INCOLS + C_V + hc]); const float pv = t ? bf2f(U[(n - 1) * INCOLS + C_V + hc]) : 0.f; const float vv = v0 + (pv - v0) * muv[ct];
                        const float gg = bf2f(DWAG[n * 1536 + 1024 + hc]);
                        const float yy = ct ? y1 : y0;
                        MIX[n * D + hc] = f2bf((((yy - mu) * rs) * lg[ct] + lb[ct] + bon * vv) * gg);
                    }
                }
            }
        }
    }
    SEAM(6);
    if (IN(7)) {
        float* Kt = ldsf; float* Vt = ldsf + 255 * 64;
        for (int unit = bx; unit < BATCH * 64 * 2; unit += G) {
            const int b = unit >> 7, blk = (unit & 127) >> 1, hk = unit & 1;
            const int base_s = blk * 128 - 127;
            __syncthreads();
            for (int i = tid; i < 255 * 64; i += NTHREADS) {
                const int jj = i >> 6, d = i & 63, s = base_s + jj;
                Vt[i] = s >= 0 ? bf2f(U[((size_t)b * SEQ + s) * INCOLS + C_VS + hk * 64 + d]) : 0.f;
            }
            for (int i = tid; i < 255 * 32; i += NTHREADS) {
                const int jj = i >> 5, f = i & 31, s = base_s + jj;
                float o1 = 0.f, o2 = 0.f;
                if (s >= 0) { const size_t n = (size_t)b * SEQ + s; const float k1 = bf2f(U[n * INCOLS + C_KS + hk * 64 + f]), k2 = bf2f(U[n * INCOLS + C_KS + hk * 64 + 32 + f]);
                    const float c = ROPE_C[n * 32 + f], sn = ROPE_S[n * 32 + f]; o1 = k1 * c - k2 * sn; o2 = k2 * c + k1 * sn; }
                Kt[jj * 64 + f] = o1; Kt[jj * 64 + 32 + f] = o2;
            }
            __syncthreads();
            const int i = tid & 127, g = tid >> 7, hq = hk * 4 + g;
            const size_t n = (size_t)b * SEQ + blk * 128 + i;
            float q[64], o[64];
#pragma unroll
            for (int f = 0; f < 32; ++f) { const float q1 = bf2f(U[n * INCOLS + C_Q + hq * 64 + f]), q2 = bf2f(U[n * INCOLS + C_Q + hq * 64 + 32 + f]);
                const float c = ROPE_C[n * 32 + f], sn = ROPE_S[n * 32 + f]; q[f] = (q1 * c - q2 * sn) * 0.125f; q[f + 32] = (q2 * c + q1 * sn) * 0.125f; }
#pragma unroll
            for (int d = 0; d < 64; ++d) o[d] = 0.f;
            float m = sinks[hq], l = 1.f;
            for (int jj = 0; jj < 255; ++jj) {
                const int s = base_s + jj;
                const bool valid = (jj >= i) && (jj <= i + 127) && (s >= 0);
                float sc = 0.f;
#pragma unroll
                for (int dq = 0; dq < 16; ++dq) { const f32x4 kv = *(const f32x4*)&Kt[jj * 64 + 4 * dq];
                    sc += q[4 * dq] * kv[0] + q[4 * dq + 1] * kv[1] + q[4 * dq + 2] * kv[2] + q[4 * dq + 3] * kv[3]; }
                if (valid) {
                    const float mn = fmaxf(m, sc), scale = expf(m - mn), p = expf(sc - mn);
                    l = l * scale + p; m = mn;
#pragma unroll
                    for (int dq = 0; dq < 16; ++dq) { const f32x4 vv = *(const f32x4*)&Vt[jj * 64 + 4 * dq];
#pragma unroll
                        for (int qd = 0; qd < 4; ++qd) o[4 * dq + qd] = o[4 * dq + qd] * scale + p * vv[qd]; }
                }
            }
            const float il = 1.f / l;
#pragma unroll
            for (int d = 0; d < 64; ++d) MIX[n * D + RW + hq * 64 + d] = f2bf(o[d] * il);
        }
    }
    SEAM(7);
    if (IN(8)) {
        pg8::DenseProb S{MIX, W_O_T, D, {}}; S.ord.init(NTOK, D, G, bx);
        pg8::EpiF32Res E{X1, D, x, ALPHA};
        pg8::gemm_phase(ldsl, S, E);
    }
    SEAM(8);
    if (IN(9)) { for (int n = gw; n < NTOK; n += NGW) ln_row(X1 + (size_t)n * D, 1.f, nullptr, X1 + (size_t)n * D, ln1_g, ln1_b, lane, X1B + (size_t)n * D); }
    SEAM(9);
    if (IN(10)) {
        { pg8::DenseProb S{X1B, WM_Q_T, D, {}}; S.ord.init(NTOK, D, G, bx); pg8::EpiF32Res E{QM, D, nullptr, 0.f}; pg8::gemm_phase(ldsl, S, E); }
        { pg8::DenseProb S{MEMB, WM_KV_T, D, {}}; S.ord.init(BATCH * MEMT, 2048, G, bx); pg8::EpiF32Res E{KVM, 2048, nullptr, 0.f}; pg8::gemm_phase(ldsl, S, E); }
    }
    SEAM(10);
    if (IN(11)) {
        const int per = (SEQ / 128) * 2;
        for (int t = bx; t < BATCH * 4 * per; t += G) {
            const int bh = t / per, tt = t % per, b = bh >> 2, h = bh & 3, tm = tt >> 1, tn = tt & 1;
            GF g{QM + (size_t)b * SEQ * D + h * 256, D, nullptr, 0, KVM + (size_t)b * MEMT * 2048 + h * 256, 2048, 1, 256};
            float* dst = SC + (size_t)b * SEQ * 1024 + h * 256;
            gemm_f32_tile(ldsf, g, tm * 128, tn * 128, [&](int r, int c, float v) { dst[(size_t)r * 1024 + c] = v * 0.0625f; });
        }
    }
    SEAM(11);
    if (IN(12)) {
        for (int row = gw; row < NTOK * 4; row += NGW) {
            float* p = SC + (size_t)row * 256 + 4 * lane;
            f32x4 v = *(const f32x4*)p;
            float m = fmaxf(fmaxf(v[0], v[1]), fmaxf(v[2], v[3]));
#pragma unroll
            for (int o = 1; o < 64; o <<= 1) m = fmaxf(m, __shfl_xor(m, o));
            v[0] = expf(v[0] - m); v[1] = expf(v[1] - m); v[2] = expf(v[2] - m); v[3] = expf(v[3] - m);
            const float s = wave_sum((v[0] + v[1]) + (v[2] + v[3]));
            *(f32x4*)p = v * (1.f / s);
        }
    }
    SEAM(12);
    if (IN(13)) {
        const int per = (SEQ / 128) * 2;
        for (int t = bx; t < BATCH * 4 * per; t += G) {
            const int bh = t / per, tt = t % per, b = bh >> 2, h = bh & 3, tm = tt >> 1, tn = tt & 1;
            GF g{SC + (size_t)b * SEQ * 1024 + h * 256, 1024, nullptr, 0, KVM + (size_t)b * MEMT * 2048 + 1024 + h * 256, 2048, 0, 256};
            bf16_t* dst = OM + (size_t)b * SEQ * D + h * 256;
            gemm_f32_tile(ldsf, g, tm * 128, tn * 128, [&](int r, int c, float v) { dst[(size_t)r * D + c] = f2bf(v); });
        }
    }
    SEAM(13);
    if (IN(14)) {
        pg8::DenseProb S{OM, WM_O_T, D, {}}; S.ord.init(NTOK, D, G, bx);
        pg8::EpiF32Res E{X2, D, X1, ALPHA};
        pg8::gemm_phase(ldsl, S, E);
    }
    SEAM(14);
    if (IN(15)) {
        for (int n = gw; n < NTOK; n += NGW) ln_row(X2 + (size_t)n * D, 1.f, nullptr, X2 + (size_t)n * D, ln2_g, ln2_b, lane, X2B + (size_t)n * D);
        if (bx == 0 && tid < 128) *(u32x4*)(X2B + (size_t)NTOK * D + tid * 8) = (u32x4){0u, 0u, 0u, 0u};
    }
    SEAM(15);
    if (IN(16)) {
        GF g{X2, D, nullptr, 0, w_router, NEXP, 0, D};
        const int nm = NTOK / 128, nn = NEXP / 128;
        for (int t = bx; t < nm * nn; t += G) {
            const int tm = t / nn, tn = t % nn;
            gemm_f32_tile(ldsf, g, tm * 128, tn * 128, [&](int r, int c, float v) { LOG[(size_t)r * NEXP + c] = v; });
        }
    }
    SEAM(16);
    if (IN(17)) {
        const int hl = lane >> 5;
        for (int i = bx * NTHREADS + tid; i < PMAX; i += G * NTHREADS) { STOK[i] = NTOK; SGATE[i] = 0.f; }
        for (int n = gw; n < NTOK; n += NGW) {
            float sc[4], bi[4], gso[4];
#pragma unroll
            for (int j = 0; j < 4; ++j) { const int e = lane + 64 * j; sc[j] = sigmoidf_(LOG[(size_t)n * NEXP + e]); bi[j] = sc[j] + router_bias[e]; }
#pragma unroll
            for (int j = 0; j < 4; ++j) {
                float m1 = bi[j], m2 = -INFINITY;
#pragma unroll
                for (int o = 1; o < 32; o <<= 1) { const float o1 = __shfl_xor(m1, o), o2 = __shfl_xor(m2, o);
                    const float n1 = fmaxf(m1, o1), n2 = fmaxf(fminf(m1, o1), fmaxf(m2, o2)); m1 = n1; m2 = n2; }
                gso[j] = m1 + m2;
            }
            float g8[8];
#pragma unroll
            for (int j = 0; j < 4; ++j) { const float oth = __shfl_xor(gso[j], 32); g8[2 * j] = hl ? oth : gso[j]; g8[2 * j + 1] = hl ? gso[j] : oth; }
            bool gsel[8];
#pragma unroll
            for (int a = 0; a < 8; ++a) { int rank = 0;
#pragma unroll
                for (int c = 0; c < 8; ++c) rank += ((g8[c] > g8[a]) || (g8[c] == g8[a] && c < a)) ? 1 : 0;
                gsel[a] = rank < 4; }
            float cand[4];
#pragma unroll
            for (int j = 0; j < 4; ++j) { const bool s = hl ? gsel[2 * j + 1] : gsel[2 * j]; cand[j] = s ? bi[j] : -1e30f; }
            int eidx[8]; float sel[8]; float ssum = 0.f;
#pragma unroll
            for (int k = 0; k < 8; ++k) {
                float bv = cand[0]; int be = lane;
#pragma unroll
                for (int j = 1; j < 4; ++j) if (cand[j] > bv) { bv = cand[j]; be = lane + 64 * j; }
#pragma unroll
                for (int o = 1; o < 64; o <<= 1) { const float ov = __shfl_xor(bv, o); const int oe = __shfl_xor(be, o);
                    if (ov > bv || (ov == bv && oe < be)) { bv = ov; be = oe; } }
                eidx[k] = be;
                const int jw = be >> 6, lw = be & 63;
                const float mys = jw == 0 ? sc[0] : (jw == 1 ? sc[1] : (jw == 2 ? sc[2] : sc[3]));
                sel[k] = __shfl(mys, lw); ssum += sel[k];
#pragma unroll
                for (int j = 0; j < 4; ++j) if (lane == lw && j == jw) cand[j] = -INFINITY;
            }
#pragma unroll
            for (int k = 0; k < 8; ++k) {
                if (lane == k) {
                    const int e = eidx[k];
                    const int pos = (int)atomicAdd(&ctl[CW_CNT + e], 1u);
                    EIDX[n * 8 + k] = e; GATE[n * 8 + k] = sel[k] / ssum * 2.5f; POS[n * 8 + k] = pos;
                }
            }
        }
    }
    SEAM(17);
    if (IN(18)) {
        if (bx == 0) {
            int* soff = (int*)ldsf;
            if (tid == 0) { int acc = 0, cacc = 0; for (int e = 0; e < NEXP; ++e) { soff[e] = acc; soff[512 + e] = cacc; const int c = (int)ctl[CW_CNT + e]; acc += ((c + MOE_TR - 1) / MOE_TR) * MOE_TR; cacc += c; } soff[NEXP] = acc; }
            __syncthreads();
            if (tid <= NEXP) ctl[CW_OFF + tid] = (unsigned)soff[tid];
            if (tid < NEXP) ctl[CW_CST + tid] = (unsigned)soff[512 + tid];
            if (tid == 0) ctl[CW_NT] = (unsigned)(soff[NEXP] / MOE_TR);
            if (tid < NEXP) { for (int t = soff[tid] / MOE_TR; t < soff[tid + 1] / MOE_TR; ++t) TEXP[t] = tid; }
        }
    }
    SEAM(18);
    if (IN(19)) {
        for (int i = bx * NTHREADS + tid; i < NK; i += G * NTHREADS) {
            const int e = EIDX[i], p = (int)ctl[CW_OFF + e] + POS[i];
            STOK[p] = i >> 3; SGATE[p] = GATE[i]; YROW[i] = (int)ctl[CW_CST + e] + POS[i];
        }
    }
    SEAM(19);
    if (IN(20)) {
        const int ntm = (int)ctl[CW_NT];
        { pg8::GatherProb S{X2B, STOK, WE_GU_T, TEXP, D, 2, ntm * 2, G, bx, (size_t)512 * D * 2}; pg8::EpiSwiGLU E{HH, EDIM}; pg8::gemm_phase(ldsl, S, E); }
        { pg8::DenseProb S{X2B, WS_GU_T, D, {}}; S.ord.init(NTOK, 512, G, bx); pg8::EpiSwiGLU E{HS, EDIM}; pg8::gemm_phase(ldsl, S, E); }
    }
    SEAM(20);
    if (IN(21)) {
        const int ntm = (int)ctl[CW_NT];
        { pg8::GroupedProb S{HH, WE_D_T, TEXP, EDIM, 4, ntm * 4, G, bx, (size_t)D * EDIM * 2}; pg8::EpiScaleY E{YY, SGATE, ctl + CW_OFF, ctl + CW_CNT, ctl + CW_CST}; pg8::gemm_phase(ldsl, S, E); }
        { pg8::DenseProb S{HS, WS_D_T, EDIM, {}}; S.ord.init(NTOK, D, G, bx); pg8::EpiF32Res E{out, D, X2, ALPHA}; pg8::gemm_phase(ldsl, S, E); }
    }
    SEAM(21);
    if (IN(22)) {
        for (int n = gw; n < NTOK; n += NGW) {
            float v[16];
            float* orow = out + (size_t)n * D;
#pragma unroll
            for (int j = 0; j < 2; ++j) { const f32x4 a = *(const f32x4*)(orow + 512 * j + 8 * lane), b = *(const f32x4*)(orow + 512 * j + 8 * lane + 4);
#pragma unroll
                for (int q = 0; q < 4; ++q) { v[8 * j + q] = a[q]; v[8 * j + 4 + q] = b[q]; } }
            int yr[8];
#pragma unroll
            for (int k = 0; k < 8; ++k) yr[k] = YROW[n * 8 + k];
#pragma unroll
            for (int k = 0; k < 8; ++k) {
                const bf16_t* yrow = YY + (size_t)yr[k] * D;
#pragma unroll
                for (int j = 0; j < 2; ++j) { const u32x4 w = *(const u32x4*)(yrow + 512 * j + 8 * lane);
#pragma unroll
                    for (int q = 0; q < 4; ++q) { v[8 * j + 2 * q] += __builtin_bit_cast(float, w[q] << 16); v[8 * j + 2 * q + 1] += __builtin_bit_cast(float, w[q] & 0xffff0000u); } }
            }
            float s = 0.f;
#pragma unroll
            for (int i = 0; i < 16; ++i) s += v[i];
            const float mean = wave_sum(s) * (1.f / D); float s2 = 0.f;
#pragma unroll
            for (int i = 0; i < 16; ++i) { v[i] -= mean; s2 += v[i] * v[i]; }
            const float rstd = 1.f / sqrtf(wave_sum(s2) * (1.f / D) + LN_EPS);
#pragma unroll
            for (int j = 0; j < 2; ++j) {
                const f32x4 g0 = *(const f32x4*)(ln3_g + 512 * j + 8 * lane), g1 = *(const f32x4*)(ln3_g + 512 * j + 8 * lane + 4);
                const f32x4 b0 = *(const f32x4*)(ln3_b + 512 * j + 8 * lane), b1 = *(const f32x4*)(ln3_b + 512 * j + 8 * lane + 4);
                f32x4 o0, o1;
#pragma unroll
                for (int q = 0; q < 4; ++q) { o0[q] = v[8 * j + q] * rstd * g0[q] + b0[q]; o1[q] = v[8 * j + 4 + q] * rstd * g1[q] + b1[q]; }
                *(f32x4*)(orow + 512 * j + 8 * lane) = o0; *(f32x4*)(orow + 512 * j + 8 * lane + 4) = o1;
            }
        }
    }
#undef IN
#undef SEAM
}

#ifndef PHASE_MASK
#define PHASE_MASK 0x7FFFFFu
#endif
#ifndef ONE_LAUNCH
#define ONE_LAUNCH 1
#endif

extern "C" void kernel_launch(void* const* d_in, const int* in_sizes, int n_in, void* d_out, int out_size, void* d_ws, size_t ws_size, hipStream_t stream) {
    static int grid = 0;
    if (grid == 0) {
        if (n_in != 34 || out_size != NTOK * D || ws_size < WS_END) { fprintf(stderr, "kernel_launch: unexpected shapes (n_in %d out %d ws %zu)\n", n_in, out_size, ws_size); grid = -1; return; }
        int dev = 0, cus = 0;
        if (hipGetDevice(&dev) != hipSuccess || hipDeviceGetAttribute(&cus, hipDeviceAttributeMultiprocessorCount, dev) != hipSuccess) { grid = -1; return; }
        if (hipFuncSetAttribute((const void*)mega, hipFuncAttributeMaxDynamicSharedMemorySize, LDS_BYTES) != hipSuccess) { fprintf(stderr, "kernel_launch: hipFuncSetAttribute failed\n"); grid = -1; return; }
        (void)hipGetLastError();
        grid = cus;
    }
    if (grid < 0) return;
    (void)hipMemsetAsync((char*)d_ws + WS_CTL, 0, CTL_ZERO_BYTES, stream);
    Args a{};
    for (int i = 0; i < 34; ++i) a.in[i] = (const float*)d_in[i];
    a.out = (float*)d_out; a.ws = (unsigned char*)d_ws;
#if ONE_LAUNCH
    a.ph_lo = 0; a.ph_hi = NPHASES;
    hipLaunchKernelGGL(mega, dim3(grid), dim3(NTHREADS), LDS_BYTES, stream, a);
#else
    for (int p = 0; p < NPHASES; ++p) { if (!((PHASE_MASK >> p) & 1)) continue; a.ph_lo = p; a.ph_hi = p + 1; hipLaunchKernelGGL(mega, dim3(grid), dim3(NTHREADS), LDS_BYTES, stream, a); }
#endif
}
```

```cpp
#include <hip/hip_runtime.h>
#include <cstdio>
#include <cstdint>

constexpr int D = 1024, BATCH = 4, SEQ = 8192, NTOK = BATCH * SEQ;
constexpr int MEMT = 256;
constexpr int RW = 512, RCOLS = 1792, INCOLS = 2560;
constexpr int C_R = 0, C_K = 512, C_V = 1024, C_WD = 1536, C_AD = 1600, C_GD = 1664, C_Q = 1792, C_KS = 2304, C_VS = 2432;
constexpr int NEXP = 256, TOPK = 8, EDIM = 256;
constexpr int NK = NTOK * TOPK;
constexpr int CH = 128, NCH = SEQ / CH;
constexpr int MOE_TR = 256;
constexpr int PMAX = NK + NEXP * MOE_TR;
constexpr float LN_EPS = 1e-5f, GN_EPS = 64e-5f;
constexpr float ALPHA = 1.189207115002721f;

constexpr size_t MiB = 1u << 20;
constexpr size_t WS_CTL = 0, CTL_ZERO_BYTES = 64 * 1024;
constexpr size_t WS_TEXP = 512 * 1024;
constexpr size_t WS_ROPE = 1 * MiB;
constexpr size_t WS_EIDX = 9 * MiB, WS_GATE = 10 * MiB, WS_POS = 11 * MiB, WS_YROW = 12 * MiB;
constexpr size_t WS_STOK = 13 * MiB, WS_SGATE = 14 * MiB + 512 * 1024;
constexpr size_t WS_WIN = 16 * MiB, WS_WO = 21 * MiB, WS_WMQ = 23 * MiB, WS_WMKV = 25 * MiB, WS_WMO = 29 * MiB, WS_WSGU = 31 * MiB, WS_WSD = 32 * MiB;
constexpr size_t WS_MEMB = 36 * MiB;
constexpr size_t WS_WED = 40 * MiB;
constexpr size_t WS_WEGU = 168 * MiB;
constexpr size_t WS_XB = 424 * MiB;
constexpr size_t WS_U = 490 * MiB;
constexpr size_t WS_LRB = 650 * MiB;
constexpr size_t WS_DWAG = 666 * MiB;
constexpr size_t WS_YLOC = 762 * MiB;
constexpr size_t WS_ZB = 826 * MiB;
constexpr size_t WS_PT = 858 * MiB;
constexpr size_t WS_SLT = 424 * MiB;
constexpr size_t WS_SIN = 456 * MiB;
constexpr size_t WS_BONUS = 472 * MiB;
constexpr size_t WS_WLR = 33 * MiB;
constexpr size_t WS_MIX = 874 * MiB;
constexpr size_t WS_X1 = 424 * MiB;
constexpr size_t WS_X1B = 552 * MiB;
constexpr size_t WS_QM = 616 * MiB;
constexpr size_t WS_KVM = 744 * MiB;
constexpr size_t WS_SC = 752 * MiB;
constexpr size_t WS_OM = 880 * MiB;
constexpr size_t WS_X2B = 424 * MiB;
constexpr size_t WS_LOG = 490 * MiB;
constexpr size_t WS_H = 768 * MiB;
constexpr size_t WS_HS = 928 * MiB;
constexpr size_t WS_Y = 168 * MiB;
constexpr size_t WS_END = 944 * MiB;
constexpr int CW_CNT = 0, CW_OFF = 512, CW_NT = 1024, CW_CST = 1280, CW_BAR = 4096;

constexpr int NTHREADS = 512, NWAVES = 8;
constexpr int LDS_BYTES = 147456;
constexpr int MISC_OFF = 140 * 1024;

#define LAS __attribute__((address_space(3)))
typedef float f32x4 __attribute__((ext_vector_type(4)));
typedef float f32x16 __attribute__((ext_vector_type(16)));

#define XB_TMO      128
#define XB_XCNT(j)  (256  + 64 * (j))
#define XB_XSUB(j)  (1280 + 64 * (j))
#define XB_XGEN(j)  (2304 + 64 * (j))
#define XB_TOP      3328
#define XB_TOPGEN   3392
#define XCD_BAR_WORDS 3456
#define XB_SPIN_CAP (1u << 18)
__device__ __forceinline__ unsigned xb_ld(unsigned* p)              { return __hip_atomic_load(p, __ATOMIC_RELAXED, __HIP_MEMORY_SCOPE_AGENT); }
__device__ __forceinline__ unsigned xb_add(unsigned* p, unsigned v) { return __hip_atomic_fetch_add(p, v, __ATOMIC_RELAXED, __HIP_MEMORY_SCOPE_AGENT); }
__device__ __forceinline__ unsigned xb_xcc_id() { return (unsigned)__builtin_amdgcn_s_getreg((3 << 11) | 20) & 0xFu; }
#define XB_SPIN(cond, bar) do { unsigned _sp = 0; while (cond) { __builtin_amdgcn_s_sleep(1); \
    if ((++_sp & 255u) == 0u) { if (xb_ld(&(bar)[XB_TMO])) break; if (_sp > XB_SPIN_CAP) { atomicAdd(&(bar)[XB_TMO], 1u); break; } } } } while (0)
struct XcdBarrier { unsigned* bar; unsigned x; volatile LAS unsigned* st; };
__device__ __forceinline__ XcdBarrier xcd_barrier_post(unsigned* bar, volatile LAS unsigned* st) {
    XcdBarrier b; b.bar = bar; b.x = xb_xcc_id(); b.st = st;
    if (threadIdx.x == 0) (void)xb_add(&bar[XB_XCNT(b.x)], 1u);
    return b;
}
__device__ __forceinline__ void xcd_barrier_complete(unsigned* bar, unsigned x, unsigned& nloc, unsigned& nx) {
    const unsigned G = gridDim.x * gridDim.y * gridDim.z;
    unsigned sum, cnt, mine, sp = 0u;
    for (;;) {
        sum = 0u; cnt = 0u; mine = 0u;
#pragma unroll
        for (unsigned j = 0; j < 16; ++j) { const unsigned c = xb_ld(&bar[XB_XCNT(j)]); sum += c; cnt += (c > 0u) ? 1u : 0u; mine = (j == x) ? c : mine; }
        if (sum == G) break;
        __builtin_amdgcn_s_sleep(1);
        if ((++sp & 255u) == 0u) { if (xb_ld(&bar[XB_TMO])) break; if (sp > XB_SPIN_CAP) { atomicAdd(&bar[XB_TMO], 1u); break; } }
    }
    nloc = mine > 0u ? mine : 1u; nx = cnt > 0u ? cnt : 1u;
}
__device__ __forceinline__ void xcd_barrier(const XcdBarrier& b) {
    asm volatile("s_waitcnt vmcnt(0)" ::: "memory");
    __syncthreads();
    if (threadIdx.x == 0) {
        unsigned* bar = b.bar;
        __builtin_amdgcn_s_waitcnt(0);
        unsigned nloc = b.st[0], nx = b.st[1];
        if (nloc == 0u) { xcd_barrier_complete(bar, b.x, nloc, nx); b.st[0] = nloc; b.st[1] = nx; }
        const unsigned old = xb_add(&bar[XB_XSUB(b.x)], 1u);
        const unsigned gen = old / nloc;
        if (old + 1u == (gen + 1u) * nloc) {
            __builtin_amdgcn_fence(__ATOMIC_RELEASE, "agent");
            asm volatile("s_waitcnt vmcnt(0)" ::: "memory");
            const unsigned og = xb_add(&bar[XB_TOP], 1u);
            const unsigned tg = og / nx;
            if (og + 1u == (tg + 1u) * nx) xb_add(&bar[XB_TOPGEN], 1u);
            else XB_SPIN(xb_ld(&bar[XB_TOPGEN]) == tg, bar);
            __builtin_amdgcn_fence(__ATOMIC_ACQUIRE, "agent");
            xb_add(&bar[XB_XGEN(b.x)], 1u);
            asm volatile("s_waitcnt vmcnt(0)" ::: "memory");
        } else {
            XB_SPIN(xb_ld(&bar[XB_XGEN(b.x)]) == gen, bar);
            __builtin_amdgcn_fence(__ATOMIC_ACQUIRE, "agent");
            asm volatile("s_waitcnt vmcnt(0)" ::: "memory");
        }
    }
    __syncthreads();
}

namespace pg8 {
#define PG8_LAS __attribute__((address_space(3)))
typedef unsigned short bf16_t;
typedef short bf16x8 __attribute__((ext_vector_type(8)));
typedef float f32x4 __attribute__((ext_vector_type(4)));
typedef float f32x2 __attribute__((ext_vector_type(2)));
typedef unsigned u32x4 __attribute__((ext_vector_type(4)));
constexpr int BM = 256, BK = 64, HALF = 128, HTB = HALF * BK * 2, STAGE_BYTES = 8 * HTB, NXCD = 8, WGM = 8;
__host__ __device__ __forceinline__ int lds_byte(int r, int c) { const int st = (r >> 4) * 2 + (c >> 5), rr = r & 15, cc = c & 31, ob = rr * 64 + cc * 2; return st * 1024 + (ob ^ (((ob >> 9) & 1) << 5)); }
__host__ __device__ __forceinline__ void stage_rc(int b, int& R, int& C) { const int st = b / 1024, sb = b % 1024, swz = sb ^ (((sb >> 9) & 1) << 5); R = (st >> 1) * 16 + swz / 64; C = (st & 1) * 32 + (swz % 64) / 2; }
__host__ __device__ __forceinline__ int perm32(int rho) { const int n = rho >> 4, i = rho & 15; return 8 * (i >> 2) + 4 * n + (i & 3); }
__device__ __forceinline__ unsigned cvt_pk_bf16(float lo, float hi) { unsigned r; asm volatile("v_cvt_pk_bf16_f32 %0, %1, %2" : "=v"(r) : "v"(lo), "v"(hi)); return r; }

struct Unit { int pm, pn, e; };
struct StaticOrder {
    int nM, nN, nwg, G, c;
    __host__ __device__ void init(int M, int N, int G_, int c_) { nM = M / BM; nN = N / BM; nwg = nM * nN; G = G_; c = c_; }
    __host__ __device__ bool next(int i, Unit& u) const {
        const long L = (long)i * G + c; if (L >= nwg) return false;
        int wgid = (int)L; { const int q = nwg / NXCD, r = nwg % NXCD, xcd = wgid % NXCD, off = wgid / NXCD; wgid = (xcd < r ? xcd * (q + 1) : r * (q + 1) + (xcd - r) * q) + off; }
        const int nig = WGM * nN, gid = wgid / nig, fm = gid * WGM, gsz = (nM - fm) < WGM ? (nM - fm) : WGM;
        u.pm = fm + ((wgid % nig) % gsz); u.pn = (wgid % nig) / gsz; u.e = 0; return true;
    }
};
struct DenseProb {
    const bf16_t* A; const bf16_t* Bt; int K; StaticOrder ord;
    __device__ __forceinline__ bool next(int i, Unit& u) const { return ord.next(i, u); }
    __device__ __forceinline__ const char* a_base(const Unit& u) const { return (const char*)A + (size_t)u.pm * BM * K * 2; }
    __device__ __forceinline__ const char* b_base(const Unit& u) const { return (const char*)Bt + (size_t)u.pn * BM * K * 2; }
    __device__ __forceinline__ void a_offs(const Unit&, unsigned (&v)[2][2], const int (&R)[2], const int (&C)[2]) const {
#pragma unroll
        for (int h = 0; h < 2; ++h)
#pragma unroll
            for (int i = 0; i < 2; ++i) v[h][i] = (unsigned)((h * HALF + R[i]) * K + C[i]) * 2u;
    }
};
struct GatherProb {
    const bf16_t* X; const int* stok; const bf16_t* Bt; const int* texp; int K, nN, nunits, G, c; size_t estride;
    __device__ __forceinline__ bool next(int i, Unit& u) const {
        const long L = (long)i * G + c; if (L >= nunits) return false;
        u.pm = (int)(L / nN); u.pn = (int)(L % nN); u.e = texp[u.pm]; return true;
    }
    __device__ __forceinline__ const char* a_base(const Unit&) const { return (const char*)X; }
    __device__ __forceinline__ const char* b_base(const Unit& u) const { return (const char*)Bt + (size_t)u.e * estride + (size_t)u.pn * BM * K * 2; }
    __device__ __forceinline__ void a_offs(const Unit& u, unsigned (&v)[2][2], const int (&R)[2], const int (&C)[2]) const {
#pragma unroll
        for (int h = 0; h < 2; ++h)
#pragma unroll
            for (int i = 0; i < 2; ++i) { const int tok = stok[u.pm * BM + h * HALF + R[i]]; v[h][i] = (unsigned)(tok * K + C[i]) * 2u; }
    }
};
struct GroupedProb {
    const bf16_t* A; const bf16_t* Bt; const int* texp; int K, nN, nunits, G, c; size_t estride;
    __device__ __forceinline__ bool next(int i, Unit& u) const {
        const long L = (long)i * G + c; if (L >= nunits) return false;
        u.pm = (int)(L / nN); u.pn = (int)(L % nN); u.e = texp[u.pm]; return true;
    }
    __device__ __forceinline__ const char* a_base(const Unit& u) const { return (const char*)A + (size_t)u.pm * BM * K * 2; }
    __device__ __forceinline__ const char* b_base(const Unit& u) const { return (const char*)Bt + (size_t)u.e * estride + (size_t)u.pn * BM * K * 2; }
    __device__ __forceinline__ void a_offs(const Unit&, unsigned (&v)[2][2], const int (&R)[2], const int (&C)[2]) const {
#pragma unroll
        for (int h = 0; h < 2; ++h)
#pragma unroll
            for (int i = 0; i < 2; ++i) v[h][i] = (unsigned)((h * HALF + R[i]) * K + C[i]) * 2u;
    }
};

struct EpiBf16 {
    static constexpr bool PERM = true;
    bf16_t* O; int ldc;
    __device__ __forceinline__ void operator()(const f32x4 (&acc)[2][2][4][2], const Unit& u, int wr, int wc, int fr, int fq) const {
        const int row0 = u.pm * BM + wr * 64 + fr, col0 = u.pn * BM + wc * 32 + 8 * fq;
#pragma unroll
        for (int ai = 0; ai < 2; ++ai)
#pragma unroll
            for (int m = 0; m < 4; ++m) { bf16_t* rowp = O + (size_t)(row0 + ai * HALF + m * 16) * ldc + col0;
#pragma unroll
                for (int bj = 0; bj < 2; ++bj) { const f32x4 v0 = acc[ai][bj][m][0], v1 = acc[ai][bj][m][1];
                    u32x4 w; w.x = cvt_pk_bf16(v0[0], v0[1]); w.y = cvt_pk_bf16(v0[2], v0[3]); w.z = cvt_pk_bf16(v1[0], v1[1]); w.w = cvt_pk_bf16(v1[2], v1[3]);
                    *(u32x4*)(rowp + bj * HALF) = w; } }
    }
};
struct EpiF32Res {
    static constexpr bool PERM = false;
    float* C; int ldc; const float* base; float alpha;
    __device__ __forceinline__ void operator()(const f32x4 (&acc)[2][2][4][2], const Unit& u, int wr, int wc, int fr, int fq) const {
        const int row0 = u.pm * BM + wr * 64 + fr, col0 = u.pn * BM + wc * 32 + 4 * fq;
#pragma unroll
        for (int ai = 0; ai < 2; ++ai)
#pragma unroll
            for (int m = 0; m < 4; ++m) { const size_t off = (size_t)(row0 + ai * HALF + m * 16) * ldc + col0;
#pragma unroll
                for (int bj = 0; bj < 2; ++bj)
#pragma unroll
                    for (int n = 0; n < 2; ++n) { f32x4 o = acc[ai][bj][m][n];
                        if (base) o += *(const f32x4*)(base + off + bj * HALF + n * 16) * alpha;
                        *(f32x4*)(C + off + bj * HALF + n * 16) = o; } }
    }
};

struct EpiSwiGLU {
    static constexpr bool PERM = true;
    bf16_t* O; int ldc;
    __device__ __forceinline__ void operator()(const f32x4 (&acc)[2][2][4][2], const Unit& u, int wr, int wc, int fr, int fq) const {
        const int row0 = u.pm * BM + wr * 64 + fr, col0 = u.pn * HALF + wc * 32 + 8 * fq;
#pragma unroll
        for (int ai = 0; ai < 2; ++ai)
#pragma unroll
            for (int m = 0; m < 4; ++m) { bf16_t* rowp = O + (size_t)(row0 + ai * HALF + m * 16) * ldc + col0;
                float h[8];
#pragma unroll
                for (int n = 0; n < 2; ++n)
#pragma unroll
                    for (int q = 0; q < 4; ++q) { const float g = acc[ai][0][m][n][q], up = acc[ai][1][m][n][q]; h[4 * n + q] = g * __builtin_amdgcn_rcpf(1.f + __expf(-g)) * up; }
                u32x4 w; w.x = cvt_pk_bf16(h[0], h[1]); w.y = cvt_pk_bf16(h[2], h[3]); w.z = cvt_pk_bf16(h[4], h[5]); w.w = cvt_pk_bf16(h[6], h[7]);
                *(u32x4*)rowp = w; }
    }
};
struct EpiScaleY {
    static constexpr bool PERM = true;
    bf16_t* Y; const float* sgate; const unsigned* off; const unsigned* cnt; const unsigned* cst;
    __device__ __forceinline__ void operator()(const f32x4 (&acc)[2][2][4][2], const Unit& u, int wr, int wc, int fr, int fq) const {
        const int o0 = (int)off[u.e], nreal = (int)cnt[u.e], c0 = (int)cst[u.e];
        const int row0 = u.pm * BM + wr * 64 + fr, col0 = u.pn * BM + wc * 32 + 8 * fq;
#pragma unroll
        for (int ai = 0; ai < 2; ++ai)
#pragma unroll
            for (int m = 0; m < 4; ++m) { const int p = row0 + ai * HALF + m * 16, rel = p - o0;
                if (rel < nreal) { const float gs = sgate[p]; bf16_t* rowp = Y + (size_t)(c0 + rel) * 1024 + col0;
#pragma unroll
                    for (int bj = 0; bj < 2; ++bj) { const f32x4 v0 = acc[ai][bj][m][0] * gs, v1 = acc[ai][bj][m][1] * gs;
                        u32x4 w; w.x = cvt_pk_bf16(v0[0], v0[1]); w.y = cvt_pk_bf16(v0[2], v0[3]); w.z = cvt_pk_bf16(v1[0], v1[1]); w.w = cvt_pk_bf16(v1[2], v1[3]);
                        *(u32x4*)(rowp + bj * HALF) = w; } } }
    }
};

template <class Epi, class Prob>
__device__ __forceinline__ void gemm_phase(PG8_LAS unsigned char* lds, const Prob& S, const Epi& E) {
    const int tid = threadIdx.x, wid = __builtin_amdgcn_readfirstlane(tid >> 6), lane = tid & 63, wr = wid >> 2, wc = wid & 3, fr = lane & 15, fq = lane >> 4;
    const int K = S.K, nt = K / BK;
    int Rr[2], Cc[2]; unsigned voffB[2];
#pragma unroll
    for (int i = 0; i < 2; ++i) { int R, C; stage_rc(tid * 16 + i * 8192, R, C); const int Rb = Epi::PERM ? ((R & ~31) + perm32(R & 31)) : R;
        Rr[i] = R; Cc[i] = C; voffB[i] = (unsigned)(Rb * K + C) * 2u; }
    const size_t kstep = (size_t)(BK * 2);
    const size_t hstep = (size_t)HALF * K * 2;
    const unsigned ldsw = (unsigned)wid * 1024u;
    const int aoff = lds_byte(wr * 64 + fr, fq * 8), boff = lds_byte(wc * 32 + fr, fq * 8);
#define PG8_SA(b, h) (((b) * 2 + (h)) * HTB)
#define PG8_SB(b, h) ((4 + (b) * 2 + (h)) * HTB)
#define PG8_STAGE(bufoff, gbase, voff) do { _Pragma("unroll") for (int _i = 0; _i < 2; ++_i) \
        __builtin_amdgcn_global_load_lds((const unsigned*)((const char*)(gbase) + (voff)[_i]), (PG8_LAS unsigned*)(lds + (bufoff) + ldsw + _i * 8192), 16, 0, 0); } while (0)
#define PG8_LDA(dst, b, h) do { _Pragma("unroll") for (int m = 0; m < 4; ++m) _Pragma("unroll") for (int k = 0; k < 2; ++k) dst[m][k] = *(const PG8_LAS bf16x8*)(lds + PG8_SA(b, h) + aoff + m * 2048 + k * 1024); } while (0)
#define PG8_LDB(dst, b, h) do { _Pragma("unroll") for (int n = 0; n < 2; ++n) _Pragma("unroll") for (int k = 0; k < 2; ++k) dst[n][k] = *(const PG8_LAS bf16x8*)(lds + PG8_SB(b, h) + boff + n * 2048 + k * 1024); } while (0)
#define PG8_MMA(ai, bj, At, Bt) do { __builtin_amdgcn_s_setprio(1); _Pragma("unroll") for (int m = 0; m < 4; ++m) _Pragma("unroll") for (int n = 0; n < 2; ++n) _Pragma("unroll") for (int k = 0; k < 2; ++k) \
        acc[ai][bj][m][n] = __builtin_amdgcn_mfma_f32_16x16x32_bf16(Bt[n][k], At[m][k], acc[ai][bj][m][n], 0, 0, 0); __builtin_amdgcn_s_setprio(0); } while (0)
#define PG8_WAIT_V(n) asm volatile("s_waitcnt vmcnt(" #n ")" ::: "memory")
#define PG8_WAIT_L(n) asm volatile("s_waitcnt lgkmcnt(" #n ")" ::: "memory")
#define PG8_BAR __builtin_amdgcn_s_barrier()
#define PG8_SCHED __builtin_amdgcn_sched_barrier(0)
    Unit cur, nxt; int ui = 0;
    if (!S.next(0, cur)) return;
    f32x4 acc[2][2][4][2];
#pragma unroll
    for (int a = 0; a < 2; ++a)
#pragma unroll
        for (int b = 0; b < 2; ++b)
#pragma unroll
            for (int m = 0; m < 4; ++m)
#pragma unroll
                for (int n = 0; n < 2; ++n) acc[a][b][m][n] = (f32x4){0.f, 0.f, 0.f, 0.f};
    bf16x8 At[4][2], B0[2][2], B1[2][2];
    const char* cA = S.a_base(cur); const char* cB = S.b_base(cur);
    unsigned vA[2][2], nvA[2][2];
    S.a_offs(cur, vA, Rr, Cc);
    PG8_STAGE(PG8_SB(0, 0), cB, voffB); PG8_STAGE(PG8_SA(0, 0), cA, vA[0]); PG8_STAGE(PG8_SB(0, 1), cB + hstep, voffB); PG8_STAGE(PG8_SA(0, 1), cA, vA[1]);
    if (wr == 1) PG8_BAR;
    PG8_WAIT_V(4); PG8_BAR;
    PG8_STAGE(PG8_SB(1, 0), cB + kstep, voffB); PG8_STAGE(PG8_SA(1, 0), cA + kstep, vA[0]); PG8_STAGE(PG8_SB(1, 1), cB + hstep + kstep, voffB);
    PG8_WAIT_V(6); PG8_BAR;
    for (;;) {
        const bool has_next = S.next(ui + 1, nxt);
        const char* nA = has_next ? S.a_base(nxt) : cA; const char* nB = has_next ? S.b_base(nxt) : cB;
        if (has_next) S.a_offs(nxt, nvA, Rr, Cc);
        else {
#pragma unroll
            for (int h = 0; h < 2; ++h)
#pragma unroll
                for (int i = 0; i < 2; ++i) nvA[h][i] = vA[h][i];
        }
        for (int t = 0; t < nt; t += 2) {
            const bool last = (t == nt - 2);
            const char* a1 = cA + (size_t)(t + 1) * kstep;
            const char* a2 = last ? nA : cA + (size_t)(t + 2) * kstep; const char* b2 = last ? nB : cB + (size_t)(t + 2) * kstep;
            const char* a3 = a2 + kstep; const char* b3 = b2 + kstep;
            unsigned v2[2][2];
#pragma unroll
            for (int h = 0; h < 2; ++h)
#pragma unroll
                for (int i = 0; i < 2; ++i) v2[h][i] = last ? nvA[h][i] : vA[h][i];
            PG8_LDB(B0, 0, 0); PG8_SCHED; PG8_LDA(At, 0, 0); PG8_STAGE(PG8_SA(1, 1), a1, vA[1]);
            PG8_WAIT_L(8); PG8_BAR; PG8_WAIT_L(0); PG8_MMA(0, 0, At, B0); PG8_BAR; PG8_SCHED;
            PG8_LDB(B1, 0, 1); PG8_STAGE(PG8_SB(0, 0), b2, voffB);
            PG8_BAR; PG8_WAIT_L(0); PG8_MMA(0, 1, At, B1); PG8_BAR;
            PG8_LDA(At, 0, 1); PG8_STAGE(PG8_SA(0, 0), a2, v2[0]);
            PG8_BAR; PG8_WAIT_L(0); PG8_MMA(1, 0, At, B0); PG8_BAR; PG8_SCHED;
            PG8_STAGE(PG8_SB(0, 1), b2 + hstep, voffB);
            PG8_WAIT_V(6); PG8_BAR; PG8_MMA(1, 1, At, B1); PG8_BAR;
            PG8_LDB(B0, 1, 0); PG8_SCHED; PG8_LDA(At, 1, 0); PG8_STAGE(PG8_SA(0, 1), a2, v2[1]);
            PG8_WAIT_L(8); PG8_BAR; PG8_WAIT_L(0); PG8_MMA(0, 0, At, B0); PG8_BAR; PG8_SCHED;
            PG8_LDB(B1, 1, 1); PG8_STAGE(PG8_SB(1, 0), b3, voffB);
            PG8_BAR; PG8_WAIT_L(0); PG8_MMA(0, 1, At, B1); PG8_BAR;
            PG8_LDA(At, 1, 1); PG8_STAGE(PG8_SA(1, 0), a3, v2[0]);
            PG8_BAR; PG8_WAIT_L(0); PG8_MMA(1, 0, At, B0); PG8_BAR; PG8_SCHED;
            PG8_STAGE(PG8_SB(1, 1), b3 + hstep, voffB);
            PG8_WAIT_V(6); PG8_BAR; PG8_MMA(1, 1, At, B1); PG8_BAR;
        }
        E(acc, cur, wr, wc, fr, fq);
        if (!has_next) break;
#pragma unroll
        for (int a = 0; a < 2; ++a)
#pragma unroll
            for (int b = 0; b < 2; ++b)
#pragma unroll
                for (int m = 0; m < 4; ++m)
#pragma unroll
                    for (int n = 0; n < 2; ++n) acc[a][b][m][n] = (f32x4){0.f, 0.f, 0.f, 0.f};
        cur = nxt; cA = nA; cB = nB; ++ui;
#pragma unroll
        for (int h = 0; h < 2; ++h)
#pragma unroll
            for (int i = 0; i < 2; ++i) vA[h][i] = nvA[h][i];
    }
    PG8_WAIT_V(0);
    if (wr == 0) PG8_BAR;
    PG8_BAR;
#undef PG8_SA
#undef PG8_SB
#undef PG8_STAGE
#undef PG8_LDA
#undef PG8_LDB
#undef PG8_MMA
#undef PG8_WAIT_V
#undef PG8_WAIT_L
#undef PG8_BAR
#undef PG8_SCHED
}
}

__device__ __forceinline__ float wave_sum(float v) {
#pragma unroll
    for (int o = 1; o < 64; o <<= 1) v += __shfl_xor(v, o);
    return v;
}
__device__ __forceinline__ float sigmoidf_(float x) { return 1.0f / (1.0f + expf(-x)); }

typedef unsigned short bf16_t;
typedef unsigned u32x4 __attribute__((ext_vector_type(4)));
typedef unsigned u32x2 __attribute__((ext_vector_type(2)));
__device__ __forceinline__ float bf2f(bf16_t b) { return __builtin_bit_cast(float, (unsigned)b << 16); }
__device__ __forceinline__ bf16_t f2bf(float f) { return (bf16_t)(pg8::cvt_pk_bf16(f, 0.f) & 0xffffu); }
__device__ __forceinline__ void transpose_item(const float* W, int K, int N, bf16_t* WT, int k0, int n0, int drow0, float* scr, int lane) {
#pragma unroll 8
    for (int i = 0; i < 32; ++i) { const int kk = 2 * i + (lane >> 5); scr[kk * 33 + (lane & 31)] = W[(size_t)(k0 + kk) * N + n0 + (lane & 31)]; }
    __builtin_amdgcn_wave_barrier();
    const int c = lane & 7;
#pragma unroll
    for (int j = 0; j < 4; ++j) { const int n = (lane >> 3) + 8 * j; const float* s = scr + (8 * c) * 33 + n;
        u32x4 o; o.x = pg8::cvt_pk_bf16(s[0 * 33], s[1 * 33]); o.y = pg8::cvt_pk_bf16(s[2 * 33], s[3 * 33]); o.z = pg8::cvt_pk_bf16(s[4 * 33], s[5 * 33]); o.w = pg8::cvt_pk_bf16(s[6 * 33], s[7 * 33]);
        *(u32x4*)(WT + (size_t)(drow0 + n) * K + k0 + 8 * c) = o; }
    __builtin_amdgcn_wave_barrier();
}
struct Args {
    const float* in[34]; float* out; unsigned char* ws;
    int ph_lo, ph_hi;
};

struct GF {
    const float* A; long lda; const int* arow; int arow_lim;
    const float* B; long ldb; int bmode;
    int K;
};
template <class Epi>
__device__ __forceinline__ void gemm_f32_tile(float* lds, const GF& g, int row0, int col0, Epi&& epi) {
    float* As = lds;
    float* Bs = lds + 16 * 132;
    const int tid = threadIdx.x, lane = tid & 63, w = tid >> 6, wm = w >> 1, wn = w & 1;
    f32x16 acc0, acc1;
#pragma unroll
    for (int i = 0; i < 16; ++i) { acc0[i] = 0.f; acc1[i] = 0.f; }
    const int ar = tid >> 2, ak = (tid & 3) * 4;
    long arow_idx = row0 + ar; bool avalid = true;
    if (g.arow) { const int t = g.arow[row0 + ar]; avalid = t < g.arow_lim; arow_idx = avalid ? t : 0; }
    const float* ap = g.A + arow_idx * g.lda + ak;
    const float* bp; int bk, bn;
    if (g.bmode == 0) { bk = tid >> 5; bn = (tid & 31) * 4; bp = g.B + (long)bk * g.ldb + col0 + bn; }
    else { bn = tid >> 2; bk = (tid & 3) * 4; bp = g.B + (long)(col0 + bn) * g.ldb + bk; }
    const int hl = lane >> 5, l31 = lane & 31;
    for (int k0 = 0; k0 < g.K; k0 += 16) {
        f32x4 av = (f32x4){0.f, 0.f, 0.f, 0.f};
        if (avalid) av = *(const f32x4*)(ap + k0);
        const f32x4 bv = g.bmode == 0 ? *(const f32x4*)(bp + (long)k0 * g.ldb) : *(const f32x4*)(bp + k0);
        __syncthreads();
        As[(ak + 0) * 132 + ar] = av[0]; As[(ak + 1) * 132 + ar] = av[1]; As[(ak + 2) * 132 + ar] = av[2]; As[(ak + 3) * 132 + ar] = av[3];
        if (g.bmode == 0) *(f32x4*)&Bs[bk * 132 + bn] = bv;
        else { Bs[(bk + 0) * 132 + bn] = bv[0]; Bs[(bk + 1) * 132 + bn] = bv[1]; Bs[(bk + 2) * 132 + bn] = bv[2]; Bs[(bk + 3) * 132 + bn] = bv[3]; }
        __syncthreads();
#pragma unroll
        for (int kk = 0; kk < 16; kk += 2) {
            const float a = As[(kk + hl) * 132 + wm * 32 + l31];
            const float b0 = Bs[(kk + hl) * 132 + wn * 64 + l31];
            const float b1 = Bs[(kk + hl) * 132 + wn * 64 + 32 + l31];
            acc0 = __builtin_amdgcn_mfma_f32_32x32x2f32(a, b0, acc0, 0, 0, 0);
            acc1 = __builtin_amdgcn_mfma_f32_32x32x2f32(a, b1, acc1, 0, 0, 0);
        }
    }
#pragma unroll
    for (int r = 0; r < 16; ++r) {
        const int row = row0 + wm * 32 + (r & 3) + 8 * (r >> 2) + 4 * hl;
        const int col = col0 + wn * 64 + l31;
        epi(row, col, acc0[r]);
        epi(row, col + 32, acc1[r]);
    }
    __syncthreads();
}

__device__ __forceinline__ void ln_row(const float* a, float alpha, const float* b, float* out, const float* gam, const float* bet, int lane, bf16_t* outb = nullptr) {
    f32x4 v[4]; float s = 0.f;
#pragma unroll
    for (int j = 0; j < 4; ++j) {
        v[j] = *(const f32x4*)(a + 4 * lane + 256 * j) * alpha;
        if (b) v[j] += *(const f32x4*)(b + 4 * lane + 256 * j);
        s += (v[j][0] + v[j][1]) + (v[j][2] + v[j][3]);
    }
    const float mean = wave_sum(s) * (1.f / D); float s2 = 0.f;
#pragma unroll
    for (int j = 0; j < 4; ++j) { v[j] = v[j] - mean; s2 += (v[j][0] * v[j][0] + v[j][1] * v[j][1]) + (v[j][2] * v[j][2] + v[j][3] * v[j][3]); }
    const float rstd = 1.f / sqrtf(wave_sum(s2) * (1.f / D) + LN_EPS);
#pragma unroll
    for (int j = 0; j < 4; ++j) {
        const f32x4 gg = *(const f32x4*)(gam + 4 * lane + 256 * j), bb = *(const f32x4*)(bet + 4 * lane + 256 * j);
        const f32x4 o = v[j] * rstd * gg + bb;
        *(f32x4*)(out + 4 * lane + 256 * j) = o;
        if (outb) { u32x2 w; w.x = pg8::cvt_pk_bf16(o[0], o[1]); w.y = pg8::cvt_pk_bf16(o[2], o[3]); *(u32x2*)(outb + 4 * lane + 256 * j) = w; }
    }
}

constexpr int NPHASES = 23;

__global__ void __launch_bounds__(NTHREADS, 2) mega(Args args) {
    extern __shared__ __attribute__((aligned(16))) unsigned char lds_raw[];
    float* ldsf = (float*)lds_raw;
    const int tid = threadIdx.x, lane = tid & 63, wave = tid >> 6;
    const int G = gridDim.x, bx = blockIdx.x;
    const int gw = bx * NWAVES + wave, NGW = G * NWAVES;
    unsigned char* ws = args.ws;
    unsigned* ctl = (unsigned*)(ws + WS_CTL);
    volatile LAS unsigned* misc = (volatile LAS unsigned*)((LAS unsigned char*)lds_raw + MISC_OFF);
    if (tid < 4) misc[tid] = 0u;
    __syncthreads();
    const int lo = args.ph_lo, hi = args.ph_hi;
    const bool multi = (hi - lo) > 1;
    XcdBarrier bar; bar.bar = ctl + CW_BAR; bar.x = 0; bar.st = nullptr;
    if (multi) bar = xcd_barrier_post(ctl + CW_BAR, misc);
#define IN(k) (lo <= (k) && (k) < hi)
#define SEAM(k) do { if (IN(k) && IN((k) + 1)) xcd_barrier(bar); } while (0)

    const float* x = args.in[0]; const float* mem = args.in[1]; const int* positions = (const int*)args.in[2];
    const float* w_in = args.in[3]; const float* mu_shift = args.in[4]; const float* w_decay_up = args.in[5]; const float* w0 = args.in[6];
    const float* a_up = args.in[7]; const float* a0 = args.in[8]; const float* g_up = args.in[9]; const float* k_k = args.in[10]; const float* k_a = args.in[11];
    const float* r_k = args.in[12]; const float* lnx_g = args.in[13]; const float* lnx_b = args.in[14]; const float* sinks = args.in[15];
    const float* w_o = args.in[16]; const float* ln1_g = args.in[17]; const float* ln1_b = args.in[18];
    const float* wm_q = args.in[19]; const float* wm_kv = args.in[20]; const float* wm_o = args.in[21]; const float* ln2_g = args.in[22]; const float* ln2_b = args.in[23];
    const float* w_router = args.in[24]; const float* router_bias = args.in[25];
    const float* we_gate = args.in[26]; const float* we_up = args.in[27]; const float* we_down = args.in[28];
    const float* ws_gate = args.in[29]; const float* ws_up = args.in[30]; const float* ws_down = args.in[31];
    const float* ln3_g = args.in[32]; const float* ln3_b = args.in[33];
    float* out = args.out;

    float* ROPE_C = (float*)(ws + WS_ROPE); float* ROPE_S = ROPE_C + (size_t)NTOK * 32;
    bf16_t* W_IN_T = (bf16_t*)(ws + WS_WIN); bf16_t* W_O_T = (bf16_t*)(ws + WS_WO); bf16_t* WM_Q_T = (bf16_t*)(ws + WS_WMQ); bf16_t* WM_KV_T = (bf16_t*)(ws + WS_WMKV); bf16_t* WM_O_T = (bf16_t*)(ws + WS_WMO);
    bf16_t* XB = (bf16_t*)(ws + WS_XB); bf16_t* MEMB = (bf16_t*)(ws + WS_MEMB);
    bf16_t* U = (bf16_t*)(ws + WS_U); bf16_t* LRB = (bf16_t*)(ws + WS_LRB); bf16_t* DWAG = (bf16_t*)(ws + WS_DWAG);
    float* YLOC = (float*)(ws + WS_YLOC); bf16_t* ZB = (bf16_t*)(ws + WS_ZB); bf16_t* PT = (bf16_t*)(ws + WS_PT); float* SLT = (float*)(ws + WS_SLT); bf16_t* SIN = (bf16_t*)(ws + WS_SIN);
    float* BONUS = (float*)(ws + WS_BONUS); bf16_t* WLR_T = (bf16_t*)(ws + WS_WLR);
    bf16_t* MIX = (bf16_t*)(ws + WS_MIX); float* X1 = (float*)(ws + WS_X1); bf16_t* X1B = (bf16_t*)(ws + WS_X1B);
    bf16_t* QMB = (bf16_t*)(ws + WS_QM); bf16_t* KM = (bf16_t*)(ws + WS_KVM); bf16_t* VT = (bf16_t*)(ws + WS_KVM + 2 * MiB); bf16_t* OM = (bf16_t*)(ws + WS_OM);
    float* X2 = out; bf16_t* X2B = (bf16_t*)(ws + WS_X2B); float* LOG = (float*)(ws + WS_LOG);
    int* EIDX = (int*)(ws + WS_EIDX); float* GATE = (float*)(ws + WS_GATE); int* POS = (int*)(ws + WS_POS); int* YROW = (int*)(ws + WS_YROW);
    int* STOK = (int*)(ws + WS_STOK); float* SGATE = (float*)(ws + WS_SGATE);
    bf16_t* HH = (bf16_t*)(ws + WS_H); bf16_t* HS = (bf16_t*)(ws + WS_HS); bf16_t* YY = (bf16_t*)(ws + WS_Y);
    bf16_t* WS_GU_T = (bf16_t*)(ws + WS_WSGU); bf16_t* WS_D_T = (bf16_t*)(ws + WS_WSD); bf16_t* WE_GU_T = (bf16_t*)(ws + WS_WEGU); bf16_t* WE_D_T = (bf16_t*)(ws + WS_WED);
    int* TEXP = (int*)(ws + WS_TEXP);
    PG8_LAS unsigned char* ldsl = (PG8_LAS unsigned char*)lds_raw;

    if (IN(0)) {
        for (int i = bx * NTHREADS + tid; i < NTOK * 32; i += G * NTHREADS) {
            const int n = i >> 5, f = i & 31;
            const double inv = exp(-(double)(2 * f) / 64.0 * 9.210340371976184);
            const double ang = (double)positions[n] * inv;
            ROPE_C[i] = (float)cos(ang); ROPE_S[i] = (float)sin(ang);
        }
        {
            float* scr = ldsf + wave * 4096;
            constexpr int I_IN = 16 * (INCOLS / 32), I_SQ = 16 * (D / 32), I_KV = 16 * (2048 / 32);
            constexpr int NIT = I_IN + 3 * I_SQ + I_KV;
            for (int it = gw; it < NIT; it += NGW) {
                int r = it;
                if (r < I_IN) { const int nb = INCOLS / 32; transpose_item(w_in, D, INCOLS, W_IN_T, 64 * (r / nb), 32 * (r % nb), 32 * (r % nb), scr, lane); continue; } r -= I_IN;
                if (r < I_SQ) { const int nb = D / 32; transpose_item(w_o, D, D, W_O_T, 64 * (r / nb), 32 * (r % nb), 32 * (r % nb), scr, lane); continue; } r -= I_SQ;
                if (r < I_SQ) { const int nb = D / 32; transpose_item(wm_q, D, D, WM_Q_T, 64 * (r / nb), 32 * (r % nb), 32 * (r % nb), scr, lane); continue; } r -= I_SQ;
                if (r < I_SQ) { const int nb = D / 32; transpose_item(wm_o, D, D, WM_O_T, 64 * (r / nb), 32 * (r % nb), 32 * (r % nb), scr, lane); continue; } r -= I_SQ;
                { const int nb = 2048 / 32; transpose_item(wm_kv, D, 2048, WM_KV_T, 64 * (r / nb), 32 * (r % nb), 32 * (r % nb), scr, lane); }
            }
        }
        for (int i = bx * NTHREADS + tid; i < 1536 * 256; i += G * NTHREADS) {
            const int n = i >> 8, k = i & 255; float v = 0.f;
            if (n < 512) { if (k < 64) v = w_decay_up[k * RW + n]; }
            else if (n < 1024) { if (k >= 64 && k < 128) v = a_up[(k - 64) * RW + (n - 512)]; }
            else { if (k >= 128) v = g_up[(k - 128) * RW + (n - 1024)]; }
            WLR_T[i] = f2bf(v);
        }
        {
            float* scr = ldsf + wave * 4096;
            const int NITE = (NEXP + 1) * 384;
            for (int it = gw; it < NITE; it += NGW) {
                const int e = it / 384, r = it % 384;
                const float* wg = e < NEXP ? we_gate + (size_t)e * D * EDIM : ws_gate; const float* wu = e < NEXP ? we_up + (size_t)e * D * EDIM : ws_up;
                const float* wd = e < NEXP ? we_down + (size_t)e * EDIM * D : ws_down;
                bf16_t* gu = e < NEXP ? WE_GU_T + (size_t)e * 512 * D : WS_GU_T; bf16_t* dt = e < NEXP ? WE_D_T + (size_t)e * D * EDIM : WS_D_T;
                if (r < 256) { const int isup = r >> 7, rr = r & 127, kb = rr >> 3, nb = rr & 7, n0 = 32 * nb;
                    transpose_item(isup ? wu : wg, D, EDIM, gu, 64 * kb, n0, (n0 >> 7) * 256 + isup * 128 + (n0 & 127), scr, lane); }
                else { const int rr = r - 256, kb = rr >> 5, nb = rr & 31;
                    transpose_item(wd, EDIM, D, dt, 64 * kb, 32 * nb, 32 * nb, scr, lane); }
            }
        }
        for (size_t i = (size_t)bx * NTHREADS + tid; i < (size_t)NTOK * D / 8; i += (size_t)G * NTHREADS) {
            const f32x4 a = *(const f32x4*)(x + i * 8), b = *(const f32x4*)(x + i * 8 + 4);
            u32x4 o; o.x = pg8::cvt_pk_bf16(a[0], a[1]); o.y = pg8::cvt_pk_bf16(a[2], a[3]); o.z = pg8::cvt_pk_bf16(b[0], b[1]); o.w = pg8::cvt_pk_bf16(b[2], b[3]);
            *(u32x4*)(XB + i * 8) = o;
        }
        for (size_t i = (size_t)bx * NTHREADS + tid; i < (size_t)BATCH * MEMT * D / 8; i += (size_t)G * NTHREADS) {
            const f32x4 a = *(const f32x4*)(mem + i * 8), b = *(const f32x4*)(mem + i * 8 + 4);
            u32x4 o; o.x = pg8::cvt_pk_bf16(a[0], a[1]); o.y = pg8::cvt_pk_bf16(a[2], a[3]); o.z = pg8::cvt_pk_bf16(b[0], b[1]); o.w = pg8::cvt_pk_bf16(b[2], b[3]);
            *(u32x4*)(MEMB + i * 8) = o;
        }
    }
    SEAM(0);
    if (IN(1)) {
        pg8::DenseProb S{XB, W_IN_T, D, {}}; S.ord.init(NTOK, INCOLS, G, bx);
        pg8::EpiBf16 E{U, INCOLS};
        pg8::gemm_phase(ldsl, S, E);
    }
    SEAM(1);
    if (IN(2)) {
        for (size_t i = (size_t)bx * NTHREADS + tid; i < (size_t)NTOK * 256; i += (size_t)G * NTHREADS) {
            const int n = (int)(i >> 8), c = (int)(i & 255), col = C_WD + c;
            const float u = bf2f(U[(size_t)n * INCOLS + col]);
            const float p = (n % SEQ) ? bf2f(U[(size_t)(n - 1) * INCOLS + col]) : 0.f;
            const float v = u + (p - u) * mu_shift[col];
            LRB[i] = f2bf(c < 64 ? tanhf(v) : (c < 128 ? v : sigmoidf_(v)));
        }
    }
    SEAM(2);
    if (IN(3)) {
        pg8::DenseProb S{LRB, WLR_T, 256, {}}; S.ord.init(NTOK, 1536, G, bx);
        pg8::EpiBf16 E{DWAG, 1536};
        pg8::gemm_phase(ldsl, S, E);
    }
    SEAM(3);
    if (IN(4)) {
        const int ul = wave >> 1, role = wave & 1, j = lane;
        for (int u0 = bx * 4; u0 < BATCH * NCH * 8; u0 += G * 4) {
            const int unit = u0 + ul, b = unit / (NCH * 8), c = (unit % (NCH * 8)) >> 3, h = unit & 7, hc = h * 64 + j;
            float S[64];
#pragma unroll
            for (int k = 0; k < 64; ++k) S[k] = (role && k == j) ? 1.f : 0.f;
            const float mur = mu_shift[C_R + hc], muk = mu_shift[C_K + hc], muv = mu_shift[C_V + hc];
            const float w0j = w0[hc], a0j = a0[hc], kkj = k_k[hc], kaj = k_a[hc], rkj = r_k[hc];
            float* vbase = ldsf + ul * (2 * 8 * 320);
            __syncthreads();
            for (int blk = 0; blk < CH / 8; ++blk) {
                float* vb = vbase + (blk & 1) * (8 * 320);
#pragma unroll
                for (int i = 0; i < 4; ++i) {
                    const int tt = role + 2 * i, t = c * CH + blk * 8 + tt; const size_t n = (size_t)b * SEQ + t;
                    const float r0 = bf2f(U[n * INCOLS + C_R + hc]), k0 = bf2f(U[n * INCOLS + C_K + hc]);
                    const float pr = t ? bf2f(U[(n - 1) * INCOLS + C_R + hc]) : 0.f, pk = t ? bf2f(U[(n - 1) * INCOLS + C_K + hc]) : 0.f;
                    const float r = r0 + (pr - r0) * mur, k = k0 + (pk - k0) * muk;
                    const float dw = bf2f(DWAG[n * 1536 + hc]), da = bf2f(DWAG[n * 1536 + 512 + hc]);
                    const float xx = -(w0j + dw);
                    const float sp = fmaxf(xx, 0.f) + log1pf(expf(-fabsf(xx)));
                    const float wdec = expf(-expf(-sp - 0.5f));
                    const float a = sigmoidf_(a0j + da);
                    const float kkv = k * kkj;
                    const float nrm = sqrtf(wave_sum(kkv * kkv));
                    const float kkn = kkv / fmaxf(nrm, 1e-12f);
                    const float kmod = k * (1.f + (a - 1.f) * kaj);
                    const float bonus = wave_sum(r * kmod * rkj);
                    float* vt = vb + tt * 320;
                    vt[j] = wdec; vt[64 + j] = -kkn; vt[128 + j] = kkn * a; vt[192 + j] = kmod; vt[256 + j] = r;
                    if (lane == 0) BONUS[n * 8 + h] = bonus;
                }
                __syncthreads();
                for (int tt = 0; tt < 8; ++tt) {
                    const int t = c * CH + blk * 8 + tt; const size_t n = (size_t)b * SEQ + t;
                    float vv = 0.f;
                    if (role == 0) { const float v0 = bf2f(U[n * INCOLS + C_V + hc]); const float pv = t ? bf2f(U[(n - 1) * INCOLS + C_V + hc]) : 0.f; vv = v0 + (pv - v0) * muv; }
                    const float* vt = vb + tt * 320;
                    float sa = 0.f;
#pragma unroll
                    for (int kq = 0; kq < 16; ++kq) { const f32x4 av = *(const f32x4*)&vt[64 + 4 * kq];
                        sa += S[4 * kq] * av[0] + S[4 * kq + 1] * av[1] + S[4 * kq + 2] * av[2] + S[4 * kq + 3] * av[3]; }
                    float y = 0.f;
#pragma unroll
                    for (int kq = 0; kq < 16; ++kq) {
                        const f32x4 wv = *(const f32x4*)&vt[4 * kq], bv = *(const f32x4*)&vt[128 + 4 * kq], kv = *(const f32x4*)&vt[192 + 4 * kq], rv = *(const f32x4*)&vt[256 + 4 * kq];
#pragma unroll
                        for (int q = 0; q < 4; ++q) { const float s = S[4 * kq + q] * wv[q] + (sa * bv[q] + vv * kv[q]); S[4 * kq + q] = s; y += s * rv[q]; }
                    }
                    if (role == 0) YLOC[n * RW + hc] = y; else ZB[n * RW + hc] = f2bf(y);
                }
            }
            if (role == 0) { float* dst = SLT + (size_t)unit * 4096 + j;
#pragma unroll
                for (int k = 0; k < 64; ++k) dst[k * 64] = S[k]; }
            else { bf16_t* dst = PT + (size_t)unit * 4096 + j;
#pragma unroll
                for (int k = 0; k < 64; ++k) dst[k * 64] = f2bf(S[k]); }
        }
    }
    SEAM(4);
    if (IN(5)) {
        if (wave == 0 && bx < 64) {
            const int bh = bx >> 1, vs = bx & 1, b = bh >> 3, h = bh & 7, col = lane & 31, hh = lane >> 5;
            f32x16 acc[2];
#pragma unroll
            for (int i = 0; i < 16; ++i) { acc[0][i] = 0.f; acc[1][i] = 0.f; }
            for (int c = 0; c < NCH; ++c) {
                const int unit = (b * NCH + c) * 8 + h;
                bf16_t* sdst = SIN + (size_t)unit * 4096 + (size_t)(32 * vs + col) * 64;
                pg8::bf16x8 Bf[2][2];
#pragma unroll
                for (int jb = 0; jb < 2; ++jb) {
                    unsigned pk[8];
#pragma unroll
                    for (int q = 0; q < 8; ++q) pk[q] = pg8::cvt_pk_bf16(acc[jb][2 * q], acc[jb][2 * q + 1]);
#pragma unroll
                    for (int q = 0; q < 4; ++q) { u32x2 w; w.x = pk[2 * q]; w.y = pk[2 * q + 1]; *(u32x2*)(sdst + 32 * jb + 8 * q + 4 * hh) = w; }
#pragma unroll
                    for (int s = 0; s < 2; ++s) { u32x4 w; w.x = pk[4 * s]; w.y = pk[4 * s + 1]; w.z = pk[4 * s + 2]; w.w = pk[4 * s + 3]; Bf[jb][s] = __builtin_bit_cast(pg8::bf16x8, w); }
                }
                if (c == NCH - 1) break;
                const bf16_t* pt = PT + (size_t)unit * 4096; const float* sl = SLT + (size_t)unit * 4096;
                f32x16 nacc[2];
#pragma unroll
                for (int jo = 0; jo < 2; ++jo) {
#pragma unroll
                    for (int r = 0; r < 16; ++r) nacc[jo][r] = sl[(size_t)(32 * jo + (r & 3) + 8 * (r >> 2) + 4 * hh) * 64 + 32 * vs + col];
#pragma unroll
                    for (int jb = 0; jb < 2; ++jb)
#pragma unroll
                        for (int s = 0; s < 2; ++s) {
                            const bf16_t* ap = pt + (size_t)(32 * jo + col) * 64 + 32 * jb + 16 * s + 4 * hh;
                            const u32x2 a0 = *(const u32x2*)ap, a1 = *(const u32x2*)(ap + 8);
                            u32x4 aw; aw.x = a0.x; aw.y = a0.y; aw.z = a1.x; aw.w = a1.y;
                            nacc[jo] = __builtin_amdgcn_mfma_f32_32x32x16_bf16(__builtin_bit_cast(pg8::bf16x8, aw), Bf[jb][s], nacc[jo], 0, 0, 0);
                        }
                }
                acc[0] = nacc[0]; acc[1] = nacc[1];
            }
        }
    }
    SEAM(5);
    if (IN(6)) {
        const int col = lane & 31, hh = lane >> 5;
        for (int unit = gw; unit < BATCH * NCH * 8; unit += NGW) {
            const int b = unit / (NCH * 8), c = (unit % (NCH * 8)) >> 3, h = unit & 7;
            const bf16_t* sin = SIN + (size_t)unit * 4096;
            pg8::bf16x8 Bf[2][4];
#pragma unroll
            for (int ct = 0; ct < 2; ++ct)
#pragma unroll
                for (int s = 0; s < 4; ++s) Bf[ct][s] = *(const pg8::bf16x8*)(sin + (size_t)(32 * ct + col) * 64 + 16 * s + 8 * hh);
            float lg[2], lb[2], muv[2];
#pragma unroll
            for (int ct = 0; ct < 2; ++ct) { lg[ct] = lnx_g[h * 64 + 32 * ct + col]; lb[ct] = lnx_b[h * 64 + 32 * ct + col]; muv[ct] = mu_shift[C_V + h * 64 + 32 * ct + col]; }
            for (int rt = 0; rt < CH / 32; ++rt) {
                const size_t n0 = (size_t)b * SEQ + c * CH + rt * 32;
                f32x16 acc[2];
#pragma unroll
                for (int i = 0; i < 16; ++i) { acc[0][i] = 0.f; acc[1][i] = 0.f; }
#pragma unroll
                for (int s = 0; s < 4; ++s) {
                    const pg8::bf16x8 Af = *(const pg8::bf16x8*)(ZB + (n0 + col) * RW + h * 64 + 16 * s + 8 * hh);
                    acc[0] = __builtin_amdgcn_mfma_f32_32x32x16_bf16(Af, Bf[0][s], acc[0], 0, 0, 0);
                    acc[1] = __builtin_amdgcn_mfma_f32_32x32x16_bf16(Af, Bf[1][s], acc[1], 0, 0, 0);
                }
#pragma unroll
                for (int r = 0; r < 16; ++r) {
                    const int trow = (r & 3) + 8 * (r >> 2) + 4 * hh; const size_t n = n0 + trow; const int t = c * CH + rt * 32 + trow;
                    float y0 = acc[0][r] + YLOC[n * RW + h * 64 + col], y1 = acc[1][r] + YLOC[n * RW + h * 64 + 32 + col];
                    float sm = y0 + y1, sq = y0 * y0 + y1 * y1;
#pragma unroll
                    for (int o = 1; o < 32; o <<= 1) { sm += __shfl_xor(sm, o); sq += __shfl_xor(sq, o); }
                    const float mu = sm * (1.f / 64.f), var = fmaxf(sq * (1.f / 64.f) - mu * mu, 0.f), rs = 1.f / sqrtf(var + GN_EPS);
                    const float bon = BONUS[n * 8 + h];
#pragma unroll
                    for (int ct = 0; ct < 2; ++ct) {
                        const int hc = h * 64 + 32 * ct + col;
                        const float v0 = bf2f(U[n * INCOLS + C_V + hc]); const float pv = t ? bf2f(U[(n - 1) * INCOLS + C_V + hc]) : 0.f; const float vv = v0 + (pv - v0) * muv[ct];
                        const float gg = bf2f(DWAG[n * 1536 + 1024 + hc]);
                        const float yy = ct ? y1 : y0;
                        MIX[n * D + hc] = f2bf((((yy - mu) * rs) * lg[ct] + lb[ct] + bon * vv) * gg);
                    }
                }
            }
        }
    }
    SEAM(6);
    if (IN(7)) {
        float* Kt = ldsf; float* Vt = ldsf + 255 * 64;
        for (int unit = bx; unit < BATCH * 64 * 2; unit += G) {
            const int b = unit >> 7, blk = (unit & 127) >> 1, hk = unit & 1;
            const int base_s = blk * 128 - 127;
            __syncthreads();
            for (int i = tid; i < 255 * 64; i += NTHREADS) {
                const int jj = i >> 6, d = i & 63, s = base_s + jj;
                Vt[i] = s >= 0 ? bf2f(U[((size_t)b * SEQ + s) * INCOLS + C_VS + hk * 64 + d]) : 0.f;
            }
            for (int i = tid; i < 255 * 32; i += NTHREADS) {
                const int jj = i >> 5, f = i & 31, s = base_s + jj;
                float o1 = 0.f, o2 = 0.f;
                if (s >= 0) { const size_t n = (size_t)b * SEQ + s; const float k1 = bf2f(U[n * INCOLS + C_KS + hk * 64 + f]), k2 = bf2f(U[n * INCOLS + C_KS + hk * 64 + 32 + f]);
                    const float c = ROPE_C[n * 32 + f], sn = ROPE_S[n * 32 + f]; o1 = k1 * c - k2 * sn; o2 = k2 * c + k1 * sn; }
                Kt[jj * 64 + f] = o1; Kt[jj * 64 + 32 + f] = o2;
            }
            __syncthreads();
            const int i = tid & 127, g = tid >> 7, hq = hk * 4 + g;
            const size_t n = (size_t)b * SEQ + blk * 128 + i;
            float q[64], o[64];
#pragma unroll
            for (int f = 0; f < 32; ++f) { const float q1 = bf2f(U[n * INCOLS + C_Q + hq * 64 + f]), q2 = bf2f(U[n * INCOLS + C_Q + hq * 64 + 32 + f]);
                const float c = ROPE_C[n * 32 + f], sn = ROPE_S[n * 32 + f]; q[f] = (q1 * c - q2 * sn) * 0.125f; q[f + 32] = (q2 * c + q1 * sn) * 0.125f; }
#pragma unroll
            for (int d = 0; d < 64; ++d) o[d] = 0.f;
            float m = sinks[hq], l = 1.f;
            for (int jj = 0; jj < 255; ++jj) {
                const int s = base_s + jj;
                const bool valid = (jj >= i) && (jj <= i + 127) && (s >= 0);
                float sc = 0.f;
#pragma unroll
                for (int dq = 0; dq < 16; ++dq) { const f32x4 kv = *(const f32x4*)&Kt[jj * 64 + 4 * dq];
                    sc += q[4 * dq] * kv[0] + q[4 * dq + 1] * kv[1] + q[4 * dq + 2] * kv[2] + q[4 * dq + 3] * kv[3]; }
                if (valid) {
                    const float mn = fmaxf(m, sc), scale = expf(m - mn), p = expf(sc - mn);
                    l = l * scale + p; m = mn;
#pragma unroll
                    for (int dq = 0; dq < 16; ++dq) { const f32x4 vv = *(const f32x4*)&Vt[jj * 64 + 4 * dq];
#pragma unroll
                        for (int qd = 0; qd < 4; ++qd) o[4 * dq + qd] = o[4 * dq + qd] * scale + p * vv[qd]; }
                }
            }
            const float il = 1.f / l;
#pragma unroll
            for (int d = 0; d < 64; ++d) MIX[n * D + RW + hq * 64 + d] = f2bf(o[d] * il);
        }
    }
    SEAM(7);
    if (IN(8)) {
        pg8::DenseProb S{MIX, W_O_T, D, {}}; S.ord.init(NTOK, D, G, bx);
        pg8::EpiF32Res E{X1, D, x, ALPHA};
        pg8::gemm_phase(ldsl, S, E);
    }
    SEAM(8);
    if (IN(9)) { for (int n = gw; n < NTOK; n += NGW) ln_row(X1 + (size_t)n * D, 1.f, nullptr, X1 + (size_t)n * D, ln1_g, ln1_b, lane, X1B + (size_t)n * D); }
    SEAM(9);
    if (IN(10)) {
        { pg8::DenseProb S{X1B, WM_Q_T, D, {}}; S.ord.init(NTOK, D, G, bx); pg8::EpiBf16 E{QMB, D}; pg8::gemm_phase(ldsl, S, E); }
        { pg8::DenseProb S{MEMB, WM_KV_T, D, {}}; S.ord.init(BATCH * MEMT, D, G, bx); pg8::EpiBf16 E{KM, D}; pg8::gemm_phase(ldsl, S, E); }
        { pg8::DenseProb S{WM_KV_T + (size_t)D * D, MEMB, D, {}}; S.ord.init(D, BATCH * MEMT, G, bx); pg8::EpiBf16 E{VT, BATCH * MEMT}; pg8::gemm_phase(ldsl, S, E); }
    }
    SEAM(10);
    if (IN(11)) {
        const int qcol = lane & 15, g = lane >> 4;
        unsigned char* ldsb = lds_raw;
        for (int unit = bx; unit < BATCH * 4 * (SEQ / 128); unit += G) {
            const int b = unit / (4 * (SEQ / 128)), h = (unit / (SEQ / 128)) & 3, qt = unit % (SEQ / 128);
            const size_t q0 = (size_t)b * SEQ + qt * 128 + wave * 16;
            pg8::bf16x8 Qf[8];
#pragma unroll
            for (int ks = 0; ks < 8; ++ks) Qf[ks] = *(const pg8::bf16x8*)(QMB + (q0 + qcol) * D + h * 256 + 32 * ks + 8 * g);
            __syncthreads();
#pragma unroll 4
            for (int i = 0; i < 16; ++i) { const int p = tid + NTHREADS * i, row = p >> 5, ch = p & 31;
                const u32x4 v = *(const u32x4*)(KM + (size_t)(b * MEMT + row) * D + h * 256 + ch * 8);
                *(u32x4*)(ldsb + row * 512 + ((ch ^ (row & 15)) << 4)) = v; }
            __syncthreads();
            pg8::f32x4 acc[16];
#pragma unroll
            for (int kt = 0; kt < 16; ++kt) { acc[kt] = (pg8::f32x4){0.f, 0.f, 0.f, 0.f};
                const int key = 16 * kt + qcol;
#pragma unroll
                for (int ks = 0; ks < 8; ++ks) { const pg8::bf16x8 a = *(const pg8::bf16x8*)(ldsb + key * 512 + (((4 * ks + g) ^ (key & 15)) << 4));
                    acc[kt] = __builtin_amdgcn_mfma_f32_16x16x32_bf16(a, Qf[ks], acc[kt], 0, 0, 0); } }
            float m = -INFINITY;
#pragma unroll
            for (int kt = 0; kt < 16; ++kt)
#pragma unroll
                for (int r = 0; r < 4; ++r) m = fmaxf(m, acc[kt][r]);
            m = fmaxf(m, __shfl_xor(m, 16)); m = fmaxf(m, __shfl_xor(m, 32));
            float lsum = 0.f;
#pragma unroll
            for (int kt = 0; kt < 16; ++kt)
#pragma unroll
                for (int r = 0; r < 4; ++r) { const float p = __expf((acc[kt][r] - m) * 0.0625f); acc[kt][r] = p; lsum += p; }
            lsum += __shfl_xor(lsum, 16); lsum += __shfl_xor(lsum, 32);
            pg8::bf16x8 Pf[8];
#pragma unroll
            for (int ks = 0; ks < 8; ++ks) { u32x4 w; w.x = pg8::cvt_pk_bf16(acc[2 * ks][0], acc[2 * ks][1]); w.y = pg8::cvt_pk_bf16(acc[2 * ks][2], acc[2 * ks][3]);
                w.z = pg8::cvt_pk_bf16(acc[2 * ks + 1][0], acc[2 * ks + 1][1]); w.w = pg8::cvt_pk_bf16(acc[2 * ks + 1][2], acc[2 * ks + 1][3]); Pf[ks] = __builtin_bit_cast(pg8::bf16x8, w); }
            __syncthreads();
#pragma unroll 4
            for (int i = 0; i < 16; ++i) { const int p = tid + NTHREADS * i, row = p >> 5, ch = p & 31;
                const u32x4 v = *(const u32x4*)(VT + (size_t)(h * 256 + row) * (BATCH * MEMT) + b * MEMT + ch * 8);
                *(u32x4*)(ldsb + row * 512 + ((ch ^ (row & 15)) << 4)) = v; }
            __syncthreads();
            float linv[4];
#pragma unroll
            for (int r = 0; r < 4; ++r) linv[r] = 1.f / __shfl(lsum, 4 * g + r);
#pragma unroll
            for (int dt = 0; dt < 16; ++dt) {
                pg8::f32x4 o = (pg8::f32x4){0.f, 0.f, 0.f, 0.f};
                const int dd = 16 * dt + qcol;
#pragma unroll
                for (int ks = 0; ks < 8; ++ks) {
                    const int c8 = 8 * ks + g;
                    const u32x2 v0 = *(const u32x2*)(ldsb + dd * 512 + ((c8 ^ (2 * (dd & 15))) << 3));
                    const u32x2 v1 = *(const u32x2*)(ldsb + dd * 512 + (((c8 + 4) ^ (2 * (dd & 15))) << 3));
                    u32x4 w; w.x = v0.x; w.y = v0.y; w.z = v1.x; w.w = v1.y;
                    o = __builtin_amdgcn_mfma_f32_16x16x32_bf16(Pf[ks], __builtin_bit_cast(pg8::bf16x8, w), o, 0, 0, 0);
                }
#pragma unroll
                for (int r = 0; r < 4; ++r) OM[(q0 + 4 * g + r) * D + h * 256 + dd] = f2bf(o[r] * linv[r]);
            }
        }
    }
    SEAM(11);
    if (IN(14)) {
        pg8::DenseProb S{OM, WM_O_T, D, {}}; S.ord.init(NTOK, D, G, bx);
        pg8::EpiF32Res E{X2, D, X1, ALPHA};
        pg8::gemm_phase(ldsl, S, E);
    }
    SEAM(14);
    if (IN(15)) {
        for (int n = gw; n < NTOK; n += NGW) ln_row(X2 + (size_t)n * D, 1.f, nullptr, X2 + (size_t)n * D, ln2_g, ln2_b, lane, X2B + (size_t)n * D);
        if (bx == 0 && tid < 128) *(u32x4*)(X2B + (size_t)NTOK * D + tid * 8) = (u32x4){0u, 0u, 0u, 0u};
    }
    SEAM(15);
    if (IN(16)) {
        GF g{X2, D, nullptr, 0, w_router, NEXP, 0, D};
        const int nm = NTOK / 128, nn = NEXP / 128;
        for (int t = bx; t < nm * nn; t += G) {
            const int tm = t / nn, tn = t % nn;
            gemm_f32_tile(ldsf, g, tm * 128, tn * 128, [&](int r, int c, float v) { LOG[(size_t)r * NEXP + c] = v; });
        }
    }
    SEAM(16);
    if (IN(17)) {
        const int hl = lane >> 5;
        for (int i = bx * NTHREADS + tid; i < PMAX; i += G * NTHREADS) { STOK[i] = NTOK; SGATE[i] = 0.f; }
        for (int n = gw; n < NTOK; n += NGW) {
            float sc[4], bi[4], gso[4];
#pragma unroll
            for (int j = 0; j < 4; ++j) { const int e = lane + 64 * j; sc[j] = sigmoidf_(LOG[(size_t)n * NEXP + e]); bi[j] = sc[j] + router_bias[e]; }
#pragma unroll
            for (int j = 0; j < 4; ++j) {
                float m1 = bi[j], m2 = -INFINITY;
#pragma unroll
                for (int o = 1; o < 32; o <<= 1) { const float o1 = __shfl_xor(m1, o), o2 = __shfl_xor(m2, o);
                    const float n1 = fmaxf(m1, o1), n2 = fmaxf(fminf(m1, o1), fmaxf(m2, o2)); m1 = n1; m2 = n2; }
                gso[j] = m1 + m2;
            }
            float g8[8];
#pragma unroll
            for (int j = 0; j < 4; ++j) { const float oth = __shfl_xor(gso[j], 32); g8[2 * j] = hl ? oth : gso[j]; g8[2 * j + 1] = hl ? gso[j] : oth; }
            bool gsel[8];
#pragma unroll
            for (int a = 0; a < 8; ++a) { int rank = 0;
#pragma unroll
                for (int c = 0; c < 8; ++c) rank += ((g8[c] > g8[a]) || (g8[c] == g8[a] && c < a)) ? 1 : 0;
                gsel[a] = rank < 4; }
            float cand[4];
#pragma unroll
            for (int j = 0; j < 4; ++j) { const bool s = hl ? gsel[2 * j + 1] : gsel[2 * j]; cand[j] = s ? bi[j] : -1e30f; }
            int eidx[8]; float sel[8]; float ssum = 0.f;
#pragma unroll
            for (int k = 0; k < 8; ++k) {
                float bv = cand[0]; int be = lane;
#pragma unroll
                for (int j = 1; j < 4; ++j) if (cand[j] > bv) { bv = cand[j]; be = lane + 64 * j; }
#pragma unroll
                for (int o = 1; o < 64; o <<= 1) { const float ov = __shfl_xor(bv, o); const int oe = __shfl_xor(be, o);
                    if (ov > bv || (ov == bv && oe < be)) { bv = ov; be = oe; } }
                eidx[k] = be;
                const int jw = be >> 6, lw = be & 63;
                const float mys = jw == 0 ? sc[0] : (jw == 1 ? sc[1] : (jw == 2 ? sc[2] : sc[3]));
                sel[k] = __shfl(mys, lw); ssum += sel[k];
#pragma unroll
                for (int j = 0; j < 4; ++j) if (lane == lw && j == jw) cand[j] = -INFINITY;
            }
#pragma unroll
            for (int k = 0; k < 8; ++k) {
                if (lane == k) {
                    const int e = eidx[k];
                    const int pos = (int)atomicAdd(&ctl[CW_CNT + e], 1u);
                    EIDX[n * 8 + k] = e; GATE[n * 8 + k] = sel[k] / ssum * 2.5f; POS[n * 8 + k] = pos;
                }
            }
        }
    }
    SEAM(17);
    if (IN(18)) {
        if (bx == 0) {
            int* soff = (int*)ldsf;
            if (tid == 0) { int acc = 0, cacc = 0; for (int e = 0; e < NEXP; ++e) { soff[e] = acc; soff[512 + e] = cacc; const int c = (int)ctl[CW_CNT + e]; acc += ((c + MOE_TR - 1) / MOE_TR) * MOE_TR; cacc += c; } soff[NEXP] = acc; }
            __syncthreads();
            if (tid <= NEXP) ctl[CW_OFF + tid] = (unsigned)soff[tid];
            if (tid < NEXP) ctl[CW_CST + tid] = (unsigned)soff[512 + tid];
            if (tid == 0) ctl[CW_NT] = (unsigned)(soff[NEXP] / MOE_TR);
            if (tid < NEXP) { for (int t = soff[tid] / MOE_TR; t < soff[tid + 1] / MOE_TR; ++t) TEXP[t] = tid; }
        }
    }
    SEAM(18);
    if (IN(19)) {
        for (int i = bx * NTHREADS + tid; i < NK; i += G * NTHREADS) {
            const int e = EIDX[i], p = (int)ctl[CW_OFF + e] + POS[i];
            STOK[p] = i >> 3; SGATE[p] = GATE[i]; YROW[i] = (int)ctl[CW_CST + e] + POS[i];
        }
    }
    SEAM(19);
    if (IN(20)) {
        const int ntm = (int)ctl[CW_NT];
        { pg8::GatherProb S{X2B, STOK, WE_GU_T, TEXP, D, 2, ntm * 2, G, bx, (size_t)512 * D * 2}; pg8::EpiSwiGLU E{HH, EDIM}; pg8::gemm_phase(ldsl, S, E); }
        { pg8::DenseProb S{X2B, WS_GU_T, D, {}}; S.ord.init(NTOK, 512, G, bx); pg8::EpiSwiGLU E{HS, EDIM}; pg8::gemm_phase(ldsl, S, E); }
    }
    SEAM(20);
    if (IN(21)) {
        const int ntm = (int)ctl[CW_NT];
        { pg8::GroupedProb S{HH, WE_D_T, TEXP, EDIM, 4, ntm * 4, G, bx, (size_t)D * EDIM * 2}; pg8::EpiScaleY E{YY, SGATE, ctl + CW_OFF, ctl + CW_CNT, ctl + CW_CST}; pg8::gemm_phase(ldsl, S, E); }
        { pg8::DenseProb S{HS, WS_D_T, EDIM, {}}; S.ord.init(NTOK, D, G, bx); pg8::EpiF32Res E{out, D, X2, ALPHA}; pg8::gemm_phase(ldsl, S, E); }
    }
    SEAM(21);
    if (IN(22)) {
        for (int n = gw; n < NTOK; n += NGW) {
            float v[16];
            float* orow = out + (size_t)n * D;
#pragma unroll
            for (int j = 0; j < 2; ++j) { const f32x4 a = *(const f32x4*)(orow + 512 * j + 8 * lane), b = *(const f32x4*)(orow + 512 * j + 8 * lane + 4);
#pragma unroll
                for (int q = 0; q < 4; ++q) { v[8 * j + q] = a[q]; v[8 * j + 4 + q] = b[q]; } }
            int yr[8];
#pragma unroll
            for (int k = 0; k < 8; ++k) yr[k] = YROW[n * 8 + k];
#pragma unroll
            for (int k = 0; k < 8; ++k) {
                const bf16_t* yrow = YY + (size_t)yr[k] * D;
#pragma unroll
                for (int j = 0; j < 2; ++j) { const u32x4 w = *(const u32x4*)(yrow + 512 * j + 8 * lane);
#pragma unroll
                    for (int q = 0; q < 4; ++q) { v[8 * j + 2 * q] += __builtin_bit_cast(float, w[q] << 16); v[8 * j + 2 * q + 1] += __builtin_bit_cast(float, w[q] & 0xffff0000u); } }
            }
            float s = 0.f;
#pragma unroll
            for (int i = 0; i < 16; ++i) s += v[i];
            const float mean = wave_sum(s) * (1.f / D); float s2 = 0.f;
#pragma unroll
            for (int i = 0; i < 16; ++i) { v[i] -= mean; s2 += v[i] * v[i]; }
            const float rstd = 1.f / sqrtf(wave_sum(s2) * (1.f / D) + LN_EPS);
#pragma unroll
            for (int j = 0; j < 2; ++j) {
                const f32x4 g0 = *(const f32x4*)(ln3_g + 512 * j + 8 * lane), g1 = *(const f32x4*)(ln3_g + 512 * j + 8 * lane + 4);
                const f32x4 b0 = *(const f32x4*)(ln3_b + 512 * j + 8 * lane), b1 = *(const f32x4*)(ln3_b + 512 * j + 8 * lane + 4);
                f32x4 o0, o1;
#pragma unroll
                for (int q = 0; q < 4; ++q) { o0[q] = v[8 * j + q] * rstd * g0[q] + b0[q]; o1[q] = v[8 * j + 4 + q] * rstd * g1[q] + b1[q]; }
                *(f32x4*)(orow + 512 * j + 8 * lane) = o0; *(f32x4*)(orow + 512 * j + 8 * lane + 4) = o1;
            }
        }
    }
#undef IN
#undef SEAM
}

#ifndef PHASE_MASK
#define PHASE_MASK 0x7FFFFFu
#endif
#ifndef ONE_LAUNCH
#define ONE_LAUNCH 1
#endif

extern "C" void kernel_launch(void* const* d_in, const int* in_sizes, int n_in, void* d_out, int out_size, void* d_ws, size_t ws_size, hipStream_t stream) {
    static int grid = 0;
    if (grid == 0) {
        if (n_in != 34 || out_size != NTOK * D || ws_size < WS_END) { fprintf(stderr, "kernel_launch: unexpected shapes (n_in %d out %d ws %zu)\n", n_in, out_size, ws_size); grid = -1; return; }
        int dev = 0, cus = 0;
        if (hipGetDevice(&dev) != hipSuccess || hipDeviceGetAttribute(&cus, hipDeviceAttributeMultiprocessorCount, dev) != hipSuccess) { grid = -1; return; }
        if (hipFuncSetAttribute((const void*)mega, hipFuncAttributeMaxDynamicSharedMemorySize, LDS_BYTES) != hipSuccess) { fprintf(stderr, "kernel_launch: hipFuncSetAttribute failed\n"); grid = -1; return; }
        (void)hipGetLastError();
        grid = cus;
    }
    if (grid < 0) return;
    (void)hipMemsetAsync((char*)d_ws + WS_CTL, 0, CTL_ZERO_BYTES, stream);
    Args a{};
    for (int i = 0; i < 34; ++i) a.in[i] = (const float*)d_in[i];
    a.out = (float*)d_out; a.ws = (unsigned char*)d_ws;
#if ONE_LAUNCH
    a.ph_lo = 0; a.ph_hi = NPHASES;
    hipLaunchKernelGGL(mega, dim3(grid), dim3(NTHREADS), LDS_BYTES, stream, a);
#else
    for (int p = 0; p < NPHASES; ++p) { if (!((PHASE_MASK >> p) & 1)) continue; a.ph_lo = p; a.ph_hi = p + 1; hipLaunchKernelGGL(mega, dim3(grid), dim3(NTHREADS), LDS_BYTES, stream, a); }
#endif
}
```

```cpp
#include <hip/hip_runtime.h>
#include <cstdio>
#include <cstdint>

constexpr int D = 1024, BATCH = 4, SEQ = 8192, NTOK = BATCH * SEQ;
constexpr int MEMT = 256;
constexpr int RW = 512, RCOLS = 1792, INCOLS = 2560;
constexpr int C_R = 0, C_K = 512, C_V = 1024, C_WD = 1536, C_AD = 1600, C_GD = 1664, C_Q = 1792, C_KS = 2304, C_VS = 2432;
constexpr int NEXP = 256, TOPK = 8, EDIM = 256;
constexpr int NK = NTOK * TOPK;
constexpr int CH = 128, NCH = SEQ / CH;
constexpr int MOE_TR = 256;
constexpr int PMAX = NK + NEXP * MOE_TR;
constexpr float LN_EPS = 1e-5f, GN_EPS = 64e-5f;
constexpr float ALPHA = 1.189207115002721f;

constexpr size_t MiB = 1u << 20;
constexpr size_t WS_CTL = 0, CTL_ZERO_BYTES = 64 * 1024;
constexpr size_t WS_TEXP = 512 * 1024;
constexpr size_t WS_ROPE = 1 * MiB;
constexpr size_t WS_EIDX = 9 * MiB, WS_GATE = 10 * MiB, WS_POS = 11 * MiB, WS_YROW = 12 * MiB;
constexpr size_t WS_STOK = 13 * MiB, WS_SGATE = 14 * MiB + 512 * 1024;
constexpr size_t WS_WIN = 16 * MiB, WS_WO = 21 * MiB, WS_WMQ = 23 * MiB, WS_WMKV = 25 * MiB, WS_WMO = 29 * MiB, WS_WSGU = 31 * MiB, WS_WSD = 32 * MiB;
constexpr size_t WS_MEMB = 36 * MiB;
constexpr size_t WS_WED = 40 * MiB;
constexpr size_t WS_WEGU = 168 * MiB;
constexpr size_t WS_XB = 424 * MiB;
constexpr size_t WS_U = 490 * MiB;
constexpr size_t WS_LRB = 650 * MiB;
constexpr size_t WS_DWAG = 666 * MiB;
constexpr size_t WS_YLOC = 762 * MiB;
constexpr size_t WS_ZB = 826 * MiB;
constexpr size_t WS_PT = 858 * MiB;
constexpr size_t WS_SLT = 424 * MiB;
constexpr size_t WS_SIN = 456 * MiB;
constexpr size_t WS_BONUS = 472 * MiB;
constexpr size_t WS_WLR = 33 * MiB;
constexpr size_t WS_MIX = 874 * MiB;
constexpr size_t WS_X1 = 424 * MiB;
constexpr size_t WS_X1B = 552 * MiB;
constexpr size_t WS_QM = 616 * MiB;
constexpr size_t WS_KVM = 744 * MiB;
constexpr size_t WS_SC = 752 * MiB;
constexpr size_t WS_OM = 880 * MiB;
constexpr size_t WS_X2B = 424 * MiB;
constexpr size_t WS_LOG = 490 * MiB;
constexpr size_t WS_H = 768 * MiB;
constexpr size_t WS_HS = 928 * MiB;
constexpr size_t WS_Y = 168 * MiB;
constexpr size_t WS_END = 944 * MiB;
constexpr int CW_CNT = 0, CW_OFF = 512, CW_NT = 1024, CW_CST = 1280, CW_BAR = 4096;

constexpr int NTHREADS = 512, NWAVES = 8;
constexpr int LDS_BYTES = 147456;
constexpr int MISC_OFF = 140 * 1024;

#define LAS __attribute__((address_space(3)))
typedef float f32x4 __attribute__((ext_vector_type(4)));
typedef float f32x16 __attribute__((ext_vector_type(16)));

#define XB_TMO      128
#define XB_XCNT(j)  (256  + 64 * (j))
#define XB_XSUB(j)  (1280 + 64 * (j))
#define XB_XGEN(j)  (2304 + 64 * (j))
#define XB_TOP      3328
#define XB_TOPGEN   3392
#define XCD_BAR_WORDS 3456
#define XB_SPIN_CAP (1u << 18)
__device__ __forceinline__ unsigned xb_ld(unsigned* p)              { return __hip_atomic_load(p, __ATOMIC_RELAXED, __HIP_MEMORY_SCOPE_AGENT); }
__device__ __forceinline__ unsigned xb_add(unsigned* p, unsigned v) { return __hip_atomic_fetch_add(p, v, __ATOMIC_RELAXED, __HIP_MEMORY_SCOPE_AGENT); }
__device__ __forceinline__ unsigned xb_xcc_id() { return (unsigned)__builtin_amdgcn_s_getreg((3 << 11) | 20) & 0xFu; }
#define XB_SPIN(cond, bar) do { unsigned _sp = 0; while (cond) { __builtin_amdgcn_s_sleep(1); \
    if ((++_sp & 255u) == 0u) { if (xb_ld(&(bar)[XB_TMO])) break; if (_sp > XB_SPIN_CAP) { atomicAdd(&(bar)[XB_TMO], 1u); break; } } } } while (0)
struct XcdBarrier { unsigned* bar; unsigned x; volatile LAS unsigned* st; };
__device__ __forceinline__ XcdBarrier xcd_barrier_post(unsigned* bar, volatile LAS unsigned* st) {
    XcdBarrier b; b.bar = bar; b.x = xb_xcc_id(); b.st = st;
    if (threadIdx.x == 0) (void)xb_add(&bar[XB_XCNT(b.x)], 1u);
    return b;
}
__device__ __forceinline__ void xcd_barrier_complete(unsigned* bar, unsigned x, unsigned& nloc, unsigned& nx) {
    const unsigned G = gridDim.x * gridDim.y * gridDim.z;
    unsigned sum, cnt, mine, sp = 0u;
    for (;;) {
        sum = 0u; cnt = 0u; mine = 0u;
#pragma unroll
        for (unsigned j = 0; j < 16; ++j) { const unsigned c = xb_ld(&bar[XB_XCNT(j)]); sum += c; cnt += (c > 0u) ? 1u : 0u; mine = (j == x) ? c : mine; }
        if (sum == G) break;
        __builtin_amdgcn_s_sleep(1);
        if ((++sp & 255u) == 0u) { if (xb_ld(&bar[XB_TMO])) break; if (sp > XB_SPIN_CAP) { atomicAdd(&bar[XB_TMO], 1u); break; } }
    }
    nloc = mine > 0u ? mine : 1u; nx = cnt > 0u ? cnt : 1u;
}
__device__ __forceinline__ void xcd_barrier(const XcdBarrier& b) {
    asm volatile("s_waitcnt vmcnt(0)" ::: "memory");
    __syncthreads();
    if (threadIdx.x == 0) {
        unsigned* bar = b.bar;
        __builtin_amdgcn_s_waitcnt(0);
        unsigned nloc = b.st[0], nx = b.st[1];
        if (nloc == 0u) { xcd_barrier_complete(bar, b.x, nloc, nx); b.st[0] = nloc; b.st[1] = nx; }
        const unsigned old = xb_add(&bar[XB_XSUB(b.x)], 1u);
        const unsigned gen = old / nloc;
        if (old + 1u == (gen + 1u) * nloc) {
            __builtin_amdgcn_fence(__ATOMIC_RELEASE, "agent");
            asm volatile("s_waitcnt vmcnt(0)" ::: "memory");
            const unsigned og = xb_add(&bar[XB_TOP], 1u);
            const unsigned tg = og / nx;
            if (og + 1u == (tg + 1u) * nx) xb_add(&bar[XB_TOPGEN], 1u);
            else XB_SPIN(xb_ld(&bar[XB_TOPGEN]) == tg, bar);
            __builtin_amdgcn_fence(__ATOMIC_ACQUIRE, "agent");
            xb_add(&bar[XB_XGEN(b.x)], 1u);
            asm volatile("s_waitcnt vmcnt(0)" ::: "memory");
        } else {
            XB_SPIN(xb_ld(&bar[XB_XGEN(b.x)]) == gen, bar);
            __builtin_amdgcn_fence(__ATOMIC_ACQUIRE, "agent");
            asm volatile("s_waitcnt vmcnt(0)" ::: "memory");
        }
    }
    __syncthreads();
}

namespace pg8 {
#define PG8_LAS __attribute__((address_space(3)))
typedef unsigned short bf16_t;
typedef short bf16x8 __attribute__((ext_vector_type(8)));
typedef float f32x4 __attribute__((ext_vector_type(4)));
typedef float f32x2 __attribute__((ext_vector_type(2)));
typedef unsigned u32x4 __attribute__((ext_vector_type(4)));
constexpr int BM = 256, BK = 64, HALF = 128, HTB = HALF * BK * 2, STAGE_BYTES = 8 * HTB, NXCD = 8, WGM = 8;
__host__ __device__ __forceinline__ int lds_byte(int r, int c) { const int st = (r >> 4) * 2 + (c >> 5), rr = r & 15, cc = c & 31, ob = rr * 64 + cc * 2; return st * 1024 + (ob ^ (((ob >> 9) & 1) << 5)); }
__host__ __device__ __forceinline__ void stage_rc(int b, int& R, int& C) { const int st = b / 1024, sb = b % 1024, swz = sb ^ (((sb >> 9) & 1) << 5); R = (st >> 1) * 16 + swz / 64; C = (st & 1) * 32 + (swz % 64) / 2; }
__host__ __device__ __forceinline__ int perm32(int rho) { const int n = rho >> 4, i = rho & 15; return 8 * (i >> 2) + 4 * n + (i & 3); }
__device__ __forceinline__ unsigned cvt_pk_bf16(float lo, float hi) { unsigned r; asm volatile("v_cvt_pk_bf16_f32 %0, %1, %2" : "=v"(r) : "v"(lo), "v"(hi)); return r; }

struct Unit { int pm, pn, e; };
struct StaticOrder {
    int nM, nN, nwg, G, c;
    __host__ __device__ void init(int M, int N, int G_, int c_) { nM = M / BM; nN = N / BM; nwg = nM * nN; G = G_; c = c_; }
    __host__ __device__ bool next(int i, Unit& u) const {
        const long L = (long)i * G + c; if (L >= nwg) return false;
        int wgid = (int)L; { const int q = nwg / NXCD, r = nwg % NXCD, xcd = wgid % NXCD, off = wgid / NXCD; wgid = (xcd < r ? xcd * (q + 1) : r * (q + 1) + (xcd - r) * q) + off; }
        const int nig = WGM * nN, gid = wgid / nig, fm = gid * WGM, gsz = (nM - fm) < WGM ? (nM - fm) : WGM;
        u.pm = fm + ((wgid % nig) % gsz); u.pn = (wgid % nig) / gsz; u.e = 0; return true;
    }
};
struct DenseProb {
    const bf16_t* A; const bf16_t* Bt; int K; StaticOrder ord;
    __device__ __forceinline__ bool next(int i, Unit& u) const { return ord.next(i, u); }
    __device__ __forceinline__ const char* a_base(const Unit& u) const { return (const char*)A + (size_t)u.pm * BM * K * 2; }
    __device__ __forceinline__ const char* b_base(const Unit& u) const { return (const char*)Bt + (size_t)u.pn * BM * K * 2; }
    __device__ __forceinline__ void a_offs(const Unit&, unsigned (&v)[2][2], const int (&R)[2], const int (&C)[2]) const {
#pragma unroll
        for (int h = 0; h < 2; ++h)
#pragma unroll
            for (int i = 0; i < 2; ++i) v[h][i] = (unsigned)((h * HALF + R[i]) * K + C[i]) * 2u;
    }
};
struct GatherProb {
    const bf16_t* X; const int* stok; const bf16_t* Bt; const int* texp; int K, nN, nunits, G, c; size_t estride;
    __device__ __forceinline__ bool next(int i, Unit& u) const {
        const long L = (long)i * G + c; if (L >= nunits) return false;
        u.pm = (int)(L / nN); u.pn = (int)(L % nN); u.e = texp[u.pm]; return true;
    }
    __device__ __forceinline__ const char* a_base(const Unit&) const { return (const char*)X; }
    __device__ __forceinline__ const char* b_base(const Unit& u) const { return (const char*)Bt + (size_t)u.e * estride + (size_t)u.pn * BM * K * 2; }
    __device__ __forceinline__ void a_offs(const Unit& u, unsigned (&v)[2][2], const int (&R)[2], const int (&C)[2]) const {
#pragma unroll
        for (int h = 0; h < 2; ++h)
#pragma unroll
            for (int i = 0; i < 2; ++i) { const int tok = stok[u.pm * BM + h * HALF + R[i]]; v[h][i] = (unsigned)(tok * K + C[i]) * 2u; }
    }
};
struct GroupedProb {
    const bf16_t* A; const bf16_t* Bt; const int* texp; int K, nN, nunits, G, c; size_t estride;
    __device__ __forceinline__ bool next(int i, Unit& u) const {
        const long L = (long)i * G + c; if (L >= nunits) return false;
        u.pm = (int)(L / nN); u.pn = (int)(L % nN); u.e = texp[u.pm]; return true;
    }
    __device__ __forceinline__ const char* a_base(const Unit& u) const { return (const char*)A + (size_t)u.pm * BM * K * 2; }
    __device__ __forceinline__ const char* b_base(const Unit& u) const { return (const char*)Bt + (size_t)u.e * estride + (size_t)u.pn * BM * K * 2; }
    __device__ __forceinline__ void a_offs(const Unit&, unsigned (&v)[2][2], const int (&R)[2], const int (&C)[2]) const {
#pragma unroll
        for (int h = 0; h < 2; ++h)
#pragma unroll
            for (int i = 0; i < 2; ++i) v[h][i] = (unsigned)((h * HALF + R[i]) * K + C[i]) * 2u;
    }
};

struct EpiBf16 {
    static constexpr bool PERM = true;
    bf16_t* O; int ldc;
    __device__ __forceinline__ void operator()(const f32x4 (&acc)[2][2][4][2], const Unit& u, int wr, int wc, int fr, int fq) const {
        const int row0 = u.pm * BM + wr * 64 + fr, col0 = u.pn * BM + wc * 32 + 8 * fq;
#pragma unroll
        for (int ai = 0; ai < 2; ++ai)
#pragma unroll
            for (int m = 0; m < 4; ++m) { bf16_t* rowp = O + (size_t)(row0 + ai * HALF + m * 16) * ldc + col0;
#pragma unroll
                for (int bj = 0; bj < 2; ++bj) { const f32x4 v0 = acc[ai][bj][m][0], v1 = acc[ai][bj][m][1];
                    u32x4 w; w.x = cvt_pk_bf16(v0[0], v0[1]); w.y = cvt_pk_bf16(v0[2], v0[3]); w.z = cvt_pk_bf16(v1[0], v1[1]); w.w = cvt_pk_bf16(v1[2], v1[3]);
                    *(u32x4*)(rowp + bj * HALF) = w; } }
    }
};
struct EpiF32Res {
    static constexpr bool PERM = false;
    float* C; int ldc; const float* base; float alpha;
    __device__ __forceinline__ void operator()(const f32x4 (&acc)[2][2][4][2], const Unit& u, int wr, int wc, int fr, int fq) const {
        const int row0 = u.pm * BM + wr * 64 + fr, col0 = u.pn * BM + wc * 32 + 4 * fq;
#pragma unroll
        for (int ai = 0; ai < 2; ++ai)
#pragma unroll
            for (int m = 0; m < 4; ++m) { const size_t off = (size_t)(row0 + ai * HALF + m * 16) * ldc + col0;
#pragma unroll
                for (int bj = 0; bj < 2; ++bj)
#pragma unroll
                    for (int n = 0; n < 2; ++n) { f32x4 o = acc[ai][bj][m][n];
                        if (base) o += *(const f32x4*)(base + off + bj * HALF + n * 16) * alpha;
                        *(f32x4*)(C + off + bj * HALF + n * 16) = o; } }
    }
};

struct EpiSwiGLU {
    static constexpr bool PERM = true;
    bf16_t* O; int ldc;
    __device__ __forceinline__ void operator()(const f32x4 (&acc)[2][2][4][2], const Unit& u, int wr, int wc, int fr, int fq) const {
        const int row0 = u.pm * BM + wr * 64 + fr, col0 = u.pn * HALF + wc * 32 + 8 * fq;
#pragma unroll
        for (int ai = 0; ai < 2; ++ai)
#pragma unroll
            for (int m = 0; m < 4; ++m) { bf16_t* rowp = O + (size_t)(row0 + ai * HALF + m * 16) * ldc + col0;
                float h[8];
#pragma unroll
                for (int n = 0; n < 2; ++n)
#pragma unroll
                    for (int q = 0; q < 4; ++q) { const float g = acc[ai][0][m][n][q], up = acc[ai][1][m][n][q]; h[4 * n + q] = g * __builtin_amdgcn_rcpf(1.f + __expf(-g)) * up; }
                u32x4 w; w.x = cvt_pk_bf16(h[0], h[1]); w.y = cvt_pk_bf16(h[2], h[3]); w.z = cvt_pk_bf16(h[4], h[5]); w.w = cvt_pk_bf16(h[6], h[7]);
                *(u32x4*)rowp = w; }
    }
};
struct EpiScaleY {
    static constexpr bool PERM = true;
    bf16_t* Y; const float* sgate; const unsigned* off; const unsigned* cnt; const unsigned* cst;
    __device__ __forceinline__ void operator()(const f32x4 (&acc)[2][2][4][2], const Unit& u, int wr, int wc, int fr, int fq) const {
        const int o0 = (int)off[u.e], nreal = (int)cnt[u.e], c0 = (int)cst[u.e];
        const int row0 = u.pm * BM + wr * 64 + fr, col0 = u.pn * BM + wc * 32 + 8 * fq;
#pragma unroll
        for (int ai = 0; ai < 2; ++ai)
#pragma unroll
            for (int m = 0; m < 4; ++m) { const int p = row0 + ai * HALF + m * 16, rel = p - o0;
                if (rel < nreal) { const float gs = sgate[p]; bf16_t* rowp = Y + (size_t)(c0 + rel) * 1024 + col0;
#pragma unroll
                    for (int bj = 0; bj < 2; ++bj) { const f32x4 v0 = acc[ai][bj][m][0] * gs, v1 = acc[ai][bj][m][1] * gs;
                        u32x4 w; w.x = cvt_pk_bf16(v0[0], v0[1]); w.y = cvt_pk_bf16(v0[2], v0[3]); w.z = cvt_pk_bf16(v1[0], v1[1]); w.w = cvt_pk_bf16(v1[2], v1[3]);
                        *(u32x4*)(rowp + bj * HALF) = w; } } }
    }
};

template <class Epi, class Prob>
__device__ __forceinline__ void gemm_phase(PG8_LAS unsigned char* lds, const Prob& S, const Epi& E) {
    const int tid = threadIdx.x, wid = __builtin_amdgcn_readfirstlane(tid >> 6), lane = tid & 63, wr = wid >> 2, wc = wid & 3, fr = lane & 15, fq = lane >> 4;
    const int K = S.K, nt = K / BK;
    int Rr[2], Cc[2]; unsigned voffB[2];
#pragma unroll
    for (int i = 0; i < 2; ++i) { int R, C; stage_rc(tid * 16 + i * 8192, R, C); const int Rb = Epi::PERM ? ((R & ~31) + perm32(R & 31)) : R;
        Rr[i] = R; Cc[i] = C; voffB[i] = (unsigned)(Rb * K + C) * 2u; }
    const size_t kstep = (size_t)(BK * 2);
    const size_t hstep = (size_t)HALF * K * 2;
    const unsigned ldsw = (unsigned)wid * 1024u;
    const int aoff = lds_byte(wr * 64 + fr, fq * 8), boff = lds_byte(wc * 32 + fr, fq * 8);
#define PG8_SA(b, h) (((b) * 2 + (h)) * HTB)
#define PG8_SB(b, h) ((4 + (b) * 2 + (h)) * HTB)
#define PG8_STAGE(bufoff, gbase, voff) do { _Pragma("unroll") for (int _i = 0; _i < 2; ++_i) \
        __builtin_amdgcn_global_load_lds((const unsigned*)((const char*)(gbase) + (voff)[_i]), (PG8_LAS unsigned*)(lds + (bufoff) + ldsw + _i * 8192), 16, 0, 0); } while (0)
#define PG8_LDA(dst, b, h) do { _Pragma("unroll") for (int m = 0; m < 4; ++m) _Pragma("unroll") for (int k = 0; k < 2; ++k) dst[m][k] = *(const PG8_LAS bf16x8*)(lds + PG8_SA(b, h) + aoff + m * 2048 + k * 1024); } while (0)
#define PG8_LDB(dst, b, h) do { _Pragma("unroll") for (int n = 0; n < 2; ++n) _Pragma("unroll") for (int k = 0; k < 2; ++k) dst[n][k] = *(const PG8_LAS bf16x8*)(lds + PG8_SB(b, h) + boff + n * 2048 + k * 1024); } while (0)
#define PG8_MMA(ai, bj, At, Bt) do { __builtin_amdgcn_s_setprio(1); _Pragma("unroll") for (int m = 0; m < 4; ++m) _Pragma("unroll") for (int n = 0; n < 2; ++n) _Pragma("unroll") for (int k = 0; k < 2; ++k) \
        acc[ai][bj][m][n] = __builtin_amdgcn_mfma_f32_16x16x32_bf16(Bt[n][k], At[m][k], acc[ai][bj][m][n], 0, 0, 0); __builtin_amdgcn_s_setprio(0); } while (0)
#define PG8_WAIT_V(n) asm volatile("s_waitcnt vmcnt(" #n ")" ::: "memory")
#define PG8_WAIT_L(n) asm volatile("s_waitcnt lgkmcnt(" #n ")" ::: "memory")
#define PG8_BAR __builtin_amdgcn_s_barrier()
#define PG8_SCHED __builtin_amdgcn_sched_barrier(0)
    Unit cur, nxt; int ui = 0;
    if (!S.next(0, cur)) return;
    f32x4 acc[2][2][4][2];
#pragma unroll
    for (int a = 0; a < 2; ++a)
#pragma unroll
        for (int b = 0; b < 2; ++b)
#pragma unroll
            for (int m = 0; m < 4; ++m)
#pragma unroll
                for (int n = 0; n < 2; ++n) acc[a][b][m][n] = (f32x4){0.f, 0.f, 0.f, 0.f};
    bf16x8 At[4][2], B0[2][2], B1[2][2];
    const char* cA = S.a_base(cur); const char* cB = S.b_base(cur);
    unsigned vA[2][2], nvA[2][2];
    S.a_offs(cur, vA, Rr, Cc);
    PG8_STAGE(PG8_SB(0, 0), cB, voffB); PG8_STAGE(PG8_SA(0, 0), cA, vA[0]); PG8_STAGE(PG8_SB(0, 1), cB + hstep, voffB); PG8_STAGE(PG8_SA(0, 1), cA, vA[1]);
    if (wr == 1) PG8_BAR;
    PG8_WAIT_V(4); PG8_BAR;
    PG8_STAGE(PG8_SB(1, 0), cB + kstep, voffB); PG8_STAGE(PG8_SA(1, 0), cA + kstep, vA[0]); PG8_STAGE(PG8_SB(1, 1), cB + hstep + kstep, voffB);
    PG8_WAIT_V(6); PG8_BAR;
    for (;;) {
        const bool has_next = S.next(ui + 1, nxt);
        const char* nA = has_next ? S.a_base(nxt) : cA; const char* nB = has_next ? S.b_base(nxt) : cB;
        if (has_next) S.a_offs(nxt, nvA, Rr, Cc);
        else {
#pragma unroll
            for (int h = 0; h < 2; ++h)
#pragma unroll
                for (int i = 0; i < 2; ++i) nvA[h][i] = vA[h][i];
        }
        for (int t = 0; t < nt; t += 2) {
            const bool last = (t == nt - 2);
            const char* a1 = cA + (size_t)(t + 1) * kstep;
            const char* a2 = last ? nA : cA + (size_t)(t + 2) * kstep; const char* b2 = last ? nB : cB + (size_t)(t + 2) * kstep;
            const char* a3 = a2 + kstep; const char* b3 = b2 + kstep;
            unsigned v2[2][2];
#pragma unroll
            for (int h = 0; h < 2; ++h)
#pragma unroll
                for (int i = 0; i < 2; ++i) v2[h][i] = last ? nvA[h][i] : vA[h][i];
            PG8_LDB(B0, 0, 0); PG8_SCHED; PG8_LDA(At, 0, 0); PG8_STAGE(PG8_SA(1, 1), a1, vA[1]);
            PG8_WAIT_L(8); PG8_BAR; PG8_WAIT_L(0); PG8_MMA(0, 0, At, B0); PG8_BAR; PG8_SCHED;
            PG8_LDB(B1, 0, 1); PG8_STAGE(PG8_SB(0, 0), b2, voffB);
            PG8_BAR; PG8_WAIT_L(0); PG8_MMA(0, 1, At, B1); PG8_BAR;
            PG8_LDA(At, 0, 1); PG8_STAGE(PG8_SA(0, 0), a2, v2[0]);
            PG8_BAR; PG8_WAIT_L(0); PG8_MMA(1, 0, At, B0); PG8_BAR; PG8_SCHED;
            PG8_STAGE(PG8_SB(0, 1), b2 + hstep, voffB);
            PG8_WAIT_V(6); PG8_BAR; PG8_MMA(1, 1, At, B1); PG8_BAR;
            PG8_LDB(B0, 1, 0); PG8_SCHED; PG8_LDA(At, 1, 0); PG8_STAGE(PG8_SA(0, 1), a2, v2[1]);
            PG8_WAIT_L(8); PG8_BAR; PG8_WAIT_L(0); PG8_MMA(0, 0, At, B0); PG8_BAR; PG8_SCHED;
            PG8_LDB(B1, 1, 1); PG8_STAGE(PG8_SB(1, 0), b3, voffB);
            PG8_BAR; PG8_WAIT_L(0); PG8_MMA(0, 1, At, B1); PG8_BAR;
            PG8_LDA(At, 1, 1); PG8_STAGE(PG8_SA(1, 0), a3, v2[0]);
            PG8_BAR; PG8_WAIT_L(0); PG8_MMA(1, 0, At, B0); PG8_BAR; PG8_SCHED;
            PG8_STAGE(PG8_SB(1, 1), b3 + hstep, voffB);
            PG8_WAIT_V(6); PG8_BAR; PG8_MMA(1, 1, At, B1); PG8_BAR;
        }
        E(acc, cur, wr, wc, fr, fq);
        if (!has_next) break;
#pragma unroll
        for (int a = 0; a < 2; ++a)
#pragma unroll
            for (int b = 0; b < 2; ++b)
#pragma unroll
                for (int m = 0; m < 4; ++m)
#pragma unroll
                    for (int n = 0; n < 2; ++n) acc[a][b][m][n] = (f32x4){0.f, 0.f, 0.f, 0.f};
        cur = nxt; cA = nA; cB = nB; ++ui;
#pragma unroll
        for (int h = 0; h < 2; ++h)
#pragma unroll
            for (int i = 0; i < 2; ++i) vA[h][i] = nvA[h][i];
    }
    PG8_WAIT_V(0);
    if (wr == 0) PG8_BAR;
    PG8_BAR;
#undef PG8_SA
#undef PG8_SB
#undef PG8_STAGE
#undef PG8_LDA
#undef PG8_LDB
#undef PG8_MMA
#undef PG8_WAIT_V
#undef PG8_WAIT_L
#undef PG8_BAR
#undef PG8_SCHED
}
}

__device__ __forceinline__ float wave_sum(float v) {
#pragma unroll
    for (int o = 1; o < 64; o <<= 1) v += __shfl_xor(v, o);
    return v;
}
__device__ __forceinline__ float sigmoidf_(float x) { return 1.0f / (1.0f + expf(-x)); }

typedef unsigned short bf16_t;
typedef unsigned u32x4 __attribute__((ext_vector_type(4)));
typedef unsigned u32x2 __attribute__((ext_vector_type(2)));
__device__ __forceinline__ float bf2f(bf16_t b) { return __builtin_bit_cast(float, (unsigned)b << 16); }
__device__ __forceinline__ bf16_t f2bf(float f) { return (bf16_t)(pg8::cvt_pk_bf16(f, 0.f) & 0xffffu); }
__device__ __forceinline__ void transpose_item(const float* W, int K, int N, bf16_t* WT, int k0, int n0, int drow0, float* scr, int lane) {
#pragma unroll 8
    for (int i = 0; i < 32; ++i) { const int kk = 2 * i + (lane >> 5); scr[kk * 33 + (lane & 31)] = W[(size_t)(k0 + kk) * N + n0 + (lane & 31)]; }
    __builtin_amdgcn_wave_barrier();
    const int c = lane & 7;
#pragma unroll
    for (int j = 0; j < 4; ++j) { const int n = (lane >> 3) + 8 * j; const float* s = scr + (8 * c) * 33 + n;
        u32x4 o; o.x = pg8::cvt_pk_bf16(s[0 * 33], s[1 * 33]); o.y = pg8::cvt_pk_bf16(s[2 * 33], s[3 * 33]); o.z = pg8::cvt_pk_bf16(s[4 * 33], s[5 * 33]); o.w = pg8::cvt_pk_bf16(s[6 * 33], s[7 * 33]);
        *(u32x4*)(WT + (size_t)(drow0 + n) * K + k0 + 8 * c) = o; }
    __builtin_amdgcn_wave_barrier();
}
struct Args {
    const float* in[34]; float* out; unsigned char* ws;
    int ph_lo, ph_hi;
};

struct GF {
    const float* A; long lda; const int* arow; int arow_lim;
    const float* B; long ldb; int bmode;
    int K;
};
template <class Epi>
__device__ __forceinline__ void gemm_f32_tile(float* lds, const GF& g, int row0, int col0, Epi&& epi) {
    float* As = lds;
    float* Bs = lds + 16 * 132;
    const int tid = threadIdx.x, lane = tid & 63, w = tid >> 6, wm = w >> 1, wn = w & 1;
    f32x16 acc0, acc1;
#pragma unroll
    for (int i = 0; i < 16; ++i) { acc0[i] = 0.f; acc1[i] = 0.f; }
    const int ar = tid >> 2, ak = (tid & 3) * 4;
    long arow_idx = row0 + ar; bool avalid = true;
    if (g.arow) { const int t = g.arow[row0 + ar]; avalid = t < g.arow_lim; arow_idx = avalid ? t : 0; }
    const float* ap = g.A + arow_idx * g.lda + ak;
    const float* bp; int bk, bn;
    if (g.bmode == 0) { bk = tid >> 5; bn = (tid & 31) * 4; bp = g.B + (long)bk * g.ldb + col0 + bn; }
    else { bn = tid >> 2; bk = (tid & 3) * 4; bp = g.B + (long)(col0 + bn) * g.ldb + bk; }
    const int hl = lane >> 5, l31 = lane & 31;
    for (int k0 = 0; k0 < g.K; k0 += 16) {
        f32x4 av = (f32x4){0.f, 0.f, 0.f, 0.f};
        if (avalid) av = *(const f32x4*)(ap + k0);
        const f32x4 bv = g.bmode == 0 ? *(const f32x4*)(bp + (long)k0 * g.ldb) : *(const f32x4*)(bp + k0);
        __syncthreads();
        As[(ak + 0) * 132 + ar] = av[0]; As[(ak + 1) * 132 + ar] = av[1]; As[(ak + 2) * 132 + ar] = av[2]; As[(ak + 3) * 132 + ar] = av[3];
        if (g.bmode == 0) *(f32x4*)&Bs[bk * 132 + bn] = bv;
        else { Bs[(bk + 0) * 132 + bn] = bv[0]; Bs[(bk + 1) * 132 + bn] = bv[1]; Bs[(bk + 2) * 132 + bn] = bv[2]; Bs[(bk + 3) * 132 + bn] = bv[3]; }
        __syncthreads();
#pragma unroll
        for (int kk = 0; kk < 16; kk += 2) {
            const float a = As[(kk + hl) * 132 + wm * 32 + l31];
            const float b0 = Bs[(kk + hl) * 132 + wn * 64 + l31];
            const float b1 = Bs[(kk + hl) * 132 + wn * 64 + 32 + l31];
            acc0 = __builtin_amdgcn_mfma_f32_32x32x2f32(a, b0, acc0, 0, 0, 0);
            acc1 = __builtin_amdgcn_mfma_f32_32x32x2f32(a, b1, acc1, 0, 0, 0);
        }
    }
#pragma unroll
    for (int r = 0; r < 16; ++r) {
        const int row = row0 + wm * 32 + (r & 3) + 8 * (r >> 2) + 4 * hl;
        const int col = col0 + wn * 64 + l31;
        epi(row, col, acc0[r]);
        epi(row, col + 32, acc1[r]);
    }
    __syncthreads();
}

__device__ __forceinline__ void ln_row(const float* a, float alpha, const float* b, float* out, const float* gam, const float* bet, int lane, bf16_t* outb = nullptr) {
    f32x4 v[4]; float s = 0.f;
#pragma unroll
    for (int j = 0; j < 4; ++j) {
        v[j] = *(const f32x4*)(a + 4 * lane + 256 * j) * alpha;
        if (b) v[j] += *(const f32x4*)(b + 4 * lane + 256 * j);
        s += (v[j][0] + v[j][1]) + (v[j][2] + v[j][3]);
    }
    const float mean = wave_sum(s) * (1.f / D); float s2 = 0.f;
#pragma unroll
    for (int j = 0; j < 4; ++j) { v[j] = v[j] - mean; s2 += (v[j][0] * v[j][0] + v[j][1] * v[j][1]) + (v[j][2] * v[j][2] + v[j][3] * v[j][3]); }
    const float rstd = 1.f / sqrtf(wave_sum(s2) * (1.f / D) + LN_EPS);
#pragma unroll
    for (int j = 0; j < 4; ++j) {
        const f32x4 gg = *(const f32x4*)(gam + 4 * lane + 256 * j), bb = *(const f32x4*)(bet + 4 * lane + 256 * j);
        const f32x4 o = v[j] * rstd * gg + bb;
        *(f32x4*)(out + 4 * lane + 256 * j) = o;
        if (outb) { u32x2 w; w.x = pg8::cvt_pk_bf16(o[0], o[1]); w.y = pg8::cvt_pk_bf16(o[2], o[3]); *(u32x2*)(outb + 4 * lane + 256 * j) = w; }
    }
}

constexpr int NPHASES = 23;

__global__ void __launch_bounds__(NTHREADS, 2) mega(Args args) {
    extern __shared__ __attribute__((aligned(16))) unsigned char lds_raw[];
    float* ldsf = (float*)lds_raw;
    const int tid = threadIdx.x, lane = tid & 63, wave = tid >> 6;
    const int G = gridDim.x, bx = blockIdx.x;
    const int gw = bx * NWAVES + wave, NGW = G * NWAVES;
    unsigned char* ws = args.ws;
    unsigned* ctl = (unsigned*)(ws + WS_CTL);
    volatile LAS unsigned* misc = (volatile LAS unsigned*)((LAS unsigned char*)lds_raw + MISC_OFF);
    if (tid < 4) misc[tid] = 0u;
    __syncthreads();
    const int lo = args.ph_lo, hi = args.ph_hi;
    const bool multi = (hi - lo) > 1;
    XcdBarrier bar; bar.bar = ctl + CW_BAR; bar.x = 0; bar.st = nullptr;
    if (multi) bar = xcd_barrier_post(ctl + CW_BAR, misc);
#define IN(k) (lo <= (k) && (k) < hi)
#define SEAM(k) do { if (IN(k) && IN((k) + 1)) xcd_barrier(bar); } while (0)

    const float* x = args.in[0]; const float* mem = args.in[1]; const int* positions = (const int*)args.in[2];
    const float* w_in = args.in[3]; const float* mu_shift = args.in[4]; const float* w_decay_up = args.in[5]; const float* w0 = args.in[6];
    const float* a_up = args.in[7]; const float* a0 = args.in[8]; const float* g_up = args.in[9]; const float* k_k = args.in[10]; const float* k_a = args.in[11];
    const float* r_k = args.in[12]; const float* lnx_g = args.in[13]; const float* lnx_b = args.in[14]; const float* sinks = args.in[15];
    const float* w_o = args.in[16]; const float* ln1_g = args.in[17]; const float* ln1_b = args.in[18];
    const float* wm_q = args.in[19]; const float* wm_kv = args.in[20]; const float* wm_o = args.in[21]; const float* ln2_g = args.in[22]; const float* ln2_b = args.in[23];
    const float* w_router = args.in[24]; const float* router_bias = args.in[25];
    const float* we_gate = args.in[26]; const float* we_up = args.in[27]; const float* we_down = args.in[28];
    const float* ws_gate = args.in[29]; const float* ws_up = args.in[30]; const float* ws_down = args.in[31];
    const float* ln3_g = args.in[32]; const float* ln3_b = args.in[33];
    float* out = args.out;

    float* ROPE_C = (float*)(ws + WS_ROPE); float* ROPE_S = ROPE_C + (size_t)NTOK * 32;
    bf16_t* W_IN_T = (bf16_t*)(ws + WS_WIN); bf16_t* W_O_T = (bf16_t*)(ws + WS_WO); bf16_t* WM_Q_T = (bf16_t*)(ws + WS_WMQ); bf16_t* WM_KV_T = (bf16_t*)(ws + WS_WMKV); bf16_t* WM_O_T = (bf16_t*)(ws + WS_WMO);
    bf16_t* XB = (bf16_t*)(ws + WS_XB); bf16_t* MEMB = (bf16_t*)(ws + WS_MEMB);
    bf16_t* U = (bf16_t*)(ws + WS_U); bf16_t* LRB = (bf16_t*)(ws + WS_LRB); bf16_t* DWAG = (bf16_t*)(ws + WS_DWAG);
    float* YLOC = (float*)(ws + WS_YLOC); bf16_t* ZB = (bf16_t*)(ws + WS_ZB); bf16_t* PT = (bf16_t*)(ws + WS_PT); float* SLT = (float*)(ws + WS_SLT); bf16_t* SIN = (bf16_t*)(ws + WS_SIN);
    float* BONUS = (float*)(ws + WS_BONUS); bf16_t* WLR_T = (bf16_t*)(ws + WS_WLR); bf16_t* W_R_T = (bf16_t*)(ws + WS_WLR + MiB);
    bf16_t* MIX = (bf16_t*)(ws + WS_MIX); float* X1 = (float*)(ws + WS_X1); bf16_t* X1B = (bf16_t*)(ws + WS_X1B);
    bf16_t* QMB = (bf16_t*)(ws + WS_QM); bf16_t* KM = (bf16_t*)(ws + WS_KVM); bf16_t* VT = (bf16_t*)(ws + WS_KVM + 2 * MiB); bf16_t* OM = (bf16_t*)(ws + WS_OM);
    float* X2 = out; bf16_t* X2B = (bf16_t*)(ws + WS_X2B); float* LOG = (float*)(ws + WS_LOG);
    int* EIDX = (int*)(ws + WS_EIDX); float* GATE = (float*)(ws + WS_GATE); int* POS = (int*)(ws + WS_POS); int* YROW = (int*)(ws + WS_YROW);
    int* STOK = (int*)(ws + WS_STOK); float* SGATE = (float*)(ws + WS_SGATE);
    bf16_t* HH = (bf16_t*)(ws + WS_H); bf16_t* HS = (bf16_t*)(ws + WS_HS); bf16_t* YY = (bf16_t*)(ws + WS_Y);
    bf16_t* WS_GU_T = (bf16_t*)(ws + WS_WSGU); bf16_t* WS_D_T = (bf16_t*)(ws + WS_WSD); bf16_t* WE_GU_T = (bf16_t*)(ws + WS_WEGU); bf16_t* WE_D_T = (bf16_t*)(ws + WS_WED);
    int* TEXP = (int*)(ws + WS_TEXP);
    PG8_LAS unsigned char* ldsl = (PG8_LAS unsigned char*)lds_raw;

    if (IN(0)) {
        for (int i = bx * NTHREADS + tid; i < NTOK * 32; i += G * NTHREADS) {
            const int n = i >> 5, f = i & 31;
            const double inv = exp(-(double)(2 * f) / 64.0 * 9.210340371976184);
            const double ang = (double)positions[n] * inv;
            ROPE_C[i] = (float)cos(ang); ROPE_S[i] = (float)sin(ang);
        }
        {
            float* scr = ldsf + wave * 4096;
            constexpr int I_IN = 16 * (INCOLS / 32), I_SQ = 16 * (D / 32), I_KV = 16 * (2048 / 32);
            constexpr int I_R = 16 * (NEXP / 32); constexpr int NIT = I_IN + 3 * I_SQ + I_KV + I_R;
            for (int it = gw; it < NIT; it += NGW) {
                int r = it;
                if (r < I_IN) { const int nb = INCOLS / 32; transpose_item(w_in, D, INCOLS, W_IN_T, 64 * (r / nb), 32 * (r % nb), 32 * (r % nb), scr, lane); continue; } r -= I_IN;
                if (r < I_SQ) { const int nb = D / 32; transpose_item(w_o, D, D, W_O_T, 64 * (r / nb), 32 * (r % nb), 32 * (r % nb), scr, lane); continue; } r -= I_SQ;
                if (r < I_SQ) { const int nb = D / 32; transpose_item(wm_q, D, D, WM_Q_T, 64 * (r / nb), 32 * (r % nb), 32 * (r % nb), scr, lane); continue; } r -= I_SQ;
                if (r < I_SQ) { const int nb = D / 32; transpose_item(wm_o, D, D, WM_O_T, 64 * (r / nb), 32 * (r % nb), 32 * (r % nb), scr, lane); continue; } r -= I_SQ;
                if (r < I_KV) { const int nb = 2048 / 32; transpose_item(wm_kv, D, 2048, WM_KV_T, 64 * (r / nb), 32 * (r % nb), 32 * (r % nb), scr, lane); continue; } r -= I_KV;
                { const int nb = NEXP / 32; transpose_item(w_router, D, NEXP, W_R_T, 64 * (r / nb), 32 * (r % nb), 32 * (r % nb), scr, lane); }
            }
        }
        for (int i = bx * NTHREADS + tid; i < 1536 * 256; i += G * NTHREADS) {
            const int n = i >> 8, k = i & 255; float v = 0.f;
            if (n < 512) { if (k < 64) v = w_decay_up[k * RW + n]; }
            else if (n < 1024) { if (k >= 64 && k < 128) v = a_up[(k - 64) * RW + (n - 512)]; }
            else { if (k >= 128) v = g_up[(k - 128) * RW + (n - 1024)]; }
            WLR_T[i] = f2bf(v);
        }
        {
            float* scr = ldsf + wave * 4096;
            const int NITE = (NEXP + 1) * 384;
            for (int it = gw; it < NITE; it += NGW) {
                const int e = it / 384, r = it % 384;
                const float* wg = e < NEXP ? we_gate + (size_t)e * D * EDIM : ws_gate; const float* wu = e < NEXP ? we_up + (size_t)e * D * EDIM : ws_up;
                const float* wd = e < NEXP ? we_down + (size_t)e * EDIM * D : ws_down;
                bf16_t* gu = e < NEXP ? WE_GU_T + (size_t)e * 512 * D : WS_GU_T; bf16_t* dt = e < NEXP ? WE_D_T + (size_t)e * D * EDIM : WS_D_T;
                if (r < 256) { const int isup = r >> 7, rr = r & 127, kb = rr >> 3, nb = rr & 7, n0 = 32 * nb;
                    transpose_item(isup ? wu : wg, D, EDIM, gu, 64 * kb, n0, (n0 >> 7) * 256 + isup * 128 + (n0 & 127), scr, lane); }
                else { const int rr = r - 256, kb = rr >> 5, nb = rr & 31;
                    transpose_item(wd, EDIM, D, dt, 64 * kb, 32 * nb, 32 * nb, scr, lane); }
            }
        }
        for (size_t i = (size_t)bx * NTHREADS + tid; i < (size_t)NTOK * D / 8; i += (size_t)G * NTHREADS) {
            const f32x4 a = *(const f32x4*)(x + i * 8), b = *(const f32x4*)(x + i * 8 + 4);
            u32x4 o; o.x = pg8::cvt_pk_bf16(a[0], a[1]); o.y = pg8::cvt_pk_bf16(a[2], a[3]); o.z = pg8::cvt_pk_bf16(b[0], b[1]); o.w = pg8::cvt_pk_bf16(b[2], b[3]);
            *(u32x4*)(XB + i * 8) = o;
        }
        for (size_t i = (size_t)bx * NTHREADS + tid; i < (size_t)BATCH * MEMT * D / 8; i += (size_t)G * NTHREADS) {
            const f32x4 a = *(const f32x4*)(mem + i * 8), b = *(const f32x4*)(mem + i * 8 + 4);
            u32x4 o; o.x = pg8::cvt_pk_bf16(a[0], a[1]); o.y = pg8::cvt_pk_bf16(a[2], a[3]); o.z = pg8::cvt_pk_bf16(b[0], b[1]); o.w = pg8::cvt_pk_bf16(b[2], b[3]);
            *(u32x4*)(MEMB + i * 8) = o;
        }
    }
    SEAM(0);
    if (IN(1)) {
        pg8::DenseProb S{XB, W_IN_T, D, {}}; S.ord.init(NTOK, INCOLS, G, bx);
        pg8::EpiBf16 E{U, INCOLS};
        pg8::gemm_phase(ldsl, S, E);
    }
    SEAM(1);
    if (IN(2)) {
        for (size_t i = (size_t)bx * NTHREADS + tid; i < (size_t)NTOK * 256; i += (size_t)G * NTHREADS) {
            const int n = (int)(i >> 8), c = (int)(i & 255), col = C_WD + c;
            const float u = bf2f(U[(size_t)n * INCOLS + col]);
            const float p = (n % SEQ) ? bf2f(U[(size_t)(n - 1) * INCOLS + col]) : 0.f;
            const float v = u + (p - u) * mu_shift[col];
            LRB[i] = f2bf(c < 64 ? tanhf(v) : (c < 128 ? v : sigmoidf_(v)));
        }
    }
    SEAM(2);
    if (IN(3)) {
        pg8::DenseProb S{LRB, WLR_T, 256, {}}; S.ord.init(NTOK, 1536, G, bx);
        pg8::EpiBf16 E{DWAG, 1536};
        pg8::gemm_phase(ldsl, S, E);
    }
    SEAM(3);
    if (IN(4)) {
        const int ul = wave >> 1, role = wave & 1, j = lane;
        for (int u0 = bx * 4; u0 < BATCH * NCH * 8; u0 += G * 4) {
            const int unit = u0 + ul, b = unit / (NCH * 8), c = (unit % (NCH * 8)) >> 3, h = unit & 7, hc = h * 64 + j;
            float S[64];
#pragma unroll
            for (int k = 0; k < 64; ++k) S[k] = (role && k == j) ? 1.f : 0.f;
            const float mur = mu_shift[C_R + hc], muk = mu_shift[C_K + hc], muv = mu_shift[C_V + hc];
            const float w0j = w0[hc], a0j = a0[hc], kkj = k_k[hc], kaj = k_a[hc], rkj = r_k[hc];
            float* vbase = ldsf + ul * (2 * 8 * 320);
            __syncthreads();
            for (int blk = 0; blk < CH / 8; ++blk) {
                float* vb = vbase + (blk & 1) * (8 * 320);
#pragma unroll
                for (int i = 0; i < 4; ++i) {
                    const int tt = role + 2 * i, t = c * CH + blk * 8 + tt; const size_t n = (size_t)b * SEQ + t;
                    const float r0 = bf2f(U[n * INCOLS + C_R + hc]), k0 = bf2f(U[n * INCOLS + C_K + hc]);
                    const float pr = t ? bf2f(U[(n - 1) * INCOLS + C_R + hc]) : 0.f, pk = t ? bf2f(U[(n - 1) * INCOLS + C_K + hc]) : 0.f;
                    const float r = r0 + (pr - r0) * mur, k = k0 + (pk - k0) * muk;
                    const float dw = bf2f(DWAG[n * 1536 + hc]), da = bf2f(DWAG[n * 1536 + 512 + hc]);
                    const float xx = -(w0j + dw);
                    const float sp = fmaxf(xx, 0.f) + log1pf(expf(-fabsf(xx)));
                    const float wdec = expf(-expf(-sp - 0.5f));
                    const float a = sigmoidf_(a0j + da);
                    const float kkv = k * kkj;
                    const float nrm = sqrtf(wave_sum(kkv * kkv));
                    const float kkn = kkv / fmaxf(nrm, 1e-12f);
                    const float kmod = k * (1.f + (a - 1.f) * kaj);
                    const float bonus = wave_sum(r * kmod * rkj);
                    float* vt = vb + tt * 320;
                    vt[j] = wdec; vt[64 + j] = -kkn; vt[128 + j] = kkn * a; vt[192 + j] = kmod; vt[256 + j] = r;
                    if (lane == 0) BONUS[n * 8 + h] = bonus;
                }
                __syncthreads();
                for (int tt = 0; tt < 8; ++tt) {
                    const int t = c * CH + blk * 8 + tt; const size_t n = (size_t)b * SEQ + t;
                    float vv = 0.f;
                    if (role == 0) { const float v0 = bf2f(U[n * INCOLS + C_V + hc]); const float pv = t ? bf2f(U[(n - 1) * INCOLS + C_V + hc]) : 0.f; vv = v0 + (pv - v0) * muv; }
                    const float* vt = vb + tt * 320;
                    float sa = 0.f;
#pragma unroll
                    for (int kq = 0; kq < 16; ++kq) { const f32x4 av = *(const f32x4*)&vt[64 + 4 * kq];
                        sa += S[4 * kq] * av[0] + S[4 * kq + 1] * av[1] + S[4 * kq + 2] * av[2] + S[4 * kq + 3] * av[3]; }
                    float y = 0.f;
#pragma unroll
                    for (int kq = 0; kq < 16; ++kq) {
                        const f32x4 wv = *(const f32x4*)&vt[4 * kq], bv = *(const f32x4*)&vt[128 + 4 * kq], kv = *(const f32x4*)&vt[192 + 4 * kq], rv = *(const f32x4*)&vt[256 + 4 * kq];
#pragma unroll
                        for (int q = 0; q < 4; ++q) { const float s = S[4 * kq + q] * wv[q] + (sa * bv[q] + vv * kv[q]); S[4 * kq + q] = s; y += s * rv[q]; }
                    }
                    if (role == 0) YLOC[n * RW + hc] = y; else ZB[n * RW + hc] = f2bf(y);
                }
            }
            if (role == 0) { float* dst = SLT + (size_t)unit * 4096 + j;
#pragma unroll
                for (int k = 0; k < 64; ++k) dst[k * 64] = S[k]; }
            else { bf16_t* dst = PT + (size_t)unit * 4096 + j;
#pragma unroll
                for (int k = 0; k < 64; ++k) dst[k * 64] = f2bf(S[k]); }
        }
    }
    SEAM(4);
    if (IN(5)) {
        if (wave == 0 && bx < 64) {
            const int bh = bx >> 1, vs = bx & 1, b = bh >> 3, h = bh & 7, col = lane & 31, hh = lane >> 5;
            f32x16 acc[2];
#pragma unroll
            for (int i = 0; i < 16; ++i) { acc[0][i] = 0.f; acc[1][i] = 0.f; }
            for (int c = 0; c < NCH; ++c) {
                const int unit = (b * NCH + c) * 8 + h;
                bf16_t* sdst = SIN + (size_t)unit * 4096 + (size_t)(32 * vs + col) * 64;
                pg8::bf16x8 Bf[2][2];
#pragma unroll
                for (int jb = 0; jb < 2; ++jb) {
                    unsigned pk[8];
#pragma unroll
                    for (int q = 0; q < 8; ++q) pk[q] = pg8::cvt_pk_bf16(acc[jb][2 * q], acc[jb][2 * q + 1]);
#pragma unroll
                    for (int q = 0; q < 4; ++q) { u32x2 w; w.x = pk[2 * q]; w.y = pk[2 * q + 1]; *(u32x2*)(sdst + 32 * jb + 8 * q + 4 * hh) = w; }
#pragma unroll
                    for (int s = 0; s < 2; ++s) { u32x4 w; w.x = pk[4 * s]; w.y = pk[4 * s + 1]; w.z = pk[4 * s + 2]; w.w = pk[4 * s + 3]; Bf[jb][s] = __builtin_bit_cast(pg8::bf16x8, w); }
                }
                if (c == NCH - 1) break;
                const bf16_t* pt = PT + (size_t)unit * 4096; const float* sl = SLT + (size_t)unit * 4096;
                f32x16 nacc[2];
#pragma unroll
                for (int jo = 0; jo < 2; ++jo) {
#pragma unroll
                    for (int r = 0; r < 16; ++r) nacc[jo][r] = sl[(size_t)(32 * jo + (r & 3) + 8 * (r >> 2) + 4 * hh) * 64 + 32 * vs + col];
#pragma unroll
                    for (int jb = 0; jb < 2; ++jb)
#pragma unroll
                        for (int s = 0; s < 2; ++s) {
                            const bf16_t* ap = pt + (size_t)(32 * jo + col) * 64 + 32 * jb + 16 * s + 4 * hh;
                            const u32x2 a0 = *(const u32x2*)ap, a1 = *(const u32x2*)(ap + 8);
                            u32x4 aw; aw.x = a0.x; aw.y = a0.y; aw.z = a1.x; aw.w = a1.y;
                            nacc[jo] = __builtin_amdgcn_mfma_f32_32x32x16_bf16(__builtin_bit_cast(pg8::bf16x8, aw), Bf[jb][s], nacc[jo], 0, 0, 0);
                        }
                }
                acc[0] = nacc[0]; acc[1] = nacc[1];
            }
        }
    }
    SEAM(5);
    if (IN(6)) {
        const int col = lane & 31, hh = lane >> 5;
        for (int unit = gw; unit < BATCH * NCH * 8; unit += NGW) {
            const int b = unit / (NCH * 8), c = (unit % (NCH * 8)) >> 3, h = unit & 7;
            const bf16_t* sin = SIN + (size_t)unit * 4096;
            pg8::bf16x8 Bf[2][4];
#pragma unroll
            for (int ct = 0; ct < 2; ++ct)
#pragma unroll
                for (int s = 0; s < 4; ++s) Bf[ct][s] = *(const pg8::bf16x8*)(sin + (size_t)(32 * ct + col) * 64 + 16 * s + 8 * hh);
            float lg[2], lb[2], muv[2];
#pragma unroll
            for (int ct = 0; ct < 2; ++ct) { lg[ct] = lnx_g[h * 64 + 32 * ct + col]; lb[ct] = lnx_b[h * 64 + 32 * ct + col]; muv[ct] = mu_shift[C_V + h * 64 + 32 * ct + col]; }
            for (int rt = 0; rt < CH / 32; ++rt) {
                const size_t n0 = (size_t)b * SEQ + c * CH + rt * 32;
                f32x16 acc[2];
#pragma unroll
                for (int i = 0; i < 16; ++i) { acc[0][i] = 0.f; acc[1][i] = 0.f; }
#pragma unroll
                for (int s = 0; s < 4; ++s) {
                    const pg8::bf16x8 Af = *(const pg8::bf16x8*)(ZB + (n0 + col) * RW + h * 64 + 16 * s + 8 * hh);
                    acc[0] = __builtin_amdgcn_mfma_f32_32x32x16_bf16(Af, Bf[0][s], acc[0], 0, 0, 0);
                    acc[1] = __builtin_amdgcn_mfma_f32_32x32x16_bf16(Af, Bf[1][s], acc[1], 0, 0, 0);
                }
#pragma unroll
                for (int r = 0; r < 16; ++r) {
                    const int trow = (r & 3) + 8 * (r >> 2) + 4 * hh; const size_t n = n0 + trow; const int t = c * CH + rt * 32 + trow;
                    float y0 = acc[0][r] + YLOC[n * RW + h * 64 + col], y1 = acc[1][r] + YLOC[n * RW + h * 64 + 32 + col];
                    float sm = y0 + y1, sq = y0 * y0 + y1 * y1;
#pragma unroll
                    for (int o = 1; o < 32; o <<= 1) { sm += __shfl_xor(sm, o); sq += __shfl_xor(sq, o); }
                    const float mu = sm * (1.f / 64.f), var = fmaxf(sq * (1.f / 64.f) - mu * mu, 0.f), rs = 1.f / sqrtf(var + GN_EPS);
                    const float bon = BONUS[n * 8 + h];
#pragma unroll
                    for (int ct = 0; ct < 2; ++ct) {
                        const int hc = h * 64 + 32 * ct + col;
                        const float v0 = bf2f(U[n * INCOLS + C_V + hc]); const float pv = t ? bf2f(U[(n - 1) * INCOLS + C_V + hc]) : 0.f; const float vv = v0 + (pv - v0) * muv[ct];
                        const float gg = bf2f(DWAG[n * 1536 + 1024 + hc]);
                        const float yy = ct ? y1 : y0;
                        MIX[n * D + hc] = f2bf((((yy - mu) * rs) * lg[ct] + lb[ct] + bon * vv) * gg);
                    }
                }
            }
        }
    }
    SEAM(6);
    if (IN(7)) {
        float* Kt = ldsf; float* Vt = ldsf + 255 * 64;
        for (int unit = bx; unit < BATCH * 64 * 2; unit += G) {
            const int b = unit >> 7, blk = (unit & 127) >> 1, hk = unit & 1;
            const int base_s = blk * 128 - 127;
            __syncthreads();
            for (int i = tid; i < 255 * 64; i += NTHREADS) {
                const int jj = i >> 6, d = i & 63, s = base_s + jj;
                Vt[i] = s >= 0 ? bf2f(U[((size_t)b * SEQ + s) * INCOLS + C_VS + hk * 64 + d]) : 0.f;
            }
            for (int i = tid; i < 255 * 32; i += NTHREADS) {
                const int jj = i >> 5, f = i & 31, s = base_s + jj;
                float o1 = 0.f, o2 = 0.f;
                if (s >= 0) { const size_t n = (size_t)b * SEQ + s; const float k1 = bf2f(U[n * INCOLS + C_KS + hk * 64 + f]), k2 = bf2f(U[n * INCOLS + C_KS + hk * 64 + 32 + f]);
                    const float c = ROPE_C[n * 32 + f], sn = ROPE_S[n * 32 + f]; o1 = k1 * c - k2 * sn; o2 = k2 * c + k1 * sn; }
                Kt[jj * 64 + f] = o1; Kt[jj * 64 + 32 + f] = o2;
            }
            __syncthreads();
            const int i = tid & 127, g = tid >> 7, hq = hk * 4 + g;
            const size_t n = (size_t)b * SEQ + blk * 128 + i;
            float q[64], o[64];
#pragma unroll
            for (int f = 0; f < 32; ++f) { const float q1 = bf2f(U[n * INCOLS + C_Q + hq * 64 + f]), q2 = bf2f(U[n * INCOLS + C_Q + hq * 64 + 32 + f]);
                const float c = ROPE_C[n * 32 + f], sn = ROPE_S[n * 32 + f]; q[f] = (q1 * c - q2 * sn) * 0.125f; q[f + 32] = (q2 * c + q1 * sn) * 0.125f; }
#pragma unroll
            for (int d = 0; d < 64; ++d) o[d] = 0.f;
            float m = sinks[hq], l = 1.f;
            for (int jj = 0; jj < 255; ++jj) {
                const int s = base_s + jj;
                const bool valid = (jj >= i) && (jj <= i + 127) && (s >= 0);
                float sc = 0.f;
#pragma unroll
                for (int dq = 0; dq < 16; ++dq) { const f32x4 kv = *(const f32x4*)&Kt[jj * 64 + 4 * dq];
                    sc += q[4 * dq] * kv[0] + q[4 * dq + 1] * kv[1] + q[4 * dq + 2] * kv[2] + q[4 * dq + 3] * kv[3]; }
                if (valid) {
                    const float mn = fmaxf(m, sc), scale = expf(m - mn), p = expf(sc - mn);
                    l = l * scale + p; m = mn;
#pragma unroll
                    for (int dq = 0; dq < 16; ++dq) { const f32x4 vv = *(const f32x4*)&Vt[jj * 64 + 4 * dq];
#pragma unroll
                        for (int qd = 0; qd < 4; ++qd) o[4 * dq + qd] = o[4 * dq + qd] * scale + p * vv[qd]; }
                }
            }
            const float il = 1.f / l;
#pragma unroll
            for (int d = 0; d < 64; ++d) MIX[n * D + RW + hq * 64 + d] = f2bf(o[d] * il);
        }
    }
    SEAM(7);
    if (IN(8)) {
        pg8::DenseProb S{MIX, W_O_T, D, {}}; S.ord.init(NTOK, D, G, bx);
        pg8::EpiF32Res E{X1, D, x, ALPHA};
        pg8::gemm_phase(ldsl, S, E);
    }
    SEAM(8);
    if (IN(9)) { for (int n = gw; n < NTOK; n += NGW) ln_row(X1 + (size_t)n * D, 1.f, nullptr, X1 + (size_t)n * D, ln1_g, ln1_b, lane, X1B + (size_t)n * D); }
    SEAM(9);
    if (IN(10)) {
        { pg8::DenseProb S{X1B, WM_Q_T, D, {}}; S.ord.init(NTOK, D, G, bx); pg8::EpiBf16 E{QMB, D}; pg8::gemm_phase(ldsl, S, E); }
        { pg8::DenseProb S{MEMB, WM_KV_T, D, {}}; S.ord.init(BATCH * MEMT, D, G, bx); pg8::EpiBf16 E{KM, D}; pg8::gemm_phase(ldsl, S, E); }
        { pg8::DenseProb S{WM_KV_T + (size_t)D * D, MEMB, D, {}}; S.ord.init(D, BATCH * MEMT, G, bx); pg8::EpiBf16 E{VT, BATCH * MEMT}; pg8::gemm_phase(ldsl, S, E); }
    }
    SEAM(10);
    if (IN(11)) {
        const int qcol = lane & 15, g = lane >> 4;
        unsigned char* ldsb = lds_raw;
        for (int unit = bx; unit < BATCH * 4 * (SEQ / 128); unit += G) {
            const int b = unit / (4 * (SEQ / 128)), h = (unit / (SEQ / 128)) & 3, qt = unit % (SEQ / 128);
            const size_t q0 = (size_t)b * SEQ + qt * 128 + wave * 16;
            pg8::bf16x8 Qf[8];
#pragma unroll
            for (int ks = 0; ks < 8; ++ks) Qf[ks] = *(const pg8::bf16x8*)(QMB + (q0 + qcol) * D + h * 256 + 32 * ks + 8 * g);
            __syncthreads();
#pragma unroll 4
            for (int i = 0; i < 16; ++i) { const int p = tid + NTHREADS * i, row = p >> 5, ch = p & 31;
                const u32x4 v = *(const u32x4*)(KM + (size_t)(b * MEMT + row) * D + h * 256 + ch * 8);
                *(u32x4*)(ldsb + row * 512 + ((ch ^ (row & 15)) << 4)) = v; }
            __syncthreads();
            pg8::f32x4 acc[16];
#pragma unroll
            for (int kt = 0; kt < 16; ++kt) { acc[kt] = (pg8::f32x4){0.f, 0.f, 0.f, 0.f};
                const int key = 16 * kt + qcol;
#pragma unroll
                for (int ks = 0; ks < 8; ++ks) { const pg8::bf16x8 a = *(const pg8::bf16x8*)(ldsb + key * 512 + (((4 * ks + g) ^ (key & 15)) << 4));
                    acc[kt] = __builtin_amdgcn_mfma_f32_16x16x32_bf16(a, Qf[ks], acc[kt], 0, 0, 0); } }
            float m = -INFINITY;
#pragma unroll
            for (int kt = 0; kt < 16; ++kt)
#pragma unroll
                for (int r = 0; r < 4; ++r) m = fmaxf(m, acc[kt][r]);
            m = fmaxf(m, __shfl_xor(m, 16)); m = fmaxf(m, __shfl_xor(m, 32));
            float lsum = 0.f;
#pragma unroll
            for (int kt = 0; kt < 16; ++kt)
#pragma unroll
                for (int r = 0; r < 4; ++r) { const float p = __expf((acc[kt][r] - m) * 0.0625f); acc[kt][r] = p; lsum += p; }
            lsum += __shfl_xor(lsum, 16); lsum += __shfl_xor(lsum, 32);
            pg8::bf16x8 Pf[8];
#pragma unroll
            for (int ks = 0; ks < 8; ++ks) { u32x4 w; w.x = pg8::cvt_pk_bf16(acc[2 * ks][0], acc[2 * ks][1]); w.y = pg8::cvt_pk_bf16(acc[2 * ks][2], acc[2 * ks][3]);
                w.z = pg8::cvt_pk_bf16(acc[2 * ks + 1][0], acc[2 * ks + 1][1]); w.w = pg8::cvt_pk_bf16(acc[2 * ks + 1][2], acc[2 * ks + 1][3]); Pf[ks] = __builtin_bit_cast(pg8::bf16x8, w); }
            __syncthreads();
#pragma unroll 4
            for (int i = 0; i < 16; ++i) { const int p = tid + NTHREADS * i, row = p >> 5, ch = p & 31;
                const u32x4 v = *(const u32x4*)(VT + (size_t)(h * 256 + row) * (BATCH * MEMT) + b * MEMT + ch * 8);
                *(u32x4*)(ldsb + row * 512 + ((ch ^ (row & 15)) << 4)) = v; }
            __syncthreads();
            float linv[4];
#pragma unroll
            for (int r = 0; r < 4; ++r) linv[r] = 1.f / __shfl(lsum, 4 * g + r);
#pragma unroll
            for (int dt = 0; dt < 16; ++dt) {
                pg8::f32x4 o = (pg8::f32x4){0.f, 0.f, 0.f, 0.f};
                const int dd = 16 * dt + qcol;
#pragma unroll
                for (int ks = 0; ks < 8; ++ks) {
                    const int c8 = 8 * ks + g;
                    const u32x2 v0 = *(const u32x2*)(ldsb + dd * 512 + ((c8 ^ (2 * (dd & 15))) << 3));
                    const u32x2 v1 = *(const u32x2*)(ldsb + dd * 512 + (((c8 + 4) ^ (2 * (dd & 15))) << 3));
                    u32x4 w; w.x = v0.x; w.y = v0.y; w.z = v1.x; w.w = v1.y;
                    o = __builtin_amdgcn_mfma_f32_16x16x32_bf16(Pf[ks], __builtin_bit_cast(pg8::bf16x8, w), o, 0, 0, 0);
                }
#pragma unroll
                for (int r = 0; r < 4; ++r) OM[(q0 + 4 * g + r) * D + h * 256 + dd] = f2bf(o[r] * linv[r]);
            }
        }
    }
    SEAM(11);
    if (IN(14)) {
        pg8::DenseProb S{OM, WM_O_T, D, {}}; S.ord.init(NTOK, D, G, bx);
        pg8::EpiF32Res E{X2, D, X1, ALPHA};
        pg8::gemm_phase(ldsl, S, E);
    }
    SEAM(14);
    if (IN(15)) {
        for (int n = gw; n < NTOK; n += NGW) ln_row(X2 + (size_t)n * D, 1.f, nullptr, X2 + (size_t)n * D, ln2_g, ln2_b, lane, X2B + (size_t)n * D);
        if (bx == 0 && tid < 128) *(u32x4*)(X2B + (size_t)NTOK * D + tid * 8) = (u32x4){0u, 0u, 0u, 0u};
    }
    SEAM(15);
    if (IN(16)) {
        pg8::DenseProb S{X2B, W_R_T, D, {}}; S.ord.init(NTOK, NEXP, G, bx);
        pg8::EpiF32Res E{LOG, NEXP, nullptr, 0.f};
        pg8::gemm_phase(ldsl, S, E);
    }
    SEAM(16);
    if (IN(17)) {
        const int hl = lane >> 5;
        for (int i = bx * NTHREADS + tid; i < PMAX; i += G * NTHREADS) { STOK[i] = NTOK; SGATE[i] = 0.f; }
        for (int n = gw; n < NTOK; n += NGW) {
            float sc[4], bi[4], gso[4];
#pragma unroll
            for (int j = 0; j < 4; ++j) { const int e = lane + 64 * j; sc[j] = sigmoidf_(LOG[(size_t)n * NEXP + e]); bi[j] = sc[j] + router_bias[e]; }
#pragma unroll
            for (int j = 0; j < 4; ++j) {
                float m1 = bi[j], m2 = -INFINITY;
#pragma unroll
                for (int o = 1; o < 32; o <<= 1) { const float o1 = __shfl_xor(m1, o), o2 = __shfl_xor(m2, o);
                    const float n1 = fmaxf(m1, o1), n2 = fmaxf(fminf(m1, o1), fmaxf(m2, o2)); m1 = n1; m2 = n2; }
                gso[j] = m1 + m2;
            }
            float g8[8];
#pragma unroll
            for (int j = 0; j < 4; ++j) { const float oth = __shfl_xor(gso[j], 32); g8[2 * j] = hl ? oth : gso[j]; g8[2 * j + 1] = hl ? gso[j] : oth; }
            bool gsel[8];
#pragma unroll
            for (int a = 0; a < 8; ++a) { int rank = 0;
#pragma unroll
                for (int c = 0; c < 8; ++c) rank += ((g8[c] > g8[a]) || (g8[c] == g8[a] && c < a)) ? 1 : 0;
                gsel[a] = rank < 4; }
            float cand[4];
#pragma unroll
            for (int j = 0; j < 4; ++j) { const bool s = hl ? gsel[2 * j + 1] : gsel[2 * j]; cand[j] = s ? bi[j] : -1e30f; }
            int eidx[8]; float sel[8]; float ssum = 0.f;
#pragma unroll
            for (int k = 0; k < 8; ++k) {
                float bv = cand[0]; int be = lane;
#pragma unroll
                for (int j = 1; j < 4; ++j) if (cand[j] > bv) { bv = cand[j]; be = lane + 64 * j; }
#pragma unroll
                for (int o = 1; o < 64; o <<= 1) { const float ov = __shfl_xor(bv, o); const int oe = __shfl_xor(be, o);
                    if (ov > bv || (ov == bv && oe < be)) { bv = ov; be = oe; } }
                eidx[k] = be;
                const int jw = be >> 6, lw = be & 63;
                const float mys = jw == 0 ? sc[0] : (jw == 1 ? sc[1] : (jw == 2 ? sc[2] : sc[3]));
                sel[k] = __shfl(mys, lw); ssum += sel[k];
#pragma unroll
                for (int j = 0; j < 4; ++j) if (lane == lw && j == jw) cand[j] = -INFINITY;
            }
#pragma unroll
            for (int k = 0; k < 8; ++k) {
                if (lane == k) {
                    const int e = eidx[k];
                    const int pos = (int)atomicAdd(&ctl[CW_CNT + e], 1u);
                    EIDX[n * 8 + k] = e; GATE[n * 8 + k] = sel[k] / ssum * 2.5f; POS[n * 8 + k] = pos;
                }
            }
        }
    }
    SEAM(17);
    if (IN(18)) {
        if (bx == 0) {
            int* soff = (int*)ldsf;
            if (tid == 0) { int acc = 0, cacc = 0; for (int e = 0; e < NEXP; ++e) { soff[e] = acc; soff[512 + e] = cacc; const int c = (int)ctl[CW_CNT + e]; acc += ((c + MOE_TR - 1) / MOE_TR) * MOE_TR; cacc += c; } soff[NEXP] = acc; }
            __syncthreads();
            if (tid <= NEXP) ctl[CW_OFF + tid] = (unsigned)soff[tid];
            if (tid < NEXP) ctl[CW_CST + tid] = (unsigned)soff[512 + tid];
            if (tid == 0) ctl[CW_NT] = (unsigned)(soff[NEXP] / MOE_TR);
            if (tid < NEXP) { for (int t = soff[tid] / MOE_TR; t < soff[tid + 1] / MOE_TR; ++t) TEXP[t] = tid; }
        }
    }
    SEAM(18);
    if (IN(19)) {
        for (int i = bx * NTHREADS + tid; i < NK; i += G * NTHREADS) {
            const int e = EIDX[i], p = (int)ctl[CW_OFF + e] + POS[i];
            STOK[p] = i >> 3; SGATE[p] = GATE[i]; YROW[i] = (int)ctl[CW_CST + e] + POS[i];
        }
    }
    SEAM(19);
    if (IN(20)) {
        const int ntm = (int)ctl[CW_NT];
        { pg8::GatherProb S{X2B, STOK, WE_GU_T, TEXP, D, 2, ntm * 2, G, bx, (size_t)512 * D * 2}; pg8::EpiSwiGLU E{HH, EDIM}; pg8::gemm_phase(ldsl, S, E); }
        { pg8::DenseProb S{X2B, WS_GU_T, D, {}}; S.ord.init(NTOK, 512, G, bx); pg8::EpiSwiGLU E{HS, EDIM}; pg8::gemm_phase(ldsl, S, E); }
    }
    SEAM(20);
    if (IN(21)) {
        const int ntm = (int)ctl[CW_NT];
        { pg8::GroupedProb S{HH, WE_D_T, TEXP, EDIM, 4, ntm * 4, G, bx, (size_t)D * EDIM * 2}; pg8::EpiScaleY E{YY, SGATE, ctl + CW_OFF, ctl + CW_CNT, ctl + CW_CST}; pg8::gemm_phase(ldsl, S, E); }
        { pg8::DenseProb S{HS, WS_D_T, EDIM, {}}; S.ord.init(NTOK, D, G, bx); pg8::EpiF32Res E{out, D, X2, ALPHA}; pg8::gemm_phase(ldsl, S, E); }
    }
    SEAM(21);
    if (IN(22)) {
        for (int n = gw; n < NTOK; n += NGW) {
            float v[16];
            float* orow = out + (size_t)n * D;
#pragma unroll
            for (int j = 0; j < 2; ++j) { const f32x4 a = *(const f32x4*)(orow + 512 * j + 8 * lane), b = *(const f32x4*)(orow + 512 * j + 8 * lane + 4);
#pragma unroll
                for (int q = 0; q < 4; ++q) { v[8 * j + q] = a[q]; v[8 * j + 4 + q] = b[q]; } }
            int yr[8];
#pragma unroll
            for (int k = 0; k < 8; ++k) yr[k] = YROW[n * 8 + k];
#pragma unroll
            for (int k = 0; k < 8; ++k) {
                const bf16_t* yrow = YY + (size_t)yr[k] * D;
#pragma unroll
                for (int j = 0; j < 2; ++j) { const u32x4 w = *(const u32x4*)(yrow + 512 * j + 8 * lane);
#pragma unroll
                    for (int q = 0; q < 4; ++q) { v[8 * j + 2 * q] += __builtin_bit_cast(float, w[q] << 16); v[8 * j + 2 * q + 1] += __builtin_bit_cast(float, w[q] & 0xffff0000u); } }
            }
            float s = 0.f;
#pragma unroll
            for (int i = 0; i < 16; ++i) s += v[i];
            const float mean = wave_sum(s) * (1.f / D); float s2 = 0.f;
#pragma unroll
            for (int i = 0; i < 16; ++i) { v[i] -= mean; s2 += v[i] * v[i]; }
            const float rstd = 1.f / sqrtf(wave_sum(s2) * (1.f / D) + LN_EPS);
#pragma unroll
            for (int j = 0; j < 2; ++j) {
                const f32x4 g0 = *(const f32x4*)(ln3_g + 512 * j + 8 * lane), g1 = *(const f32x4*)(ln3_g + 512 * j + 8 * lane + 4);
                const f32x4 b0 = *(const f32x4*)(ln3_b + 512 * j + 8 * lane), b1 = *(const f32x4*)(ln3_b + 512 * j + 8 * lane + 4);
                f32x4 o0, o1;
#pragma unroll
                for (int q = 0; q < 4; ++q) { o0[q] = v[8 * j + q] * rstd * g0[q] + b0[q]; o1[q] = v[8 * j + 4 + q] * rstd * g1[q] + b1[q]; }
                *(f32x4*)(orow + 512 * j + 8 * lane) = o0; *(f32x4*)(orow + 512 * j + 8 * lane + 4) = o1;
            }
        }
    }
#undef IN
#undef SEAM
}

#ifndef PHASE_MASK
#define PHASE_MASK 0x7FFFFFu
#endif
#ifndef ONE_LAUNCH
#define ONE_LAUNCH 1
#endif

extern "C" void kernel_launch(void* const* d_in, const int* in_sizes, int n_in, void* d_out, int out_size, void* d_ws, size_t ws_size, hipStream_t stream) {
    static int grid = 0;
    if (grid == 0) {
        if (n_in != 34 || out_size != NTOK * D || ws_size < WS_END) { fprintf(stderr, "kernel_launch: unexpected shapes (n_in %d out %d ws %zu)\n", n_in, out_size, ws_size); grid = -1; return; }
        int dev = 0, cus = 0;
        if (hipGetDevice(&dev) != hipSuccess || hipDeviceGetAttribute(&cus, hipDeviceAttributeMultiprocessorCount, dev) != hipSuccess) { grid = -1; return; }
        if (hipFuncSetAttribute((const void*)mega, hipFuncAttributeMaxDynamicSharedMemorySize, LDS_BYTES) != hipSuccess) { fprintf(stderr, "kernel_launch: hipFuncSetAttribute failed\n"); grid = -1; return; }
        (void)hipGetLastError();
        grid = cus;
    }
    if (grid < 0) return;
    (void)hipMemsetAsync((char*)d_ws + WS_CTL, 0, CTL_ZERO_BYTES, stream);
    Args a{};
    for (int i = 0; i < 34; ++i) a.in[i] = (const float*)d_in[i];
    a.out = (float*)d_out; a.ws = (unsigned char*)d_ws;
#if ONE_LAUNCH
    a.ph_lo = 0; a.ph_hi = NPHASES;
    hipLaunchKernelGGL(mega, dim3(grid), dim3(NTHREADS), LDS_BYTES, stream, a);
#else
    for (int p = 0; p < NPHASES; ++p) { if (!((PHASE_MASK >> p) & 1)) continue; a.ph_lo = p; a.ph_hi = p + 1; hipLaunchKernelGGL(mega, dim3(grid), dim3(NTHREADS), LDS_BYTES, stream, a); }
#endif
}
```

```cpp
#include <hip/hip_runtime.h>
#include <cstdio>
#include <cstdint>

constexpr int D = 1024, BATCH = 4, SEQ = 8192, NTOK = BATCH * SEQ;
constexpr int MEMT = 256;
constexpr int RW = 512, RCOLS = 1792, INCOLS = 2560;
constexpr int C_R = 0, C_K = 512, C_V = 1024, C_WD = 1536, C_AD = 1600, C_GD = 1664, C_Q = 1792, C_KS = 2304, C_VS = 2432;
constexpr int NEXP = 256, TOPK = 8, EDIM = 256;
constexpr int NK = NTOK * TOPK;
constexpr int CH = 128, NCH = SEQ / CH;
constexpr int MOE_TR = 256;
constexpr int PMAX = NK + NEXP * MOE_TR;
constexpr float LN_EPS = 1e-5f, GN_EPS = 64e-5f;
constexpr float ALPHA = 1.189207115002721f;

constexpr size_t MiB = 1u << 20;
constexpr size_t WS_CTL = 0, CTL_ZERO_BYTES = 64 * 1024;
constexpr size_t WS_TEXP = 512 * 1024;
constexpr size_t WS_ROPE = 1 * MiB;
constexpr size_t WS_EIDX = 9 * MiB, WS_GATE = 10 * MiB, WS_POS = 11 * MiB, WS_YROW = 12 * MiB;
constexpr size_t WS_STOK = 13 * MiB, WS_SGATE = 14 * MiB + 512 * 1024;
constexpr size_t WS_WIN = 16 * MiB, WS_WO = 21 * MiB, WS_WMQ = 23 * MiB, WS_WMKV = 25 * MiB, WS_WMO = 29 * MiB, WS_WSGU = 31 * MiB, WS_WSD = 32 * MiB;
constexpr size_t WS_MEMB = 36 * MiB;
constexpr size_t WS_WED = 40 * MiB;
constexpr size_t WS_WEGU = 168 * MiB;
constexpr size_t WS_XB = 424 * MiB;
constexpr size_t WS_U = 490 * MiB;
constexpr size_t WS_LRB = 650 * MiB;
constexpr size_t WS_DWAG = 666 * MiB;
constexpr size_t WS_YLOC = 762 * MiB;
constexpr size_t WS_ZB = 826 * MiB;
constexpr size_t WS_PT = 858 * MiB;
constexpr size_t WS_SLT = 424 * MiB;
constexpr size_t WS_SIN = 456 * MiB;
constexpr size_t WS_BONUS = 472 * MiB;
constexpr size_t WS_WLR = 33 * MiB;
constexpr size_t WS_MIX = 874 * MiB;
constexpr size_t WS_X1 = 424 * MiB;
constexpr size_t WS_X1B = 552 * MiB;
constexpr size_t WS_QM = 616 * MiB;
constexpr size_t WS_KVM = 744 * MiB;
constexpr size_t WS_SC = 752 * MiB;
constexpr size_t WS_OM = 880 * MiB;
constexpr size_t WS_X2B = 424 * MiB;
constexpr size_t WS_LOG = 490 * MiB;
constexpr size_t WS_H = 768 * MiB;
constexpr size_t WS_HS = 928 * MiB;
constexpr size_t WS_Y = 168 * MiB;
constexpr size_t WS_END = 944 * MiB;
constexpr int CW_CNT = 0, CW_OFF = 512, CW_NT = 1024, CW_CST = 1280, CW_BAR = 4096;

constexpr int NTHREADS = 512, NWAVES = 8;
constexpr int LDS_BYTES = 147456;
constexpr int MISC_OFF = 140 * 1024;

#define LAS __attribute__((address_space(3)))
typedef float f32x4 __attribute__((ext_vector_type(4)));
typedef float f32x16 __attribute__((ext_vector_type(16)));

#define XB_TMO      128
#define XB_XCNT(j)  (256  + 64 * (j))
#define XB_XSUB(j)  (1280 + 64 * (j))
#define XB_XGEN(j)  (2304 + 64 * (j))
#define XB_TOP      3328
#define XB_TOPGEN   3392
#define XCD_BAR_WORDS 3456
#define XB_SPIN_CAP (1u << 18)
__device__ __forceinline__ unsigned xb_ld(unsigned* p)              { return __hip_atomic_load(p, __ATOMIC_RELAXED, __HIP_MEMORY_SCOPE_AGENT); }
__device__ __forceinline__ unsigned xb_add(unsigned* p, unsigned v) { return __hip_atomic_fetch_add(p, v, __ATOMIC_RELAXED, __HIP_MEMORY_SCOPE_AGENT); }
__device__ __forceinline__ unsigned xb_xcc_id() { return (unsigned)__builtin_amdgcn_s_getreg((3 << 11) | 20) & 0xFu; }
#define XB_SPIN(cond, bar) do { unsigned _sp = 0; while (cond) { __builtin_amdgcn_s_sleep(1); \
    if ((++_sp & 255u) == 0u) { if (xb_ld(&(bar)[XB_TMO])) break; if (_sp > XB_SPIN_CAP) { atomicAdd(&(bar)[XB_TMO], 1u); break; } } } } while (0)
struct XcdBarrier { unsigned* bar; unsigned x; volatile LAS unsigned* st; };
__device__ __forceinline__ XcdBarrier xcd_barrier_post(unsigned* bar, volatile LAS unsigned* st) {
    XcdBarrier b; b.bar = bar; b.x = xb_xcc_id(); b.st = st;
    if (threadIdx.x == 0) (void)xb_add(&bar[XB_XCNT(b.x)], 1u);
    return b;
}
__device__ __forceinline__ void xcd_barrier_complete(unsigned* bar, unsigned x, unsigned& nloc, unsigned& nx) {
    const unsigned G = gridDim.x * gridDim.y * gridDim.z;
    unsigned sum, cnt, mine, sp = 0u;
    for (;;) {
        sum = 0u; cnt = 0u; mine = 0u;
#pragma unroll
        for (unsigned j = 0; j < 16; ++j) { const unsigned c = xb_ld(&bar[XB_XCNT(j)]); sum += c; cnt += (c > 0u) ? 1u : 0u; mine = (j == x) ? c : mine; }
        if (sum == G) break;
        __builtin_amdgcn_s_sleep(1);
        if ((++sp & 255u) == 0u) { if (xb_ld(&bar[XB_TMO])) break; if (sp > XB_SPIN_CAP) { atomicAdd(&bar[XB_TMO], 1u); break; } }
    }
    nloc = mine > 0u ? mine : 1u; nx = cnt > 0u ? cnt : 1u;
}
__device__ __forceinline__ void xcd_barrier(const XcdBarrier& b) {
    asm volatile("s_waitcnt vmcnt(0)" ::: "memory");
    __syncthreads();
    if (threadIdx.x == 0) {
        unsigned* bar = b.bar;
        __builtin_amdgcn_s_waitcnt(0);
        unsigned nloc = b.st[0], nx = b.st[1];
        if (nloc == 0u) { xcd_barrier_complete(bar, b.x, nloc, nx); b.st[0] = nloc; b.st[1] = nx; }
        const unsigned old = xb_add(&bar[XB_XSUB(b.x)], 1u);
        const unsigned gen = old / nloc;
        if (old + 1u == (gen + 1u) * nloc) {
            __builtin_amdgcn_fence(__ATOMIC_RELEASE, "agent");
            asm volatile("s_waitcnt vmcnt(0)" ::: "memory");
            const unsigned og = xb_add(&bar[XB_TOP], 1u);
            const unsigned tg = og / nx;
            if (og + 1u == (tg + 1u) * nx) xb_add(&bar[XB_TOPGEN], 1u);
            else XB_SPIN(xb_ld(&bar[XB_TOPGEN]) == tg, bar);
            __builtin_amdgcn_fence(__ATOMIC_ACQUIRE, "agent");
            xb_add(&bar[XB_XGEN(b.x)], 1u);
            asm volatile("s_waitcnt vmcnt(0)" ::: "memory");
        } else {
            XB_SPIN(xb_ld(&bar[XB_XGEN(b.x)]) == gen, bar);
            __builtin_amdgcn_fence(__ATOMIC_ACQUIRE, "agent");
            asm volatile("s_waitcnt vmcnt(0)" ::: "memory");
        }
    }
    __syncthreads();
}

namespace pg8 {
#define PG8_LAS __attribute__((address_space(3)))
typedef unsigned short bf16_t;
typedef short bf16x8 __attribute__((ext_vector_type(8)));
typedef float f32x4 __attribute__((ext_vector_type(4)));
typedef float f32x2 __attribute__((ext_vector_type(2)));
typedef unsigned u32x4 __attribute__((ext_vector_type(4)));
constexpr int BM = 256, BK = 64, HALF = 128, HTB = HALF * BK * 2, STAGE_BYTES = 8 * HTB, NXCD = 8, WGM = 8;
__host__ __device__ __forceinline__ int lds_byte(int r, int c) { const int st = (r >> 4) * 2 + (c >> 5), rr = r & 15, cc = c & 31, ob = rr * 64 + cc * 2; return st * 1024 + (ob ^ (((ob >> 9) & 1) << 5)); }
__host__ __device__ __forceinline__ void stage_rc(int b, int& R, int& C) { const int st = b / 1024, sb = b % 1024, swz = sb ^ (((sb >> 9) & 1) << 5); R = (st >> 1) * 16 + swz / 64; C = (st & 1) * 32 + (swz % 64) / 2; }
__host__ __device__ __forceinline__ int perm32(int rho) { const int n = rho >> 4, i = rho & 15; return 8 * (i >> 2) + 4 * n + (i & 3); }
__device__ __forceinline__ unsigned cvt_pk_bf16(float lo, float hi) { unsigned r; asm volatile("v_cvt_pk_bf16_f32 %0, %1, %2" : "=v"(r) : "v"(lo), "v"(hi)); return r; }

struct Unit { int pm, pn, e; };
struct StaticOrder {
    int nM, nN, nwg, G, c;
    __host__ __device__ void init(int M, int N, int G_, int c_) { nM = M / BM; nN = N / BM; nwg = nM * nN; G = G_; c = c_; }
    __host__ __device__ bool next(int i, Unit& u) const {
        const long L = (long)i * G + c; if (L >= nwg) return false;
        int wgid = (int)L; { const int q = nwg / NXCD, r = nwg % NXCD, xcd = wgid % NXCD, off = wgid / NXCD; wgid = (xcd < r ? xcd * (q + 1) : r * (q + 1) + (xcd - r) * q) + off; }
        const int nig = WGM * nN, gid = wgid / nig, fm = gid * WGM, gsz = (nM - fm) < WGM ? (nM - fm) : WGM;
        u.pm = fm + ((wgid % nig) % gsz); u.pn = (wgid % nig) / gsz; u.e = 0; return true;
    }
};
struct DenseProb {
    const bf16_t* A; const bf16_t* Bt; int K; StaticOrder ord;
    __device__ __forceinline__ bool next(int i, Unit& u) const { return ord.next(i, u); }
    __device__ __forceinline__ const char* a_base(const Unit& u) const { return (const char*)A + (size_t)u.pm * BM * K * 2; }
    __device__ __forceinline__ const char* b_base(const Unit& u) const { return (const char*)Bt + (size_t)u.pn * BM * K * 2; }
    __device__ __forceinline__ void a_offs(const Unit&, unsigned (&v)[2][2], const int (&R)[2], const int (&C)[2]) const {
#pragma unroll
        for (int h = 0; h < 2; ++h)
#pragma unroll
            for (int i = 0; i < 2; ++i) v[h][i] = (unsigned)((h * HALF + R[i]) * K + C[i]) * 2u;
    }
};
struct GatherProb {
    const bf16_t* X; const int* stok; const bf16_t* Bt; const int* texp; int K, nN, nunits, G, c; size_t estride;
    __device__ __forceinline__ bool next(int i, Unit& u) const {
        const long L = (long)i * G + c; if (L >= nunits) return false;
        u.pm = (int)(L / nN); u.pn = (int)(L % nN); u.e = texp[u.pm]; return true;
    }
    __device__ __forceinline__ const char* a_base(const Unit&) const { return (const char*)X; }
    __device__ __forceinline__ const char* b_base(const Unit& u) const { return (const char*)Bt + (size_t)u.e * estride + (size_t)u.pn * BM * K * 2; }
    __device__ __forceinline__ void a_offs(const Unit& u, unsigned (&v)[2][2], const int (&R)[2], const int (&C)[2]) const {
#pragma unroll
        for (int h = 0; h < 2; ++h)
#pragma unroll
            for (int i = 0; i < 2; ++i) { const int tok = stok[u.pm * BM + h * HALF + R[i]]; v[h][i] = (unsigned)(tok * K + C[i]) * 2u; }
    }
};
struct GroupedProb {
    const bf16_t* A; const bf16_t* Bt; const int* texp; int K, nN, nunits, G, c; size_t estride;
    __device__ __forceinline__ bool next(int i, Unit& u) const {
        const long L = (long)i * G + c; if (L >= nunits) return false;
        u.pm = (int)(L / nN); u.pn = (int)(L % nN); u.e = texp[u.pm]; return true;
    }
    __device__ __forceinline__ const char* a_base(const Unit& u) const { return (const char*)A + (size_t)u.pm * BM * K * 2; }
    __device__ __forceinline__ const char* b_base(const Unit& u) const { return (const char*)Bt + (size_t)u.e * estride + (size_t)u.pn * BM * K * 2; }
    __device__ __forceinline__ void a_offs(const Unit&, unsigned (&v)[2][2], const int (&R)[2], const int (&C)[2]) const {
#pragma unroll
        for (int h = 0; h < 2; ++h)
#pragma unroll
            for (int i = 0; i < 2; ++i) v[h][i] = (unsigned)((h * HALF + R[i]) * K + C[i]) * 2u;
    }
};

struct EpiBf16 {
    static constexpr bool PERM = true;
    bf16_t* O; int ldc;
    __device__ __forceinline__ void operator()(const f32x4 (&acc)[2][2][4][2], const Unit& u, int wr, int wc, int fr, int fq) const {
        const int row0 = u.pm * BM + wr * 64 + fr, col0 = u.pn * BM + wc * 32 + 8 * fq;
#pragma unroll
        for (int ai = 0; ai < 2; ++ai)
#pragma unroll
            for (int m = 0; m < 4; ++m) { bf16_t* rowp = O + (size_t)(row0 + ai * HALF + m * 16) * ldc + col0;
#pragma unroll
                for (int bj = 0; bj < 2; ++bj) { const f32x4 v0 = acc[ai][bj][m][0], v1 = acc[ai][bj][m][1];
                    u32x4 w; w.x = cvt_pk_bf16(v0[0], v0[1]); w.y = cvt_pk_bf16(v0[2], v0[3]); w.z = cvt_pk_bf16(v1[0], v1[1]); w.w = cvt_pk_bf16(v1[2], v1[3]);
                    *(u32x4*)(rowp + bj * HALF) = w; } }
    }
};
struct EpiF32Res {
    static constexpr bool PERM = false;
    float* C; int ldc; const float* base; float alpha;
    __device__ __forceinline__ void operator()(const f32x4 (&acc)[2][2][4][2], const Unit& u, int wr, int wc, int fr, int fq) const {
        const int row0 = u.pm * BM + wr * 64 + fr, col0 = u.pn * BM + wc * 32 + 4 * fq;
#pragma unroll
        for (int ai = 0; ai < 2; ++ai)
#pragma unroll
            for (int m = 0; m < 4; ++m) { const size_t off = (size_t)(row0 + ai * HALF + m * 16) * ldc + col0;
#pragma unroll
                for (int bj = 0; bj < 2; ++bj)
#pragma unroll
                    for (int n = 0; n < 2; ++n) { f32x4 o = acc[ai][bj][m][n];
                        if (base) o += *(const f32x4*)(base + off + bj * HALF + n * 16) * alpha;
                        *(f32x4*)(C + off + bj * HALF + n * 16) = o; } }
    }
};

struct EpiSwiGLU {
    static constexpr bool PERM = true;
    bf16_t* O; int ldc;
    __device__ __forceinline__ void operator()(const f32x4 (&acc)[2][2][4][2], const Unit& u, int wr, int wc, int fr, int fq) const {
        const int row0 = u.pm * BM + wr * 64 + fr, col0 = u.pn * HALF + wc * 32 + 8 * fq;
#pragma unroll
        for (int ai = 0; ai < 2; ++ai)
#pragma unroll
            for (int m = 0; m < 4; ++m) { bf16_t* rowp = O + (size_t)(row0 + ai * HALF + m * 16) * ldc + col0;
                float h[8];
#pragma unroll
                for (int n = 0; n < 2; ++n)
#pragma unroll
                    for (int q = 0; q < 4; ++q) { const float g = acc[ai][0][m][n][q], up = acc[ai][1][m][n][q]; h[4 * n + q] = g * __builtin_amdgcn_rcpf(1.f + __expf(-g)) * up; }
                u32x4 w; w.x = cvt_pk_bf16(h[0], h[1]); w.y = cvt_pk_bf16(h[2], h[3]); w.z = cvt_pk_bf16(h[4], h[5]); w.w = cvt_pk_bf16(h[6], h[7]);
                *(u32x4*)rowp = w; }
    }
};
struct EpiScaleY {
    static constexpr bool PERM = true;
    bf16_t* Y; const float* sgate; const unsigned* off; const unsigned* cnt; const unsigned* cst;
    __device__ __forceinline__ void operator()(const f32x4 (&acc)[2][2][4][2], const Unit& u, int wr, int wc, int fr, int fq) const {
        const int o0 = (int)off[u.e], nreal = (int)cnt[u.e], c0 = (int)cst[u.e];
        const int row0 = u.pm * BM + wr * 64 + fr, col0 = u.pn * BM + wc * 32 + 8 * fq;
#pragma unroll
        for (int ai = 0; ai < 2; ++ai)
#pragma unroll
            for (int m = 0; m < 4; ++m) { const int p = row0 + ai * HALF + m * 16, rel = p - o0;
                if (rel < nreal) { const float gs = sgate[p]; bf16_t* rowp = Y + (size_t)(c0 + rel) * 1024 + col0;
#pragma unroll
                    for (int bj = 0; bj < 2; ++bj) { const f32x4 v0 = acc[ai][bj][m][0] * gs, v1 = acc[ai][bj][m][1] * gs;
                        u32x4 w; w.x = cvt_pk_bf16(v0[0], v0[1]); w.y = cvt_pk_bf16(v0[2], v0[3]); w.z = cvt_pk_bf16(v1[0], v1[1]); w.w = cvt_pk_bf16(v1[2], v1[3]);
                        *(u32x4*)(rowp + bj * HALF) = w; } } }
    }
};

template <class Epi, class Prob>
__device__ __forceinline__ void gemm_phase(PG8_LAS unsigned char* lds, const Prob& S, const Epi& E) {
    const int tid = threadIdx.x, wid = __builtin_amdgcn_readfirstlane(tid >> 6), lane = tid & 63, wr = wid >> 2, wc = wid & 3, fr = lane & 15, fq = lane >> 4;
    const int K = S.K, nt = K / BK;
    int Rr[2], Cc[2]; unsigned voffB[2];
#pragma unroll
    for (int i = 0; i < 2; ++i) { int R, C; stage_rc(tid * 16 + i * 8192, R, C); const int Rb = Epi::PERM ? ((R & ~31) + perm32(R & 31)) : R;
        Rr[i] = R; Cc[i] = C; voffB[i] = (unsigned)(Rb * K + C) * 2u; }
    const size_t kstep = (size_t)(BK * 2);
    const size_t hstep = (size_t)HALF * K * 2;
    const unsigned ldsw = (unsigned)wid * 1024u;
    const int aoff = lds_byte(wr * 64 + fr, fq * 8), boff = lds_byte(wc * 32 + fr, fq * 8);
#define PG8_SA(b, h) (((b) * 2 + (h)) * HTB)
#define PG8_SB(b, h) ((4 + (b) * 2 + (h)) * HTB)
#define PG8_STAGE(bufoff, gbase, voff) do { _Pragma("unroll") for (int _i = 0; _i < 2; ++_i) \
        __builtin_amdgcn_global_load_lds((const unsigned*)((const char*)(gbase) + (voff)[_i]), (PG8_LAS unsigned*)(lds + (bufoff) + ldsw + _i * 8192), 16, 0, 0); } while (0)
#define PG8_LDA(dst, b, h) do { _Pragma("unroll") for (int m = 0; m < 4; ++m) _Pragma("unroll") for (int k = 0; k < 2; ++k) dst[m][k] = *(const PG8_LAS bf16x8*)(lds + PG8_SA(b, h) + aoff + m * 2048 + k * 1024); } while (0)
#define PG8_LDB(dst, b, h) do { _Pragma("unroll") for (int n = 0; n < 2; ++n) _Pragma("unroll") for (int k = 0; k < 2; ++k) dst[n][k] = *(const PG8_LAS bf16x8*)(lds + PG8_SB(b, h) + boff + n * 2048 + k * 1024); } while (0)
#define PG8_MMA(ai, bj, At, Bt) do { __builtin_amdgcn_s_setprio(1); _Pragma("unroll") for (int m = 0; m < 4; ++m) _Pragma("unroll") for (int n = 0; n < 2; ++n) _Pragma("unroll") for (int k = 0; k < 2; ++k) \
        acc[ai][bj][m][n] = __builtin_amdgcn_mfma_f32_16x16x32_bf16(Bt[n][k], At[m][k], acc[ai][bj][m][n], 0, 0, 0); __builtin_amdgcn_s_setprio(0); } while (0)
#define PG8_WAIT_V(n) asm volatile("s_waitcnt vmcnt(" #n ")" ::: "memory")
#define PG8_WAIT_L(n) asm volatile("s_waitcnt lgkmcnt(" #n ")" ::: "memory")
#define PG8_BAR __builtin_amdgcn_s_barrier()
#define PG8_SCHED __builtin_amdgcn_sched_barrier(0)
    Unit cur, nxt; int ui = 0;
    if (!S.next(0, cur)) return;
    f32x4 acc[2][2][4][2];
#pragma unroll
    for (int a = 0; a < 2; ++a)
#pragma unroll
        for (int b = 0; b < 2; ++b)
#pragma unroll
            for (int m = 0; m < 4; ++m)
#pragma unroll
                for (int n = 0; n < 2; ++n) acc[a][b][m][n] = (f32x4){0.f, 0.f, 0.f, 0.f};
    bf16x8 At[4][2], B0[2][2], B1[2][2];
    const char* cA = S.a_base(cur); const char* cB = S.b_base(cur);
    unsigned vA[2][2], nvA[2][2];
    S.a_offs(cur, vA, Rr, Cc);
    PG8_STAGE(PG8_SB(0, 0), cB, voffB); PG8_STAGE(PG8_SA(0, 0), cA, vA[0]); PG8_STAGE(PG8_SB(0, 1), cB + hstep, voffB); PG8_STAGE(PG8_SA(0, 1), cA, vA[1]);
    if (wr == 1) PG8_BAR;
    PG8_WAIT_V(4); PG8_BAR;
    PG8_STAGE(PG8_SB(1, 0), cB + kstep, voffB); PG8_STAGE(PG8_SA(1, 0), cA + kstep, vA[0]); PG8_STAGE(PG8_SB(1, 1), cB + hstep + kstep, voffB);
    PG8_WAIT_V(6); PG8_BAR;
    for (;;) {
        const bool has_next = S.next(ui + 1, nxt);
        const char* nA = has_next ? S.a_base(nxt) : cA; const char* nB = has_next ? S.b_base(nxt) : cB;
        if (has_next) S.a_offs(nxt, nvA, Rr, Cc);
        else {
#pragma unroll
            for (int h = 0; h < 2; ++h)
#pragma unroll
                for (int i = 0; i < 2; ++i) nvA[h][i] = vA[h][i];
        }
        for (int t = 0; t < nt; t += 2) {
            const bool last = (t == nt - 2);
            const char* a1 = cA + (size_t)(t + 1) * kstep;
            const char* a2 = last ? nA : cA + (size_t)(t + 2) * kstep; const char* b2 = last ? nB : cB + (size_t)(t + 2) * kstep;
            const char* a3 = a2 + kstep; const char* b3 = b2 + kstep;
            unsigned v2[2][2];
#pragma unroll
            for (int h = 0; h < 2; ++h)
#pragma unroll
                for (int i = 0; i < 2; ++i) v2[h][i] = last ? nvA[h][i] : vA[h][i];
            PG8_LDB(B0, 0, 0); PG8_SCHED; PG8_LDA(At, 0, 0); PG8_STAGE(PG8_SA(1, 1), a1, vA[1]);
            PG8_WAIT_L(8); PG8_BAR; PG8_WAIT_L(0); PG8_MMA(0, 0, At, B0); PG8_BAR; PG8_SCHED;
            PG8_LDB(B1, 0, 1); PG8_STAGE(PG8_SB(0, 0), b2, voffB);
            PG8_BAR; PG8_WAIT_L(0); PG8_MMA(0, 1, At, B1); PG8_BAR;
            PG8_LDA(At, 0, 1); PG8_STAGE(PG8_SA(0, 0), a2, v2[0]);
            PG8_BAR; PG8_WAIT_L(0); PG8_MMA(1, 0, At, B0); PG8_BAR; PG8_SCHED;
            PG8_STAGE(PG8_SB(0, 1), b2 + hstep, voffB);
            PG8_WAIT_V(6); PG8_BAR; PG8_MMA(1, 1, At, B1); PG8_BAR;
            PG8_LDB(B0, 1, 0); PG8_SCHED; PG8_LDA(At, 1, 0); PG8_STAGE(PG8_SA(0, 1), a2, v2[1]);
            PG8_WAIT_L(8); PG8_BAR; PG8_WAIT_L(0); PG8_MMA(0, 0, At, B0); PG8_BAR; PG8_SCHED;
            PG8_LDB(B1, 1, 1); PG8_STAGE(PG8_SB(1, 0), b3, voffB);
            PG8_BAR; PG8_WAIT_L(0); PG8_MMA(0, 1, At, B1); PG8_BAR;
            PG8_LDA(At, 1, 1); PG8_STAGE(PG8_SA(1, 0), a3, v2[0]);
            PG8_BAR; PG8_WAIT_L(0); PG8_MMA(1, 0, At, B0); PG8_BAR; PG8_SCHED;
            PG8_STAGE(PG8_SB(1, 1), b3 + hstep, voffB);
            PG8_WAIT_V(6); PG8_BAR; PG8_MMA(1, 1, At, B1); PG8_BAR;
        }
        E(acc, cur, wr, wc, fr, fq);
        if (!has_next) break;
#pragma unroll
        for (int a = 0; a < 2; ++a)
#pragma unroll
            for (int b = 0; b < 2; ++b)
#pragma unroll
                for (int m = 0; m < 4; ++m)
#pragma unroll
                    for (int n = 0; n < 2; ++n) acc[a][b][m][n] = (f32x4){0.f, 0.f, 0.f, 0.f};
        cur = nxt; cA = nA; cB = nB; ++ui;
#pragma unroll
        for (int h = 0; h < 2; ++h)
#pragma unroll
            for (int i = 0; i < 2; ++i) vA[h][i] = nvA[h][i];
    }
    PG8_WAIT_V(0);
    if (wr == 0) PG8_BAR;
    PG8_BAR;
#undef PG8_SA
#undef PG8_SB
#undef PG8_STAGE
#undef PG8_LDA
#undef PG8_LDB
#undef PG8_MMA
#undef PG8_WAIT_V
#undef PG8_WAIT_L
#undef PG8_BAR
#undef PG8_SCHED
}
}

__device__ __forceinline__ float wave_sum(float v) {
#pragma unroll
    for (int o = 1; o < 64; o <<= 1) v += __shfl_xor(v, o);
    return v;
}
__device__ __forceinline__ float sigmoidf_(float x) { return 1.0f / (1.0f + expf(-x)); }
__device__ __forceinline__ float fma1(float a, float b, float c) { float d; asm("v_fma_f32 %0, %1, %2, %3" : "=v"(d) : "v"(a), "v"(b), "v"(c)); return d; }
__device__ __forceinline__ float mul1(float a, float b) { float d; asm("v_mul_f32 %0, %1, %2" : "=v"(d) : "v"(a), "v"(b)); return d; }

typedef unsigned short bf16_t;
typedef unsigned u32x4 __attribute__((ext_vector_type(4)));
typedef unsigned u32x2 __attribute__((ext_vector_type(2)));
__device__ __forceinline__ float bf2f(bf16_t b) { return __builtin_bit_cast(float, (unsigned)b << 16); }
__device__ __forceinline__ bf16_t f2bf(float f) { return (bf16_t)(pg8::cvt_pk_bf16(f, 0.f) & 0xffffu); }
__device__ __forceinline__ void transpose_item(const float* W, int K, int N, bf16_t* WT, int k0, int n0, int drow0, float* scr, int lane) {
#pragma unroll 8
    for (int i = 0; i < 32; ++i) { const int kk = 2 * i + (lane >> 5); scr[kk * 33 + (lane & 31)] = W[(size_t)(k0 + kk) * N + n0 + (lane & 31)]; }
    __builtin_amdgcn_wave_barrier();
    const int c = lane & 7;
#pragma unroll
    for (int j = 0; j < 4; ++j) { const int n = (lane >> 3) + 8 * j; const float* s = scr + (8 * c) * 33 + n;
        u32x4 o; o.x = pg8::cvt_pk_bf16(s[0 * 33], s[1 * 33]); o.y = pg8::cvt_pk_bf16(s[2 * 33], s[3 * 33]); o.z = pg8::cvt_pk_bf16(s[4 * 33], s[5 * 33]); o.w = pg8::cvt_pk_bf16(s[6 * 33], s[7 * 33]);
        *(u32x4*)(WT + (size_t)(drow0 + n) * K + k0 + 8 * c) = o; }
    __builtin_amdgcn_wave_barrier();
}
struct Args {
    const float* in[34]; float* out; unsigned char* ws;
    int ph_lo, ph_hi;
};

struct GF {
    const float* A; long lda; const int* arow; int arow_lim;
    const float* B; long ldb; int bmode;
    int K;
};
template <class Epi>
__device__ __forceinline__ void gemm_f32_tile(float* lds, const GF& g, int row0, int col0, Epi&& epi) {
    float* As = lds;
    float* Bs = lds + 16 * 132;
    const int tid = threadIdx.x, lane = tid & 63, w = tid >> 6, wm = w >> 1, wn = w & 1;
    f32x16 acc0, acc1;
#pragma unroll
    for (int i = 0; i < 16; ++i) { acc0[i] = 0.f; acc1[i] = 0.f; }
    const int ar = tid >> 2, ak = (tid & 3) * 4;
    long arow_idx = row0 + ar; bool avalid = true;
    if (g.arow) { const int t = g.arow[row0 + ar]; avalid = t < g.arow_lim; arow_idx = avalid ? t : 0; }
    const float* ap = g.A + arow_idx * g.lda + ak;
    const float* bp; int bk, bn;
    if (g.bmode == 0) { bk = tid >> 5; bn = (tid & 31) * 4; bp = g.B + (long)bk * g.ldb + col0 + bn; }
    else { bn = tid >> 2; bk = (tid & 3) * 4; bp = g.B + (long)(col0 + bn) * g.ldb + bk; }
    const int hl = lane >> 5, l31 = lane & 31;
    for (int k0 = 0; k0 < g.K; k0 += 16) {
        f32x4 av = (f32x4){0.f, 0.f, 0.f, 0.f};
        if (avalid) av = *(const f32x4*)(ap + k0);
        const f32x4 bv = g.bmode == 0 ? *(const f32x4*)(bp + (long)k0 * g.ldb) : *(const f32x4*)(bp + k0);
        __syncthreads();
        As[(ak + 0) * 132 + ar] = av[0]; As[(ak + 1) * 132 + ar] = av[1]; As[(ak + 2) * 132 + ar] = av[2]; As[(ak + 3) * 132 + ar] = av[3];
        if (g.bmode == 0) *(f32x4*)&Bs[bk * 132 + bn] = bv;
        else { Bs[(bk + 0) * 132 + bn] = bv[0]; Bs[(bk + 1) * 132 + bn] = bv[1]; Bs[(bk + 2) * 132 + bn] = bv[2]; Bs[(bk + 3) * 132 + bn] = bv[3]; }
        __syncthreads();
#pragma unroll
        for (int kk = 0; kk < 16; kk += 2) {
            const float a = As[(kk + hl) * 132 + wm * 32 + l31];
            const float b0 = Bs[(kk + hl) * 132 + wn * 64 + l31];
            const float b1 = Bs[(kk + hl) * 132 + wn * 64 + 32 + l31];
            acc0 = __builtin_amdgcn_mfma_f32_32x32x2f32(a, b0, acc0, 0, 0, 0);
            acc1 = __builtin_amdgcn_mfma_f32_32x32x2f32(a, b1, acc1, 0, 0, 0);
        }
    }
#pragma unroll
    for (int r = 0; r < 16; ++r) {
        const int row = row0 + wm * 32 + (r & 3) + 8 * (r >> 2) + 4 * hl;
        const int col = col0 + wn * 64 + l31;
        epi(row, col, acc0[r]);
        epi(row, col + 32, acc1[r]);
    }
    __syncthreads();
}

__device__ __forceinline__ void ln_row(const float* a, float alpha, const float* b, float* out, const float* gam, const float* bet, int lane, bf16_t* outb = nullptr) {
    f32x4 v[4]; float s = 0.f;
#pragma unroll
    for (int j = 0; j < 4; ++j) {
        v[j] = *(const f32x4*)(a + 4 * lane + 256 * j) * alpha;
        if (b) v[j] += *(const f32x4*)(b + 4 * lane + 256 * j);
        s += (v[j][0] + v[j][1]) + (v[j][2] + v[j][3]);
    }
    const float mean = wave_sum(s) * (1.f / D); float s2 = 0.f;
#pragma unroll
    for (int j = 0; j < 4; ++j) { v[j] = v[j] - mean; s2 += (v[j][0] * v[j][0] + v[j][1] * v[j][1]) + (v[j][2] * v[j][2] + v[j][3] * v[j][3]); }
    const float rstd = 1.f / sqrtf(wave_sum(s2) * (1.f / D) + LN_EPS);
#pragma unroll
    for (int j = 0; j < 4; ++j) {
        const f32x4 gg = *(const f32x4*)(gam + 4 * lane + 256 * j), bb = *(const f32x4*)(bet + 4 * lane + 256 * j);
        const f32x4 o = v[j] * rstd * gg + bb;
        *(f32x4*)(out + 4 * lane + 256 * j) = o;
        if (outb) { u32x2 w; w.x = pg8::cvt_pk_bf16(o[0], o[1]); w.y = pg8::cvt_pk_bf16(o[2], o[3]); *(u32x2*)(outb + 4 * lane + 256 * j) = w; }
    }
}

constexpr int NPHASES = 23;

__global__ void __launch_bounds__(NTHREADS, 2) mega(Args args) {
    extern __shared__ __attribute__((aligned(16))) unsigned char lds_raw[];
    float* ldsf = (float*)lds_raw;
    const int tid = threadIdx.x, lane = tid & 63, wave = tid >> 6;
    const int G = gridDim.x, bx = blockIdx.x;
    const int gw = bx * NWAVES + wave, NGW = G * NWAVES;
    unsigned char* ws = args.ws;
    unsigned* ctl = (unsigned*)(ws + WS_CTL);
    volatile LAS unsigned* misc = (volatile LAS unsigned*)((LAS unsigned char*)lds_raw + MISC_OFF);
    if (tid < 4) misc[tid] = 0u;
    __syncthreads();
    const int lo = args.ph_lo, hi = args.ph_hi;
    const bool multi = (hi - lo) > 1;
    XcdBarrier bar; bar.bar = ctl + CW_BAR; bar.x = 0; bar.st = nullptr;
    if (multi) bar = xcd_barrier_post(ctl + CW_BAR, misc);
#define IN(k) (lo <= (k) && (k) < hi)
#define SEAM(k) do { if (IN(k) && IN((k) + 1)) xcd_barrier(bar); } while (0)

    const float* x = args.in[0]; const float* mem = args.in[1]; const int* positions = (const int*)args.in[2];
    const float* w_in = args.in[3]; const float* mu_shift = args.in[4]; const float* w_decay_up = args.in[5]; const float* w0 = args.in[6];
    const float* a_up = args.in[7]; const float* a0 = args.in[8]; const float* g_up = args.in[9]; const float* k_k = args.in[10]; const float* k_a = args.in[11];
    const float* r_k = args.in[12]; const float* lnx_g = args.in[13]; const float* lnx_b = args.in[14]; const float* sinks = args.in[15];
    const float* w_o = args.in[16]; const float* ln1_g = args.in[17]; const float* ln1_b = args.in[18];
    const float* wm_q = args.in[19]; const float* wm_kv = args.in[20]; const float* wm_o = args.in[21]; const float* ln2_g = args.in[22]; const float* ln2_b = args.in[23];
    const float* w_router = args.in[24]; const float* router_bias = args.in[25];
    const float* we_gate = args.in[26]; const float* we_up = args.in[27]; const float* we_down = args.in[28];
    const float* ws_gate = args.in[29]; const float* ws_up = args.in[30]; const float* ws_down = args.in[31];
    const float* ln3_g = args.in[32]; const float* ln3_b = args.in[33];
    float* out = args.out;

    float* ROPE_C = (float*)(ws + WS_ROPE); float* ROPE_S = ROPE_C + (size_t)NTOK * 32;
    bf16_t* W_IN_T = (bf16_t*)(ws + WS_WIN); bf16_t* W_O_T = (bf16_t*)(ws + WS_WO); bf16_t* WM_Q_T = (bf16_t*)(ws + WS_WMQ); bf16_t* WM_KV_T = (bf16_t*)(ws + WS_WMKV); bf16_t* WM_O_T = (bf16_t*)(ws + WS_WMO);
    bf16_t* XB = (bf16_t*)(ws + WS_XB); bf16_t* MEMB = (bf16_t*)(ws + WS_MEMB);
    bf16_t* U = (bf16_t*)(ws + WS_U); bf16_t* LRB = (bf16_t*)(ws + WS_LRB); bf16_t* DWAG = (bf16_t*)(ws + WS_DWAG);
    float* YLOC = (float*)(ws + WS_YLOC); bf16_t* ZB = (bf16_t*)(ws + WS_ZB); bf16_t* PT = (bf16_t*)(ws + WS_PT); float* SLT = (float*)(ws + WS_SLT); bf16_t* SIN = (bf16_t*)(ws + WS_SIN);
    float* BONUS = (float*)(ws + WS_BONUS); bf16_t* WLR_T = (bf16_t*)(ws + WS_WLR); bf16_t* W_R_T = (bf16_t*)(ws + WS_WLR + MiB);
    bf16_t* MIX = (bf16_t*)(ws + WS_MIX); float* X1 = (float*)(ws + WS_X1); bf16_t* X1B = (bf16_t*)(ws + WS_X1B);
    bf16_t* QMB = (bf16_t*)(ws + WS_QM); bf16_t* KM = (bf16_t*)(ws + WS_KVM); bf16_t* VT = (bf16_t*)(ws + WS_KVM + 2 * MiB); bf16_t* OM = (bf16_t*)(ws + WS_OM);
    float* X2 = out; bf16_t* X2B = (bf16_t*)(ws + WS_X2B); float* LOG = (float*)(ws + WS_LOG);
    int* EIDX = (int*)(ws + WS_EIDX); float* GATE = (float*)(ws + WS_GATE); int* POS = (int*)(ws + WS_POS); int* YROW = (int*)(ws + WS_YROW);
    int* STOK = (int*)(ws + WS_STOK); float* SGATE = (float*)(ws + WS_SGATE);
    bf16_t* HH = (bf16_t*)(ws + WS_H); bf16_t* HS = (bf16_t*)(ws + WS_HS); bf16_t* YY = (bf16_t*)(ws + WS_Y);
    bf16_t* WS_GU_T = (bf16_t*)(ws + WS_WSGU); bf16_t* WS_D_T = (bf16_t*)(ws + WS_WSD); bf16_t* WE_GU_T = (bf16_t*)(ws + WS_WEGU); bf16_t* WE_D_T = (bf16_t*)(ws + WS_WED);
    int* TEXP = (int*)(ws + WS_TEXP);
    PG8_LAS unsigned char* ldsl = (PG8_LAS unsigned char*)lds_raw;

    if (IN(0)) {
        for (int i = bx * NTHREADS + tid; i < NTOK * 32; i += G * NTHREADS) {
            const int n = i >> 5, f = i & 31;
            const double inv = exp(-(double)(2 * f) / 64.0 * 9.210340371976184);
            const double ang = (double)positions[n] * inv;
            ROPE_C[i] = (float)cos(ang); ROPE_S[i] = (float)sin(ang);
        }
        {
            float* scr = ldsf + wave * 4096;
            constexpr int I_IN = 16 * (INCOLS / 32), I_SQ = 16 * (D / 32), I_KV = 16 * (2048 / 32);
            constexpr int I_R = 16 * (NEXP / 32); constexpr int NIT = I_IN + 3 * I_SQ + I_KV + I_R;
            for (int it = gw; it < NIT; it += NGW) {
                int r = it;
                if (r < I_IN) { const int nb = INCOLS / 32; transpose_item(w_in, D, INCOLS, W_IN_T, 64 * (r / nb), 32 * (r % nb), 32 * (r % nb), scr, lane); continue; } r -= I_IN;
                if (r < I_SQ) { const int nb = D / 32; transpose_item(w_o, D, D, W_O_T, 64 * (r / nb), 32 * (r % nb), 32 * (r % nb), scr, lane); continue; } r -= I_SQ;
                if (r < I_SQ) { const int nb = D / 32; transpose_item(wm_q, D, D, WM_Q_T, 64 * (r / nb), 32 * (r % nb), 32 * (r % nb), scr, lane); continue; } r -= I_SQ;
                if (r < I_SQ) { const int nb = D / 32; transpose_item(wm_o, D, D, WM_O_T, 64 * (r / nb), 32 * (r % nb), 32 * (r % nb), scr, lane); continue; } r -= I_SQ;
                if (r < I_KV) { const int nb = 2048 / 32; transpose_item(wm_kv, D, 2048, WM_KV_T, 64 * (r / nb), 32 * (r % nb), 32 * (r % nb), scr, lane); continue; } r -= I_KV;
                { const int nb = NEXP / 32; transpose_item(w_router, D, NEXP, W_R_T, 64 * (r / nb), 32 * (r % nb), 32 * (r % nb), scr, lane); }
            }
        }
        for (int i = bx * NTHREADS + tid; i < 1536 * 256; i += G * NTHREADS) {
            const int n = i >> 8, k = i & 255; float v = 0.f;
            if (n < 512) { if (k < 64) v = w_decay_up[k * RW + n]; }
            else if (n < 1024) { if (k >= 64 && k < 128) v = a_up[(k - 64) * RW + (n - 512)]; }
            else { if (k >= 128) v = g_up[(k - 128) * RW + (n - 1024)]; }
            WLR_T[i] = f2bf(v);
        }
        {
            float* scr = ldsf + wave * 4096;
            const int NITE = (NEXP + 1) * 384;
            for (int it = gw; it < NITE; it += NGW) {
                const int e = it / 384, r = it % 384;
                const float* wg = e < NEXP ? we_gate + (size_t)e * D * EDIM : ws_gate; const float* wu = e < NEXP ? we_up + (size_t)e * D * EDIM : ws_up;
                const float* wd = e < NEXP ? we_down + (size_t)e * EDIM * D : ws_down;
                bf16_t* gu = e < NEXP ? WE_GU_T + (size_t)e * 512 * D : WS_GU_T; bf16_t* dt = e < NEXP ? WE_D_T + (size_t)e * D * EDIM : WS_D_T;
                if (r < 256) { const int isup = r >> 7, rr = r & 127, kb = rr >> 3, nb = rr & 7, n0 = 32 * nb;
                    transpose_item(isup ? wu : wg, D, EDIM, gu, 64 * kb, n0, (n0 >> 7) * 256 + isup * 128 + (n0 & 127), scr, lane); }
                else { const int rr = r - 256, kb = rr >> 5, nb = rr & 31;
                    transpose_item(wd, EDIM, D, dt, 64 * kb, 32 * nb, 32 * nb, scr, lane); }
            }
        }
        for (size_t i = (size_t)bx * NTHREADS + tid; i < (size_t)NTOK * D / 8; i += (size_t)G * NTHREADS) {
            const f32x4 a = *(const f32x4*)(x + i * 8), b = *(const f32x4*)(x + i * 8 + 4);
            u32x4 o; o.x = pg8::cvt_pk_bf16(a[0], a[1]); o.y = pg8::cvt_pk_bf16(a[2], a[3]); o.z = pg8::cvt_pk_bf16(b[0], b[1]); o.w = pg8::cvt_pk_bf16(b[2], b[3]);
            *(u32x4*)(XB + i * 8) = o;
        }
        for (size_t i = (size_t)bx * NTHREADS + tid; i < (size_t)BATCH * MEMT * D / 8; i += (size_t)G * NTHREADS) {
            const f32x4 a = *(const f32x4*)(mem + i * 8), b = *(const f32x4*)(mem + i * 8 + 4);
            u32x4 o; o.x = pg8::cvt_pk_bf16(a[0], a[1]); o.y = pg8::cvt_pk_bf16(a[2], a[3]); o.z = pg8::cvt_pk_bf16(b[0], b[1]); o.w = pg8::cvt_pk_bf16(b[2], b[3]);
            *(u32x4*)(MEMB + i * 8) = o;
        }
    }
    SEAM(0);
    if (IN(1)) {
        pg8::DenseProb S{XB, W_IN_T, D, {}}; S.ord.init(NTOK, INCOLS, G, bx);
        pg8::EpiBf16 E{U, INCOLS};
        pg8::gemm_phase(ldsl, S, E);
    }
    SEAM(1);
    if (IN(2)) {
        for (size_t i = (size_t)bx * NTHREADS + tid; i < (size_t)NTOK * 256; i += (size_t)G * NTHREADS) {
            const int n = (int)(i >> 8), c = (int)(i & 255), col = C_WD + c;
            const float u = bf2f(U[(size_t)n * INCOLS + col]);
            const float p = (n % SEQ) ? bf2f(U[(size_t)(n - 1) * INCOLS + col]) : 0.f;
            const float v = u + (p - u) * mu_shift[col];
            LRB[i] = f2bf(c < 64 ? tanhf(v) : (c < 128 ? v : sigmoidf_(v)));
        }
    }
    SEAM(2);
    if (IN(3)) {
        pg8::DenseProb S{LRB, WLR_T, 256, {}}; S.ord.init(NTOK, 1536, G, bx);
        pg8::EpiBf16 E{DWAG, 1536};
        pg8::gemm_phase(ldsl, S, E);
    }
    SEAM(3);
    if (IN(4)) {
        const int j = lane; constexpr int TB = 2;
        float* vec = ldsf + wave * (TB * 384);
        const auto rsU = __builtin_amdgcn_make_buffer_rsrc(U, 0, (int)((size_t)NTOK * INCOLS * 2), 0x00020000);
        const auto rsD = __builtin_amdgcn_make_buffer_rsrc(DWAG, 0, (int)((size_t)NTOK * 1536 * 2), 0x00020000);
        const auto rsY = __builtin_amdgcn_make_buffer_rsrc(YLOC, 0, (int)((size_t)NTOK * RW * 4), 0x00020000);
        const auto rsZ = __builtin_amdgcn_make_buffer_rsrc(ZB, 0, (int)((size_t)NTOK * RW * 2), 0x00020000);
        for (int unit_v = gw; unit_v < BATCH * NCH * 8; unit_v += NGW) {
            const int unit = __builtin_amdgcn_readfirstlane(unit_v);
            const int b = unit / (NCH * 8), c = (unit % (NCH * 8)) >> 3, h = unit & 7, hc = h * 64 + j;
            float S0[64], S1[64];
            float one_ = 1.f; asm volatile("" : "+v"(one_));
#pragma unroll
            for (int k = 0; k < 64; ++k) { S0[k] = 0.f; S1[k] = (k == j) ? one_ : 0.f; }
            const float mur = mu_shift[C_R + hc], muk = mu_shift[C_K + hc], muv = mu_shift[C_V + hc];
            const float w0j = w0[hc], a0j = a0[hc], kkj = k_k[hc], kaj = k_a[hc], rkj = r_k[hc];
            const int nb0 = b * SEQ + c * CH;
            const int vo2 = hc * 2, vo4 = hc * 4;
            bf16_t lr[TB], lk[TB], lv[TB], ldw[TB], lda[TB];
            float pr = 0.f, pk = 0.f, pv = 0.f;
            if (c) { const int so = (nb0 - 1) * INCOLS * 2;
                pr = bf2f(__builtin_amdgcn_raw_buffer_load_b16(rsU, vo2, so + C_R * 2, 0)); pk = bf2f(__builtin_amdgcn_raw_buffer_load_b16(rsU, vo2, so + C_K * 2, 0)); pv = bf2f(__builtin_amdgcn_raw_buffer_load_b16(rsU, vo2, so + C_V * 2, 0)); }
#pragma unroll
            for (int i = 0; i < TB; ++i) { const int so = (nb0 + i) * INCOLS * 2, sd = (nb0 + i) * 1536 * 2;
                lr[i] = __builtin_amdgcn_raw_buffer_load_b16(rsU, vo2, so + C_R * 2, 0); lk[i] = __builtin_amdgcn_raw_buffer_load_b16(rsU, vo2, so + C_K * 2, 0); lv[i] = __builtin_amdgcn_raw_buffer_load_b16(rsU, vo2, so + C_V * 2, 0);
                ldw[i] = __builtin_amdgcn_raw_buffer_load_b16(rsD, vo2, sd, 0); lda[i] = __builtin_amdgcn_raw_buffer_load_b16(rsD, vo2, sd + 1024, 0); }
            for (int blk = 0; blk < CH / TB; ++blk) {
                const int n0 = nb0 + blk * TB;
#pragma unroll
                for (int i = 0; i < TB; ++i) {
                    const float r0 = bf2f(lr[i]), k0 = bf2f(lk[i]), v0 = bf2f(lv[i]);
                    const float r = r0 + (pr - r0) * mur, k = k0 + (pk - k0) * muk, vsh = v0 + (pv - v0) * muv;
                    pr = r0; pk = k0; pv = v0;
                    const float xx = -(w0j + bf2f(ldw[i]));
                    const float sp = fmaxf(xx, 0.f) + log1pf(expf(-fabsf(xx)));
                    const float wdec = expf(-expf(-sp - 0.5f));
                    const float a = sigmoidf_(a0j + bf2f(lda[i]));
                    const float kkv = k * kkj;
                    const float nrm = sqrtf(wave_sum(kkv * kkv));
                    const float kkn = kkv / fmaxf(nrm, 1e-12f);
                    const float kmod = k * (1.f + (a - 1.f) * kaj);
                    const float bonus = wave_sum(r * kmod * rkj);
                    float* vt = vec + i * 384;
                    vt[j] = wdec; vt[64 + j] = -kkn; vt[128 + j] = kkn * a; vt[192 + j] = kmod; vt[256 + j] = r; vt[320 + j] = vsh;
                    if (lane == 0) BONUS[(size_t)(n0 + i) * 8 + h] = bonus;
                }
                if (blk + 1 < CH / TB) {
#pragma unroll
                    for (int i = 0; i < TB; ++i) { const int so = (n0 + TB + i) * INCOLS * 2, sd = (n0 + TB + i) * 1536 * 2;
                        lr[i] = __builtin_amdgcn_raw_buffer_load_b16(rsU, vo2, so + C_R * 2, 0); lk[i] = __builtin_amdgcn_raw_buffer_load_b16(rsU, vo2, so + C_K * 2, 0); lv[i] = __builtin_amdgcn_raw_buffer_load_b16(rsU, vo2, so + C_V * 2, 0);
                        ldw[i] = __builtin_amdgcn_raw_buffer_load_b16(rsD, vo2, sd, 0); lda[i] = __builtin_amdgcn_raw_buffer_load_b16(rsD, vo2, sd + 1024, 0); }
                }
                __builtin_amdgcn_wave_barrier();
#pragma nounroll
                for (int tt = 0; tt < TB; ++tt) {
                    const float* vt = vec + tt * 384;
                    float sa0 = 0.f, sa1 = 0.f;
                    f32x4 aA = *(const f32x4*)&vt[64], aB;
#pragma unroll
                    for (int kq = 0; kq < 16; kq += 2) {
                        aB = *(const f32x4*)&vt[64 + 4 * (kq + 1)];
                        __builtin_amdgcn_sched_barrier(0);
#pragma unroll
                        for (int q = 0; q < 4; ++q) { sa0 = fma1(S0[4 * kq + q], aA[q], sa0); sa1 = fma1(S1[4 * kq + q], aA[q], sa1); }
                        __builtin_amdgcn_sched_barrier(0);
                        if (kq + 2 < 16) aA = *(const f32x4*)&vt[64 + 4 * (kq + 2)];
                        __builtin_amdgcn_sched_barrier(0);
#pragma unroll
                        for (int q = 0; q < 4; ++q) { sa0 = fma1(S0[4 * kq + 4 + q], aB[q], sa0); sa1 = fma1(S1[4 * kq + 4 + q], aB[q], sa1); }
                        __builtin_amdgcn_sched_barrier(0);
                    }
                    float y0 = 0.f, y1 = 0.f; const float vq = vt[320 + j];
                    f32x4 wA = *(const f32x4*)&vt[0], bA = *(const f32x4*)&vt[128], kA = *(const f32x4*)&vt[192], rA = *(const f32x4*)&vt[256], wB, bB, kB, rB;
#define P4_UPD(kq_, w_, b_, k_, r_) _Pragma("unroll") for (int q = 0; q < 4; ++q) { \
                        const float s0 = fma1(S0[4 * (kq_) + q], w_[q], fma1(sa0, b_[q], mul1(vq, k_[q]))); S0[4 * (kq_) + q] = s0; y0 = fma1(s0, r_[q], y0); \
                        const float s1 = fma1(S1[4 * (kq_) + q], w_[q], mul1(sa1, b_[q])); S1[4 * (kq_) + q] = s1; y1 = fma1(s1, r_[q], y1); }
#pragma unroll
                    for (int kq = 0; kq < 16; kq += 2) {
                        wB = *(const f32x4*)&vt[4 * (kq + 1)]; bB = *(const f32x4*)&vt[128 + 4 * (kq + 1)]; kB = *(const f32x4*)&vt[192 + 4 * (kq + 1)]; rB = *(const f32x4*)&vt[256 + 4 * (kq + 1)];
                        __builtin_amdgcn_sched_barrier(0);
                        P4_UPD(kq, wA, bA, kA, rA)
                        __builtin_amdgcn_sched_barrier(0);
                        if (kq + 2 < 16) { wA = *(const f32x4*)&vt[4 * (kq + 2)]; bA = *(const f32x4*)&vt[128 + 4 * (kq + 2)]; kA = *(const f32x4*)&vt[192 + 4 * (kq + 2)]; rA = *(const f32x4*)&vt[256 + 4 * (kq + 2)]; }
                        __builtin_amdgcn_sched_barrier(0);
                        P4_UPD(kq + 1, wB, bB, kB, rB)
                        __builtin_amdgcn_sched_barrier(0);
                    }
#undef P4_UPD
                    const int nn = __builtin_amdgcn_readfirstlane(n0 + tt);
                    __builtin_amdgcn_raw_buffer_store_b32(__builtin_bit_cast(unsigned, y0), rsY, vo4, nn * (RW * 4), 0);
                    __builtin_amdgcn_raw_buffer_store_b16(f2bf(y1), rsZ, vo2, nn * (RW * 2), 0);
                }
                __builtin_amdgcn_wave_barrier();
            }
            { const auto rsS = __builtin_amdgcn_make_buffer_rsrc(SLT, 0, BATCH * NCH * 8 * 4096 * 4, 0x00020000);
              const auto rsP = __builtin_amdgcn_make_buffer_rsrc(PT, 0, BATCH * NCH * 8 * 4096 * 2, 0x00020000);
#pragma unroll
              for (int k = 0; k < 64; ++k) { __builtin_amdgcn_raw_buffer_store_b32(__builtin_bit_cast(unsigned, S0[k]), rsS, j * 4, unit * 16384 + k * 256, 0);
                  __builtin_amdgcn_raw_buffer_store_b16(f2bf(S1[k]), rsP, j * 2, unit * 8192 + k * 128, 0); } }
        }
    }
    SEAM(4);
    if (IN(5)) {
        if (wave == 0 && bx < 128) {
            const int bh = bx >> 2, vs = bx & 3, b = bh >> 3, h = bh & 7, col = lane & 15, g = lane >> 4;
            pg8::f32x4 acc[4];
#pragma unroll
            for (int t = 0; t < 4; ++t) acc[t] = (pg8::f32x4){0.f, 0.f, 0.f, 0.f};
            u32x4 Aw[8], An[8]; pg8::f32x4 sl[4], sn[4];
#define P5_LOAD(c_, A_, s_) do { const int unit_ = (b * NCH + (c_)) * 8 + h; const bf16_t* pt_ = PT + (size_t)unit_ * 4096; const float* slp_ = SLT + (size_t)unit_ * 4096; \
                _Pragma("unroll") for (int jo = 0; jo < 4; ++jo) { \
                    _Pragma("unroll") for (int r = 0; r < 4; ++r) s_[jo][r] = slp_[(size_t)(16 * jo + 4 * g + r) * 64 + 16 * vs + col]; \
                    _Pragma("unroll") for (int sx = 0; sx < 2; ++sx) { const bf16_t* ap_ = pt_ + (size_t)(16 * jo + col) * 64 + 32 * sx + 4 * g; \
                        const u32x2 a0_ = *(const u32x2*)ap_, a1_ = *(const u32x2*)(ap_ + 16); u32x4 aw_; aw_.x = a0_.x; aw_.y = a0_.y; aw_.z = a1_.x; aw_.w = a1_.y; A_[jo * 2 + sx] = aw_; } } } while (0)
            P5_LOAD(0, Aw, sl);
            for (int c = 0; c < NCH; ++c) {
                const int unit = (b * NCH + c) * 8 + h;
                if (c + 2 < NCH) P5_LOAD(c + 1, An, sn);
                bf16_t* sdst = SIN + (size_t)unit * 4096 + (size_t)(16 * vs + col) * 64;
                unsigned pk[8];
#pragma unroll
                for (int t = 0; t < 4; ++t) { pk[2 * t] = pg8::cvt_pk_bf16(acc[t][0], acc[t][1]); pk[2 * t + 1] = pg8::cvt_pk_bf16(acc[t][2], acc[t][3]);
                    u32x2 w; w.x = pk[2 * t]; w.y = pk[2 * t + 1]; *(u32x2*)(sdst + 16 * t + 4 * g) = w; }
                if (c == NCH - 1) break;
                pg8::bf16x8 Bf[2];
#pragma unroll
                for (int s = 0; s < 2; ++s) { u32x4 w; w.x = pk[4 * s]; w.y = pk[4 * s + 1]; w.z = pk[4 * s + 2]; w.w = pk[4 * s + 3]; Bf[s] = __builtin_bit_cast(pg8::bf16x8, w); }
#pragma unroll
                for (int jo = 0; jo < 4; ++jo) {
                    pg8::f32x4 na = sl[jo];
#pragma unroll
                    for (int s = 0; s < 2; ++s) na = __builtin_amdgcn_mfma_f32_16x16x32_bf16(__builtin_bit_cast(pg8::bf16x8, Aw[jo * 2 + s]), Bf[s], na, 0, 0, 0);
                    acc[jo] = na;
                }
#pragma unroll
                for (int i = 0; i < 8; ++i) Aw[i] = An[i];
#pragma unroll
                for (int i = 0; i < 4; ++i) sl[i] = sn[i];
            }
#undef P5_LOAD
        }
    }
    SEAM(5);
    if (IN(6)) {
        const int col = lane & 31, hh = lane >> 5;
        for (int unit = gw; unit < BATCH * NCH * 8; unit += NGW) {
            const int b = unit / (NCH * 8), c = (unit % (NCH * 8)) >> 3, h = unit & 7;
            const bf16_t* sin = SIN + (size_t)unit * 4096;
            pg8::bf16x8 Bf[2][4];
#pragma unroll
            for (int ct = 0; ct < 2; ++ct)
#pragma unroll
                for (int s = 0; s < 4; ++s) Bf[ct][s] = *(const pg8::bf16x8*)(sin + (size_t)(32 * ct + col) * 64 + 16 * s + 8 * hh);
            float lg[2], lb[2], muv[2];
#pragma unroll
            for (int ct = 0; ct < 2; ++ct) { lg[ct] = lnx_g[h * 64 + 32 * ct + col]; lb[ct] = lnx_b[h * 64 + 32 * ct + col]; muv[ct] = mu_shift[C_V + h * 64 + 32 * ct + col]; }
            for (int rt = 0; rt < CH / 32; ++rt) {
                const size_t n0 = (size_t)b * SEQ + c * CH + rt * 32;
                f32x16 acc[2];
#pragma unroll
                for (int i = 0; i < 16; ++i) { acc[0][i] = 0.f; acc[1][i] = 0.f; }
#pragma unroll
                for (int s = 0; s < 4; ++s) {
                    const pg8::bf16x8 Af = *(const pg8::bf16x8*)(ZB + (n0 + col) * RW + h * 64 + 16 * s + 8 * hh);
                    acc[0] = __builtin_amdgcn_mfma_f32_32x32x16_bf16(Af, Bf[0][s], acc[0], 0, 0, 0);
                    acc[1] = __builtin_amdgcn_mfma_f32_32x32x16_bf16(Af, Bf[1][s], acc[1], 0, 0, 0);
                }
#pragma unroll
                for (int r = 0; r < 16; ++r) {
                    const int trow = (r & 3) + 8 * (r >> 2) + 4 * hh; const size_t n = n0 + trow; const int t = c * CH + rt * 32 + trow;
                    float y0 = acc[0][r] + YLOC[n * RW + h * 64 + col], y1 = acc[1][r] + YLOC[n * RW + h * 64 + 32 + col];
                    float sm = y0 + y1, sq = y0 * y0 + y1 * y1;
#pragma unroll
                    for (int o = 1; o < 32; o <<= 1) { sm += __shfl_xor(sm, o); sq += __shfl_xor(sq, o); }
                    const float mu = sm * (1.f / 64.f), var = fmaxf(sq * (1.f / 64.f) - mu * mu, 0.f), rs = 1.f / sqrtf(var + GN_EPS);
                    const float bon = BONUS[n * 8 + h];
#pragma unroll
                    for (int ct = 0; ct < 2; ++ct) {
                        const int hc = h * 64 + 32 * ct + col;
                        const float v0 = bf2f(U[n * INCOLS + C_V + hc]); const float pv = t ? bf2f(U[(n - 1) * INCOLS + C_V + hc]) : 0.f; const float vv = v0 + (pv - v0) * muv[ct];
                        const float gg = bf2f(DWAG[n * 1536 + 1024 + hc]);
                        const float yy = ct ? y1 : y0;
                        MIX[n * D + hc] = f2bf((((yy - mu) * rs) * lg[ct] + lb[ct] + bon * vv) * gg);
                    }
                }
            }
        }
    }
    SEAM(6);
    if (IN(7)) {
        const int qcol = lane & 15, g = lane >> 4;
        unsigned char* ldsK = lds_raw;
        unsigned char* ldsV = lds_raw + 32768;
        for (int unit = bx; unit < BATCH * 64 * 2; unit += G) {
            const int b = unit >> 7, blk = (unit & 127) >> 1, hk = unit & 1;
            const int s0 = blk * 128 - 128;
            __syncthreads();
            {
                const int key = tid >> 1, hf = tid & 1, s = s0 + key;
                u32x4 ko[4], vv[4];
                if (s >= 0) {
                    const size_t n = (size_t)b * SEQ + s;
                    const bf16_t* kp = U + n * INCOLS + C_KS + hk * 64 + 16 * hf;
                    const u32x4 a0 = *(const u32x4*)kp, a1 = *(const u32x4*)(kp + 8), b0 = *(const u32x4*)(kp + 32), b1 = *(const u32x4*)(kp + 40);
                    const unsigned k1w[8] = {a0.x, a0.y, a0.z, a0.w, a1.x, a1.y, a1.z, a1.w}, k2w[8] = {b0.x, b0.y, b0.z, b0.w, b1.x, b1.y, b1.z, b1.w};
                    unsigned o1[8], o2[8];
#pragma unroll
                    for (int q = 0; q < 8; ++q) {
                        const float c0 = ROPE_C[n * 32 + 16 * hf + 2 * q], c1 = ROPE_C[n * 32 + 16 * hf + 2 * q + 1], sn0 = ROPE_S[n * 32 + 16 * hf + 2 * q], sn1 = ROPE_S[n * 32 + 16 * hf + 2 * q + 1];
                        const float x1a = __builtin_bit_cast(float, k1w[q] << 16), x1b = __builtin_bit_cast(float, k1w[q] & 0xffff0000u), x2a = __builtin_bit_cast(float, k2w[q] << 16), x2b = __builtin_bit_cast(float, k2w[q] & 0xffff0000u);
                        o1[q] = pg8::cvt_pk_bf16(x1a * c0 - x2a * sn0, x1b * c1 - x2b * sn1); o2[q] = pg8::cvt_pk_bf16(x2a * c0 + x1a * sn0, x2b * c1 + x1b * sn1);
                    }
                    ko[0] = (u32x4){o1[0], o1[1], o1[2], o1[3]}; ko[1] = (u32x4){o1[4], o1[5], o1[6], o1[7]}; ko[2] = (u32x4){o2[0], o2[1], o2[2], o2[3]}; ko[3] = (u32x4){o2[4], o2[5], o2[6], o2[7]};
                    const bf16_t* vp = U + n * INCOLS + C_VS + hk * 64 + 32 * hf;
#pragma unroll
                    for (int q = 0; q < 4; ++q) vv[q] = *(const u32x4*)(vp + 8 * q);
                } else {
#pragma unroll
                    for (int q = 0; q < 4; ++q) { ko[q] = (u32x4){0u, 0u, 0u, 0u}; vv[q] = (u32x4){0u, 0u, 0u, 0u}; }
                }
                const int sw = (key >> 1) & 7;
                *(u32x4*)(ldsK + key * 128 + (((2 * hf) ^ sw) << 4)) = ko[0]; *(u32x4*)(ldsK + key * 128 + (((2 * hf + 1) ^ sw) << 4)) = ko[1];
                *(u32x4*)(ldsK + key * 128 + (((4 + 2 * hf) ^ sw) << 4)) = ko[2]; *(u32x4*)(ldsK + key * 128 + (((5 + 2 * hf) ^ sw) << 4)) = ko[3];
#pragma unroll
                for (int q = 0; q < 4; ++q)
#pragma unroll
                    for (int e2 = 0; e2 < 4; ++e2) {
                        const unsigned wv = vv[q][e2]; const int d0 = 32 * hf + 8 * q + 2 * e2;
                        *(bf16_t*)(ldsV + d0 * 512 + ((((key >> 2) ^ (2 * (d0 & 15)))) << 3) + (key & 3) * 2) = (bf16_t)(wv & 0xffffu);
                        *(bf16_t*)(ldsV + (d0 + 1) * 512 + ((((key >> 2) ^ (2 * ((d0 + 1) & 15)))) << 3) + (key & 3) * 2) = (bf16_t)(wv >> 16);
                    }
            }
            __syncthreads();
            const int i0 = 16 * wave, qi = i0 + qcol;
            const size_t nq = (size_t)b * SEQ + blk * 128 + qi;
#pragma unroll 1
            for (int gq = 0; gq < 4; ++gq) {
                const int hq = hk * 4 + gq;
                pg8::bf16x8 Qf[2];
                {
                    const bf16_t* qp = U + nq * INCOLS + C_Q + hq * 64 + 8 * g;
                    const u32x4 qa = *(const u32x4*)qp, qb = *(const u32x4*)(qp + 32);
                    const f32x4 c0 = *(const f32x4*)(ROPE_C + nq * 32 + 8 * g), c1 = *(const f32x4*)(ROPE_C + nq * 32 + 8 * g + 4), sn0 = *(const f32x4*)(ROPE_S + nq * 32 + 8 * g), sn1 = *(const f32x4*)(ROPE_S + nq * 32 + 8 * g + 4);
                    const float cc[8] = {c0[0], c0[1], c0[2], c0[3], c1[0], c1[1], c1[2], c1[3]}, ss[8] = {sn0[0], sn0[1], sn0[2], sn0[3], sn1[0], sn1[1], sn1[2], sn1[3]};
                    u32x4 w1, w2;
#pragma unroll
                    for (int q = 0; q < 4; ++q) {
                        const float x1a = __builtin_bit_cast(float, qa[q] << 16), x1b = __builtin_bit_cast(float, qa[q] & 0xffff0000u), x2a = __builtin_bit_cast(float, qb[q] << 16), x2b = __builtin_bit_cast(float, qb[q] & 0xffff0000u);
                        w1[q] = pg8::cvt_pk_bf16((x1a * cc[2 * q] - x2a * ss[2 * q]) * 0.125f, (x1b * cc[2 * q + 1] - x2b * ss[2 * q + 1]) * 0.125f);
                        w2[q] = pg8::cvt_pk_bf16((x2a * cc[2 * q] + x1a * ss[2 * q]) * 0.125f, (x2b * cc[2 * q + 1] + x1b * ss[2 * q + 1]) * 0.125f);
                    }
                    Qf[0] = __builtin_bit_cast(pg8::bf16x8, w1); Qf[1] = __builtin_bit_cast(pg8::bf16x8, w2);
                }
                const float sink = sinks[hq];
                pg8::f32x4 acc[10];
                float m = sink;
#pragma unroll
                for (int t = 0; t < 10; ++t) {
                    const int kt = wave + t, ktc = kt < 16 ? kt : 15, key = 16 * ktc + qcol, sw = (key >> 1) & 7;
                    pg8::f32x4 a = (pg8::f32x4){0.f, 0.f, 0.f, 0.f};
#pragma unroll
                    for (int ks = 0; ks < 2; ++ks) { const pg8::bf16x8 kf = *(const pg8::bf16x8*)(ldsK + key * 128 + (((4 * ks + g) ^ sw) << 4));
                        a = __builtin_amdgcn_mfma_f32_16x16x32_bf16(kf, Qf[ks], a, 0, 0, 0); }
#pragma unroll
                    for (int r = 0; r < 4; ++r) { const int kk = 16 * kt + 4 * g + r; const bool ok = (kk > qi) && (kk <= qi + 128) && (s0 + kk >= 0) && (kt < 16);
                        a[r] = ok ? a[r] : -INFINITY; m = fmaxf(m, a[r]); }
                    acc[t] = a;
                }
                m = fmaxf(m, __shfl_xor(m, 16)); m = fmaxf(m, __shfl_xor(m, 32));
                float lsum = 0.f;
#pragma unroll
                for (int t = 0; t < 10; ++t)
#pragma unroll
                    for (int r = 0; r < 4; ++r) { const float p = __expf(acc[t][r] - m); acc[t][r] = p; lsum += p; }
                lsum += __shfl_xor(lsum, 16); lsum += __shfl_xor(lsum, 32);
                lsum += __expf(sink - m);
                pg8::bf16x8 Pf[5];
#pragma unroll
                for (int ks = 0; ks < 5; ++ks) { u32x4 w; w.x = pg8::cvt_pk_bf16(acc[2 * ks][0], acc[2 * ks][1]); w.y = pg8::cvt_pk_bf16(acc[2 * ks][2], acc[2 * ks][3]);
                    w.z = pg8::cvt_pk_bf16(acc[2 * ks + 1][0], acc[2 * ks + 1][1]); w.w = pg8::cvt_pk_bf16(acc[2 * ks + 1][2], acc[2 * ks + 1][3]); Pf[ks] = __builtin_bit_cast(pg8::bf16x8, w); }
                float linv[4];
#pragma unroll
                for (int r = 0; r < 4; ++r) linv[r] = 1.f / __shfl(lsum, 4 * g + r);
#pragma unroll
                for (int dt = 0; dt < 4; ++dt) {
                    pg8::f32x4 o = (pg8::f32x4){0.f, 0.f, 0.f, 0.f};
                    const int dd = 16 * dt + qcol;
#pragma unroll
                    for (int ks = 0; ks < 5; ++ks) {
                        const int ka = wave + 2 * ks, kb = ka + 1, kac = ka < 16 ? ka : 15, kbc = kb < 16 ? kb : 15;
                        const u32x2 v0 = *(const u32x2*)(ldsV + dd * 512 + (((4 * kac + g) ^ (2 * (dd & 15))) << 3));
                        const u32x2 v1 = *(const u32x2*)(ldsV + dd * 512 + (((4 * kbc + g) ^ (2 * (dd & 15))) << 3));
                        u32x4 w; w.x = v0.x; w.y = v0.y; w.z = v1.x; w.w = v1.y;
                        o = __builtin_amdgcn_mfma_f32_16x16x32_bf16(Pf[ks], __builtin_bit_cast(pg8::bf16x8, w), o, 0, 0, 0);
                    }
#pragma unroll
                    for (int r = 0; r < 4; ++r) MIX[((size_t)b * SEQ + blk * 128 + i0 + 4 * g + r) * D + RW + hq * 64 + dd] = f2bf(o[r] * linv[r]);
                }
            }
        }
    }
    SEAM(7);
    if (IN(8)) {
        pg8::DenseProb S{MIX, W_O_T, D, {}}; S.ord.init(NTOK, D, G, bx);
        pg8::EpiF32Res E{X1, D, x, ALPHA};
        pg8::gemm_phase(ldsl, S, E);
    }
    SEAM(8);
    if (IN(9)) { for (int n = gw; n < NTOK; n += NGW) ln_row(X1 + (size_t)n * D, 1.f, nullptr, X1 + (size_t)n * D, ln1_g, ln1_b, lane, X1B + (size_t)n * D); }
    SEAM(9);
    if (IN(10)) {
        { pg8::DenseProb S{X1B, WM_Q_T, D, {}}; S.ord.init(NTOK, D, G, bx); pg8::EpiBf16 E{QMB, D}; pg8::gemm_phase(ldsl, S, E); }
        { pg8::DenseProb S{MEMB, WM_KV_T, D, {}}; S.ord.init(BATCH * MEMT, D, G, bx); pg8::EpiBf16 E{KM, D}; pg8::gemm_phase(ldsl, S, E); }
        { pg8::DenseProb S{WM_KV_T + (size_t)D * D, MEMB, D, {}}; S.ord.init(D, BATCH * MEMT, G, bx); pg8::EpiBf16 E{VT, BATCH * MEMT}; pg8::gemm_phase(ldsl, S, E); }
    }
    SEAM(10);
    if (IN(11)) {
        const int qcol = lane & 15, g = lane >> 4;
        unsigned char* ldsb = lds_raw;
        for (int unit = bx; unit < BATCH * 4 * (SEQ / 128); unit += G) {
            const int b = unit / (4 * (SEQ / 128)), h = (unit / (SEQ / 128)) & 3, qt = unit % (SEQ / 128);
            const size_t q0 = (size_t)b * SEQ + qt * 128 + wave * 16;
            pg8::bf16x8 Qf[8];
#pragma unroll
            for (int ks = 0; ks < 8; ++ks) Qf[ks] = *(const pg8::bf16x8*)(QMB + (q0 + qcol) * D + h * 256 + 32 * ks + 8 * g);
            __syncthreads();
#pragma unroll 4
            for (int i = 0; i < 16; ++i) { const int p = tid + NTHREADS * i, row = p >> 5, ch = p & 31;
                const u32x4 v = *(const u32x4*)(KM + (size_t)(b * MEMT + row) * D + h * 256 + ch * 8);
                *(u32x4*)(ldsb + row * 512 + ((ch ^ (row & 15)) << 4)) = v; }
            __syncthreads();
            pg8::f32x4 acc[16];
#pragma unroll
            for (int kt = 0; kt < 16; ++kt) { acc[kt] = (pg8::f32x4){0.f, 0.f, 0.f, 0.f};
                const int key = 16 * kt + qcol;
#pragma unroll
                for (int ks = 0; ks < 8; ++ks) { const pg8::bf16x8 a = *(const pg8::bf16x8*)(ldsb + key * 512 + (((4 * ks + g) ^ (key & 15)) << 4));
                    acc[kt] = __builtin_amdgcn_mfma_f32_16x16x32_bf16(a, Qf[ks], acc[kt], 0, 0, 0); } }
            float m = -INFINITY;
#pragma unroll
            for (int kt = 0; kt < 16; ++kt)
#pragma unroll
                for (int r = 0; r < 4; ++r) m = fmaxf(m, acc[kt][r]);
            m = fmaxf(m, __shfl_xor(m, 16)); m = fmaxf(m, __shfl_xor(m, 32));
            float lsum = 0.f;
#pragma unroll
            for (int kt = 0; kt < 16; ++kt)
#pragma unroll
                for (int r = 0; r < 4; ++r) { const float p = __expf((acc[kt][r] - m) * 0.0625f); acc[kt][r] = p; lsum += p; }
            lsum += __shfl_xor(lsum, 16); lsum += __shfl_xor(lsum, 32);
            pg8::bf16x8 Pf[8];
#pragma unroll
            for (int ks = 0; ks < 8; ++ks) { u32x4 w; w.x = pg8::cvt_pk_bf16(acc[2 * ks][0], acc[2 * ks][1]); w.y = pg8::cvt_pk_bf16(acc[2 * ks][2], acc[2 * ks][3]);
                w.z = pg8::cvt_pk_bf16(acc[2 * ks + 1][0], acc[2 * ks + 1][1]); w.w = pg8::cvt_pk_bf16(acc[2 * ks + 1][2], acc[2 * ks + 1][3]); Pf[ks] = __builtin_bit_cast(pg8::bf16x8, w); }
            __syncthreads();
#pragma unroll 4
            for (int i = 0; i < 16; ++i) { const int p = tid + NTHREADS * i, row = p >> 5, ch = p & 31;
                const u32x4 v = *(const u32x4*)(VT + (size_t)(h * 256 + row) * (BATCH * MEMT) + b * MEMT + ch * 8);
                *(u32x4*)(ldsb + row * 512 + ((ch ^ (row & 15)) << 4)) = v; }
            __syncthreads();
            float linv[4];
#pragma unroll
            for (int r = 0; r < 4; ++r) linv[r] = 1.f / __shfl(lsum, 4 * g + r);
#pragma unroll
            for (int dt = 0; dt < 16; ++dt) {
                pg8::f32x4 o = (pg8::f32x4){0.f, 0.f, 0.f, 0.f};
                const int dd = 16 * dt + qcol;
#pragma unroll
                for (int ks = 0; ks < 8; ++ks) {
                    const int c8 = 8 * ks + g;
                    const u32x2 v0 = *(const u32x2*)(ldsb + dd * 512 + ((c8 ^ (2 * (dd & 15))) << 3));
                    const u32x2 v1 = *(const u32x2*)(ldsb + dd * 512 + (((c8 + 4) ^ (2 * (dd & 15))) << 3));
                    u32x4 w; w.x = v0.x; w.y = v0.y; w.z = v1.x; w.w = v1.y;
                    o = __builtin_amdgcn_mfma_f32_16x16x32_bf16(Pf[ks], __builtin_bit_cast(pg8::bf16x8, w), o, 0, 0, 0);
                }
#pragma unroll
                for (int r = 0; r < 4; ++r) OM[(q0 + 4 * g + r) * D + h * 256 + dd] = f2bf(o[r] * linv[r]);
            }
        }
    }
    SEAM(11);
    if (IN(14)) {
        pg8::DenseProb S{OM, WM_O_T, D, {}}; S.ord.init(NTOK, D, G, bx);
        pg8::EpiF32Res E{X2, D, X1, ALPHA};
        pg8::gemm_phase(ldsl, S, E);
    }
    SEAM(14);
    if (IN(15)) {
        for (int n = gw; n < NTOK; n += NGW) ln_row(X2 + (size_t)n * D, 1.f, nullptr, X2 + (size_t)n * D, ln2_g, ln2_b, lane, X2B + (size_t)n * D);
        if (bx == 0 && tid < 128) *(u32x4*)(X2B + (size_t)NTOK * D + tid * 8) = (u32x4){0u, 0u, 0u, 0u};
    }
    SEAM(15);
    if (IN(16)) {
        pg8::DenseProb S{X2B, W_R_T, D, {}}; S.ord.init(NTOK, NEXP, G, bx);
        pg8::EpiF32Res E{LOG, NEXP, nullptr, 0.f};
        pg8::gemm_phase(ldsl, S, E);
    }
    SEAM(16);
    if (IN(17)) {
        const int hl = lane >> 5;
        for (int i = bx * NTHREADS + tid; i < PMAX; i += G * NTHREADS) { STOK[i] = NTOK; SGATE[i] = 0.f; }
        for (int n = gw; n < NTOK; n += NGW) {
            float sc[4], bi[4], gso[4];
#pragma unroll
            for (int j = 0; j < 4; ++j) { const int e = lane + 64 * j; sc[j] = sigmoidf_(LOG[(size_t)n * NEXP + e]); bi[j] = sc[j] + router_bias[e]; }
#pragma unroll
            for (int j = 0; j < 4; ++j) {
                float m1 = bi[j], m2 = -INFINITY;
#pragma unroll
                for (int o = 1; o < 32; o <<= 1) { const float o1 = __shfl_xor(m1, o), o2 = __shfl_xor(m2, o);
                    const float n1 = fmaxf(m1, o1), n2 = fmaxf(fminf(m1, o1), fmaxf(m2, o2)); m1 = n1; m2 = n2; }
                gso[j] = m1 + m2;
            }
            float g8[8];
#pragma unroll
            for (int j = 0; j < 4; ++j) { const float oth = __shfl_xor(gso[j], 32); g8[2 * j] = hl ? oth : gso[j]; g8[2 * j + 1] = hl ? gso[j] : oth; }
            bool gsel[8];
#pragma unroll
            for (int a = 0; a < 8; ++a) { int rank = 0;
#pragma unroll
                for (int c = 0; c < 8; ++c) rank += ((g8[c] > g8[a]) || (g8[c] == g8[a] && c < a)) ? 1 : 0;
                gsel[a] = rank < 4; }
            float cand[4];
#pragma unroll
            for (int j = 0; j < 4; ++j) { const bool s = hl ? gsel[2 * j + 1] : gsel[2 * j]; cand[j] = s ? bi[j] : -1e30f; }
            int eidx[8]; float sel[8]; float ssum = 0.f;
#pragma unroll
            for (int k = 0; k < 8; ++k) {
                float bv = cand[0]; int be = lane;
#pragma unroll
                for (int j = 1; j < 4; ++j) if (cand[j] > bv) { bv = cand[j]; be = lane + 64 * j; }
#pragma unroll
                for (int o = 1; o < 64; o <<= 1) { const float ov = __shfl_xor(bv, o); const int oe = __shfl_xor(be, o);
                    if (ov > bv || (ov == bv && oe < be)) { bv = ov; be = oe; } }
                eidx[k] = be;
                const int jw = be >> 6, lw = be & 63;
                const float mys = jw == 0 ? sc[0] : (jw == 1 ? sc[1] : (jw == 2 ? sc[2] : sc[3]));
                sel[k] = __shfl(mys, lw); ssum += sel[k];
#pragma unroll
                for (int j = 0; j < 4; ++j) if (lane == lw && j == jw) cand[j] = -INFINITY;
            }
#pragma unroll
            for (int k = 0; k < 8; ++k) {
                if (lane == k) {
                    const int e = eidx[k];
                    const int pos = (int)atomicAdd(&ctl[CW_CNT + e], 1u);
                    EIDX[n * 8 + k] = e; GATE[n * 8 + k] = sel[k] / ssum * 2.5f; POS[n * 8 + k] = pos;
                }
            }
        }
    }
    SEAM(17);
    if (IN(18)) {
        if (bx == 0) {
            int* soff = (int*)ldsf;
            if (tid == 0) { int acc = 0, cacc = 0; for (int e = 0; e < NEXP; ++e) { soff[e] = acc; soff[512 + e] = cacc; const int c = (int)ctl[CW_CNT + e]; acc += ((c + MOE_TR - 1) / MOE_TR) * MOE_TR; cacc += c; } soff[NEXP] = acc; }
            __syncthreads();
            if (tid <= NEXP) ctl[CW_OFF + tid] = (unsigned)soff[tid];
            if (tid < NEXP) ctl[CW_CST + tid] = (unsigned)soff[512 + tid];
            if (tid == 0) ctl[CW_NT] = (unsigned)(soff[NEXP] / MOE_TR);
            if (tid < NEXP) { for (int t = soff[tid] / MOE_TR; t < soff[tid + 1] / MOE_TR; ++t) TEXP[t] = tid; }
        }
    }
    SEAM(18);
    if (IN(19)) {
        for (int i = bx * NTHREADS + tid; i < NK; i += G * NTHREADS) {
            const int e = EIDX[i], p = (int)ctl[CW_OFF + e] + POS[i];
            STOK[p] = i >> 3; SGATE[p] = GATE[i]; YROW[i] = (int)ctl[CW_CST + e] + POS[i];
        }
    }
    SEAM(19);
    if (IN(20)) {
        const int ntm = (int)ctl[CW_NT];
        { pg8::GatherProb S{X2B, STOK, WE_GU_T, TEXP, D, 2, ntm * 2, G, bx, (size_t)512 * D * 2}; pg8::EpiSwiGLU E{HH, EDIM}; pg8::gemm_phase(ldsl, S, E); }
        { pg8::DenseProb S{X2B, WS_GU_T, D, {}}; S.ord.init(NTOK, 512, G, bx); pg8::EpiSwiGLU E{HS, EDIM}; pg8::gemm_phase(ldsl, S, E); }
    }
    SEAM(20);
    if (IN(21)) {
        const int ntm = (int)ctl[CW_NT];
        { pg8::GroupedProb S{HH, WE_D_T, TEXP, EDIM, 4, ntm * 4, G, bx, (size_t)D * EDIM * 2}; pg8::EpiScaleY E{YY, SGATE, ctl + CW_OFF, ctl + CW_CNT, ctl + CW_CST}; pg8::gemm_phase(ldsl, S, E); }
        { pg8::DenseProb S{HS, WS_D_T, EDIM, {}}; S.ord.init(NTOK, D, G, bx); pg8::EpiF32Res E{out, D, X2, ALPHA}; pg8::gemm_phase(ldsl, S, E); }
    }
    SEAM(21);
    if (IN(22)) {
        for (int n = gw; n < NTOK; n += NGW) {
            float v[16];
            float* orow = out + (size_t)n * D;
#pragma unroll
            for (int j = 0; j < 2; ++j) { const f32x4 a = *(const f32x4*)(orow + 512 * j + 8 * lane), b = *(const f32x4*)(orow + 512 * j + 8 * lane + 4);
#pragma unroll
                for (int q = 0; q < 4; ++q) { v[8 * j + q] = a[q]; v[8 * j + 4 + q] = b[q]; } }
            int yr[8];
#pragma unroll
            for (int k = 0; k < 8; ++k) yr[k] = YROW[n * 8 + k];
#pragma unroll
            for (int k = 0; k < 8; ++k) {
                const bf16_t* yrow = YY + (size_t)yr[k] * D;
#pragma unroll
                for (int j = 0; j < 2; ++j) { const u32x4 w = *(const u32x4*)(yrow + 512 * j + 8 * lane);
#pragma unroll
                    for (int q = 0; q < 4; ++q) { v[8 * j + 2 * q] += __builtin_bit_cast(float, w[q] << 16); v[8 * j + 2 * q + 1] += __builtin_bit_cast(float, w[q] & 0xffff0000u); } }
            }
            float s = 0.f;
#pragma unroll
            for (int i = 0; i < 16; ++i) s += v[i];
            const float mean = wave_sum(s) * (1.f / D); float s2 = 0.f;
#pragma unroll
            for (int i = 0; i < 16; ++i) { v[i] -= mean; s2 += v[i] * v[i]; }
            const float rstd = 1.f / sqrtf(wave_sum(s2) * (1.f / D) + LN_EPS);
#pragma unroll
            for (int j = 0; j < 2; ++j) {
                const f32x4 g0 = *(const f32x4*)(ln3_g + 512 * j + 8 * lane), g1 = *(const f32x4*)(ln3_g + 512 * j + 8 * lane + 4);
                const f32x4 b0 = *(const f32x4*)(ln3_b + 512 * j + 8 * lane), b1 = *(const f32x4*)(ln3_b + 512 * j + 8 * lane + 4);
                f32x4 o0, o1;
#pragma unroll
                for (int q = 0; q < 4; ++q) { o0[q] = v[8 * j + q] * rstd * g0[q] + b0[q]; o1[q] = v[8 * j + 4 + q] * rstd * g1[q] + b1[q]; }
                *(f32x4*)(orow + 512 * j + 8 * lane) = o0; *(f32x4*)(orow + 512 * j + 8 * lane + 4) = o1;
            }
        }
    }
#undef IN
#undef SEAM
}

#ifndef PHASE_MASK
#define PHASE_MASK 0x7FFFFFu
#endif
#ifndef ONE_LAUNCH
#define ONE_LAUNCH 1
#endif

extern "C" void kernel_launch(void* const* d_in, const int* in_sizes, int n_in, void* d_out, int out_size, void* d_ws, size_t ws_size, hipStream_t stream) {
    static int grid = 0;
    if (grid == 0) {
        if (n_in != 34 || out_size != NTOK * D || ws_size < WS_END) { fprintf(stderr, "kernel_launch: unexpected shapes (n_in %d out %d ws %zu)\n", n_in, out_size, ws_size); grid = -1; return; }
        int dev = 0, cus = 0;
        if (hipGetDevice(&dev) != hipSuccess || hipDeviceGetAttribute(&cus, hipDeviceAttributeMultiprocessorCount, dev) != hipSuccess) { grid = -1; return; }
        if (hipFuncSetAttribute((const void*)mega, hipFuncAttributeMaxDynamicSharedMemorySize, LDS_BYTES) != hipSuccess) { fprintf(stderr, "kernel_launch: hipFuncSetAttribute failed\n"); grid = -1; return; }
        (void)hipGetLastError();
        grid = cus;
    }
    if (grid < 0) return;
    (void)hipMemsetAsync((char*)d_ws + WS_CTL, 0, CTL_ZERO_BYTES, stream);
    Args a{};
    for (int i = 0; i < 34; ++i) a.in[i] = (const float*)d_in[i];
    a.out = (float*)d_out; a.ws = (unsigned char*)d_ws;
#if ONE_LAUNCH
    a.ph_lo = 0; a.ph_hi = NPHASES;
    hipLaunchKernelGGL(mega, dim3(grid), dim3(NTHREADS), LDS_BYTES, stream, a);
#else
    for (int p = 0; p < NPHASES; ++p) { if (!((PHASE_MASK >> p) & 1)) continue; a.ph_lo = p; a.ph_hi = p + 1; hipLaunchKernelGGL(mega, dim3(grid), dim3(NTHREADS), LDS_BYTES, stream, a); }
#endif
}
```

```cpp
#include <hip/hip_runtime.h>
#include <cstdio>
#include <cstdint>

constexpr int D = 1024, BATCH = 4, SEQ = 8192, NTOK = BATCH * SEQ;
constexpr int MEMT = 256;
constexpr int RW = 512, RCOLS = 1792, INCOLS = 2560;
constexpr int C_R = 0, C_K = 512, C_V = 1024, C_WD = 1536, C_AD = 1600, C_GD = 1664, C_Q = 1792, C_KS = 2304, C_VS = 2432;
constexpr int NEXP = 256, TOPK = 8, EDIM = 256;
constexpr int NK = NTOK * TOPK;
constexpr int CH = 128, NCH = SEQ / CH;
constexpr int MOE_TR = 256;
constexpr int PMAX = NK + NEXP * MOE_TR;
constexpr float LN_EPS = 1e-5f, GN_EPS = 64e-5f;
constexpr float ALPHA = 1.189207115002721f;

constexpr size_t MiB = 1u << 20;
constexpr size_t WS_CTL = 0, CTL_ZERO_BYTES = 64 * 1024;
constexpr size_t WS_TEXP = 512 * 1024;
constexpr size_t WS_ROPE = 1 * MiB;
constexpr size_t WS_EIDX = 9 * MiB, WS_GATE = 10 * MiB, WS_POS = 11 * MiB, WS_YROW = 12 * MiB;
constexpr size_t WS_STOK = 13 * MiB, WS_SGATE = 14 * MiB + 512 * 1024;
constexpr size_t WS_WIN = 16 * MiB, WS_WO = 21 * MiB, WS_WMQ = 23 * MiB, WS_WMKV = 25 * MiB, WS_WMO = 29 * MiB, WS_WSGU = 31 * MiB, WS_WSD = 32 * MiB;
constexpr size_t WS_MEMB = 36 * MiB;
constexpr size_t WS_WED = 40 * MiB;
constexpr size_t WS_WEGU = 168 * MiB;
constexpr size_t WS_XB = 424 * MiB;
constexpr size_t WS_U = 490 * MiB;
constexpr size_t WS_LRB = 650 * MiB;
constexpr size_t WS_DWAG = 666 * MiB;
constexpr size_t WS_YLOC = 762 * MiB;
constexpr size_t WS_ZB = 826 * MiB;
constexpr size_t WS_PT = 858 * MiB;
constexpr size_t WS_SLT = 424 * MiB;
constexpr size_t WS_SIN = 456 * MiB;
constexpr size_t WS_BONUS = 472 * MiB;
constexpr size_t WS_WLR = 33 * MiB;
constexpr size_t WS_MIX = 874 * MiB;
constexpr size_t WS_X1 = 424 * MiB;
constexpr size_t WS_X1B = 552 * MiB;
constexpr size_t WS_QM = 616 * MiB;
constexpr size_t WS_KVM = 744 * MiB;
constexpr size_t WS_SC = 752 * MiB;
constexpr size_t WS_OM = 880 * MiB;
constexpr size_t WS_X2B = 424 * MiB;
constexpr size_t WS_LOG = 490 * MiB;
constexpr size_t WS_H = 768 * MiB;
constexpr size_t WS_HS = 928 * MiB;
constexpr size_t WS_Y = 168 * MiB;
constexpr size_t WS_END = 944 * MiB;
constexpr int CW_CNT = 0, CW_OFF = 512, CW_NT = 1024, CW_CST = 1280, CW_BAR = 4096;

constexpr int NTHREADS = 512, NWAVES = 8;
constexpr int LDS_BYTES = 147456;
constexpr int MISC_OFF = 140 * 1024;

#define LAS __attribute__((address_space(3)))
typedef float f32x4 __attribute__((ext_vector_type(4)));
typedef float f32x16 __attribute__((ext_vector_type(16)));

#define XB_TMO      128
#define XB_XCNT(j)  (256  + 64 * (j))
#define XB_XSUB(j)  (1280 + 64 * (j))
#define XB_XGEN(j)  (2304 + 64 * (j))
#define XB_TOP      3328
#define XB_TOPGEN   3392
#define XCD_BAR_WORDS 3456
#define XB_SPIN_CAP (1u << 18)
__device__ __forceinline__ unsigned xb_ld(unsigned* p)              { return __hip_atomic_load(p, __ATOMIC_RELAXED, __HIP_MEMORY_SCOPE_AGENT); }
__device__ __forceinline__ unsigned xb_add(unsigned* p, unsigned v) { return __hip_atomic_fetch_add(p, v, __ATOMIC_RELAXED, __HIP_MEMORY_SCOPE_AGENT); }
__device__ __forceinline__ unsigned xb_xcc_id() { return (unsigned)__builtin_amdgcn_s_getreg((3 << 11) | 20) & 0xFu; }
#define XB_SPIN(cond, bar) do { unsigned _sp = 0; while (cond) { __builtin_amdgcn_s_sleep(1); \
    if ((++_sp & 255u) == 0u) { if (xb_ld(&(bar)[XB_TMO])) break; if (_sp > XB_SPIN_CAP) { atomicAdd(&(bar)[XB_TMO], 1u); break; } } } } while (0)
struct XcdBarrier { unsigned* bar; unsigned x; volatile LAS unsigned* st; };
__device__ __forceinline__ XcdBarrier xcd_barrier_post(unsigned* bar, volatile LAS unsigned* st) {
    XcdBarrier b; b.bar = bar; b.x = xb_xcc_id(); b.st = st;
    if (threadIdx.x == 0) (void)xb_add(&bar[XB_XCNT(b.x)], 1u);
    return b;
}
__device__ __forceinline__ void xcd_barrier_complete(unsigned* bar, unsigned x, unsigned& nloc, unsigned& nx) {
    const unsigned G = gridDim.x * gridDim.y * gridDim.z;
    unsigned sum, cnt, mine, sp = 0u;
    for (;;) {
        sum = 0u; cnt = 0u; mine = 0u;
#pragma unroll
        for (unsigned j = 0; j < 16; ++j) { const unsigned c = xb_ld(&bar[XB_XCNT(j)]); sum += c; cnt += (c > 0u) ? 1u : 0u; mine = (j == x) ? c : mine; }
        if (sum == G) break;
        __builtin_amdgcn_s_sleep(1);
        if ((++sp & 255u) == 0u) { if (xb_ld(&bar[XB_TMO])) break; if (sp > XB_SPIN_CAP) { atomicAdd(&bar[XB_TMO], 1u); break; } }
    }
    nloc = mine > 0u ? mine : 1u; nx = cnt > 0u ? cnt : 1u;
}
__device__ __forceinline__ void xcd_barrier(const XcdBarrier& b) {
    asm volatile("s_waitcnt vmcnt(0)" ::: "memory");
    __syncthreads();
    if (threadIdx.x == 0) {
        unsigned* bar = b.bar;
        __builtin_amdgcn_s_waitcnt(0);
        unsigned nloc = b.st[0], nx = b.st[1];
        if (nloc == 0u) { xcd_barrier_complete(bar, b.x, nloc, nx); b.st[0] = nloc; b.st[1] = nx; }
        const unsigned old = xb_add(&bar[XB_XSUB(b.x)], 1u);
        const unsigned gen = old / nloc;
        if (old + 1u == (gen + 1u) * nloc) {
            __builtin_amdgcn_fence(__ATOMIC_RELEASE, "agent");
            asm volatile("s_waitcnt vmcnt(0)" ::: "memory");
            const unsigned og = xb_add(&bar[XB_TOP], 1u);
            const unsigned tg = og / nx;
            if (og + 1u == (tg + 1u) * nx) xb_add(&bar[XB_TOPGEN], 1u);
            else XB_SPIN(xb_ld(&bar[XB_TOPGEN]) == tg, bar);
            __builtin_amdgcn_fence(__ATOMIC_ACQUIRE, "agent");
            xb_add(&bar[XB_XGEN(b.x)], 1u);
            asm volatile("s_waitcnt vmcnt(0)" ::: "memory");
        } else {
            XB_SPIN(xb_ld(&bar[XB_XGEN(b.x)]) == gen, bar);
            __builtin_amdgcn_fence(__ATOMIC_ACQUIRE, "agent");
            asm volatile("s_waitcnt vmcnt(0)" ::: "memory");
        }
    }
    __syncthreads();
}

namespace pg8 {
#define PG8_LAS __attribute__((address_space(3)))
typedef unsigned short bf16_t;
typedef short bf16x8 __attribute__((ext_vector_type(8)));
typedef float f32x4 __attribute__((ext_vector_type(4)));
typedef float f32x2 __attribute__((ext_vector_type(2)));
typedef unsigned u32x4 __attribute__((ext_vector_type(4)));
constexpr int BM = 256, BK = 64, HALF = 128, HTB = HALF * BK * 2, STAGE_BYTES = 8 * HTB, NXCD = 8, WGM = 8;
__host__ __device__ __forceinline__ int lds_byte(int r, int c) { const int st = (r >> 4) * 2 + (c >> 5), rr = r & 15, cc = c & 31, ob = rr * 64 + cc * 2; return st * 1024 + (ob ^ (((ob >> 9) & 1) << 5)); }
__host__ __device__ __forceinline__ void stage_rc(int b, int& R, int& C) { const int st = b / 1024, sb = b % 1024, swz = sb ^ (((sb >> 9) & 1) << 5); R = (st >> 1) * 16 + swz / 64; C = (st & 1) * 32 + (swz % 64) / 2; }
__host__ __device__ __forceinline__ int perm32(int rho) { const int n = rho >> 4, i = rho & 15; return 8 * (i >> 2) + 4 * n + (i & 3); }
__device__ __forceinline__ unsigned cvt_pk_bf16(float lo, float hi) { unsigned r; asm volatile("v_cvt_pk_bf16_f32 %0, %1, %2" : "=v"(r) : "v"(lo), "v"(hi)); return r; }

struct Unit { int pm, pn, e; };
struct StaticOrder {
    int nM, nN, nwg, G, c;
    __host__ __device__ void init(int M, int N, int G_, int c_) { nM = M / BM; nN = N / BM; nwg = nM * nN; G = G_; c = c_; }
    __host__ __device__ bool next(int i, Unit& u) const {
        const long L = (long)i * G + c; if (L >= nwg) return false;
        int wgid = (int)L; { const int q = nwg / NXCD, r = nwg % NXCD, xcd = wgid % NXCD, off = wgid / NXCD; wgid = (xcd < r ? xcd * (q + 1) : r * (q + 1) + (xcd - r) * q) + off; }
        const int nig = WGM * nN, gid = wgid / nig, fm = gid * WGM, gsz = (nM - fm) < WGM ? (nM - fm) : WGM;
        u.pm = fm + ((wgid % nig) % gsz); u.pn = (wgid % nig) / gsz; u.e = 0; return true;
    }
};
struct DenseProb {
    const bf16_t* A; const bf16_t* Bt; int K; StaticOrder ord;
    __device__ __forceinline__ bool next(int i, Unit& u) const { return ord.next(i, u); }
    __device__ __forceinline__ const char* a_base(const Unit& u) const { return (const char*)A + (size_t)u.pm * BM * K * 2; }
    __device__ __forceinline__ const char* b_base(const Unit& u) const { return (const char*)Bt + (size_t)u.pn * BM * K * 2; }
    __device__ __forceinline__ void a_offs(const Unit&, unsigned (&v)[2][2], const int (&R)[2], const int (&C)[2]) const {
#pragma unroll
        for (int h = 0; h < 2; ++h)
#pragma unroll
            for (int i = 0; i < 2; ++i) v[h][i] = (unsigned)((h * HALF + R[i]) * K + C[i]) * 2u;
    }
};
struct GatherProb {
    const bf16_t* X; const int* stok; const bf16_t* Bt; const int* texp; int K, nN, nunits, G, c; size_t estride;
    __device__ __forceinline__ bool next(int i, Unit& u) const {
        const int per = (nunits + G - 1) / G; const long L = (long)c * per + i; if (i >= per || L >= nunits) return false;
        u.pm = (int)(L / nN); u.pn = (int)(L % nN); u.e = texp[u.pm]; return true;
    }
    __device__ __forceinline__ const char* a_base(const Unit&) const { return (const char*)X; }
    __device__ __forceinline__ const char* b_base(const Unit& u) const { return (const char*)Bt + (size_t)u.e * estride + (size_t)u.pn * BM * K * 2; }
    __device__ __forceinline__ void a_offs(const Unit& u, unsigned (&v)[2][2], const int (&R)[2], const int (&C)[2]) const {
#pragma unroll
        for (int h = 0; h < 2; ++h)
#pragma unroll
            for (int i = 0; i < 2; ++i) { const int tok = stok[u.pm * BM + h * HALF + R[i]]; v[h][i] = (unsigned)(tok * K + C[i]) * 2u; }
    }
};
struct GroupedProb {
    const bf16_t* A; const bf16_t* Bt; const int* texp; int K, nN, nunits, G, c; size_t estride;
    __device__ __forceinline__ bool next(int i, Unit& u) const {
        const int per = (nunits + G - 1) / G; const long L = (long)c * per + i; if (i >= per || L >= nunits) return false;
        u.pm = (int)(L / nN); u.pn = (int)(L % nN); u.e = texp[u.pm]; return true;
    }
    __device__ __forceinline__ const char* a_base(const Unit& u) const { return (const char*)A + (size_t)u.pm * BM * K * 2; }
    __device__ __forceinline__ const char* b_base(const Unit& u) const { return (const char*)Bt + (size_t)u.e * estride + (size_t)u.pn * BM * K * 2; }
    __device__ __forceinline__ void a_offs(const Unit&, unsigned (&v)[2][2], const int (&R)[2], const int (&C)[2]) const {
#pragma unroll
        for (int h = 0; h < 2; ++h)
#pragma unroll
            for (int i = 0; i < 2; ++i) v[h][i] = (unsigned)((h * HALF + R[i]) * K + C[i]) * 2u;
    }
};

struct EpiBf16 {
    static constexpr bool PERM = true;
    bf16_t* O; int ldc;
    __device__ __forceinline__ void operator()(const f32x4 (&acc)[2][2][4][2], const Unit& u, int wr, int wc, int fr, int fq) const {
        const int row0 = u.pm * BM + wr * 64 + fr, col0 = u.pn * BM + wc * 32 + 8 * fq;
#pragma unroll
        for (int ai = 0; ai < 2; ++ai)
#pragma unroll
            for (int m = 0; m < 4; ++m) { bf16_t* rowp = O + (size_t)(row0 + ai * HALF + m * 16) * ldc + col0;
#pragma unroll
                for (int bj = 0; bj < 2; ++bj) { const f32x4 v0 = acc[ai][bj][m][0], v1 = acc[ai][bj][m][1];
                    u32x4 w; w.x = cvt_pk_bf16(v0[0], v0[1]); w.y = cvt_pk_bf16(v0[2], v0[3]); w.z = cvt_pk_bf16(v1[0], v1[1]); w.w = cvt_pk_bf16(v1[2], v1[3]);
                    *(u32x4*)(rowp + bj * HALF) = w; } }
    }
};
struct EpiF32Res {
    static constexpr bool PERM = false;
    float* C; int ldc; const float* base; float alpha;
    __device__ __forceinline__ void operator()(const f32x4 (&acc)[2][2][4][2], const Unit& u, int wr, int wc, int fr, int fq) const {
        const int row0 = u.pm * BM + wr * 64 + fr, col0 = u.pn * BM + wc * 32 + 4 * fq;
#pragma unroll
        for (int ai = 0; ai < 2; ++ai)
#pragma unroll
            for (int m = 0; m < 4; ++m) { const size_t off = (size_t)(row0 + ai * HALF + m * 16) * ldc + col0;
#pragma unroll
                for (int bj = 0; bj < 2; ++bj)
#pragma unroll
                    for (int n = 0; n < 2; ++n) { f32x4 o = acc[ai][bj][m][n];
                        if (base) o += *(const f32x4*)(base + off + bj * HALF + n * 16) * alpha;
                        *(f32x4*)(C + off + bj * HALF + n * 16) = o; } }
    }
};

struct EpiSwiGLU {
    static constexpr bool PERM = true;
    bf16_t* O; int ldc;
    __device__ __forceinline__ void operator()(const f32x4 (&acc)[2][2][4][2], const Unit& u, int wr, int wc, int fr, int fq) const {
        const int row0 = u.pm * BM + wr * 64 + fr, col0 = u.pn * HALF + wc * 32 + 8 * fq;
#pragma unroll
        for (int ai = 0; ai < 2; ++ai)
#pragma unroll
            for (int m = 0; m < 4; ++m) { bf16_t* rowp = O + (size_t)(row0 + ai * HALF + m * 16) * ldc + col0;
                float h[8];
#pragma unroll
                for (int n = 0; n < 2; ++n)
#pragma unroll
                    for (int q = 0; q < 4; ++q) { const float g = acc[ai][0][m][n][q], up = acc[ai][1][m][n][q]; h[4 * n + q] = g * __builtin_amdgcn_rcpf(1.f + __expf(-g)) * up; }
                u32x4 w; w.x = cvt_pk_bf16(h[0], h[1]); w.y = cvt_pk_bf16(h[2], h[3]); w.z = cvt_pk_bf16(h[4], h[5]); w.w = cvt_pk_bf16(h[6], h[7]);
                *(u32x4*)rowp = w; }
    }
};
struct EpiScaleY {
    static constexpr bool PERM = true;
    bf16_t* Y; const float* sgate; const unsigned* off; const unsigned* cnt; const unsigned* cst;
    __device__ __forceinline__ void operator()(const f32x4 (&acc)[2][2][4][2], const Unit& u, int wr, int wc, int fr, int fq) const {
        const int o0 = (int)off[u.e], nreal = (int)cnt[u.e], c0 = (int)cst[u.e];
        const int row0 = u.pm * BM + wr * 64 + fr, col0 = u.pn * BM + wc * 32 + 8 * fq;
#pragma unroll
        for (int ai = 0; ai < 2; ++ai)
#pragma unroll
            for (int m = 0; m < 4; ++m) { const int p = row0 + ai * HALF + m * 16, rel = p - o0;
                if (rel < nreal) { bf16_t* rowp = Y + (size_t)(c0 + rel) * 1024 + col0;
#pragma unroll
                    for (int bj = 0; bj < 2; ++bj) { const f32x4 v0 = acc[ai][bj][m][0], v1 = acc[ai][bj][m][1];
                        u32x4 w; w.x = cvt_pk_bf16(v0[0], v0[1]); w.y = cvt_pk_bf16(v0[2], v0[3]); w.z = cvt_pk_bf16(v1[0], v1[1]); w.w = cvt_pk_bf16(v1[2], v1[3]);
                        *(u32x4*)(rowp + bj * HALF) = w; } } }
    }
};

template <class Epi, class Prob>
__device__ __forceinline__ void gemm_phase(PG8_LAS unsigned char* lds, const Prob& S, const Epi& E) {
    int tid = threadIdx.x; asm volatile("" : "+v"(tid));
    const int wid = __builtin_amdgcn_readfirstlane(tid >> 6), lane = tid & 63, wr = wid >> 2, wc = wid & 3, fr = lane & 15, fq = lane >> 4;
    const int K = S.K, nt = K / BK;
    int Rr[2], Cc[2]; unsigned voffB[2];
#pragma unroll
    for (int i = 0; i < 2; ++i) { int R, C; stage_rc(tid * 16 + i * 8192, R, C); const int Rb = Epi::PERM ? ((R & ~31) + perm32(R & 31)) : R;
        Rr[i] = R; Cc[i] = C; voffB[i] = (unsigned)(Rb * K + C) * 2u; }
    const size_t kstep = (size_t)(BK * 2);
    const size_t hstep = (size_t)HALF * K * 2;
    const unsigned ldsw = (unsigned)wid * 1024u;
    const int aoff = lds_byte(wr * 64 + fr, fq * 8), boff = lds_byte(wc * 32 + fr, fq * 8);
#define PG8_SA(b, h) (((b) * 2 + (h)) * HTB)
#define PG8_SB(b, h) ((4 + (b) * 2 + (h)) * HTB)
#define PG8_STAGE(bufoff, gbase, voff) do { _Pragma("unroll") for (int _i = 0; _i < 2; ++_i) \
        __builtin_amdgcn_global_load_lds((const unsigned*)((const char*)(gbase) + (voff)[_i]), (PG8_LAS unsigned*)(lds + (bufoff) + ldsw + _i * 8192), 16, 0, 0); } while (0)
#define PG8_LDA(dst, b, h) do { _Pragma("unroll") for (int m = 0; m < 4; ++m) _Pragma("unroll") for (int k = 0; k < 2; ++k) dst[m][k] = *(const PG8_LAS bf16x8*)(lds + PG8_SA(b, h) + aoff + m * 2048 + k * 1024); } while (0)
#define PG8_LDB(dst, b, h) do { _Pragma("unroll") for (int n = 0; n < 2; ++n) _Pragma("unroll") for (int k = 0; k < 2; ++k) dst[n][k] = *(const PG8_LAS bf16x8*)(lds + PG8_SB(b, h) + boff + n * 2048 + k * 1024); } while (0)
#define PG8_MMA(ai, bj, At, Bt) do { __builtin_amdgcn_s_setprio(1); _Pragma("unroll") for (int m = 0; m < 4; ++m) _Pragma("unroll") for (int n = 0; n < 2; ++n) _Pragma("unroll") for (int k = 0; k < 2; ++k) \
        acc[ai][bj][m][n] = __builtin_amdgcn_mfma_f32_16x16x32_bf16(Bt[n][k], At[m][k], acc[ai][bj][m][n], 0, 0, 0); __builtin_amdgcn_s_setprio(0); } while (0)
#define PG8_WAIT_V(n) asm volatile("s_waitcnt vmcnt(" #n ")" ::: "memory")
#define PG8_WAIT_L(n) asm volatile("s_waitcnt lgkmcnt(" #n ")" ::: "memory")
#define PG8_BAR __builtin_amdgcn_s_barrier()
#define PG8_SCHED __builtin_amdgcn_sched_barrier(0)
    Unit cur, nxt; int ui = 0;
    if (!S.next(0, cur)) return;
    f32x4 acc[2][2][4][2];
#pragma unroll
    for (int a = 0; a < 2; ++a)
#pragma unroll
        for (int b = 0; b < 2; ++b)
#pragma unroll
            for (int m = 0; m < 4; ++m)
#pragma unroll
                for (int n = 0; n < 2; ++n) acc[a][b][m][n] = (f32x4){0.f, 0.f, 0.f, 0.f};
    bf16x8 At[4][2], B0[2][2], B1[2][2];
    const char* cA = S.a_base(cur); const char* cB = S.b_base(cur);
    unsigned vA[2][2], nvA[2][2];
    S.a_offs(cur, vA, Rr, Cc);
    PG8_STAGE(PG8_SB(0, 0), cB, voffB); PG8_STAGE(PG8_SA(0, 0), cA, vA[0]); PG8_STAGE(PG8_SB(0, 1), cB + hstep, voffB); PG8_STAGE(PG8_SA(0, 1), cA, vA[1]);
    if (wr == 1) PG8_BAR;
    PG8_WAIT_V(4); PG8_BAR;
    PG8_STAGE(PG8_SB(1, 0), cB + kstep, voffB); PG8_STAGE(PG8_SA(1, 0), cA + kstep, vA[0]); PG8_STAGE(PG8_SB(1, 1), cB + hstep + kstep, voffB);
    PG8_WAIT_V(6); PG8_BAR;
    for (;;) {
        const bool has_next = S.next(ui + 1, nxt);
        const char* nA = has_next ? S.a_base(nxt) : cA; const char* nB = has_next ? S.b_base(nxt) : cB;
        if (has_next) S.a_offs(nxt, nvA, Rr, Cc);
        else {
#pragma unroll
            for (int h = 0; h < 2; ++h)
#pragma unroll
                for (int i = 0; i < 2; ++i) nvA[h][i] = vA[h][i];
        }
        for (int t = 0; t < nt; t += 2) {
            const bool last = (t == nt - 2);
            const char* a1 = cA + (size_t)(t + 1) * kstep;
            const char* a2 = last ? nA : cA + (size_t)(t + 2) * kstep; const char* b2 = last ? nB : cB + (size_t)(t + 2) * kstep;
            const char* a3 = a2 + kstep; const char* b3 = b2 + kstep;
            unsigned v2[2][2];
#pragma unroll
            for (int h = 0; h < 2; ++h)
#pragma unroll
                for (int i = 0; i < 2; ++i) v2[h][i] = last ? nvA[h][i] : vA[h][i];
            PG8_LDB(B0, 0, 0); PG8_SCHED; PG8_LDA(At, 0, 0); PG8_STAGE(PG8_SA(1, 1), a1, vA[1]);
            PG8_WAIT_L(8); PG8_BAR; PG8_WAIT_L(0); PG8_MMA(0, 0, At, B0); PG8_BAR; PG8_SCHED;
            PG8_LDB(B1, 0, 1); PG8_STAGE(PG8_SB(0, 0), b2, voffB);
            PG8_BAR; PG8_WAIT_L(0); PG8_MMA(0, 1, At, B1); PG8_BAR;
            PG8_LDA(At, 0, 1); PG8_STAGE(PG8_SA(0, 0), a2, v2[0]);
            PG8_BAR; PG8_WAIT_L(0); PG8_MMA(1, 0, At, B0); PG8_BAR; PG8_SCHED;
            PG8_STAGE(PG8_SB(0, 1), b2 + hstep, voffB);
            PG8_WAIT_V(6); PG8_BAR; PG8_MMA(1, 1, At, B1); PG8_BAR;
            PG8_LDB(B0, 1, 0); PG8_SCHED; PG8_LDA(At, 1, 0); PG8_STAGE(PG8_SA(0, 1), a2, v2[1]);
            PG8_WAIT_L(8); PG8_BAR; PG8_WAIT_L(0); PG8_MMA(0, 0, At, B0); PG8_BAR; PG8_SCHED;
            PG8_LDB(B1, 1, 1); PG8_STAGE(PG8_SB(1, 0), b3, voffB);
            PG8_BAR; PG8_WAIT_L(0); PG8_MMA(0, 1, At, B1); PG8_BAR;
            PG8_LDA(At, 1, 1); PG8_STAGE(PG8_SA(1, 0), a3, v2[0]);
            PG8_BAR; PG8_WAIT_L(0); PG8_MMA(1, 0, At, B0); PG8_BAR; PG8_SCHED;
            PG8_STAGE(PG8_SB(1, 1), b3 + hstep, voffB);
            PG8_WAIT_V(6); PG8_BAR; PG8_MMA(1, 1, At, B1); PG8_BAR;
        }
        E(acc, cur, wr, wc, fr, fq);
        if (!has_next) break;
#pragma unroll
        for (int a = 0; a < 2; ++a)
#pragma unroll
            for (int b = 0; b < 2; ++b)
#pragma unroll
                for (int m = 0; m < 4; ++m)
#pragma unroll
                    for (int n = 0; n < 2; ++n) acc[a][b][m][n] = (f32x4){0.f, 0.f, 0.f, 0.f};
        cur = nxt; cA = nA; cB = nB; ++ui;
#pragma unroll
        for (int h = 0; h < 2; ++h)
#pragma unroll
            for (int i = 0; i < 2; ++i) vA[h][i] = nvA[h][i];
    }
    PG8_WAIT_V(0);
    if (wr == 0) PG8_BAR;
    PG8_BAR;
#undef PG8_SA
#undef PG8_SB
#undef PG8_STAGE
#undef PG8_LDA
#undef PG8_LDB
#undef PG8_MMA
#undef PG8_WAIT_V
#undef PG8_WAIT_L
#undef PG8_BAR
#undef PG8_SCHED
}
}

__device__ __forceinline__ float wave_sum(float v) {
#pragma unroll
    for (int o = 1; o < 64; o <<= 1) v += __shfl_xor(v, o);
    return v;
}
__device__ __forceinline__ float sigmoidf_(float x) { return 1.0f / (1.0f + expf(-x)); }
__device__ __forceinline__ float fma1(float a, float b, float c) { float d; asm("v_fma_f32 %0, %1, %2, %3" : "=v"(d) : "v"(a), "v"(b), "v"(c)); return d; }
__device__ __forceinline__ float mul1(float a, float b) { float d; asm("v_mul_f32 %0, %1, %2" : "=v"(d) : "v"(a), "v"(b)); return d; }

typedef unsigned short bf16_t;
typedef unsigned u32x4 __attribute__((ext_vector_type(4)));
typedef unsigned u32x2 __attribute__((ext_vector_type(2)));
__device__ __forceinline__ float bf2f(bf16_t b) { return __builtin_bit_cast(float, (unsigned)b << 16); }
__device__ __forceinline__ bf16_t f2bf(float f) { return (bf16_t)(pg8::cvt_pk_bf16(f, 0.f) & 0xffffu); }
__device__ __forceinline__ void transpose_item(const float* W, int K, int N, bf16_t* WT, int k0, int n0, int drow0, float* scr, int lane) {
#pragma unroll 8
    for (int i = 0; i < 32; ++i) { const int kk = 2 * i + (lane >> 5); scr[kk * 33 + (lane & 31)] = W[(size_t)(k0 + kk) * N + n0 + (lane & 31)]; }
    __builtin_amdgcn_wave_barrier();
    const int c = lane & 7;
#pragma unroll
    for (int j = 0; j < 4; ++j) { const int n = (lane >> 3) + 8 * j; const float* s = scr + (8 * c) * 33 + n;
        u32x4 o; o.x = pg8::cvt_pk_bf16(s[0 * 33], s[1 * 33]); o.y = pg8::cvt_pk_bf16(s[2 * 33], s[3 * 33]); o.z = pg8::cvt_pk_bf16(s[4 * 33], s[5 * 33]); o.w = pg8::cvt_pk_bf16(s[6 * 33], s[7 * 33]);
        *(u32x4*)(WT + (size_t)(drow0 + n) * K + k0 + 8 * c) = o; }
    __builtin_amdgcn_wave_barrier();
}
struct Args {
    const float* in[34]; float* out; unsigned char* ws;
    int ph_lo, ph_hi;
};

struct GF {
    const float* A; long lda; const int* arow; int arow_lim;
    const float* B; long ldb; int bmode;
    int K;
};
template <class Epi>
__device__ __forceinline__ void gemm_f32_tile(float* lds, const GF& g, int row0, int col0, Epi&& epi) {
    float* As = lds;
    float* Bs = lds + 16 * 132;
    const int tid = threadIdx.x, lane = tid & 63, w = tid >> 6, wm = w >> 1, wn = w & 1;
    f32x16 acc0, acc1;
#pragma unroll
    for (int i = 0; i < 16; ++i) { acc0[i] = 0.f; acc1[i] = 0.f; }
    const int ar = tid >> 2, ak = (tid & 3) * 4;
    long arow_idx = row0 + ar; bool avalid = true;
    if (g.arow) { const int t = g.arow[row0 + ar]; avalid = t < g.arow_lim; arow_idx = avalid ? t : 0; }
    const float* ap = g.A + arow_idx * g.lda + ak;
    const float* bp; int bk, bn;
    if (g.bmode == 0) { bk = tid >> 5; bn = (tid & 31) * 4; bp = g.B + (long)bk * g.ldb + col0 + bn; }
    else { bn = tid >> 2; bk = (tid & 3) * 4; bp = g.B + (long)(col0 + bn) * g.ldb + bk; }
    const int hl = lane >> 5, l31 = lane & 31;
    for (int k0 = 0; k0 < g.K; k0 += 16) {
        f32x4 av = (f32x4){0.f, 0.f, 0.f, 0.f};
        if (avalid) av = *(const f32x4*)(ap + k0);
        const f32x4 bv = g.bmode == 0 ? *(const f32x4*)(bp + (long)k0 * g.ldb) : *(const f32x4*)(bp + k0);
        __syncthreads();
        As[(ak + 0) * 132 + ar] = av[0]; As[(ak + 1) * 132 + ar] = av[1]; As[(ak + 2) * 132 + ar] = av[2]; As[(ak + 3) * 132 + ar] = av[3];
        if (g.bmode == 0) *(f32x4*)&Bs[bk * 132 + bn] = bv;
        else { Bs[(bk + 0) * 132 + bn] = bv[0]; Bs[(bk + 1) * 132 + bn] = bv[1]; Bs[(bk + 2) * 132 + bn] = bv[2]; Bs[(bk + 3) * 132 + bn] = bv[3]; }
        __syncthreads();
#pragma unroll
        for (int kk = 0; kk < 16; kk += 2) {
            const float a = As[(kk + hl) * 132 + wm * 32 + l31];
            const float b0 = Bs[(kk + hl) * 132 + wn * 64 + l31];
            const float b1 = Bs[(kk + hl) * 132 + wn * 64 + 32 + l31];
            acc0 = __builtin_amdgcn_mfma_f32_32x32x2f32(a, b0, acc0, 0, 0, 0);
            acc1 = __builtin_amdgcn_mfma_f32_32x32x2f32(a, b1, acc1, 0, 0, 0);
        }
    }
#pragma unroll
    for (int r = 0; r < 16; ++r) {
        const int row = row0 + wm * 32 + (r & 3) + 8 * (r >> 2) + 4 * hl;
        const int col = col0 + wn * 64 + l31;
        epi(row, col, acc0[r]);
        epi(row, col + 32, acc1[r]);
    }
    __syncthreads();
}

__device__ __forceinline__ void ln_row(const float* a, float alpha, const float* b, float* out, const float* gam, const float* bet, int lane, bf16_t* outb = nullptr) {
    f32x4 v[4]; float s = 0.f;
#pragma unroll
    for (int j = 0; j < 4; ++j) {
        v[j] = *(const f32x4*)(a + 4 * lane + 256 * j) * alpha;
        if (b) v[j] += *(const f32x4*)(b + 4 * lane + 256 * j);
        s += (v[j][0] + v[j][1]) + (v[j][2] + v[j][3]);
    }
    const float mean = wave_sum(s) * (1.f / D); float s2 = 0.f;
#pragma unroll
    for (int j = 0; j < 4; ++j) { v[j] = v[j] - mean; s2 += (v[j][0] * v[j][0] + v[j][1] * v[j][1]) + (v[j][2] * v[j][2] + v[j][3] * v[j][3]); }
    const float rstd = 1.f / sqrtf(wave_sum(s2) * (1.f / D) + LN_EPS);
#pragma unroll
    for (int j = 0; j < 4; ++j) {
        const f32x4 gg = *(const f32x4*)(gam + 4 * lane + 256 * j), bb = *(const f32x4*)(bet + 4 * lane + 256 * j);
        const f32x4 o = v[j] * rstd * gg + bb;
        *(f32x4*)(out + 4 * lane + 256 * j) = o;
        if (outb) { u32x2 w; w.x = pg8::cvt_pk_bf16(o[0], o[1]); w.y = pg8::cvt_pk_bf16(o[2], o[3]); *(u32x2*)(outb + 4 * lane + 256 * j) = w; }
    }
}

constexpr int NPHASES = 23;

__global__ void __launch_bounds__(NTHREADS, 2) mega(Args args) {
    extern __shared__ __attribute__((aligned(16))) unsigned char lds_raw[];
    float* ldsf = (float*)lds_raw;
    const int tid = threadIdx.x, lane = tid & 63, wave = tid >> 6;
    const int G = gridDim.x, bx = blockIdx.x;
    const int gw = bx * NWAVES + wave, NGW = G * NWAVES;
    unsigned char* ws = args.ws;
    unsigned* ctl = (unsigned*)(ws + WS_CTL);
    volatile LAS unsigned* misc = (volatile LAS unsigned*)((LAS unsigned char*)lds_raw + MISC_OFF);
    if (tid < 4) misc[tid] = 0u;
    __syncthreads();
    const int lo = args.ph_lo, hi = args.ph_hi;
    const bool multi = (hi - lo) > 1;
    XcdBarrier bar; bar.bar = ctl + CW_BAR; bar.x = 0; bar.st = nullptr;
    if (multi) bar = xcd_barrier_post(ctl + CW_BAR, misc);
#define IN(k) (lo <= (k) && (k) < hi)
#define SEAM(k) do { if (IN(k) && IN((k) + 1)) xcd_barrier(bar); } while (0)

    const float* x = args.in[0]; const float* mem = args.in[1]; const int* positions = (const int*)args.in[2];
    const float* w_in = args.in[3]; const float* mu_shift = args.in[4]; const float* w_decay_up = args.in[5]; const float* w0 = args.in[6];
    const float* a_up = args.in[7]; const float* a0 = args.in[8]; const float* g_up = args.in[9]; const float* k_k = args.in[10]; const float* k_a = args.in[11];
    const float* r_k = args.in[12]; const float* lnx_g = args.in[13]; const float* lnx_b = args.in[14]; const float* sinks = args.in[15];
    const float* w_o = args.in[16]; const float* ln1_g = args.in[17]; const float* ln1_b = args.in[18];
    const float* wm_q = args.in[19]; const float* wm_kv = args.in[20]; const float* wm_o = args.in[21]; const float* ln2_g = args.in[22]; const float* ln2_b = args.in[23];
    const float* w_router = args.in[24]; const float* router_bias = args.in[25];
    const float* we_gate = args.in[26]; const float* we_up = args.in[27]; const float* we_down = args.in[28];
    const float* ws_gate = args.in[29]; const float* ws_up = args.in[30]; const float* ws_down = args.in[31];
    const float* ln3_g = args.in[32]; const float* ln3_b = args.in[33];
    float* out = args.out;

    float* ROPE_C = (float*)(ws + WS_ROPE); float* ROPE_S = ROPE_C + (size_t)NTOK * 32;
    bf16_t* W_IN_T = (bf16_t*)(ws + WS_WIN); bf16_t* W_O_T = (bf16_t*)(ws + WS_WO); bf16_t* WM_Q_T = (bf16_t*)(ws + WS_WMQ); bf16_t* WM_KV_T = (bf16_t*)(ws + WS_WMKV); bf16_t* WM_O_T = (bf16_t*)(ws + WS_WMO);
    bf16_t* XB = (bf16_t*)(ws + WS_XB); bf16_t* MEMB = (bf16_t*)(ws + WS_MEMB);
    bf16_t* U = (bf16_t*)(ws + WS_U); bf16_t* LRB = (bf16_t*)(ws + WS_LRB); bf16_t* DWAG = (bf16_t*)(ws + WS_DWAG);
    float* YLOC = (float*)(ws + WS_YLOC); bf16_t* ZB = (bf16_t*)(ws + WS_ZB); bf16_t* PT = (bf16_t*)(ws + WS_PT); float* SLT = (float*)(ws + WS_SLT); bf16_t* SIN = (bf16_t*)(ws + WS_SIN);
    float* BONUS = (float*)(ws + WS_BONUS); bf16_t* WLR_T = (bf16_t*)(ws + WS_WLR); bf16_t* W_R_T = (bf16_t*)(ws + WS_WLR + MiB);
    bf16_t* MIX = (bf16_t*)(ws + WS_MIX); float* X1 = (float*)(ws + WS_X1); bf16_t* X1B = (bf16_t*)(ws + WS_X1B);
    bf16_t* QMB = (bf16_t*)(ws + WS_QM); bf16_t* KM = (bf16_t*)(ws + WS_KVM); bf16_t* VT = (bf16_t*)(ws + WS_KVM + 2 * MiB); bf16_t* OM = (bf16_t*)(ws + WS_OM);
    float* X2 = out; bf16_t* X2B = (bf16_t*)(ws + WS_X2B); float* LOG = (float*)(ws + WS_LOG);
    int* EIDX = (int*)(ws + WS_EIDX); float* GATE = (float*)(ws + WS_GATE); int* POS = (int*)(ws + WS_POS); int* YROW = (int*)(ws + WS_YROW);
    int* STOK = (int*)(ws + WS_STOK); float* SGATE = (float*)(ws + WS_SGATE);
    bf16_t* HH = (bf16_t*)(ws + WS_H); bf16_t* HS = (bf16_t*)(ws + WS_HS); bf16_t* YY = (bf16_t*)(ws + WS_Y);
    bf16_t* WS_GU_T = (bf16_t*)(ws + WS_WSGU); bf16_t* WS_D_T = (bf16_t*)(ws + WS_WSD); bf16_t* WE_GU_T = (bf16_t*)(ws + WS_WEGU); bf16_t* WE_D_T = (bf16_t*)(ws + WS_WED);
    int* TEXP = (int*)(ws + WS_TEXP);
    PG8_LAS unsigned char* ldsl = (PG8_LAS unsigned char*)lds_raw;

    if (IN(0)) {
        for (int i = bx * NTHREADS + tid; i < NTOK * 32; i += G * NTHREADS) {
            const int n = i >> 5, f = i & 31;
            const double inv = exp(-(double)(2 * f) / 64.0 * 9.210340371976184);
            const double ang = (double)positions[n] * inv;
            ROPE_C[i] = (float)cos(ang); ROPE_S[i] = (float)sin(ang);
        }
        {
            float* scr = ldsf + wave * 4096;
            constexpr int I_IN = 16 * (INCOLS / 32), I_SQ = 16 * (D / 32), I_KV = 16 * (2048 / 32);
            constexpr int I_R = 16 * (NEXP / 32); constexpr int NIT = I_IN + 3 * I_SQ + I_KV + I_R;
            for (int it = gw; it < NIT; it += NGW) {
                int r = it;
                if (r < I_IN) { const int nb = INCOLS / 32; transpose_item(w_in, D, INCOLS, W_IN_T, 64 * (r / nb), 32 * (r % nb), 32 * (r % nb), scr, lane); continue; } r -= I_IN;
                if (r < I_SQ) { const int nb = D / 32; transpose_item(w_o, D, D, W_O_T, 64 * (r / nb), 32 * (r % nb), 32 * (r % nb), scr, lane); continue; } r -= I_SQ;
                if (r < I_SQ) { const int nb = D / 32; transpose_item(wm_q, D, D, WM_Q_T, 64 * (r / nb), 32 * (r % nb), 32 * (r % nb), scr, lane); continue; } r -= I_SQ;
                if (r < I_SQ) { const int nb = D / 32; transpose_item(wm_o, D, D, WM_O_T, 64 * (r / nb), 32 * (r % nb), 32 * (r % nb), scr, lane); continue; } r -= I_SQ;
                if (r < I_KV) { const int nb = 2048 / 32; transpose_item(wm_kv, D, 2048, WM_KV_T, 64 * (r / nb), 32 * (r % nb), 32 * (r % nb), scr, lane); continue; } r -= I_KV;
                { const int nb = NEXP / 32; transpose_item(w_router, D, NEXP, W_R_T, 64 * (r / nb), 32 * (r % nb), 32 * (r % nb), scr, lane); }
            }
        }
        for (int i = bx * NTHREADS + tid; i < 1536 * 256; i += G * NTHREADS) {
            const int n = i >> 8, k = i & 255; float v = 0.f;
            if (n < 512) { if (k < 64) v = w_decay_up[k * RW + n]; }
            else if (n < 1024) { if (k >= 64 && k < 128) v = a_up[(k - 64) * RW + (n - 512)]; }
            else { if (k >= 128) v = g_up[(k - 128) * RW + (n - 1024)]; }
            WLR_T[i] = f2bf(v);
        }
        {
            float* scr = ldsf + wave * 4096;
            const int NITE = (NEXP + 1) * 384;
            for (int it = gw; it < NITE; it += NGW) {
                const int e = it / 384, r = it % 384;
                const float* wg = e < NEXP ? we_gate + (size_t)e * D * EDIM : ws_gate; const float* wu = e < NEXP ? we_up + (size_t)e * D * EDIM : ws_up;
                const float* wd = e < NEXP ? we_down + (size_t)e * EDIM * D : ws_down;
                bf16_t* gu = e < NEXP ? WE_GU_T + (size_t)e * 512 * D : WS_GU_T; bf16_t* dt = e < NEXP ? WE_D_T + (size_t)e * D * EDIM : WS_D_T;
                if (r < 256) { const int isup = r >> 7, rr = r & 127, kb = rr >> 3, nb = rr & 7, n0 = 32 * nb;
                    transpose_item(isup ? wu : wg, D, EDIM, gu, 64 * kb, n0, (n0 >> 7) * 256 + isup * 128 + (n0 & 127), scr, lane); }
                else { const int rr = r - 256, kb = rr >> 5, nb = rr & 31;
                    transpose_item(wd, EDIM, D, dt, 64 * kb, 32 * nb, 32 * nb, scr, lane); }
            }
        }
        for (size_t i = (size_t)bx * NTHREADS + tid; i < (size_t)NTOK * D / 8; i += (size_t)G * NTHREADS) {
            const f32x4 a = *(const f32x4*)(x + i * 8), b = *(const f32x4*)(x + i * 8 + 4);
            u32x4 o; o.x = pg8::cvt_pk_bf16(a[0], a[1]); o.y = pg8::cvt_pk_bf16(a[2], a[3]); o.z = pg8::cvt_pk_bf16(b[0], b[1]); o.w = pg8::cvt_pk_bf16(b[2], b[3]);
            *(u32x4*)(XB + i * 8) = o;
        }
        for (size_t i = (size_t)bx * NTHREADS + tid; i < (size_t)BATCH * MEMT * D / 8; i += (size_t)G * NTHREADS) {
            const f32x4 a = *(const f32x4*)(mem + i * 8), b = *(const f32x4*)(mem + i * 8 + 4);
            u32x4 o; o.x = pg8::cvt_pk_bf16(a[0], a[1]); o.y = pg8::cvt_pk_bf16(a[2], a[3]); o.z = pg8::cvt_pk_bf16(b[0], b[1]); o.w = pg8::cvt_pk_bf16(b[2], b[3]);
            *(u32x4*)(MEMB + i * 8) = o;
        }
    }
    SEAM(0);
    if (IN(1)) {
        pg8::DenseProb S{XB, W_IN_T, D, {}}; S.ord.init(NTOK, INCOLS, G, bx);
        pg8::EpiBf16 E{U, INCOLS};
        pg8::gemm_phase(ldsl, S, E);
    }
    SEAM(1);
    if (IN(2)) {
        for (size_t i = (size_t)bx * NTHREADS + tid; i < (size_t)NTOK * 256; i += (size_t)G * NTHREADS) {
            const int n = (int)(i >> 8), c = (int)(i & 255), col = C_WD + c;
            const float u = bf2f(U[(size_t)n * INCOLS + col]);
            const float p = (n % SEQ) ? bf2f(U[(size_t)(n - 1) * INCOLS + col]) : 0.f;
            const float v = u + (p - u) * mu_shift[col];
            LRB[i] = f2bf(c < 64 ? tanhf(v) : (c < 128 ? v : sigmoidf_(v)));
        }
    }
    SEAM(2);
    if (IN(3)) {
        pg8::DenseProb S{LRB, WLR_T, 256, {}}; S.ord.init(NTOK, 1536, G, bx);
        pg8::EpiBf16 E{DWAG, 1536};
        pg8::gemm_phase(ldsl, S, E);
    }
    SEAM(3);
    if (IN(4)) {
        const int j = lane; constexpr int TB = 2;
        float* vec = ldsf + wave * (TB * 384);
        const auto rsU = __builtin_amdgcn_make_buffer_rsrc(U, 0, (int)((size_t)NTOK * INCOLS * 2), 0x00020000);
        const auto rsD = __builtin_amdgcn_make_buffer_rsrc(DWAG, 0, (int)((size_t)NTOK * 1536 * 2), 0x00020000);
        const auto rsY = __builtin_amdgcn_make_buffer_rsrc(YLOC, 0, (int)((size_t)NTOK * RW * 4), 0x00020000);
        const auto rsZ = __builtin_amdgcn_make_buffer_rsrc(ZB, 0, (int)((size_t)NTOK * RW * 2), 0x00020000);
        for (int unit_v = gw; unit_v < BATCH * NCH * 8; unit_v += NGW) {
            const int unit = __builtin_amdgcn_readfirstlane(unit_v);
            const int b = unit / (NCH * 8), c = (unit % (NCH * 8)) >> 3, h = unit & 7, hc = h * 64 + j;
            float S0[64], S1[64];
            float one_ = 1.f; asm volatile("" : "+v"(one_));
#pragma unroll
            for (int k = 0; k < 64; ++k) { S0[k] = 0.f; S1[k] = (k == j) ? one_ : 0.f; }
            const float mur = mu_shift[C_R + hc], muk = mu_shift[C_K + hc], muv = mu_shift[C_V + hc];
            const float w0j = w0[hc], a0j = a0[hc], kkj = k_k[hc], kaj = k_a[hc], rkj = r_k[hc];
            const int nb0 = b * SEQ + c * CH;
            const int vo2 = hc * 2, vo4 = hc * 4;
            bf16_t lr[TB], lk[TB], lv[TB], ldw[TB], lda[TB];
            float pr = 0.f, pk = 0.f, pv = 0.f;
            if (c) { const int so = (nb0 - 1) * INCOLS * 2;
                pr = bf2f(__builtin_amdgcn_raw_buffer_load_b16(rsU, vo2, so + C_R * 2, 0)); pk = bf2f(__builtin_amdgcn_raw_buffer_load_b16(rsU, vo2, so + C_K * 2, 0)); pv = bf2f(__builtin_amdgcn_raw_buffer_load_b16(rsU, vo2, so + C_V * 2, 0)); }
#pragma unroll
            for (int i = 0; i < TB; ++i) { const int so = (nb0 + i) * INCOLS * 2, sd = (nb0 + i) * 1536 * 2;
                lr[i] = __builtin_amdgcn_raw_buffer_load_b16(rsU, vo2, so + C_R * 2, 0); lk[i] = __builtin_amdgcn_raw_buffer_load_b16(rsU, vo2, so + C_K * 2, 0); lv[i] = __builtin_amdgcn_raw_buffer_load_b16(rsU, vo2, so + C_V * 2, 0);
                ldw[i] = __builtin_amdgcn_raw_buffer_load_b16(rsD, vo2, sd, 0); lda[i] = __builtin_amdgcn_raw_buffer_load_b16(rsD, vo2, sd + 1024, 0); }
            for (int blk = 0; blk < CH / TB; ++blk) {
                const int n0 = nb0 + blk * TB;
#pragma unroll
                for (int i = 0; i < TB; ++i) {
                    const float r0 = bf2f(lr[i]), k0 = bf2f(lk[i]), v0 = bf2f(lv[i]);
                    const float r = r0 + (pr - r0) * mur, k = k0 + (pk - k0) * muk, vsh = v0 + (pv - v0) * muv;
                    pr = r0; pk = k0; pv = v0;
                    const float xx = -(w0j + bf2f(ldw[i]));
                    const float sp = fmaxf(xx, 0.f) + log1pf(expf(-fabsf(xx)));
                    const float wdec = expf(-expf(-sp - 0.5f));
                    const float a = sigmoidf_(a0j + bf2f(lda[i]));
                    const float kkv = k * kkj;
                    const float nrm = sqrtf(wave_sum(kkv * kkv));
                    const float kkn = kkv / fmaxf(nrm, 1e-12f);
                    const float kmod = k * (1.f + (a - 1.f) * kaj);
                    const float bonus = wave_sum(r * kmod * rkj);
                    float* vt = vec + i * 384;
                    vt[j] = wdec; vt[64 + j] = -kkn; vt[128 + j] = kkn * a; vt[192 + j] = kmod; vt[256 + j] = r; vt[320 + j] = vsh;
                    if (lane == 0) BONUS[(size_t)(n0 + i) * 8 + h] = bonus;
                }
                if (blk + 1 < CH / TB) {
#pragma unroll
                    for (int i = 0; i < TB; ++i) { const int so = (n0 + TB + i) * INCOLS * 2, sd = (n0 + TB + i) * 1536 * 2;
                        lr[i] = __builtin_amdgcn_raw_buffer_load_b16(rsU, vo2, so + C_R * 2, 0); lk[i] = __builtin_amdgcn_raw_buffer_load_b16(rsU, vo2, so + C_K * 2, 0); lv[i] = __builtin_amdgcn_raw_buffer_load_b16(rsU, vo2, so + C_V * 2, 0);
                        ldw[i] = __builtin_amdgcn_raw_buffer_load_b16(rsD, vo2, sd, 0); lda[i] = __builtin_amdgcn_raw_buffer_load_b16(rsD, vo2, sd + 1024, 0); }
                }
                __builtin_amdgcn_wave_barrier();
#pragma nounroll
                for (int tt = 0; tt < TB; ++tt) {
                    const float* vt = vec + tt * 384;
                    float sa0 = 0.f, sa1 = 0.f;
                    f32x4 aA = *(const f32x4*)&vt[64], aB;
#pragma unroll
                    for (int kq = 0; kq < 16; kq += 2) {
                        aB = *(const f32x4*)&vt[64 + 4 * (kq + 1)];
                        __builtin_amdgcn_sched_barrier(0);
#pragma unroll
                        for (int q = 0; q < 4; ++q) { sa0 = fma1(S0[4 * kq + q], aA[q], sa0); sa1 = fma1(S1[4 * kq + q], aA[q], sa1); }
                        __builtin_amdgcn_sched_barrier(0);
                        if (kq + 2 < 16) aA = *(const f32x4*)&vt[64 + 4 * (kq + 2)];
                        __builtin_amdgcn_sched_barrier(0);
#pragma unroll
                        for (int q = 0; q < 4; ++q) { sa0 = fma1(S0[4 * kq + 4 + q], aB[q], sa0); sa1 = fma1(S1[4 * kq + 4 + q], aB[q], sa1); }
                        __builtin_amdgcn_sched_barrier(0);
                    }
                    float y0 = 0.f, y1 = 0.f; const float vq = vt[320 + j];
                    f32x4 wA = *(const f32x4*)&vt[0], bA = *(const f32x4*)&vt[128], kA = *(const f32x4*)&vt[192], rA = *(const f32x4*)&vt[256], wB, bB, kB, rB;
#define P4_UPD(kq_, w_, b_, k_, r_) _Pragma("unroll") for (int q = 0; q < 4; ++q) { \
                        const float s0 = fma1(S0[4 * (kq_) + q], w_[q], fma1(sa0, b_[q], mul1(vq, k_[q]))); S0[4 * (kq_) + q] = s0; y0 = fma1(s0, r_[q], y0); \
                        const float s1 = fma1(S1[4 * (kq_) + q], w_[q], mul1(sa1, b_[q])); S1[4 * (kq_) + q] = s1; y1 = fma1(s1, r_[q], y1); }
#pragma unroll
                    for (int kq = 0; kq < 16; kq += 2) {
                        wB = *(const f32x4*)&vt[4 * (kq + 1)]; bB = *(const f32x4*)&vt[128 + 4 * (kq + 1)]; kB = *(const f32x4*)&vt[192 + 4 * (kq + 1)]; rB = *(const f32x4*)&vt[256 + 4 * (kq + 1)];
                        __builtin_amdgcn_sched_barrier(0);
                        P4_UPD(kq, wA, bA, kA, rA)
                        __builtin_amdgcn_sched_barrier(0);
                        if (kq + 2 < 16) { wA = *(const f32x4*)&vt[4 * (kq + 2)]; bA = *(const f32x4*)&vt[128 + 4 * (kq + 2)]; kA = *(const f32x4*)&vt[192 + 4 * (kq + 2)]; rA = *(const f32x4*)&vt[256 + 4 * (kq + 2)]; }
                        __builtin_amdgcn_sched_barrier(0);
                        P4_UPD(kq + 1, wB, bB, kB, rB)
                        __builtin_amdgcn_sched_barrier(0);
                    }
#undef P4_UPD
                    const int nn = __builtin_amdgcn_readfirstlane(n0 + tt);
                    __builtin_amdgcn_raw_buffer_store_b32(__builtin_bit_cast(unsigned, y0), rsY, vo4, nn * (RW * 4), 0);
                    __builtin_amdgcn_raw_buffer_store_b16(f2bf(y1), rsZ, vo2, nn * (RW * 2), 0);
                }
                __builtin_amdgcn_wave_barrier();
            }
            { const auto rsS = __builtin_amdgcn_make_buffer_rsrc(SLT, 0, BATCH * NCH * 8 * 4096 * 4, 0x00020000);
              const auto rsP = __builtin_amdgcn_make_buffer_rsrc(PT, 0, BATCH * NCH * 8 * 4096 * 2, 0x00020000);
#pragma unroll
              for (int k = 0; k < 64; ++k) { __builtin_amdgcn_raw_buffer_store_b32(__builtin_bit_cast(unsigned, S0[k]), rsS, j * 4, unit * 16384 + k * 256, 0);
                  __builtin_amdgcn_raw_buffer_store_b16(f2bf(S1[k]), rsP, j * 2, unit * 8192 + k * 128, 0); } }
        }
    }
    SEAM(4);
    if (IN(5)) {
        if (wave == 0 && bx < 128) {
            const int bh = bx >> 2, vs = bx & 3, b = bh >> 3, h = bh & 7, col = lane & 15, g = lane >> 4;
            pg8::f32x4 acc[4];
#pragma unroll
            for (int t = 0; t < 4; ++t) acc[t] = (pg8::f32x4){0.f, 0.f, 0.f, 0.f};
            u32x4 Aw[8], An[8]; pg8::f32x4 sl[4], sn[4];
#define P5_LOAD(c_, A_, s_) do { const int unit_ = (b * NCH + (c_)) * 8 + h; const bf16_t* pt_ = PT + (size_t)unit_ * 4096; const float* slp_ = SLT + (size_t)unit_ * 4096; \
                _Pragma("unroll") for (int jo = 0; jo < 4; ++jo) { \
                    _Pragma("unroll") for (int r = 0; r < 4; ++r) s_[jo][r] = slp_[(size_t)(16 * jo + 4 * g + r) * 64 + 16 * vs + col]; \
                    _Pragma("unroll") for (int sx = 0; sx < 2; ++sx) { const bf16_t* ap_ = pt_ + (size_t)(16 * jo + col) * 64 + 32 * sx + 4 * g; \
                        const u32x2 a0_ = *(const u32x2*)ap_, a1_ = *(const u32x2*)(ap_ + 16); u32x4 aw_; aw_.x = a0_.x; aw_.y = a0_.y; aw_.z = a1_.x; aw_.w = a1_.y; A_[jo * 2 + sx] = aw_; } } } while (0)
            P5_LOAD(0, Aw, sl);
            for (int c = 0; c < NCH; ++c) {
                const int unit = (b * NCH + c) * 8 + h;
                if (c + 2 < NCH) P5_LOAD(c + 1, An, sn);
                bf16_t* sdst = SIN + (size_t)unit * 4096 + (size_t)(16 * vs + col) * 64;
                unsigned pk[8];
#pragma unroll
                for (int t = 0; t < 4; ++t) { pk[2 * t] = pg8::cvt_pk_bf16(acc[t][0], acc[t][1]); pk[2 * t + 1] = pg8::cvt_pk_bf16(acc[t][2], acc[t][3]);
                    u32x2 w; w.x = pk[2 * t]; w.y = pk[2 * t + 1]; *(u32x2*)(sdst + 16 * t + 4 * g) = w; }
                if (c == NCH - 1) break;
                pg8::bf16x8 Bf[2];
#pragma unroll
                for (int s = 0; s < 2; ++s) { u32x4 w; w.x = pk[4 * s]; w.y = pk[4 * s + 1]; w.z = pk[4 * s + 2]; w.w = pk[4 * s + 3]; Bf[s] = __builtin_bit_cast(pg8::bf16x8, w); }
#pragma unroll
                for (int jo = 0; jo < 4; ++jo) {
                    pg8::f32x4 na = sl[jo];
#pragma unroll
                    for (int s = 0; s < 2; ++s) na = __builtin_amdgcn_mfma_f32_16x16x32_bf16(__builtin_bit_cast(pg8::bf16x8, Aw[jo * 2 + s]), Bf[s], na, 0, 0, 0);
                    acc[jo] = na;
                }
#pragma unroll
                for (int i = 0; i < 8; ++i) Aw[i] = An[i];
#pragma unroll
                for (int i = 0; i < 4; ++i) sl[i] = sn[i];
            }
#undef P5_LOAD
        }
    }
    SEAM(5);
    if (IN(6)) {
        const int col = lane & 31, hh = lane >> 5;
        for (int unit = gw; unit < BATCH * NCH * 8; unit += NGW) {
            const int b = unit / (NCH * 8), c = (unit % (NCH * 8)) >> 3, h = unit & 7;
            const bf16_t* sin = SIN + (size_t)unit * 4096;
            pg8::bf16x8 Bf[2][4];
#pragma unroll
            for (int ct = 0; ct < 2; ++ct)
#pragma unroll
                for (int s = 0; s < 4; ++s) Bf[ct][s] = *(const pg8::bf16x8*)(sin + (size_t)(32 * ct + col) * 64 + 16 * s + 8 * hh);
            float lg[2], lb[2], muv[2];
#pragma unroll
            for (int ct = 0; ct < 2; ++ct) { lg[ct] = lnx_g[h * 64 + 32 * ct + col]; lb[ct] = lnx_b[h * 64 + 32 * ct + col]; muv[ct] = mu_shift[C_V + h * 64 + 32 * ct + col]; }
            for (int rt = 0; rt < CH / 32; ++rt) {
                const size_t n0 = (size_t)b * SEQ + c * CH + rt * 32;
                f32x16 acc[2];
#pragma unroll
                for (int i = 0; i < 16; ++i) { acc[0][i] = 0.f; acc[1][i] = 0.f; }
#pragma unroll
                for (int s = 0; s < 4; ++s) {
                    const pg8::bf16x8 Af = *(const pg8::bf16x8*)(ZB + (n0 + col) * RW + h * 64 + 16 * s + 8 * hh);
                    acc[0] = __builtin_amdgcn_mfma_f32_32x32x16_bf16(Af, Bf[0][s], acc[0], 0, 0, 0);
                    acc[1] = __builtin_amdgcn_mfma_f32_32x32x16_bf16(Af, Bf[1][s], acc[1], 0, 0, 0);
                }
#pragma unroll
                for (int r = 0; r < 16; ++r) {
                    const int trow = (r & 3) + 8 * (r >> 2) + 4 * hh; const size_t n = n0 + trow; const int t = c * CH + rt * 32 + trow;
                    float y0 = acc[0][r] + YLOC[n * RW + h * 64 + col], y1 = acc[1][r] + YLOC[n * RW + h * 64 + 32 + col];
                    float sm = y0 + y1, sq = y0 * y0 + y1 * y1;
#pragma unroll
                    for (int o = 1; o < 32; o <<= 1) { sm += __shfl_xor(sm, o); sq += __shfl_xor(sq, o); }
                    const float mu = sm * (1.f / 64.f), var = fmaxf(sq * (1.f / 64.f) - mu * mu, 0.f), rs = 1.f / sqrtf(var + GN_EPS);
                    const float bon = BONUS[n * 8 + h];
#pragma unroll
                    for (int ct = 0; ct < 2; ++ct) {
                        const int hc = h * 64 + 32 * ct + col;
                        const float v0 = bf2f(U[n * INCOLS + C_V + hc]); const float pv = t ? bf2f(U[(n - 1) * INCOLS + C_V + hc]) : 0.f; const float vv = v0 + (pv - v0) * muv[ct];
                        const float gg = bf2f(DWAG[n * 1536 + 1024 + hc]);
                        const float yy = ct ? y1 : y0;
                        MIX[n * D + hc] = f2bf((((yy - mu) * rs) * lg[ct] + lb[ct] + bon * vv) * gg);
                    }
                }
            }
        }
    }
    SEAM(6);
    if (IN(7)) {
        const int qcol = lane & 15, g = lane >> 4;
        unsigned char* ldsK = lds_raw;
        unsigned char* ldsV = lds_raw + 32768;
        for (int unit = bx; unit < BATCH * 64 * 2; unit += G) {
            const int b = unit >> 7, blk = (unit & 127) >> 1, hk = unit & 1;
            const int s0 = blk * 128 - 128;
            __syncthreads();
            {
                const int key = tid >> 1, hf = tid & 1, s = s0 + key;
                u32x4 ko[4], vv[4];
                if (s >= 0) {
                    const size_t n = (size_t)b * SEQ + s;
                    const bf16_t* kp = U + n * INCOLS + C_KS + hk * 64 + 16 * hf;
                    const u32x4 a0 = *(const u32x4*)kp, a1 = *(const u32x4*)(kp + 8), b0 = *(const u32x4*)(kp + 32), b1 = *(const u32x4*)(kp + 40);
                    const unsigned k1w[8] = {a0.x, a0.y, a0.z, a0.w, a1.x, a1.y, a1.z, a1.w}, k2w[8] = {b0.x, b0.y, b0.z, b0.w, b1.x, b1.y, b1.z, b1.w};
                    unsigned o1[8], o2[8];
#pragma unroll
                    for (int q = 0; q < 8; ++q) {
                        const float c0 = ROPE_C[n * 32 + 16 * hf + 2 * q], c1 = ROPE_C[n * 32 + 16 * hf + 2 * q + 1], sn0 = ROPE_S[n * 32 + 16 * hf + 2 * q], sn1 = ROPE_S[n * 32 + 16 * hf + 2 * q + 1];
                        const float x1a = __builtin_bit_cast(float, k1w[q] << 16), x1b = __builtin_bit_cast(float, k1w[q] & 0xffff0000u), x2a = __builtin_bit_cast(float, k2w[q] << 16), x2b = __builtin_bit_cast(float, k2w[q] & 0xffff0000u);
                        o1[q] = pg8::cvt_pk_bf16(x1a * c0 - x2a * sn0, x1b * c1 - x2b * sn1); o2[q] = pg8::cvt_pk_bf16(x2a * c0 + x1a * sn0, x2b * c1 + x1b * sn1);
                    }
                    ko[0] = (u32x4){o1[0], o1[1], o1[2], o1[3]}; ko[1] = (u32x4){o1[4], o1[5], o1[6], o1[7]}; ko[2] = (u32x4){o2[0], o2[1], o2[2], o2[3]}; ko[3] = (u32x4){o2[4], o2[5], o2[6], o2[7]};
                    const bf16_t* vp = U + n * INCOLS + C_VS + hk * 64 + 32 * hf;
#pragma unroll
                    for (int q = 0; q < 4; ++q) vv[q] = *(const u32x4*)(vp + 8 * q);
                } else {
#pragma unroll
                    for (int q = 0; q < 4; ++q) { ko[q] = (u32x4){0u, 0u, 0u, 0u}; vv[q] = (u32x4){0u, 0u, 0u, 0u}; }
                }
                const int sw = (key >> 1) & 7;
                *(u32x4*)(ldsK + key * 128 + (((2 * hf) ^ sw) << 4)) = ko[0]; *(u32x4*)(ldsK + key * 128 + (((2 * hf + 1) ^ sw) << 4)) = ko[1];
                *(u32x4*)(ldsK + key * 128 + (((4 + 2 * hf) ^ sw) << 4)) = ko[2]; *(u32x4*)(ldsK + key * 128 + (((5 + 2 * hf) ^ sw) << 4)) = ko[3];
#pragma unroll
                for (int q = 0; q < 4; ++q)
#pragma unroll
                    for (int e2 = 0; e2 < 4; ++e2) {
                        const unsigned wv = vv[q][e2]; const int d0 = 32 * hf + 8 * q + 2 * e2;
                        *(bf16_t*)(ldsV + d0 * 512 + ((((key >> 2) ^ (2 * (d0 & 15)))) << 3) + (key & 3) * 2) = (bf16_t)(wv & 0xffffu);
                        *(bf16_t*)(ldsV + (d0 + 1) * 512 + ((((key >> 2) ^ (2 * ((d0 + 1) & 15)))) << 3) + (key & 3) * 2) = (bf16_t)(wv >> 16);
                    }
            }
            __syncthreads();
            const int i0 = 16 * wave, qi = i0 + qcol;
            const size_t nq = (size_t)b * SEQ + blk * 128 + qi;
#pragma unroll 1
            for (int gq = 0; gq < 4; ++gq) {
                const int hq = hk * 4 + gq;
                pg8::bf16x8 Qf[2];
                {
                    const bf16_t* qp = U + nq * INCOLS + C_Q + hq * 64 + 8 * g;
                    const u32x4 qa = *(const u32x4*)qp, qb = *(const u32x4*)(qp + 32);
                    const f32x4 c0 = *(const f32x4*)(ROPE_C + nq * 32 + 8 * g), c1 = *(const f32x4*)(ROPE_C + nq * 32 + 8 * g + 4), sn0 = *(const f32x4*)(ROPE_S + nq * 32 + 8 * g), sn1 = *(const f32x4*)(ROPE_S + nq * 32 + 8 * g + 4);
                    const float cc[8] = {c0[0], c0[1], c0[2], c0[3], c1[0], c1[1], c1[2], c1[3]}, ss[8] = {sn0[0], sn0[1], sn0[2], sn0[3], sn1[0], sn1[1], sn1[2], sn1[3]};
                    u32x4 w1, w2;
#pragma unroll
                    for (int q = 0; q < 4; ++q) {
                        const float x1a = __builtin_bit_cast(float, qa[q] << 16), x1b = __builtin_bit_cast(float, qa[q] & 0xffff0000u), x2a = __builtin_bit_cast(float, qb[q] << 16), x2b = __builtin_bit_cast(float, qb[q] & 0xffff0000u);
                        w1[q] = pg8::cvt_pk_bf16((x1a * cc[2 * q] - x2a * ss[2 * q]) * 0.125f, (x1b * cc[2 * q + 1] - x2b * ss[2 * q + 1]) * 0.125f);
                        w2[q] = pg8::cvt_pk_bf16((x2a * cc[2 * q] + x1a * ss[2 * q]) * 0.125f, (x2b * cc[2 * q + 1] + x1b * ss[2 * q + 1]) * 0.125f);
                    }
                    Qf[0] = __builtin_bit_cast(pg8::bf16x8, w1); Qf[1] = __builtin_bit_cast(pg8::bf16x8, w2);
                }
                const float sink = sinks[hq];
                pg8::f32x4 acc[10];
                float m = sink;
#pragma unroll
                for (int t = 0; t < 10; ++t) {
                    const int kt = wave + t, ktc = kt < 16 ? kt : 15, key = 16 * ktc + qcol, sw = (key >> 1) & 7;
                    pg8::f32x4 a = (pg8::f32x4){0.f, 0.f, 0.f, 0.f};
#pragma unroll
                    for (int ks = 0; ks < 2; ++ks) { const pg8::bf16x8 kf = *(const pg8::bf16x8*)(ldsK + key * 128 + (((4 * ks + g) ^ sw) << 4));
                        a = __builtin_amdgcn_mfma_f32_16x16x32_bf16(kf, Qf[ks], a, 0, 0, 0); }
#pragma unroll
                    for (int r = 0; r < 4; ++r) { const int kk = 16 * kt + 4 * g + r; const bool ok = (kk > qi) && (kk <= qi + 128) && (s0 + kk >= 0) && (kt < 16);
                        a[r] = ok ? a[r] : -INFINITY; m = fmaxf(m, a[r]); }
                    acc[t] = a;
                }
                m = fmaxf(m, __shfl_xor(m, 16)); m = fmaxf(m, __shfl_xor(m, 32));
                float lsum = 0.f;
#pragma unroll
                for (int t = 0; t < 10; ++t)
#pragma unroll
                    for (int r = 0; r < 4; ++r) { const float p = __expf(acc[t][r] - m); acc[t][r] = p; lsum += p; }
                lsum += __shfl_xor(lsum, 16); lsum += __shfl_xor(lsum, 32);
                lsum += __expf(sink - m);
                pg8::bf16x8 Pf[5];
#pragma unroll
                for (int ks = 0; ks < 5; ++ks) { u32x4 w; w.x = pg8::cvt_pk_bf16(acc[2 * ks][0], acc[2 * ks][1]); w.y = pg8::cvt_pk_bf16(acc[2 * ks][2], acc[2 * ks][3]);
                    w.z = pg8::cvt_pk_bf16(acc[2 * ks + 1][0], acc[2 * ks + 1][1]); w.w = pg8::cvt_pk_bf16(acc[2 * ks + 1][2], acc[2 * ks + 1][3]); Pf[ks] = __builtin_bit_cast(pg8::bf16x8, w); }
                float linv[4];
#pragma unroll
                for (int r = 0; r < 4; ++r) linv[r] = 1.f / __shfl(lsum, 4 * g + r);
#pragma unroll
                for (int dt = 0; dt < 4; ++dt) {
                    pg8::f32x4 o = (pg8::f32x4){0.f, 0.f, 0.f, 0.f};
                    const int dd = 16 * dt + qcol;
#pragma unroll
                    for (int ks = 0; ks < 5; ++ks) {
                        const int ka = wave + 2 * ks, kb = ka + 1, kac = ka < 16 ? ka : 15, kbc = kb < 16 ? kb : 15;
                        const u32x2 v0 = *(const u32x2*)(ldsV + dd * 512 + (((4 * kac + g) ^ (2 * (dd & 15))) << 3));
                        const u32x2 v1 = *(const u32x2*)(ldsV + dd * 512 + (((4 * kbc + g) ^ (2 * (dd & 15))) << 3));
                        u32x4 w; w.x = v0.x; w.y = v0.y; w.z = v1.x; w.w = v1.y;
                        o = __builtin_amdgcn_mfma_f32_16x16x32_bf16(Pf[ks], __builtin_bit_cast(pg8::bf16x8, w), o, 0, 0, 0);
                    }
#pragma unroll
                    for (int r = 0; r < 4; ++r) MIX[((size_t)b * SEQ + blk * 128 + i0 + 4 * g + r) * D + RW + hq * 64 + dd] = f2bf(o[r] * linv[r]);
                }
            }
        }
    }
    SEAM(7);
    if (IN(8)) {
        pg8::DenseProb S{MIX, W_O_T, D, {}}; S.ord.init(NTOK, D, G, bx);
        pg8::EpiF32Res E{X1, D, x, ALPHA};
        pg8::gemm_phase(ldsl, S, E);
    }
    SEAM(8);
    if (IN(9)) { for (int n = gw; n < NTOK; n += NGW) ln_row(X1 + (size_t)n * D, 1.f, nullptr, X1 + (size_t)n * D, ln1_g, ln1_b, lane, X1B + (size_t)n * D); }
    SEAM(9);
    if (IN(10)) {
        { pg8::DenseProb S{X1B, WM_Q_T, D, {}}; S.ord.init(NTOK, D, G, bx); pg8::EpiBf16 E{QMB, D}; pg8::gemm_phase(ldsl, S, E); }
        { pg8::DenseProb S{MEMB, WM_KV_T, D, {}}; S.ord.init(BATCH * MEMT, D, G, bx); pg8::EpiBf16 E{KM, D}; pg8::gemm_phase(ldsl, S, E); }
        { pg8::DenseProb S{WM_KV_T + (size_t)D * D, MEMB, D, {}}; S.ord.init(D, BATCH * MEMT, G, bx); pg8::EpiBf16 E{VT, BATCH * MEMT}; pg8::gemm_phase(ldsl, S, E); }
    }
    SEAM(10);
    if (IN(11)) {
        const int qcol = lane & 15, g = lane >> 4;
        unsigned char* ldsb = lds_raw;
        for (int unit = bx; unit < BATCH * 4 * (SEQ / 128); unit += G) {
            const int b = unit / (4 * (SEQ / 128)), h = (unit / (SEQ / 128)) & 3, qt = unit % (SEQ / 128);
            const size_t q0 = (size_t)b * SEQ + qt * 128 + wave * 16;
            pg8::bf16x8 Qf[8];
#pragma unroll
            for (int ks = 0; ks < 8; ++ks) Qf[ks] = *(const pg8::bf16x8*)(QMB + (q0 + qcol) * D + h * 256 + 32 * ks + 8 * g);
            __syncthreads();
#pragma unroll 4
            for (int i = 0; i < 16; ++i) { const int p = tid + NTHREADS * i, row = p >> 5, ch = p & 31;
                const u32x4 v = *(const u32x4*)(KM + (size_t)(b * MEMT + row) * D + h * 256 + ch * 8);
                *(u32x4*)(ldsb + row * 512 + ((ch ^ (row & 15)) << 4)) = v; }
            __syncthreads();
            pg8::f32x4 acc[16];
#pragma unroll
            for (int kt = 0; kt < 16; ++kt) { acc[kt] = (pg8::f32x4){0.f, 0.f, 0.f, 0.f};
                const int key = 16 * kt + qcol;
#pragma unroll
                for (int ks = 0; ks < 8; ++ks) { const pg8::bf16x8 a = *(const pg8::bf16x8*)(ldsb + key * 512 + (((4 * ks + g) ^ (key & 15)) << 4));
                    acc[kt] = __builtin_amdgcn_mfma_f32_16x16x32_bf16(a, Qf[ks], acc[kt], 0, 0, 0); } }
            float m = -INFINITY;
#pragma unroll
            for (int kt = 0; kt < 16; ++kt)
#pragma unroll
                for (int r = 0; r < 4; ++r) m = fmaxf(m, acc[kt][r]);
            m = fmaxf(m, __shfl_xor(m, 16)); m = fmaxf(m, __shfl_xor(m, 32));
            float lsum = 0.f;
#pragma unroll
            for (int kt = 0; kt < 16; ++kt)
#pragma unroll
                for (int r = 0; r < 4; ++r) { const float p = __expf((acc[kt][r] - m) * 0.0625f); acc[kt][r] = p; lsum += p; }
            lsum += __shfl_xor(lsum, 16); lsum += __shfl_xor(lsum, 32);
            pg8::bf16x8 Pf[8];
#pragma unroll
            for (int ks = 0; ks < 8; ++ks) { u32x4 w; w.x = pg8::cvt_pk_bf16(acc[2 * ks][0], acc[2 * ks][1]); w.y = pg8::cvt_pk_bf16(acc[2 * ks][2], acc[2 * ks][3]);
                w.z = pg8::cvt_pk_bf16(acc[2 * ks + 1][0], acc[2 * ks + 1][1]); w.w = pg8::cvt_pk_bf16(acc[2 * ks + 1][2], acc[2 * ks + 1][3]); Pf[ks] = __builtin_bit_cast(pg8::bf16x8, w); }
            __syncthreads();
#pragma unroll 4
            for (int i = 0; i < 16; ++i) { const int p = tid + NTHREADS * i, row = p >> 5, ch = p & 31;
                const u32x4 v = *(const u32x4*)(VT + (size_t)(h * 256 + row) * (BATCH * MEMT) + b * MEMT + ch * 8);
                *(u32x4*)(ldsb + row * 512 + ((ch ^ (row & 15)) << 4)) = v; }
            __syncthreads();
            float linv[4];
#pragma unroll
            for (int r = 0; r < 4; ++r) linv[r] = 1.f / __shfl(lsum, 4 * g + r);
#pragma unroll
            for (int dt = 0; dt < 16; ++dt) {
                pg8::f32x4 o = (pg8::f32x4){0.f, 0.f, 0.f, 0.f};
                const int dd = 16 * dt + qcol;
#pragma unroll
                for (int ks = 0; ks < 8; ++ks) {
                    const int c8 = 8 * ks + g;
                    const u32x2 v0 = *(const u32x2*)(ldsb + dd * 512 + ((c8 ^ (2 * (dd & 15))) << 3));
                    const u32x2 v1 = *(const u32x2*)(ldsb + dd * 512 + (((c8 + 4) ^ (2 * (dd & 15))) << 3));
                    u32x4 w; w.x = v0.x; w.y = v0.y; w.z = v1.x; w.w = v1.y;
                    o = __builtin_amdgcn_mfma_f32_16x16x32_bf16(Pf[ks], __builtin_bit_cast(pg8::bf16x8, w), o, 0, 0, 0);
                }
#pragma unroll
                for (int r = 0; r < 4; ++r) OM[(q0 + 4 * g + r) * D + h * 256 + dd] = f2bf(o[r] * linv[r]);
            }
        }
    }
    SEAM(11);
    if (IN(14)) {
        pg8::DenseProb S{OM, WM_O_T, D, {}}; S.ord.init(NTOK, D, G, bx);
        pg8::EpiF32Res E{X2, D, X1, ALPHA};
        pg8::gemm_phase(ldsl, S, E);
    }
    SEAM(14);
    if (IN(15)) {
        for (int n = gw; n < NTOK; n += NGW) ln_row(X2 + (size_t)n * D, 1.f, nullptr, X2 + (size_t)n * D, ln2_g, ln2_b, lane, X2B + (size_t)n * D);
        if (bx == 0 && tid < 128) *(u32x4*)(X2B + (size_t)NTOK * D + tid * 8) = (u32x4){0u, 0u, 0u, 0u};
    }
    SEAM(15);
    if (IN(16)) {
        pg8::DenseProb S{X2B, W_R_T, D, {}}; S.ord.init(NTOK, NEXP, G, bx);
        pg8::EpiF32Res E{LOG, NEXP, nullptr, 0.f};
        pg8::gemm_phase(ldsl, S, E);
    }
    SEAM(16);
    if (IN(17)) {
        const int hl = lane >> 5;
        for (int i = bx * NTHREADS + tid; i < PMAX; i += G * NTHREADS) { STOK[i] = NTOK; SGATE[i] = 0.f; }
        for (int n = gw; n < NTOK; n += NGW) {
            float sc[4], bi[4], gso[4];
#pragma unroll
            for (int j = 0; j < 4; ++j) { const int e = lane + 64 * j; sc[j] = sigmoidf_(LOG[(size_t)n * NEXP + e]); bi[j] = sc[j] + router_bias[e]; }
#pragma unroll
            for (int j = 0; j < 4; ++j) {
                float m1 = bi[j], m2 = -INFINITY;
#pragma unroll
                for (int o = 1; o < 32; o <<= 1) { const float o1 = __shfl_xor(m1, o), o2 = __shfl_xor(m2, o);
                    const float n1 = fmaxf(m1, o1), n2 = fmaxf(fminf(m1, o1), fmaxf(m2, o2)); m1 = n1; m2 = n2; }
                gso[j] = m1 + m2;
            }
            float g8[8];
#pragma unroll
            for (int j = 0; j < 4; ++j) { const float oth = __shfl_xor(gso[j], 32); g8[2 * j] = hl ? oth : gso[j]; g8[2 * j + 1] = hl ? gso[j] : oth; }
            bool gsel[8];
#pragma unroll
            for (int a = 0; a < 8; ++a) { int rank = 0;
#pragma unroll
                for (int c = 0; c < 8; ++c) rank += ((g8[c] > g8[a]) || (g8[c] == g8[a] && c < a)) ? 1 : 0;
                gsel[a] = rank < 4; }
            float cand[4];
#pragma unroll
            for (int j = 0; j < 4; ++j) { const bool s = hl ? gsel[2 * j + 1] : gsel[2 * j]; cand[j] = s ? bi[j] : -1e30f; }
            int eidx[8]; float sel[8]; float ssum = 0.f;
#pragma unroll
            for (int k = 0; k < 8; ++k) {
                float bv = cand[0]; int be = lane;
#pragma unroll
                for (int j = 1; j < 4; ++j) if (cand[j] > bv) { bv = cand[j]; be = lane + 64 * j; }
#pragma unroll
                for (int o = 1; o < 64; o <<= 1) { const float ov = __shfl_xor(bv, o); const int oe = __shfl_xor(be, o);
                    if (ov > bv || (ov == bv && oe < be)) { bv = ov; be = oe; } }
                eidx[k] = be;
                const int jw = be >> 6, lw = be & 63;
                const float mys = jw == 0 ? sc[0] : (jw == 1 ? sc[1] : (jw == 2 ? sc[2] : sc[3]));
                sel[k] = __shfl(mys, lw); ssum += sel[k];
#pragma unroll
                for (int j = 0; j < 4; ++j) if (lane == lw && j == jw) cand[j] = -INFINITY;
            }
#pragma unroll
            for (int k = 0; k < 8; ++k) {
                if (lane == k) {
                    const int e = eidx[k];
                    const int pos = (int)atomicAdd(&ctl[CW_CNT + e], 1u);
                    EIDX[n * 8 + k] = e; GATE[n * 8 + k] = sel[k] / ssum * 2.5f; POS[n * 8 + k] = pos;
                }
            }
        }
    }
    SEAM(17);
    if (IN(19)) {
        int* soff = (int*)ldsf;
        __syncthreads();
        if (tid < NEXP) soff[1024 + tid] = (int)ctl[CW_CNT + tid];
        __syncthreads();
        if (tid == 0) { int acc = 0, cacc = 0; for (int e = 0; e < NEXP; ++e) { soff[e] = acc; soff[512 + e] = cacc; const int c = soff[1024 + e]; acc += ((c + MOE_TR - 1) / MOE_TR) * MOE_TR; cacc += c; } soff[NEXP] = acc; }
        __syncthreads();
        if (bx == 0) {
            if (tid <= NEXP) ctl[CW_OFF + tid] = (unsigned)soff[tid];
            if (tid < NEXP) ctl[CW_CST + tid] = (unsigned)soff[512 + tid];
            if (tid == 0) ctl[CW_NT] = (unsigned)(soff[NEXP] / MOE_TR);
            if (tid < NEXP) { for (int t = soff[tid] / MOE_TR; t < soff[tid + 1] / MOE_TR; ++t) TEXP[t] = tid; }
        }
        for (int i = bx * NTHREADS + tid; i < NK; i += G * NTHREADS) {
            const int e = EIDX[i], p = soff[e] + POS[i];
            STOK[p] = i >> 3; YROW[i] = soff[512 + e] + POS[i];
        }
    }
    SEAM(19);
    if (IN(20)) {
        const int ntm = (int)ctl[CW_NT];
        { pg8::GatherProb S{X2B, STOK, WE_GU_T, TEXP, D, 2, ntm * 2, G, bx, (size_t)512 * D * 2}; pg8::EpiSwiGLU E{HH, EDIM}; pg8::gemm_phase(ldsl, S, E); }
        { pg8::DenseProb S{X2B, WS_GU_T, D, {}}; S.ord.init(NTOK, 512, G, bx); pg8::EpiSwiGLU E{HS, EDIM}; pg8::gemm_phase(ldsl, S, E); }
    }
    SEAM(20);
    if (IN(21)) {
        const int ntm = (int)ctl[CW_NT];
        { pg8::GroupedProb S{HH, WE_D_T, TEXP, EDIM, 4, ntm * 4, G, bx, (size_t)D * EDIM * 2}; pg8::EpiScaleY E{YY, SGATE, ctl + CW_OFF, ctl + CW_CNT, ctl + CW_CST}; pg8::gemm_phase(ldsl, S, E); }
        { pg8::DenseProb S{HS, WS_D_T, EDIM, {}}; S.ord.init(NTOK, D, G, bx); pg8::EpiF32Res E{out, D, X2, ALPHA}; pg8::gemm_phase(ldsl, S, E); }
    }
    SEAM(21);
    if (IN(22)) {
        for (int n = gw; n < NTOK; n += NGW) {
            float v[16];
            float* orow = out + (size_t)n * D;
#pragma unroll
            for (int j = 0; j < 2; ++j) { const f32x4 a = *(const f32x4*)(orow + 512 * j + 8 * lane), b = *(const f32x4*)(orow + 512 * j + 8 * lane + 4);
#pragma unroll
                for (int q = 0; q < 4; ++q) { v[8 * j + q] = a[q]; v[8 * j + 4 + q] = b[q]; } }
            int yr[8]; float gk[8];
#pragma unroll
            for (int k = 0; k < 8; ++k) { yr[k] = YROW[n * 8 + k]; gk[k] = GATE[n * 8 + k]; }
#pragma unroll
            for (int k = 0; k < 8; ++k) {
                const bf16_t* yrow = YY + (size_t)yr[k] * D;
#pragma unroll
                for (int j = 0; j < 2; ++j) { const u32x4 w = *(const u32x4*)(yrow + 512 * j + 8 * lane);
#pragma unroll
                    for (int q = 0; q < 4; ++q) { v[8 * j + 2 * q] += gk[k] * __builtin_bit_cast(float, w[q] << 16); v[8 * j + 2 * q + 1] += gk[k] * __builtin_bit_cast(float, w[q] & 0xffff0000u); } }
            }
            float s = 0.f;
#pragma unroll
            for (int i = 0; i < 16; ++i) s += v[i];
            const float mean = wave_sum(s) * (1.f / D); float s2 = 0.f;
#pragma unroll
            for (int i = 0; i < 16; ++i) { v[i] -= mean; s2 += v[i] * v[i]; }
            const float rstd = 1.f / sqrtf(wave_sum(s2) * (1.f / D) + LN_EPS);
#pragma unroll
            for (int j = 0; j < 2; ++j) {
                const f32x4 g0 = *(const f32x4*)(ln3_g + 512 * j + 8 * lane), g1 = *(const f32x4*)(ln3_g + 512 * j + 8 * lane + 4);
                const f32x4 b0 = *(const f32x4*)(ln3_b + 512 * j + 8 * lane), b1 = *(const f32x4*)(ln3_b + 512 * j + 8 * lane + 4);
                f32x4 o0, o1;
#pragma unroll
                for (int q = 0; q < 4; ++q) { o0[q] = v[8 * j + q] * rstd * g0[q] + b0[q]; o1[q] = v[8 * j + 4 + q] * rstd * g1[q] + b1[q]; }
                *(f32x4*)(orow + 512 * j + 8 * lane) = o0; *(f32x4*)(orow + 512 * j + 8 * lane + 4) = o1;
            }
        }
    }
#undef IN
#undef SEAM
}

#ifndef PHASE_MASK
#define PHASE_MASK 0x7FFFFFu
#endif
#ifndef ONE_LAUNCH
#define ONE_LAUNCH 1
#endif

extern "C" void kernel_launch(void* const* d_in, const int* in_sizes, int n_in, void* d_out, int out_size, void* d_ws, size_t ws_size, hipStream_t stream) {
    static int grid = 0;
    if (grid == 0) {
        if (n_in != 34 || out_size != NTOK * D || ws_size < WS_END) { fprintf(stderr, "kernel_launch: unexpected shapes (n_in %d out %d ws %zu)\n", n_in, out_size, ws_size); grid = -1; return; }
        int dev = 0, cus = 0;
        if (hipGetDevice(&dev) != hipSuccess || hipDeviceGetAttribute(&cus, hipDeviceAttributeMultiprocessorCount, dev) != hipSuccess) { grid = -1; return; }
        if (hipFuncSetAttribute((const void*)mega, hipFuncAttributeMaxDynamicSharedMemorySize, LDS_BYTES) != hipSuccess) { fprintf(stderr, "kernel_launch: hipFuncSetAttribute failed\n"); grid = -1; return; }
        (void)hipGetLastError();
        grid = cus;
    }
    if (grid < 0) return;
    (void)hipMemsetAsync((char*)d_ws + WS_CTL, 0, CTL_ZERO_BYTES, stream);
    Args a{};
    for (int i = 0; i < 34; ++i) a.in[i] = (const float*)d_in[i];
    a.out = (float*)d_out; a.ws = (unsigned char*)d_ws;
#if ONE_LAUNCH
    a.ph_lo = 0; a.ph_hi = NPHASES;
    hipLaunchKernelGGL(mega, dim3(grid), dim3(NTHREADS), LDS_BYTES, stream, a);
#else
    for (int p = 0; p < NPHASES; ++p) { if (!((PHASE_MASK >> p) & 1)) continue; a.ph_lo = p; a.ph_hi = p + 1; hipLaunchKernelGGL(mega, dim3(grid), dim3(NTHREADS), LDS_BYTES, stream, a); }
#endif
}
```

```cpp
#include <hip/hip_runtime.h>
#include <cstdio>
#include <cstdint>

constexpr int D = 1024, BATCH = 4, SEQ = 8192, NTOK = BATCH * SEQ;
constexpr int MEMT = 256;
constexpr int RW = 512, RCOLS = 1792, INCOLS = 2560;
constexpr int C_R = 0, C_K = 512, C_V = 1024, C_WD = 1536, C_AD = 1600, C_GD = 1664, C_Q = 1792, C_KS = 2304, C_VS = 2432;
constexpr int NEXP = 256, TOPK = 8, EDIM = 256;
constexpr int NK = NTOK * TOPK;
constexpr int CH = 128, NCH = SEQ / CH;
constexpr int MOE_TR = 256;
constexpr int PMAX = NK + NEXP * MOE_TR;
constexpr float LN_EPS = 1e-5f, GN_EPS = 64e-5f;
constexpr float ALPHA = 1.189207115002721f;

constexpr size_t MiB = 1u << 20;
constexpr size_t WS_CTL = 0, CTL_ZERO_BYTES = 64 * 1024;
constexpr size_t WS_TEXP = 512 * 1024;
constexpr size_t WS_ROPE = 1 * MiB;
constexpr size_t WS_EIDX = 9 * MiB, WS_GATE = 10 * MiB, WS_POS = 11 * MiB, WS_YROW = 12 * MiB;
constexpr size_t WS_STOK = 13 * MiB, WS_SGATE = 14 * MiB + 512 * 1024;
constexpr size_t WS_WIN = 16 * MiB, WS_WO = 21 * MiB, WS_WMQ = 23 * MiB, WS_WMKV = 25 * MiB, WS_WMO = 29 * MiB, WS_WSGU = 31 * MiB, WS_WSD = 32 * MiB;
constexpr size_t WS_MEMB = 36 * MiB;
constexpr size_t WS_WED = 40 * MiB;
constexpr size_t WS_WEGU = 168 * MiB;
constexpr size_t WS_XB = 424 * MiB;
constexpr size_t WS_U = 490 * MiB;
constexpr size_t WS_LRB = 650 * MiB;
constexpr size_t WS_DWAG = 666 * MiB;
constexpr size_t WS_YLOC = 762 * MiB;
constexpr size_t WS_ZB = 826 * MiB;
constexpr size_t WS_PT = 858 * MiB;
constexpr size_t WS_SLT = 424 * MiB;
constexpr size_t WS_SIN = 456 * MiB;
constexpr size_t WS_BONUS = 472 * MiB;
constexpr size_t WS_WLR = 33 * MiB;
constexpr size_t WS_MIX = 874 * MiB;
constexpr size_t WS_X1 = 424 * MiB;
constexpr size_t WS_X1B = 552 * MiB;
constexpr size_t WS_QM = 616 * MiB;
constexpr size_t WS_KVM = 744 * MiB;
constexpr size_t WS_SC = 752 * MiB;
constexpr size_t WS_OM = 880 * MiB;
constexpr size_t WS_X2B = 680 * MiB;
constexpr size_t WS_LOG = 490 * MiB;
constexpr size_t WS_H = 768 * MiB;
constexpr size_t WS_HS = 928 * MiB;
constexpr size_t WS_Y = 168 * MiB;
constexpr size_t WS_END = 944 * MiB;
constexpr int CW_CNT = 0, CW_OFF = 512, CW_NT = 1024, CW_CST = 1280, CW_BAR = 4096;

constexpr int NTHREADS = 512, NWAVES = 8;
constexpr int LDS_BYTES = 147456;
constexpr int MISC_OFF = 140 * 1024;

#define LAS __attribute__((address_space(3)))
typedef float f32x4 __attribute__((ext_vector_type(4)));
typedef float f32x16 __attribute__((ext_vector_type(16)));

#define XB_TMO      128
#define XB_XCNT(j)  (256  + 64 * (j))
#define XB_XSUB(j)  (1280 + 64 * (j))
#define XB_XGEN(j)  (2304 + 64 * (j))
#define XB_TOP      3328
#define XB_TOPGEN   3392
#define XCD_BAR_WORDS 3456
#define XB_SPIN_CAP (1u << 18)
__device__ __forceinline__ unsigned xb_ld(unsigned* p)              { return __hip_atomic_load(p, __ATOMIC_RELAXED, __HIP_MEMORY_SCOPE_AGENT); }
__device__ __forceinline__ unsigned xb_add(unsigned* p, unsigned v) { return __hip_atomic_fetch_add(p, v, __ATOMIC_RELAXED, __HIP_MEMORY_SCOPE_AGENT); }
__device__ __forceinline__ unsigned xb_xcc_id() { return (unsigned)__builtin_amdgcn_s_getreg((3 << 11) | 20) & 0xFu; }
#define XB_SPIN(cond, bar) do { unsigned _sp = 0; while (cond) { __builtin_amdgcn_s_sleep(1); \
    if ((++_sp & 255u) == 0u) { if (xb_ld(&(bar)[XB_TMO])) break; if (_sp > XB_SPIN_CAP) { atomicAdd(&(bar)[XB_TMO], 1u); break; } } } } while (0)
struct XcdBarrier { unsigned* bar; unsigned x; volatile LAS unsigned* st; };
__device__ __forceinline__ XcdBarrier xcd_barrier_post(unsigned* bar, volatile LAS unsigned* st) {
    XcdBarrier b; b.bar = bar; b.x = xb_xcc_id(); b.st = st;
    if (threadIdx.x == 0) (void)xb_add(&bar[XB_XCNT(b.x)], 1u);
    return b;
}
__device__ __forceinline__ void xcd_barrier_complete(unsigned* bar, unsigned x, unsigned& nloc, unsigned& nx) {
    const unsigned G = gridDim.x * gridDim.y * gridDim.z;
    unsigned sum, cnt, mine, sp = 0u;
    for (;;) {
        sum = 0u; cnt = 0u; mine = 0u;
#pragma unroll
        for (unsigned j = 0; j < 16; ++j) { const unsigned c = xb_ld(&bar[XB_XCNT(j)]); sum += c; cnt += (c > 0u) ? 1u : 0u; mine = (j == x) ? c : mine; }
        if (sum == G) break;
        __builtin_amdgcn_s_sleep(1);
        if ((++sp & 255u) == 0u) { if (xb_ld(&bar[XB_TMO])) break; if (sp > XB_SPIN_CAP) { atomicAdd(&bar[XB_TMO], 1u); break; } }
    }
    nloc = mine > 0u ? mine : 1u; nx = cnt > 0u ? cnt : 1u;
}
__device__ __forceinline__ void xcd_barrier(const XcdBarrier& b) {
    asm volatile("s_waitcnt vmcnt(0)" ::: "memory");
    __syncthreads();
    if (threadIdx.x == 0) {
        unsigned* bar = b.bar;
        __builtin_amdgcn_s_waitcnt(0);
        unsigned nloc = b.st[0], nx = b.st[1];
        if (nloc == 0u) { xcd_barrier_complete(bar, b.x, nloc, nx); b.st[0] = nloc; b.st[1] = nx; }
        const unsigned old = xb_add(&bar[XB_XSUB(b.x)], 1u);
        const unsigned gen = old / nloc;
        if (old + 1u == (gen + 1u) * nloc) {
            __builtin_amdgcn_fence(__ATOMIC_RELEASE, "agent");
            asm volatile("s_waitcnt vmcnt(0)" ::: "memory");
            const unsigned og = xb_add(&bar[XB_TOP], 1u);
            const unsigned tg = og / nx;
            if (og + 1u == (tg + 1u) * nx) xb_add(&bar[XB_TOPGEN], 1u);
            else XB_SPIN(xb_ld(&bar[XB_TOPGEN]) == tg, bar);
            __builtin_amdgcn_fence(__ATOMIC_ACQUIRE, "agent");
            xb_add(&bar[XB_XGEN(b.x)], 1u);
            asm volatile("s_waitcnt vmcnt(0)" ::: "memory");
        } else {
            XB_SPIN(xb_ld(&bar[XB_XGEN(b.x)]) == gen, bar);
            __builtin_amdgcn_fence(__ATOMIC_ACQUIRE, "agent");
            asm volatile("s_waitcnt vmcnt(0)" ::: "memory");
        }
    }
    __syncthreads();
}

namespace pg8 {
#define PG8_LAS __attribute__((address_space(3)))
typedef unsigned short bf16_t;
typedef short bf16x8 __attribute__((ext_vector_type(8)));
typedef float f32x4 __attribute__((ext_vector_type(4)));
typedef float f32x2 __attribute__((ext_vector_type(2)));
typedef unsigned u32x4 __attribute__((ext_vector_type(4)));
constexpr int BM = 256, BK = 64, HALF = 128, HTB = HALF * BK * 2, STAGE_BYTES = 8 * HTB, NXCD = 8, WGM = 8;
__host__ __device__ __forceinline__ int lds_byte(int r, int c) { const int st = (r >> 4) * 2 + (c >> 5), rr = r & 15, cc = c & 31, ob = rr * 64 + cc * 2; return st * 1024 + (ob ^ (((ob >> 9) & 1) << 5)); }
__host__ __device__ __forceinline__ void stage_rc(int b, int& R, int& C) { const int st = b / 1024, sb = b % 1024, swz = sb ^ (((sb >> 9) & 1) << 5); R = (st >> 1) * 16 + swz / 64; C = (st & 1) * 32 + (swz % 64) / 2; }
__host__ __device__ __forceinline__ int perm32(int rho) { const int n = rho >> 4, i = rho & 15; return 8 * (i >> 2) + 4 * n + (i & 3); }
__device__ __forceinline__ unsigned cvt_pk_bf16(float lo, float hi) { unsigned r; asm volatile("v_cvt_pk_bf16_f32 %0, %1, %2" : "=v"(r) : "v"(lo), "v"(hi)); return r; }

struct Unit { int pm, pn, e; };
struct StaticOrder {
    int nM, nN, nwg, G, c;
    __host__ __device__ void init(int M, int N, int G_, int c_) { nM = M / BM; nN = N / BM; nwg = nM * nN; G = G_; c = c_; }
    __host__ __device__ bool next(int i, Unit& u) const {
        const long L = (long)i * G + c; if (L >= nwg) return false;
        int wgid = (int)L; { const int q = nwg / NXCD, r = nwg % NXCD, xcd = wgid % NXCD, off = wgid / NXCD; wgid = (xcd < r ? xcd * (q + 1) : r * (q + 1) + (xcd - r) * q) + off; }
        const int nig = WGM * nN, gid = wgid / nig, fm = gid * WGM, gsz = (nM - fm) < WGM ? (nM - fm) : WGM;
        u.pm = fm + ((wgid % nig) % gsz); u.pn = (wgid % nig) / gsz; u.e = 0; return true;
    }
};
struct DenseProb {
    const bf16_t* A; const bf16_t* Bt; int K; StaticOrder ord;
    __device__ __forceinline__ bool next(int i, Unit& u) const { return ord.next(i, u); }
    __device__ __forceinline__ const char* a_base(const Unit& u) const { return (const char*)A + (size_t)u.pm * BM * K * 2; }
    __device__ __forceinline__ const char* b_base(const Unit& u) const { return (const char*)Bt + (size_t)u.pn * BM * K * 2; }
    __device__ __forceinline__ void a_offs(const Unit&, unsigned (&v)[2][2], const int (&R)[2], const int (&C)[2]) const {
#pragma unroll
        for (int h = 0; h < 2; ++h)
#pragma unroll
            for (int i = 0; i < 2; ++i) v[h][i] = (unsigned)((h * HALF + R[i]) * K + C[i]) * 2u;
    }
};
struct GatherProb {
    const bf16_t* X; const int* stok; const bf16_t* Bt; const int* texp; int K, nN, nunits, G, c; size_t estride;
    __device__ __forceinline__ bool next(int i, Unit& u) const {
        const int per = (nunits + G - 1) / G; const long L = (long)c * per + i; if (i >= per || L >= nunits) return false;
        u.pm = (int)(L / nN); u.pn = (int)(L % nN); u.e = texp[u.pm]; return true;
    }
    __device__ __forceinline__ const char* a_base(const Unit&) const { return (const char*)X; }
    __device__ __forceinline__ const char* b_base(const Unit& u) const { return (const char*)Bt + (size_t)u.e * estride + (size_t)u.pn * BM * K * 2; }
    __device__ __forceinline__ void a_offs(const Unit& u, unsigned (&v)[2][2], const int (&R)[2], const int (&C)[2]) const {
#pragma unroll
        for (int h = 0; h < 2; ++h)
#pragma unroll
            for (int i = 0; i < 2; ++i) { const int tok = stok[u.pm * BM + h * HALF + R[i]]; v[h][i] = (unsigned)(tok * K + C[i]) * 2u; }
    }
};
struct GroupedProb {
    const bf16_t* A; const bf16_t* Bt; const int* texp; int K, nN, nunits, G, c; size_t estride;
    __device__ __forceinline__ bool next(int i, Unit& u) const {
        const int per = (nunits + G - 1) / G; const long L = (long)c * per + i; if (i >= per || L >= nunits) return false;
        u.pm = (int)(L / nN); u.pn = (int)(L % nN); u.e = texp[u.pm]; return true;
    }
    __device__ __forceinline__ const char* a_base(const Unit& u) const { return (const char*)A + (size_t)u.pm * BM * K * 2; }
    __device__ __forceinline__ const char* b_base(const Unit& u) const { return (const char*)Bt + (size_t)u.e * estride + (size_t)u.pn * BM * K * 2; }
    __device__ __forceinline__ void a_offs(const Unit&, unsigned (&v)[2][2], const int (&R)[2], const int (&C)[2]) const {
#pragma unroll
        for (int h = 0; h < 2; ++h)
#pragma unroll
            for (int i = 0; i < 2; ++i) v[h][i] = (unsigned)((h * HALF + R[i]) * K + C[i]) * 2u;
    }
};

struct EpiBf16 {
    static constexpr bool PERM = true;
    bf16_t* O; int ldc;
    __device__ __forceinline__ void operator()(const f32x4 (&acc)[2][2][4][2], const Unit& u, int wr, int wc, int fr, int fq) const {
        const int row0 = u.pm * BM + wr * 64 + fr, col0 = u.pn * BM + wc * 32 + 8 * fq;
#pragma unroll
        for (int ai = 0; ai < 2; ++ai)
#pragma unroll
            for (int m = 0; m < 4; ++m) { bf16_t* rowp = O + (size_t)(row0 + ai * HALF + m * 16) * ldc + col0;
#pragma unroll
                for (int bj = 0; bj < 2; ++bj) { const f32x4 v0 = acc[ai][bj][m][0], v1 = acc[ai][bj][m][1];
                    u32x4 w; w.x = cvt_pk_bf16(v0[0], v0[1]); w.y = cvt_pk_bf16(v0[2], v0[3]); w.z = cvt_pk_bf16(v1[0], v1[1]); w.w = cvt_pk_bf16(v1[2], v1[3]);
                    *(u32x4*)(rowp + bj * HALF) = w; } }
    }
};
struct EpiF32Res {
    static constexpr bool PERM = false;
    float* C; int ldc; const float* base; float alpha;
    __device__ __forceinline__ void operator()(const f32x4 (&acc)[2][2][4][2], const Unit& u, int wr, int wc, int fr, int fq) const {
        const int row0 = u.pm * BM + wr * 64 + fr, col0 = u.pn * BM + wc * 32 + 4 * fq;
#pragma unroll
        for (int ai = 0; ai < 2; ++ai)
#pragma unroll
            for (int m = 0; m < 4; ++m) { const size_t off = (size_t)(row0 + ai * HALF + m * 16) * ldc + col0;
#pragma unroll
                for (int bj = 0; bj < 2; ++bj)
#pragma unroll
                    for (int n = 0; n < 2; ++n) { f32x4 o = acc[ai][bj][m][n];
                        if (base) o += *(const f32x4*)(base + off + bj * HALF + n * 16) * alpha;
                        *(f32x4*)(C + off + bj * HALF + n * 16) = o; } }
    }
};

struct EpiF32ResB {
    static constexpr bool PERM = false;
    float* C; int ldc; const bf16_t* base; float alpha;
    __device__ __forceinline__ void operator()(const f32x4 (&acc)[2][2][4][2], const Unit& u, int wr, int wc, int fr, int fq) const {
        typedef unsigned u32x2v __attribute__((ext_vector_type(2)));
        const int row0 = u.pm * BM + wr * 64 + fr, col0 = u.pn * BM + wc * 32 + 4 * fq;
#pragma unroll
        for (int ai = 0; ai < 2; ++ai)
#pragma unroll
            for (int m = 0; m < 4; ++m) { const size_t off = (size_t)(row0 + ai * HALF + m * 16) * ldc + col0;
#pragma unroll
                for (int bj = 0; bj < 2; ++bj)
#pragma unroll
                    for (int n = 0; n < 2; ++n) { f32x4 o = acc[ai][bj][m][n];
                        const u32x2v w = *(const u32x2v*)(base + off + bj * HALF + n * 16);
                        o[0] += alpha * __builtin_bit_cast(float, w.x << 16); o[1] += alpha * __builtin_bit_cast(float, w.x & 0xffff0000u);
                        o[2] += alpha * __builtin_bit_cast(float, w.y << 16); o[3] += alpha * __builtin_bit_cast(float, w.y & 0xffff0000u);
                        *(f32x4*)(C + off + bj * HALF + n * 16) = o; } }
    }
};
struct EpiSwiGLU {
    static constexpr bool PERM = true;
    bf16_t* O; int ldc;
    __device__ __forceinline__ void operator()(const f32x4 (&acc)[2][2][4][2], const Unit& u, int wr, int wc, int fr, int fq) const {
        const int row0 = u.pm * BM + wr * 64 + fr, col0 = u.pn * HALF + wc * 32 + 8 * fq;
#pragma unroll
        for (int ai = 0; ai < 2; ++ai)
#pragma unroll
            for (int m = 0; m < 4; ++m) { bf16_t* rowp = O + (size_t)(row0 + ai * HALF + m * 16) * ldc + col0;
                float h[8];
#pragma unroll
                for (int n = 0; n < 2; ++n)
#pragma unroll
                    for (int q = 0; q < 4; ++q) { const float g = acc[ai][0][m][n][q], up = acc[ai][1][m][n][q]; h[4 * n + q] = g * __builtin_amdgcn_rcpf(1.f + __expf(-g)) * up; }
                u32x4 w; w.x = cvt_pk_bf16(h[0], h[1]); w.y = cvt_pk_bf16(h[2], h[3]); w.z = cvt_pk_bf16(h[4], h[5]); w.w = cvt_pk_bf16(h[6], h[7]);
                *(u32x4*)rowp = w; }
    }
};
struct EpiScaleY {
    static constexpr bool PERM = true;
    bf16_t* Y; const float* sgate; const unsigned* off; const unsigned* cnt; const unsigned* cst;
    __device__ __forceinline__ void operator()(const f32x4 (&acc)[2][2][4][2], const Unit& u, int wr, int wc, int fr, int fq) const {
        const int o0 = (int)off[u.e], nreal = (int)cnt[u.e], c0 = (int)cst[u.e];
        const int row0 = u.pm * BM + wr * 64 + fr, col0 = u.pn * BM + wc * 32 + 8 * fq;
#pragma unroll
        for (int ai = 0; ai < 2; ++ai)
#pragma unroll
            for (int m = 0; m < 4; ++m) { const int p = row0 + ai * HALF + m * 16, rel = p - o0;
                if (rel < nreal) { bf16_t* rowp = Y + (size_t)(c0 + rel) * 1024 + col0;
#pragma unroll
                    for (int bj = 0; bj < 2; ++bj) { const f32x4 v0 = acc[ai][bj][m][0], v1 = acc[ai][bj][m][1];
                        u32x4 w; w.x = cvt_pk_bf16(v0[0], v0[1]); w.y = cvt_pk_bf16(v0[2], v0[3]); w.z = cvt_pk_bf16(v1[0], v1[1]); w.w = cvt_pk_bf16(v1[2], v1[3]);
                        *(u32x4*)(rowp + bj * HALF) = w; } } }
    }
};

template <class Epi, class Prob>
__device__ __forceinline__ void gemm_phase(PG8_LAS unsigned char* lds, const Prob& S, const Epi& E) {
    int tid = threadIdx.x; asm volatile("" : "+v"(tid));
    const int wid = __builtin_amdgcn_readfirstlane(tid >> 6), lane = tid & 63, wr = wid >> 2, wc = wid & 3, fr = lane & 15, fq = lane >> 4;
    const int K = S.K, nt = K / BK;
    int Rr[2], Cc[2]; unsigned voffB[2];
#pragma unroll
    for (int i = 0; i < 2; ++i) { int R, C; stage_rc(tid * 16 + i * 8192, R, C); const int Rb = Epi::PERM ? ((R & ~31) + perm32(R & 31)) : R;
        Rr[i] = R; Cc[i] = C; voffB[i] = (unsigned)(Rb * K + C) * 2u; }
    const size_t kstep = (size_t)(BK * 2);
    const size_t hstep = (size_t)HALF * K * 2;
    const unsigned ldsw = (unsigned)wid * 1024u;
    const int aoff = lds_byte(wr * 64 + fr, fq * 8), boff = lds_byte(wc * 32 + fr, fq * 8);
#define PG8_SA(b, h) (((b) * 2 + (h)) * HTB)
#define PG8_SB(b, h) ((4 + (b) * 2 + (h)) * HTB)
#define PG8_STAGE(bufoff, gbase, voff) do { _Pragma("unroll") for (int _i = 0; _i < 2; ++_i) \
        __builtin_amdgcn_global_load_lds((const unsigned*)((const char*)(gbase) + (voff)[_i]), (PG8_LAS unsigned*)(lds + (bufoff) + ldsw + _i * 8192), 16, 0, 0); } while (0)
#define PG8_LDA(dst, b, h) do { _Pragma("unroll") for (int m = 0; m < 4; ++m) _Pragma("unroll") for (int k = 0; k < 2; ++k) dst[m][k] = *(const PG8_LAS bf16x8*)(lds + PG8_SA(b, h) + aoff + m * 2048 + k * 1024); } while (0)
#define PG8_LDB(dst, b, h) do { _Pragma("unroll") for (int n = 0; n < 2; ++n) _Pragma("unroll") for (int k = 0; k < 2; ++k) dst[n][k] = *(const PG8_LAS bf16x8*)(lds + PG8_SB(b, h) + boff + n * 2048 + k * 1024); } while (0)
#define PG8_MMA(ai, bj, At, Bt) do { __builtin_amdgcn_s_setprio(1); _Pragma("unroll") for (int m = 0; m < 4; ++m) _Pragma("unroll") for (int n = 0; n < 2; ++n) _Pragma("unroll") for (int k = 0; k < 2; ++k) \
        acc[ai][bj][m][n] = __builtin_amdgcn_mfma_f32_16x16x32_bf16(Bt[n][k], At[m][k], acc[ai][bj][m][n], 0, 0, 0); __builtin_amdgcn_s_setprio(0); } while (0)
#define PG8_WAIT_V(n) asm volatile("s_waitcnt vmcnt(" #n ")" ::: "memory")
#define PG8_WAIT_L(n) asm volatile("s_waitcnt lgkmcnt(" #n ")" ::: "memory")
#define PG8_BAR __builtin_amdgcn_s_barrier()
#define PG8_SCHED __builtin_amdgcn_sched_barrier(0)
    Unit cur, nxt; int ui = 0;
    if (!S.next(0, cur)) return;
    f32x4 acc[2][2][4][2];
#pragma unroll
    for (int a = 0; a < 2; ++a)
#pragma unroll
        for (int b = 0; b < 2; ++b)
#pragma unroll
            for (int m = 0; m < 4; ++m)
#pragma unroll
                for (int n = 0; n < 2; ++n) acc[a][b][m][n] = (f32x4){0.f, 0.f, 0.f, 0.f};
    bf16x8 At[4][2], B0[2][2], B1[2][2];
    const char* cA = S.a_base(cur); const char* cB = S.b_base(cur);
    unsigned vA[2][2], nvA[2][2];
    S.a_offs(cur, vA, Rr, Cc);
    PG8_STAGE(PG8_SB(0, 0), cB, voffB); PG8_STAGE(PG8_SA(0, 0), cA, vA[0]); PG8_STAGE(PG8_SB(0, 1), cB + hstep, voffB); PG8_STAGE(PG8_SA(0, 1), cA, vA[1]);
    if (wr == 1) PG8_BAR;
    PG8_WAIT_V(4); PG8_BAR;
    PG8_STAGE(PG8_SB(1, 0), cB + kstep, voffB); PG8_STAGE(PG8_SA(1, 0), cA + kstep, vA[0]); PG8_STAGE(PG8_SB(1, 1), cB + hstep + kstep, voffB);
    PG8_WAIT_V(6); PG8_BAR;
    for (;;) {
        const bool has_next = S.next(ui + 1, nxt);
        const char* nA = has_next ? S.a_base(nxt) : cA; const char* nB = has_next ? S.b_base(nxt) : cB;
        if (has_next) S.a_offs(nxt, nvA, Rr, Cc);
        else {
#pragma unroll
            for (int h = 0; h < 2; ++h)
#pragma unroll
                for (int i = 0; i < 2; ++i) nvA[h][i] = vA[h][i];
        }
        for (int t = 0; t < nt; t += 2) {
            const bool last = (t == nt - 2);
            const char* a1 = cA + (size_t)(t + 1) * kstep;
            const char* a2 = last ? nA : cA + (size_t)(t + 2) * kstep; const char* b2 = last ? nB : cB + (size_t)(t + 2) * kstep;
            const char* a3 = a2 + kstep; const char* b3 = b2 + kstep;
            unsigned v2[2][2];
#pragma unroll
            for (int h = 0; h < 2; ++h)
#pragma unroll
                for (int i = 0; i < 2; ++i) v2[h][i] = last ? nvA[h][i] : vA[h][i];
            PG8_LDB(B0, 0, 0); PG8_SCHED; PG8_LDA(At, 0, 0); PG8_STAGE(PG8_SA(1, 1), a1, vA[1]);
            PG8_WAIT_L(8); PG8_BAR; PG8_WAIT_L(0); PG8_MMA(0, 0, At, B0); PG8_BAR; PG8_SCHED;
            PG8_LDB(B1, 0, 1); PG8_STAGE(PG8_SB(0, 0), b2, voffB);
            PG8_BAR; PG8_WAIT_L(0); PG8_MMA(0, 1, At, B1); PG8_BAR;
            PG8_LDA(At, 0, 1); PG8_STAGE(PG8_SA(0, 0), a2, v2[0]);
            PG8_BAR; PG8_WAIT_L(0); PG8_MMA(1, 0, At, B0); PG8_BAR; PG8_SCHED;
            PG8_STAGE(PG8_SB(0, 1), b2 + hstep, voffB);
            PG8_WAIT_V(6); PG8_BAR; PG8_MMA(1, 1, At, B1); PG8_BAR;
            PG8_LDB(B0, 1, 0); PG8_SCHED; PG8_LDA(At, 1, 0); PG8_STAGE(PG8_SA(0, 1), a2, v2[1]);
            PG8_WAIT_L(8); PG8_BAR; PG8_WAIT_L(0); PG8_MMA(0, 0, At, B0); PG8_BAR; PG8_SCHED;
            PG8_LDB(B1, 1, 1); PG8_STAGE(PG8_SB(1, 0), b3, voffB);
            PG8_BAR; PG8_WAIT_L(0); PG8_MMA(0, 1, At, B1); PG8_BAR;
            PG8_LDA(At, 1, 1); PG8_STAGE(PG8_SA(1, 0), a3, v2[0]);
            PG8_BAR; PG8_WAIT_L(0); PG8_MMA(1, 0, At, B0); PG8_BAR; PG8_SCHED;
            PG8_STAGE(PG8_SB(1, 1), b3 + hstep, voffB);
            PG8_WAIT_V(6); PG8_BAR; PG8_MMA(1, 1, At, B1); PG8_BAR;
        }
        E(acc, cur, wr, wc, fr, fq);
        if (!has_next) break;
#pragma unroll
        for (int a = 0; a < 2; ++a)
#pragma unroll
            for (int b = 0; b < 2; ++b)
#pragma unroll
                for (int m = 0; m < 4; ++m)
#pragma unroll
                    for (int n = 0; n < 2; ++n) acc[a][b][m][n] = (f32x4){0.f, 0.f, 0.f, 0.f};
        cur = nxt; cA = nA; cB = nB; ++ui;
#pragma unroll
        for (int h = 0; h < 2; ++h)
#pragma unroll
            for (int i = 0; i < 2; ++i) vA[h][i] = nvA[h][i];
    }
    PG8_WAIT_V(0);
    if (wr == 0) PG8_BAR;
    PG8_BAR;
#undef PG8_SA
#undef PG8_SB
#undef PG8_STAGE
#undef PG8_LDA
#undef PG8_LDB
#undef PG8_MMA
#undef PG8_WAIT_V
#undef PG8_WAIT_L
#undef PG8_BAR
#undef PG8_SCHED
}
}

__device__ __forceinline__ float wave_sum(float v) {
#pragma unroll
    for (int o = 1; o < 64; o <<= 1) v += __shfl_xor(v, o);
    return v;
}
__device__ __forceinline__ float sigmoidf_(float x) { return 1.0f / (1.0f + expf(-x)); }
__device__ __forceinline__ float wave_sum_dpp(float v) {
    v += __builtin_bit_cast(float, __builtin_amdgcn_update_dpp(0, __builtin_bit_cast(int, v), 0xB1, 0xF, 0xF, false));
    v += __builtin_bit_cast(float, __builtin_amdgcn_update_dpp(0, __builtin_bit_cast(int, v), 0x4E, 0xF, 0xF, false));
    v += __builtin_bit_cast(float, __builtin_amdgcn_update_dpp(0, __builtin_bit_cast(int, v), 0x124, 0xF, 0xF, false));
    v += __builtin_bit_cast(float, __builtin_amdgcn_update_dpp(0, __builtin_bit_cast(int, v), 0x128, 0xF, 0xF, false));
    const int vi = __builtin_bit_cast(int, v);
    const float r0 = __builtin_bit_cast(float, __builtin_amdgcn_readlane(vi, 0)), r1 = __builtin_bit_cast(float, __builtin_amdgcn_readlane(vi, 16));
    const float r2 = __builtin_bit_cast(float, __builtin_amdgcn_readlane(vi, 32)), r3 = __builtin_bit_cast(float, __builtin_amdgcn_readlane(vi, 48));
    return (r0 + r1) + (r2 + r3);
}
__device__ __forceinline__ float fma1(float a, float b, float c) { float d; asm("v_fma_f32 %0, %1, %2, %3" : "=v"(d) : "v"(a), "v"(b), "v"(c)); return d; }
__device__ __forceinline__ float mul1(float a, float b) { float d; asm("v_mul_f32 %0, %1, %2" : "=v"(d) : "v"(a), "v"(b)); return d; }

typedef unsigned short bf16_t;
typedef unsigned u32x4 __attribute__((ext_vector_type(4)));
typedef unsigned u32x2 __attribute__((ext_vector_type(2)));
__device__ __forceinline__ float bf2f(bf16_t b) { return __builtin_bit_cast(float, (unsigned)b << 16); }
__device__ __forceinline__ bf16_t f2bf(float f) { return (bf16_t)(pg8::cvt_pk_bf16(f, 0.f) & 0xffffu); }
__device__ __forceinline__ void transpose_item(const float* W, int K, int N, bf16_t* WT, int k0, int n0, int drow0, float* scr, int lane) {
#pragma unroll 8
    for (int i = 0; i < 32; ++i) { const int kk = 2 * i + (lane >> 5); scr[kk * 33 + (lane & 31)] = W[(size_t)(k0 + kk) * N + n0 + (lane & 31)]; }
    __builtin_amdgcn_wave_barrier();
    const int c = lane & 7;
#pragma unroll
    for (int j = 0; j < 4; ++j) { const int n = (lane >> 3) + 8 * j; const float* s = scr + (8 * c) * 33 + n;
        u32x4 o; o.x = pg8::cvt_pk_bf16(s[0 * 33], s[1 * 33]); o.y = pg8::cvt_pk_bf16(s[2 * 33], s[3 * 33]); o.z = pg8::cvt_pk_bf16(s[4 * 33], s[5 * 33]); o.w = pg8::cvt_pk_bf16(s[6 * 33], s[7 * 33]);
        *(u32x4*)(WT + (size_t)(drow0 + n) * K + k0 + 8 * c) = o; }
    __builtin_amdgcn_wave_barrier();
}
struct Args {
    const float* in[34]; float* out; unsigned char* ws;
    int ph_lo, ph_hi;
};

struct GF {
    const float* A; long lda; const int* arow; int arow_lim;
    const float* B; long ldb; int bmode;
    int K;
};
template <class Epi>
__device__ __forceinline__ void gemm_f32_tile(float* lds, const GF& g, int row0, int col0, Epi&& epi) {
    float* As = lds;
    float* Bs = lds + 16 * 132;
    const int tid = threadIdx.x, lane = tid & 63, w = tid >> 6, wm = w >> 1, wn = w & 1;
    f32x16 acc0, acc1;
#pragma unroll
    for (int i = 0; i < 16; ++i) { acc0[i] = 0.f; acc1[i] = 0.f; }
    const int ar = tid >> 2, ak = (tid & 3) * 4;
    long arow_idx = row0 + ar; bool avalid = true;
    if (g.arow) { const int t = g.arow[row0 + ar]; avalid = t < g.arow_lim; arow_idx = avalid ? t : 0; }
    const float* ap = g.A + arow_idx * g.lda + ak;
    const float* bp; int bk, bn;
    if (g.bmode == 0) { bk = tid >> 5; bn = (tid & 31) * 4; bp = g.B + (long)bk * g.ldb + col0 + bn; }
    else { bn = tid >> 2; bk = (tid & 3) * 4; bp = g.B + (long)(col0 + bn) * g.ldb + bk; }
    const int hl = lane >> 5, l31 = lane & 31;
    for (int k0 = 0; k0 < g.K; k0 += 16) {
        f32x4 av = (f32x4){0.f, 0.f, 0.f, 0.f};
        if (avalid) av = *(const f32x4*)(ap + k0);
        const f32x4 bv = g.bmode == 0 ? *(const f32x4*)(bp + (long)k0 * g.ldb) : *(const f32x4*)(bp + k0);
        __syncthreads();
        As[(ak + 0) * 132 + ar] = av[0]; As[(ak + 1) * 132 + ar] = av[1]; As[(ak + 2) * 132 + ar] = av[2]; As[(ak + 3) * 132 + ar] = av[3];
        if (g.bmode == 0) *(f32x4*)&Bs[bk * 132 + bn] = bv;
        else { Bs[(bk + 0) * 132 + bn] = bv[0]; Bs[(bk + 1) * 132 + bn] = bv[1]; Bs[(bk + 2) * 132 + bn] = bv[2]; Bs[(bk + 3) * 132 + bn] = bv[3]; }
        __syncthreads();
#pragma unroll
        for (int kk = 0; kk < 16; kk += 2) {
            const float a = As[(kk + hl) * 132 + wm * 32 + l31];
            const float b0 = Bs[(kk + hl) * 132 + wn * 64 + l31];
            const float b1 = Bs[(kk + hl) * 132 + wn * 64 + 32 + l31];
            acc0 = __builtin_amdgcn_mfma_f32_32x32x2f32(a, b0, acc0, 0, 0, 0);
            acc1 = __builtin_amdgcn_mfma_f32_32x32x2f32(a, b1, acc1, 0, 0, 0);
        }
    }
#pragma unroll
    for (int r = 0; r < 16; ++r) {
        const int row = row0 + wm * 32 + (r & 3) + 8 * (r >> 2) + 4 * hl;
        const int col = col0 + wn * 64 + l31;
        epi(row, col, acc0[r]);
        epi(row, col + 32, acc1[r]);
    }
    __syncthreads();
}

__device__ __forceinline__ void ln_row(const float* a, float alpha, const float* b, float* out, const float* gam, const float* bet, int lane, bf16_t* outb = nullptr) {
    f32x4 v[4]; float s = 0.f;
#pragma unroll
    for (int j = 0; j < 4; ++j) {
        v[j] = *(const f32x4*)(a + 4 * lane + 256 * j) * alpha;
        if (b) v[j] += *(const f32x4*)(b + 4 * lane + 256 * j);
        s += (v[j][0] + v[j][1]) + (v[j][2] + v[j][3]);
    }
    const float mean = wave_sum(s) * (1.f / D); float s2 = 0.f;
#pragma unroll
    for (int j = 0; j < 4; ++j) { v[j] = v[j] - mean; s2 += (v[j][0] * v[j][0] + v[j][1] * v[j][1]) + (v[j][2] * v[j][2] + v[j][3] * v[j][3]); }
    const float rstd = 1.f / sqrtf(wave_sum(s2) * (1.f / D) + LN_EPS);
#pragma unroll
    for (int j = 0; j < 4; ++j) {
        const f32x4 gg = *(const f32x4*)(gam + 4 * lane + 256 * j), bb = *(const f32x4*)(bet + 4 * lane + 256 * j);
        const f32x4 o = v[j] * rstd * gg + bb;
        if (out) *(f32x4*)(out + 4 * lane + 256 * j) = o;
        if (outb) { u32x2 w; w.x = pg8::cvt_pk_bf16(o[0], o[1]); w.y = pg8::cvt_pk_bf16(o[2], o[3]); *(u32x2*)(outb + 4 * lane + 256 * j) = w; }
    }
}

constexpr int NPHASES = 23;

__global__ void __launch_bounds__(NTHREADS, 2) mega(Args args) {
    extern __shared__ __attribute__((aligned(16))) unsigned char lds_raw[];
    float* ldsf = (float*)lds_raw;
    const int tid = threadIdx.x, lane = tid & 63, wave = tid >> 6;
    const int G = gridDim.x, bx = blockIdx.x;
    const int gw = bx * NWAVES + wave, NGW = G * NWAVES;
    unsigned char* ws = args.ws;
    unsigned* ctl = (unsigned*)(ws + WS_CTL);
    volatile LAS unsigned* misc = (volatile LAS unsigned*)((LAS unsigned char*)lds_raw + MISC_OFF);
    if (tid < 4) misc[tid] = 0u;
    __syncthreads();
    const int lo = args.ph_lo, hi = args.ph_hi;
    const bool multi = (hi - lo) > 1;
    XcdBarrier bar; bar.bar = ctl + CW_BAR; bar.x = 0; bar.st = nullptr;
    if (multi) bar = xcd_barrier_post(ctl + CW_BAR, misc);
#define IN(k) (lo <= (k) && (k) < hi)
#define SEAM(k) do { if (IN(k) && IN((k) + 1)) xcd_barrier(bar); } while (0)

    const float* x = args.in[0]; const float* mem = args.in[1]; const int* positions = (const int*)args.in[2];
    const float* w_in = args.in[3]; const float* mu_shift = args.in[4]; const float* w_decay_up = args.in[5]; const float* w0 = args.in[6];
    const float* a_up = args.in[7]; const float* a0 = args.in[8]; const float* g_up = args.in[9]; const float* k_k = args.in[10]; const float* k_a = args.in[11];
    const float* r_k = args.in[12]; const float* lnx_g = args.in[13]; const float* lnx_b = args.in[14]; const float* sinks = args.in[15];
    const float* w_o = args.in[16]; const float* ln1_g = args.in[17]; const float* ln1_b = args.in[18];
    const float* wm_q = args.in[19]; const float* wm_kv = args.in[20]; const float* wm_o = args.in[21]; const float* ln2_g = args.in[22]; const float* ln2_b = args.in[23];
    const float* w_router = args.in[24]; const float* router_bias = args.in[25];
    const float* we_gate = args.in[26]; const float* we_up = args.in[27]; const float* we_down = args.in[28];
    const float* ws_gate = args.in[29]; const float* ws_up = args.in[30]; const float* ws_down = args.in[31];
    const float* ln3_g = args.in[32]; const float* ln3_b = args.in[33];
    float* out = args.out;

    float* ROPE_C = (float*)(ws + WS_ROPE); float* ROPE_S = ROPE_C + (size_t)NTOK * 32;
    bf16_t* W_IN_T = (bf16_t*)(ws + WS_WIN); bf16_t* W_O_T = (bf16_t*)(ws + WS_WO); bf16_t* WM_Q_T = (bf16_t*)(ws + WS_WMQ); bf16_t* WM_KV_T = (bf16_t*)(ws + WS_WMKV); bf16_t* WM_O_T = (bf16_t*)(ws + WS_WMO);
    bf16_t* XB = (bf16_t*)(ws + WS_XB); bf16_t* MEMB = (bf16_t*)(ws + WS_MEMB);
    bf16_t* U = (bf16_t*)(ws + WS_U); bf16_t* LRB = (bf16_t*)(ws + WS_LRB); bf16_t* DWAG = (bf16_t*)(ws + WS_DWAG);
    float* YLOC = (float*)(ws + WS_YLOC); bf16_t* ZB = (bf16_t*)(ws + WS_ZB); bf16_t* PT = (bf16_t*)(ws + WS_PT); float* SLT = (float*)(ws + WS_SLT); bf16_t* SIN = (bf16_t*)(ws + WS_SIN);
    float* BONUS = (float*)(ws + WS_BONUS); bf16_t* WLR_T = (bf16_t*)(ws + WS_WLR); bf16_t* W_R_T = (bf16_t*)(ws + WS_WLR + MiB);
    bf16_t* MIX = (bf16_t*)(ws + WS_MIX); float* X1 = (float*)(ws + WS_X1); bf16_t* X1B = (bf16_t*)(ws + WS_X1B);
    bf16_t* QMB = (bf16_t*)(ws + WS_QM); bf16_t* KM = (bf16_t*)(ws + WS_KVM); bf16_t* VT = (bf16_t*)(ws + WS_KVM + 2 * MiB); bf16_t* OM = (bf16_t*)(ws + WS_OM);
    float* X2 = out; bf16_t* X2B = (bf16_t*)(ws + WS_X2B); float* LOG = (float*)(ws + WS_LOG);
    int* EIDX = (int*)(ws + WS_EIDX); float* GATE = (float*)(ws + WS_GATE); int* POS = (int*)(ws + WS_POS); int* YROW = (int*)(ws + WS_YROW);
    int* STOK = (int*)(ws + WS_STOK); float* SGATE = (float*)(ws + WS_SGATE);
    bf16_t* HH = (bf16_t*)(ws + WS_H); bf16_t* HS = (bf16_t*)(ws + WS_HS); bf16_t* YY = (bf16_t*)(ws + WS_Y);
    bf16_t* WS_GU_T = (bf16_t*)(ws + WS_WSGU); bf16_t* WS_D_T = (bf16_t*)(ws + WS_WSD); bf16_t* WE_GU_T = (bf16_t*)(ws + WS_WEGU); bf16_t* WE_D_T = (bf16_t*)(ws + WS_WED);
    int* TEXP = (int*)(ws + WS_TEXP);
    PG8_LAS unsigned char* ldsl = (PG8_LAS unsigned char*)lds_raw;

    if (IN(0)) {
        for (int i = bx * NTHREADS + tid; i < NTOK * 32; i += G * NTHREADS) {
            const int n = i >> 5, f = i & 31;
            const double inv = exp(-(double)(2 * f) / 64.0 * 9.210340371976184);
            const double ang = (double)positions[n] * inv;
            ROPE_C[i] = (float)cos(ang); ROPE_S[i] = (float)sin(ang);
        }
        {
            float* scr = ldsf + wave * 4096;
            constexpr int I_IN = 16 * (INCOLS / 32), I_SQ = 16 * (D / 32), I_KV = 16 * (2048 / 32);
            constexpr int I_R = 16 * (NEXP / 32); constexpr int NIT = I_IN + 3 * I_SQ + I_KV + I_R;
            for (int it = gw; it < NIT; it += NGW) {
                int r = it;
                if (r < I_IN) { const int nb = INCOLS / 32; transpose_item(w_in, D, INCOLS, W_IN_T, 64 * (r / nb), 32 * (r % nb), 32 * (r % nb), scr, lane); continue; } r -= I_IN;
                if (r < I_SQ) { const int nb = D / 32; transpose_item(w_o, D, D, W_O_T, 64 * (r / nb), 32 * (r % nb), 32 * (r % nb), scr, lane); continue; } r -= I_SQ;
                if (r < I_SQ) { const int nb = D / 32; transpose_item(wm_q, D, D, WM_Q_T, 64 * (r / nb), 32 * (r % nb), 32 * (r % nb), scr, lane); continue; } r -= I_SQ;
                if (r < I_SQ) { const int nb = D / 32; transpose_item(wm_o, D, D, WM_O_T, 64 * (r / nb), 32 * (r % nb), 32 * (r % nb), scr, lane); continue; } r -= I_SQ;
                if (r < I_KV) { const int nb = 2048 / 32; transpose_item(wm_kv, D, 2048, WM_KV_T, 64 * (r / nb), 32 * (r % nb), 32 * (r % nb), scr, lane); continue; } r -= I_KV;
                { const int nb = NEXP / 32; transpose_item(w_router, D, NEXP, W_R_T, 64 * (r / nb), 32 * (r % nb), 32 * (r % nb), scr, lane); }
            }
        }
        for (int i = bx * NTHREADS + tid; i < 1536 * 256; i += G * NTHREADS) {
            const int n = i >> 8, k = i & 255; float v = 0.f;
            if (n < 512) { if (k < 64) v = w_decay_up[k * RW + n]; }
            else if (n < 1024) { if (k >= 64 && k < 128) v = a_up[(k - 64) * RW + (n - 512)]; }
            else { if (k >= 128) v = g_up[(k - 128) * RW + (n - 1024)]; }
            WLR_T[i] = f2bf(v);
        }
        {
            float* scr = ldsf + wave * 4096;
            const int NITE = (NEXP + 1) * 384;
            for (int it = gw; it < NITE; it += NGW) {
                const int e = it / 384, r = it % 384;
                const float* wg = e < NEXP ? we_gate + (size_t)e * D * EDIM : ws_gate; const float* wu = e < NEXP ? we_up + (size_t)e * D * EDIM : ws_up;
                const float* wd = e < NEXP ? we_down + (size_t)e * EDIM * D : ws_down;
                bf16_t* gu = e < NEXP ? WE_GU_T + (size_t)e * 512 * D : WS_GU_T; bf16_t* dt = e < NEXP ? WE_D_T + (size_t)e * D * EDIM : WS_D_T;
                if (r < 256) { const int isup = r >> 7, rr = r & 127, kb = rr >> 3, nb = rr & 7, n0 = 32 * nb;
                    transpose_item(isup ? wu : wg, D, EDIM, gu, 64 * kb, n0, (n0 >> 7) * 256 + isup * 128 + (n0 & 127), scr, lane); }
                else { const int rr = r - 256, kb = rr >> 5, nb = rr & 31;
                    transpose_item(wd, EDIM, D, dt, 64 * kb, 32 * nb, 32 * nb, scr, lane); }
            }
        }
        for (size_t i = (size_t)bx * NTHREADS + tid; i < (size_t)NTOK * D / 8; i += (size_t)G * NTHREADS) {
            const f32x4 a = *(const f32x4*)(x + i * 8), b = *(const f32x4*)(x + i * 8 + 4);
            u32x4 o; o.x = pg8::cvt_pk_bf16(a[0], a[1]); o.y = pg8::cvt_pk_bf16(a[2], a[3]); o.z = pg8::cvt_pk_bf16(b[0], b[1]); o.w = pg8::cvt_pk_bf16(b[2], b[3]);
            *(u32x4*)(XB + i * 8) = o;
        }
        for (size_t i = (size_t)bx * NTHREADS + tid; i < (size_t)BATCH * MEMT * D / 8; i += (size_t)G * NTHREADS) {
            const f32x4 a = *(const f32x4*)(mem + i * 8), b = *(const f32x4*)(mem + i * 8 + 4);
            u32x4 o; o.x = pg8::cvt_pk_bf16(a[0], a[1]); o.y = pg8::cvt_pk_bf16(a[2], a[3]); o.z = pg8::cvt_pk_bf16(b[0], b[1]); o.w = pg8::cvt_pk_bf16(b[2], b[3]);
            *(u32x4*)(MEMB + i * 8) = o;
        }
    }
    SEAM(0);
    if (IN(1)) {
        pg8::DenseProb S{XB, W_IN_T, D, {}}; S.ord.init(NTOK, INCOLS, G, bx);
        pg8::EpiBf16 E{U, INCOLS};
        pg8::gemm_phase(ldsl, S, E);
    }
    SEAM(1);
    if (IN(2)) {
        for (size_t i = (size_t)bx * NTHREADS + tid; i < (size_t)NTOK * 256; i += (size_t)G * NTHREADS) {
            const int n = (int)(i >> 8), c = (int)(i & 255), col = C_WD + c;
            const float u = bf2f(U[(size_t)n * INCOLS + col]);
            const float p = (n % SEQ) ? bf2f(U[(size_t)(n - 1) * INCOLS + col]) : 0.f;
            const float v = u + (p - u) * mu_shift[col];
            LRB[i] = f2bf(c < 64 ? tanhf(v) : (c < 128 ? v : sigmoidf_(v)));
        }
    }
    SEAM(2);
    if (IN(3)) {
        pg8::DenseProb S{LRB, WLR_T, 256, {}}; S.ord.init(NTOK, 1536, G, bx);
        pg8::EpiBf16 E{DWAG, 1536};
        pg8::gemm_phase(ldsl, S, E);
    }
    SEAM(3);
    if (IN(4)) {
        const int j = lane; constexpr int TB = 2;
        float* vec = ldsf + wave * (TB * 384);
        const auto rsU = __builtin_amdgcn_make_buffer_rsrc(U, 0, (int)((size_t)NTOK * INCOLS * 2), 0x00020000);
        const auto rsD = __builtin_amdgcn_make_buffer_rsrc(DWAG, 0, (int)((size_t)NTOK * 1536 * 2), 0x00020000);
        const auto rsY = __builtin_amdgcn_make_buffer_rsrc(YLOC, 0, (int)((size_t)NTOK * RW * 4), 0x00020000);
        const auto rsZ = __builtin_amdgcn_make_buffer_rsrc(ZB, 0, (int)((size_t)NTOK * RW * 2), 0x00020000);
        for (int unit_v = gw; unit_v < BATCH * NCH * 8; unit_v += NGW) {
            const int unit = __builtin_amdgcn_readfirstlane(unit_v);
            const int b = unit / (NCH * 8), c = (unit % (NCH * 8)) >> 3, h = unit & 7, hc = h * 64 + j;
            float S0[64], S1[64];
            float one_ = 1.f; asm volatile("" : "+v"(one_));
#pragma unroll
            for (int k = 0; k < 64; ++k) { S0[k] = 0.f; S1[k] = (k == j) ? one_ : 0.f; }
            const float mur = mu_shift[C_R + hc], muk = mu_shift[C_K + hc], muv = mu_shift[C_V + hc];
            const float w0j = w0[hc], a0j = a0[hc], kkj = k_k[hc], kaj = k_a[hc], rkj = r_k[hc];
            const int nb0 = b * SEQ + c * CH;
            const int vo2 = hc * 2, vo4 = hc * 4;
            bf16_t lr[TB], lk[TB], lv[TB], ldw[TB], lda[TB];
            float pr = 0.f, pk = 0.f, pv = 0.f;
            if (c) { const int so = (nb0 - 1) * INCOLS * 2;
                pr = bf2f(__builtin_amdgcn_raw_buffer_load_b16(rsU, vo2, so + C_R * 2, 0)); pk = bf2f(__builtin_amdgcn_raw_buffer_load_b16(rsU, vo2, so + C_K * 2, 0)); pv = bf2f(__builtin_amdgcn_raw_buffer_load_b16(rsU, vo2, so + C_V * 2, 0)); }
#pragma unroll
            for (int i = 0; i < TB; ++i) { const int so = (nb0 + i) * INCOLS * 2, sd = (nb0 + i) * 1536 * 2;
                lr[i] = __builtin_amdgcn_raw_buffer_load_b16(rsU, vo2, so + C_R * 2, 0); lk[i] = __builtin_amdgcn_raw_buffer_load_b16(rsU, vo2, so + C_K * 2, 0); lv[i] = __builtin_amdgcn_raw_buffer_load_b16(rsU, vo2, so + C_V * 2, 0);
                ldw[i] = __builtin_amdgcn_raw_buffer_load_b16(rsD, vo2, sd, 0); lda[i] = __builtin_amdgcn_raw_buffer_load_b16(rsD, vo2, sd + 1024, 0); }
            for (int blk = 0; blk < CH / TB; ++blk) {
                const int n0 = nb0 + blk * TB;
#pragma unroll
                for (int i = 0; i < TB; ++i) {
                    const float r0 = bf2f(lr[i]), k0 = bf2f(lk[i]), v0 = bf2f(lv[i]);
                    const float r = r0 + (pr - r0) * mur, k = k0 + (pk - k0) * muk, vsh = v0 + (pv - v0) * muv;
                    pr = r0; pk = k0; pv = v0;
                    const float xx = -(w0j + bf2f(ldw[i]));
                    const float sp = fmaxf(xx, 0.f) + __logf(1.f + __expf(-fabsf(xx)));
                    const float wdec = __expf(-__expf(-sp - 0.5f));
                    const float a = __builtin_amdgcn_rcpf(1.f + __expf(-(a0j + bf2f(lda[i]))));
                    const float kkv = k * kkj;
                    const float nrm = sqrtf(wave_sum_dpp(kkv * kkv));
                    const float kkn = kkv * __builtin_amdgcn_rcpf(fmaxf(nrm, 1e-12f));
                    const float kmod = k * (1.f + (a - 1.f) * kaj);
                    const float bonus = wave_sum_dpp(r * kmod * rkj);
                    float* vt = vec + i * 384;
                    vt[j] = wdec; vt[64 + j] = -kkn; vt[128 + j] = kkn * a; vt[192 + j] = kmod; vt[256 + j] = r; vt[320 + j] = vsh;
                    if (lane == 0) BONUS[(size_t)(n0 + i) * 8 + h] = bonus;
                }
                if (blk + 1 < CH / TB) {
#pragma unroll
                    for (int i = 0; i < TB; ++i) { const int so = (n0 + TB + i) * INCOLS * 2, sd = (n0 + TB + i) * 1536 * 2;
                        lr[i] = __builtin_amdgcn_raw_buffer_load_b16(rsU, vo2, so + C_R * 2, 0); lk[i] = __builtin_amdgcn_raw_buffer_load_b16(rsU, vo2, so + C_K * 2, 0); lv[i] = __builtin_amdgcn_raw_buffer_load_b16(rsU, vo2, so + C_V * 2, 0);
                        ldw[i] = __builtin_amdgcn_raw_buffer_load_b16(rsD, vo2, sd, 0); lda[i] = __builtin_amdgcn_raw_buffer_load_b16(rsD, vo2, sd + 1024, 0); }
                }
                __builtin_amdgcn_wave_barrier();
#pragma nounroll
                for (int tt = 0; tt < TB; ++tt) {
                    const float* vt = vec + tt * 384;
                    float sa0 = 0.f, sa1 = 0.f;
                    f32x4 aA = *(const f32x4*)&vt[64], aB;
#pragma unroll
                    for (int kq = 0; kq < 16; kq += 2) {
                        aB = *(const f32x4*)&vt[64 + 4 * (kq + 1)];
                        __builtin_amdgcn_sched_barrier(0);
#pragma unroll
                        for (int q = 0; q < 4; ++q) { sa0 = fma1(S0[4 * kq + q], aA[q], sa0); sa1 = fma1(S1[4 * kq + q], aA[q], sa1); }
                        __builtin_amdgcn_sched_barrier(0);
                        if (kq + 2 < 16) aA = *(const f32x4*)&vt[64 + 4 * (kq + 2)];
                        __builtin_amdgcn_sched_barrier(0);
#pragma unroll
                        for (int q = 0; q < 4; ++q) { sa0 = fma1(S0[4 * kq + 4 + q], aB[q], sa0); sa1 = fma1(S1[4 * kq + 4 + q], aB[q], sa1); }
                        __builtin_amdgcn_sched_barrier(0);
                    }
                    float y0 = 0.f, y1 = 0.f; const float vq = vt[320 + j];
                    f32x4 wA = *(const f32x4*)&vt[0], bA = *(const f32x4*)&vt[128], kA = *(const f32x4*)&vt[192], rA = *(const f32x4*)&vt[256], wB, bB, kB, rB;
#define P4_UPD(kq_, w_, b_, k_, r_) _Pragma("unroll") for (int q = 0; q < 4; ++q) { \
                        const float s0 = fma1(S0[4 * (kq_) + q], w_[q], fma1(sa0, b_[q], mul1(vq, k_[q]))); S0[4 * (kq_) + q] = s0; y0 = fma1(s0, r_[q], y0); \
                        const float s1 = fma1(S1[4 * (kq_) + q], w_[q], mul1(sa1, b_[q])); S1[4 * (kq_) + q] = s1; y1 = fma1(s1, r_[q], y1); }
#pragma unroll
                    for (int kq = 0; kq < 16; kq += 2) {
                        wB = *(const f32x4*)&vt[4 * (kq + 1)]; bB = *(const f32x4*)&vt[128 + 4 * (kq + 1)]; kB = *(const f32x4*)&vt[192 + 4 * (kq + 1)]; rB = *(const f32x4*)&vt[256 + 4 * (kq + 1)];
                        __builtin_amdgcn_sched_barrier(0);
                        P4_UPD(kq, wA, bA, kA, rA)
                        __builtin_amdgcn_sched_barrier(0);
                        if (kq + 2 < 16) { wA = *(const f32x4*)&vt[4 * (kq + 2)]; bA = *(const f32x4*)&vt[128 + 4 * (kq + 2)]; kA = *(const f32x4*)&vt[192 + 4 * (kq + 2)]; rA = *(const f32x4*)&vt[256 + 4 * (kq + 2)]; }
                        __builtin_amdgcn_sched_barrier(0);
                        P4_UPD(kq + 1, wB, bB, kB, rB)
                        __builtin_amdgcn_sched_barrier(0);
                    }
#undef P4_UPD
                    const int nn = __builtin_amdgcn_readfirstlane(n0 + tt);
                    __builtin_amdgcn_raw_buffer_store_b32(__builtin_bit_cast(unsigned, y0), rsY, vo4, nn * (RW * 4), 0);
                    __builtin_amdgcn_raw_buffer_store_b16(f2bf(y1), rsZ, vo2, nn * (RW * 2), 0);
                }
                __builtin_amdgcn_wave_barrier();
            }
            { const auto rsS = __builtin_amdgcn_make_buffer_rsrc(SLT, 0, BATCH * NCH * 8 * 4096 * 4, 0x00020000);
              const auto rsP = __builtin_amdgcn_make_buffer_rsrc(PT, 0, BATCH * NCH * 8 * 4096 * 2, 0x00020000);
#pragma unroll
              for (int k = 0; k < 64; ++k) { __builtin_amdgcn_raw_buffer_store_b32(__builtin_bit_cast(unsigned, S0[k]), rsS, j * 4, unit * 16384 + k * 256, 0);
                  __builtin_amdgcn_raw_buffer_store_b16(f2bf(S1[k]), rsP, j * 2, unit * 8192 + k * 128, 0); } }
        }
    }
    SEAM(4);
    if (IN(5)) {
        if (wave == 0 && bx < 128) {
            const int bh = bx >> 2, vs = bx & 3, b = bh >> 3, h = bh & 7, col = lane & 15, g = lane >> 4;
            pg8::f32x4 acc[4];
#pragma unroll
            for (int t = 0; t < 4; ++t) acc[t] = (pg8::f32x4){0.f, 0.f, 0.f, 0.f};
            u32x4 Aw[8], An[8]; pg8::f32x4 sl[4], sn[4];
#define P5_LOAD(c_, A_, s_) do { const int unit_ = (b * NCH + (c_)) * 8 + h; const bf16_t* pt_ = PT + (size_t)unit_ * 4096; const float* slp_ = SLT + (size_t)unit_ * 4096; \
                _Pragma("unroll") for (int jo = 0; jo < 4; ++jo) { \
                    _Pragma("unroll") for (int r = 0; r < 4; ++r) s_[jo][r] = slp_[(size_t)(16 * jo + 4 * g + r) * 64 + 16 * vs + col]; \
                    _Pragma("unroll") for (int sx = 0; sx < 2; ++sx) { const bf16_t* ap_ = pt_ + (size_t)(16 * jo + col) * 64 + 32 * sx + 4 * g; \
                        const u32x2 a0_ = *(const u32x2*)ap_, a1_ = *(const u32x2*)(ap_ + 16); u32x4 aw_; aw_.x = a0_.x; aw_.y = a0_.y; aw_.z = a1_.x; aw_.w = a1_.y; A_[jo * 2 + sx] = aw_; } } } while (0)
            P5_LOAD(0, Aw, sl);
            for (int c = 0; c < NCH; ++c) {
                const int unit = (b * NCH + c) * 8 + h;
                if (c + 2 < NCH) P5_LOAD(c + 1, An, sn);
                bf16_t* sdst = SIN + (size_t)unit * 4096 + (size_t)(16 * vs + col) * 64;
                unsigned pk[8];
#pragma unroll
                for (int t = 0; t < 4; ++t) { pk[2 * t] = pg8::cvt_pk_bf16(acc[t][0], acc[t][1]); pk[2 * t + 1] = pg8::cvt_pk_bf16(acc[t][2], acc[t][3]);
                    u32x2 w; w.x = pk[2 * t]; w.y = pk[2 * t + 1]; *(u32x2*)(sdst + 16 * t + 4 * g) = w; }
                if (c == NCH - 1) break;
                pg8::bf16x8 Bf[2];
#pragma unroll
                for (int s = 0; s < 2; ++s) { u32x4 w; w.x = pk[4 * s]; w.y = pk[4 * s + 1]; w.z = pk[4 * s + 2]; w.w = pk[4 * s + 3]; Bf[s] = __builtin_bit_cast(pg8::bf16x8, w); }
#pragma unroll
                for (int jo = 0; jo < 4; ++jo) {
                    pg8::f32x4 na = sl[jo];
#pragma unroll
                    for (int s = 0; s < 2; ++s) na = __builtin_amdgcn_mfma_f32_16x16x32_bf16(__builtin_bit_cast(pg8::bf16x8, Aw[jo * 2 + s]), Bf[s], na, 0, 0, 0);
                    acc[jo] = na;
                }
#pragma unroll
                for (int i = 0; i < 8; ++i) Aw[i] = An[i];
#pragma unroll
                for (int i = 0; i < 4; ++i) sl[i] = sn[i];
            }
#undef P5_LOAD
        }
    }
    SEAM(5);
    if (IN(6)) {
        const int col = lane & 31, hh = lane >> 5;
        for (int unit = gw; unit < BATCH * NCH * 8; unit += NGW) {
            const int b = unit / (NCH * 8), c = (unit % (NCH * 8)) >> 3, h = unit & 7;
            const bf16_t* sin = SIN + (size_t)unit * 4096;
            pg8::bf16x8 Bf[2][4];
#pragma unroll
            for (int ct = 0; ct < 2; ++ct)
#pragma unroll
                for (int s = 0; s < 4; ++s) Bf[ct][s] = *(const pg8::bf16x8*)(sin + (size_t)(32 * ct + col) * 64 + 16 * s + 8 * hh);
            float lg[2], lb[2], muv[2];
#pragma unroll
            for (int ct = 0; ct < 2; ++ct) { lg[ct] = lnx_g[h * 64 + 32 * ct + col]; lb[ct] = lnx_b[h * 64 + 32 * ct + col]; muv[ct] = mu_shift[C_V + h * 64 + 32 * ct + col]; }
            for (int rt = 0; rt < CH / 32; ++rt) {
                const size_t n0 = (size_t)b * SEQ + c * CH + rt * 32;
                f32x16 acc[2];
#pragma unroll
                for (int i = 0; i < 16; ++i) { acc[0][i] = 0.f; acc[1][i] = 0.f; }
#pragma unroll
                for (int s = 0; s < 4; ++s) {
                    const pg8::bf16x8 Af = *(const pg8::bf16x8*)(ZB + (n0 + col) * RW + h * 64 + 16 * s + 8 * hh);
                    acc[0] = __builtin_amdgcn_mfma_f32_32x32x16_bf16(Af, Bf[0][s], acc[0], 0, 0, 0);
                    acc[1] = __builtin_amdgcn_mfma_f32_32x32x16_bf16(Af, Bf[1][s], acc[1], 0, 0, 0);
                }
#pragma unroll
                for (int r = 0; r < 16; ++r) {
                    const int trow = (r & 3) + 8 * (r >> 2) + 4 * hh; const size_t n = n0 + trow; const int t = c * CH + rt * 32 + trow;
                    float y0 = acc[0][r] + YLOC[n * RW + h * 64 + col], y1 = acc[1][r] + YLOC[n * RW + h * 64 + 32 + col];
                    float sm = y0 + y1, sq = y0 * y0 + y1 * y1;
#pragma unroll
                    for (int o = 1; o < 32; o <<= 1) { sm += __shfl_xor(sm, o); sq += __shfl_xor(sq, o); }
                    const float mu = sm * (1.f / 64.f), var = fmaxf(sq * (1.f / 64.f) - mu * mu, 0.f), rs = 1.f / sqrtf(var + GN_EPS);
                    const float bon = BONUS[n * 8 + h];
#pragma unroll
                    for (int ct = 0; ct < 2; ++ct) {
                        const int hc = h * 64 + 32 * ct + col;
                        const float v0 = bf2f(U[n * INCOLS + C_V + hc]); const float pv = t ? bf2f(U[(n - 1) * INCOLS + C_V + hc]) : 0.f; const float vv = v0 + (pv - v0) * muv[ct];
                        const float gg = bf2f(DWAG[n * 1536 + 1024 + hc]);
                        const float yy = ct ? y1 : y0;
                        MIX[n * D + hc] = f2bf((((yy - mu) * rs) * lg[ct] + lb[ct] + bon * vv) * gg);
                    }
                }
            }
        }
    }
    SEAM(6);
    if (IN(7)) {
        const int qcol = lane & 15, g = lane >> 4;
        unsigned char* ldsK = lds_raw;
        unsigned char* ldsV = lds_raw + 32768;
        for (int unit = bx; unit < BATCH * 64 * 2; unit += G) {
            const int b = unit >> 7, blk = (unit & 127) >> 1, hk = unit & 1;
            const int s0 = blk * 128 - 128;
            __syncthreads();
            {
                const int key = tid >> 1, hf = tid & 1, s = s0 + key;
                u32x4 ko[4], vv[4];
                if (s >= 0) {
                    const size_t n = (size_t)b * SEQ + s;
                    const bf16_t* kp = U + n * INCOLS + C_KS + hk * 64 + 16 * hf;
                    const u32x4 a0 = *(const u32x4*)kp, a1 = *(const u32x4*)(kp + 8), b0 = *(const u32x4*)(kp + 32), b1 = *(const u32x4*)(kp + 40);
                    const unsigned k1w[8] = {a0.x, a0.y, a0.z, a0.w, a1.x, a1.y, a1.z, a1.w}, k2w[8] = {b0.x, b0.y, b0.z, b0.w, b1.x, b1.y, b1.z, b1.w};
                    unsigned o1[8], o2[8];
#pragma unroll
                    for (int q = 0; q < 8; ++q) {
                        const float c0 = ROPE_C[n * 32 + 16 * hf + 2 * q], c1 = ROPE_C[n * 32 + 16 * hf + 2 * q + 1], sn0 = ROPE_S[n * 32 + 16 * hf + 2 * q], sn1 = ROPE_S[n * 32 + 16 * hf + 2 * q + 1];
                        const float x1a = __builtin_bit_cast(float, k1w[q] << 16), x1b = __builtin_bit_cast(float, k1w[q] & 0xffff0000u), x2a = __builtin_bit_cast(float, k2w[q] << 16), x2b = __builtin_bit_cast(float, k2w[q] & 0xffff0000u);
                        o1[q] = pg8::cvt_pk_bf16(x1a * c0 - x2a * sn0, x1b * c1 - x2b * sn1); o2[q] = pg8::cvt_pk_bf16(x2a * c0 + x1a * sn0, x2b * c1 + x1b * sn1);
                    }
                    ko[0] = (u32x4){o1[0], o1[1], o1[2], o1[3]}; ko[1] = (u32x4){o1[4], o1[5], o1[6], o1[7]}; ko[2] = (u32x4){o2[0], o2[1], o2[2], o2[3]}; ko[3] = (u32x4){o2[4], o2[5], o2[6], o2[7]};
                    const bf16_t* vp = U + n * INCOLS + C_VS + hk * 64 + 32 * hf;
#pragma unroll
                    for (int q = 0; q < 4; ++q) vv[q] = *(const u32x4*)(vp + 8 * q);
                } else {
#pragma unroll
                    for (int q = 0; q < 4; ++q) { ko[q] = (u32x4){0u, 0u, 0u, 0u}; vv[q] = (u32x4){0u, 0u, 0u, 0u}; }
                }
                const int sw = (key >> 1) & 7;
                *(u32x4*)(ldsK + key * 128 + (((2 * hf) ^ sw) << 4)) = ko[0]; *(u32x4*)(ldsK + key * 128 + (((2 * hf + 1) ^ sw) << 4)) = ko[1];
                *(u32x4*)(ldsK + key * 128 + (((4 + 2 * hf) ^ sw) << 4)) = ko[2]; *(u32x4*)(ldsK + key * 128 + (((5 + 2 * hf) ^ sw) << 4)) = ko[3];
#pragma unroll
                for (int q = 0; q < 4; ++q)
#pragma unroll
                    for (int e2 = 0; e2 < 4; ++e2) {
                        const unsigned wv = vv[q][e2]; const int d0 = 32 * hf + 8 * q + 2 * e2;
                        *(bf16_t*)(ldsV + d0 * 512 + ((((key >> 2) ^ (2 * (d0 & 15)))) << 3) + (key & 3) * 2) = (bf16_t)(wv & 0xffffu);
                        *(bf16_t*)(ldsV + (d0 + 1) * 512 + ((((key >> 2) ^ (2 * ((d0 + 1) & 15)))) << 3) + (key & 3) * 2) = (bf16_t)(wv >> 16);
                    }
            }
            __syncthreads();
            const int i0 = 16 * wave, qi = i0 + qcol;
            const size_t nq = (size_t)b * SEQ + blk * 128 + qi;
#pragma unroll 1
            for (int gq = 0; gq < 4; ++gq) {
                const int hq = hk * 4 + gq;
                pg8::bf16x8 Qf[2];
                {
                    const bf16_t* qp = U + nq * INCOLS + C_Q + hq * 64 + 8 * g;
                    const u32x4 qa = *(const u32x4*)qp, qb = *(const u32x4*)(qp + 32);
                    const f32x4 c0 = *(const f32x4*)(ROPE_C + nq * 32 + 8 * g), c1 = *(const f32x4*)(ROPE_C + nq * 32 + 8 * g + 4), sn0 = *(const f32x4*)(ROPE_S + nq * 32 + 8 * g), sn1 = *(const f32x4*)(ROPE_S + nq * 32 + 8 * g + 4);
                    const float cc[8] = {c0[0], c0[1], c0[2], c0[3], c1[0], c1[1], c1[2], c1[3]}, ss[8] = {sn0[0], sn0[1], sn0[2], sn0[3], sn1[0], sn1[1], sn1[2], sn1[3]};
                    u32x4 w1, w2;
#pragma unroll
                    for (int q = 0; q < 4; ++q) {
                        const float x1a = __builtin_bit_cast(float, qa[q] << 16), x1b = __builtin_bit_cast(float, qa[q] & 0xffff0000u), x2a = __builtin_bit_cast(float, qb[q] << 16), x2b = __builtin_bit_cast(float, qb[q] & 0xffff0000u);
                        w1[q] = pg8::cvt_pk_bf16((x1a * cc[2 * q] - x2a * ss[2 * q]) * 0.125f, (x1b * cc[2 * q + 1] - x2b * ss[2 * q + 1]) * 0.125f);
                        w2[q] = pg8::cvt_pk_bf16((x2a * cc[2 * q] + x1a * ss[2 * q]) * 0.125f, (x2b * cc[2 * q + 1] + x1b * ss[2 * q + 1]) * 0.125f);
                    }
                    Qf[0] = __builtin_bit_cast(pg8::bf16x8, w1); Qf[1] = __builtin_bit_cast(pg8::bf16x8, w2);
                }
                const float sink = sinks[hq];
                pg8::f32x4 acc[10];
                float m = sink;
#pragma unroll
                for (int t = 0; t < 10; ++t) {
                    const int kt = wave + t, ktc = kt < 16 ? kt : 15, key = 16 * ktc + qcol, sw = (key >> 1) & 7;
                    pg8::f32x4 a = (pg8::f32x4){0.f, 0.f, 0.f, 0.f};
#pragma unroll
                    for (int ks = 0; ks < 2; ++ks) { const pg8::bf16x8 kf = *(const pg8::bf16x8*)(ldsK + key * 128 + (((4 * ks + g) ^ sw) << 4));
                        a = __builtin_amdgcn_mfma_f32_16x16x32_bf16(kf, Qf[ks], a, 0, 0, 0); }
#pragma unroll
                    for (int r = 0; r < 4; ++r) { const int kk = 16 * kt + 4 * g + r; const bool ok = (kk > qi) && (kk <= qi + 128) && (s0 + kk >= 0) && (kt < 16);
                        a[r] = ok ? a[r] : -INFINITY; m = fmaxf(m, a[r]); }
                    acc[t] = a;
                }
                m = fmaxf(m, __shfl_xor(m, 16)); m = fmaxf(m, __shfl_xor(m, 32));
                float lsum = 0.f;
#pragma unroll
                for (int t = 0; t < 10; ++t)
#pragma unroll
                    for (int r = 0; r < 4; ++r) { const float p = __expf(acc[t][r] - m); acc[t][r] = p; lsum += p; }
                lsum += __shfl_xor(lsum, 16); lsum += __shfl_xor(lsum, 32);
                lsum += __expf(sink - m);
                pg8::bf16x8 Pf[5];
#pragma unroll
                for (int ks = 0; ks < 5; ++ks) { u32x4 w; w.x = pg8::cvt_pk_bf16(acc[2 * ks][0], acc[2 * ks][1]); w.y = pg8::cvt_pk_bf16(acc[2 * ks][2], acc[2 * ks][3]);
                    w.z = pg8::cvt_pk_bf16(acc[2 * ks + 1][0], acc[2 * ks + 1][1]); w.w = pg8::cvt_pk_bf16(acc[2 * ks + 1][2], acc[2 * ks + 1][3]); Pf[ks] = __builtin_bit_cast(pg8::bf16x8, w); }
                float linv[4];
#pragma unroll
                for (int r = 0; r < 4; ++r) linv[r] = 1.f / __shfl(lsum, 4 * g + r);
#pragma unroll
                for (int dt = 0; dt < 4; ++dt) {
                    pg8::f32x4 o = (pg8::f32x4){0.f, 0.f, 0.f, 0.f};
                    const int dd = 16 * dt + qcol;
#pragma unroll
                    for (int ks = 0; ks < 5; ++ks) {
                        const int ka = wave + 2 * ks, kb = ka + 1, kac = ka < 16 ? ka : 15, kbc = kb < 16 ? kb : 15;
                        const u32x2 v0 = *(const u32x2*)(ldsV + dd * 512 + (((4 * kac + g) ^ (2 * (dd & 15))) << 3));
                        const u32x2 v1 = *(const u32x2*)(ldsV + dd * 512 + (((4 * kbc + g) ^ (2 * (dd & 15))) << 3));
                        u32x4 w; w.x = v0.x; w.y = v0.y; w.z = v1.x; w.w = v1.y;
                        o = __builtin_amdgcn_mfma_f32_16x16x32_bf16(Pf[ks], __builtin_bit_cast(pg8::bf16x8, w), o, 0, 0, 0);
                    }
#pragma unroll
                    for (int r = 0; r < 4; ++r) MIX[((size_t)b * SEQ + blk * 128 + i0 + 4 * g + r) * D + RW + hq * 64 + dd] = f2bf(o[r] * linv[r]);
                }
            }
        }
    }
    SEAM(7);
    if (IN(8)) {
        pg8::DenseProb S{MIX, W_O_T, D, {}}; S.ord.init(NTOK, D, G, bx);
        pg8::EpiF32Res E{X1, D, x, ALPHA};
        pg8::gemm_phase(ldsl, S, E);
    }
    SEAM(8);
    if (IN(9)) { for (int n = gw; n < NTOK; n += NGW) ln_row(X1 + (size_t)n * D, 1.f, nullptr, nullptr, ln1_g, ln1_b, lane, X1B + (size_t)n * D); }
    SEAM(9);
    if (IN(10)) {
        { pg8::DenseProb S{X1B, WM_Q_T, D, {}}; S.ord.init(NTOK, D, G, bx); pg8::EpiBf16 E{QMB, D}; pg8::gemm_phase(ldsl, S, E); }
        { pg8::DenseProb S{MEMB, WM_KV_T, D, {}}; S.ord.init(BATCH * MEMT, D, G, bx); pg8::EpiBf16 E{KM, D}; pg8::gemm_phase(ldsl, S, E); }
        { pg8::DenseProb S{WM_KV_T + (size_t)D * D, MEMB, D, {}}; S.ord.init(D, BATCH * MEMT, G, bx); pg8::EpiBf16 E{VT, BATCH * MEMT}; pg8::gemm_phase(ldsl, S, E); }
    }
    SEAM(10);
    if (IN(11)) {
        const int qcol = lane & 15, g = lane >> 4;
        unsigned char* ldsb = lds_raw;
        for (int unit = bx; unit < BATCH * 4 * (SEQ / 128); unit += G) {
            const int b = unit / (4 * (SEQ / 128)), h = (unit / (SEQ / 128)) & 3, qt = unit % (SEQ / 128);
            const size_t q0 = (size_t)b * SEQ + qt * 128 + wave * 16;
            pg8::bf16x8 Qf[8];
#pragma unroll
            for (int ks = 0; ks < 8; ++ks) Qf[ks] = *(const pg8::bf16x8*)(QMB + (q0 + qcol) * D + h * 256 + 32 * ks + 8 * g);
            __syncthreads();
#pragma unroll 4
            for (int i = 0; i < 16; ++i) { const int p = tid + NTHREADS * i, row = p >> 5, ch = p & 31;
                const u32x4 v = *(const u32x4*)(KM + (size_t)(b * MEMT + row) * D + h * 256 + ch * 8);
                *(u32x4*)(ldsb + row * 512 + ((ch ^ (row & 15)) << 4)) = v; }
            __syncthreads();
            pg8::f32x4 acc[16];
#pragma unroll
            for (int kt = 0; kt < 16; ++kt) { acc[kt] = (pg8::f32x4){0.f, 0.f, 0.f, 0.f};
                const int key = 16 * kt + qcol;
#pragma unroll
                for (int ks = 0; ks < 8; ++ks) { const pg8::bf16x8 a = *(const pg8::bf16x8*)(ldsb + key * 512 + (((4 * ks + g) ^ (key & 15)) << 4));
                    acc[kt] = __builtin_amdgcn_mfma_f32_16x16x32_bf16(a, Qf[ks], acc[kt], 0, 0, 0); } }
            float m = -INFINITY;
#pragma unroll
            for (int kt = 0; kt < 16; ++kt)
#pragma unroll
                for (int r = 0; r < 4; ++r) m = fmaxf(m, acc[kt][r]);
            m = fmaxf(m, __shfl_xor(m, 16)); m = fmaxf(m, __shfl_xor(m, 32));
            float lsum = 0.f;
#pragma unroll
            for (int kt = 0; kt < 16; ++kt)
#pragma unroll
                for (int r = 0; r < 4; ++r) { const float p = __expf((acc[kt][r] - m) * 0.0625f); acc[kt][r] = p; lsum += p; }
            lsum += __shfl_xor(lsum, 16); lsum += __shfl_xor(lsum, 32);
            pg8::bf16x8 Pf[8];
#pragma unroll
            for (int ks = 0; ks < 8; ++ks) { u32x4 w; w.x = pg8::cvt_pk_bf16(acc[2 * ks][0], acc[2 * ks][1]); w.y = pg8::cvt_pk_bf16(acc[2 * ks][2], acc[2 * ks][3]);
                w.z = pg8::cvt_pk_bf16(acc[2 * ks + 1][0], acc[2 * ks + 1][1]); w.w = pg8::cvt_pk_bf16(acc[2 * ks + 1][2], acc[2 * ks + 1][3]); Pf[ks] = __builtin_bit_cast(pg8::bf16x8, w); }
            __syncthreads();
#pragma unroll 4
            for (int i = 0; i < 16; ++i) { const int p = tid + NTHREADS * i, row = p >> 5, ch = p & 31;
                const u32x4 v = *(const u32x4*)(VT + (size_t)(h * 256 + row) * (BATCH * MEMT) + b * MEMT + ch * 8);
                *(u32x4*)(ldsb + row * 512 + ((ch ^ (row & 15)) << 4)) = v; }
            __syncthreads();
            float linv[4];
#pragma unroll
            for (int r = 0; r < 4; ++r) linv[r] = 1.f / __shfl(lsum, 4 * g + r);
#pragma unroll
            for (int dt = 0; dt < 16; ++dt) {
                pg8::f32x4 o = (pg8::f32x4){0.f, 0.f, 0.f, 0.f};
                const int dd = 16 * dt + qcol;
#pragma unroll
                for (int ks = 0; ks < 8; ++ks) {
                    const int c8 = 8 * ks + g;
                    const u32x2 v0 = *(const u32x2*)(ldsb + dd * 512 + ((c8 ^ (2 * (dd & 15))) << 3));
                    const u32x2 v1 = *(const u32x2*)(ldsb + dd * 512 + (((c8 + 4) ^ (2 * (dd & 15))) << 3));
                    u32x4 w; w.x = v0.x; w.y = v0.y; w.z = v1.x; w.w = v1.y;
                    o = __builtin_amdgcn_mfma_f32_16x16x32_bf16(Pf[ks], __builtin_bit_cast(pg8::bf16x8, w), o, 0, 0, 0);
                }
#pragma unroll
                for (int r = 0; r < 4; ++r) OM[(q0 + 4 * g + r) * D + h * 256 + dd] = f2bf(o[r] * linv[r]);
            }
        }
    }
    SEAM(11);
    if (IN(14)) {
        pg8::DenseProb S{OM, WM_O_T, D, {}}; S.ord.init(NTOK, D, G, bx);
        pg8::EpiF32ResB E{X2, D, X1B, ALPHA};
        pg8::gemm_phase(ldsl, S, E);
    }
    SEAM(14);
    if (IN(15)) {
        for (int n = gw; n < NTOK; n += NGW) ln_row(X2 + (size_t)n * D, 1.f, nullptr, nullptr, ln2_g, ln2_b, lane, X2B + (size_t)n * D);
        if (bx == 0 && tid < 128) *(u32x4*)(X2B + (size_t)NTOK * D + tid * 8) = (u32x4){0u, 0u, 0u, 0u};
    }
    SEAM(15);
    if (IN(16)) {
        pg8::DenseProb S{X2B, W_R_T, D, {}}; S.ord.init(NTOK, NEXP, G, bx);
        pg8::EpiF32Res E{LOG, NEXP, nullptr, 0.f};
        pg8::gemm_phase(ldsl, S, E);
    }
    SEAM(16);
    if (IN(17)) {
        const int hl = lane >> 5;
        for (int i = bx * NTHREADS + tid; i < PMAX; i += G * NTHREADS) { STOK[i] = NTOK; SGATE[i] = 0.f; }
        for (int n = gw; n < NTOK; n += NGW) {
            float sc[4], bi[4], gso[4];
#pragma unroll
            for (int j = 0; j < 4; ++j) { const int e = lane + 64 * j; sc[j] = sigmoidf_(LOG[(size_t)n * NEXP + e]); bi[j] = sc[j] + router_bias[e]; }
#pragma unroll
            for (int j = 0; j < 4; ++j) {
                float m1 = bi[j], m2 = -INFINITY;
#pragma unroll
                for (int o = 1; o < 32; o <<= 1) { const float o1 = __shfl_xor(m1, o), o2 = __shfl_xor(m2, o);
                    const float n1 = fmaxf(m1, o1), n2 = fmaxf(fminf(m1, o1), fmaxf(m2, o2)); m1 = n1; m2 = n2; }
                gso[j] = m1 + m2;
            }
            float g8[8];
#pragma unroll
            for (int j = 0; j < 4; ++j) { const float oth = __shfl_xor(gso[j], 32); g8[2 * j] = hl ? oth : gso[j]; g8[2 * j + 1] = hl ? gso[j] : oth; }
            bool gsel[8];
#pragma unroll
            for (int a = 0; a < 8; ++a) { int rank = 0;
#pragma unroll
                for (int c = 0; c < 8; ++c) rank += ((g8[c] > g8[a]) || (g8[c] == g8[a] && c < a)) ? 1 : 0;
                gsel[a] = rank < 4; }
            float cand[4];
#pragma unroll
            for (int j = 0; j < 4; ++j) { const bool s = hl ? gsel[2 * j + 1] : gsel[2 * j]; cand[j] = s ? bi[j] : -1e30f; }
            int eidx[8]; float sel[8]; float ssum = 0.f;
#pragma unroll
            for (int k = 0; k < 8; ++k) {
                float bv = cand[0]; int be = lane;
#pragma unroll
                for (int j = 1; j < 4; ++j) if (cand[j] > bv) { bv = cand[j]; be = lane + 64 * j; }
#pragma unroll
                for (int o = 1; o < 64; o <<= 1) { const float ov = __shfl_xor(bv, o); const int oe = __shfl_xor(be, o);
                    if (ov > bv || (ov == bv && oe < be)) { bv = ov; be = oe; } }
                eidx[k] = be;
                const int jw = be >> 6, lw = be & 63;
                const float mys = jw == 0 ? sc[0] : (jw == 1 ? sc[1] : (jw == 2 ? sc[2] : sc[3]));
                sel[k] = __shfl(mys, lw); ssum += sel[k];
#pragma unroll
                for (int j = 0; j < 4; ++j) if (lane == lw && j == jw) cand[j] = -INFINITY;
            }
#pragma unroll
            for (int k = 0; k < 8; ++k) {
                if (lane == k) {
                    const int e = eidx[k];
                    const int pos = (int)atomicAdd(&ctl[CW_CNT + e], 1u);
                    EIDX[n * 8 + k] = e; GATE[n * 8 + k] = sel[k] / ssum * 2.5f; POS[n * 8 + k] = pos;
                }
            }
        }
    }
    SEAM(17);
    if (IN(19)) {
        int* soff = (int*)ldsf;
        __syncthreads();
        if (tid < NEXP) soff[1024 + tid] = (int)ctl[CW_CNT + tid];
        __syncthreads();
        if (tid == 0) { int acc = 0, cacc = 0; for (int e = 0; e < NEXP; ++e) { soff[e] = acc; soff[512 + e] = cacc; const int c = soff[1024 + e]; acc += ((c + MOE_TR - 1) / MOE_TR) * MOE_TR; cacc += c; } soff[NEXP] = acc; }
        __syncthreads();
        if (bx == 0) {
            if (tid <= NEXP) ctl[CW_OFF + tid] = (unsigned)soff[tid];
            if (tid < NEXP) ctl[CW_CST + tid] = (unsigned)soff[512 + tid];
            if (tid == 0) ctl[CW_NT] = (unsigned)(soff[NEXP] / MOE_TR);
            if (tid < NEXP) { for (int t = soff[tid] / MOE_TR; t < soff[tid + 1] / MOE_TR; ++t) TEXP[t] = tid; }
        }
        for (int i = bx * NTHREADS + tid; i < NK; i += G * NTHREADS) {
            const int e = EIDX[i], p = soff[e] + POS[i];
            STOK[p] = i >> 3; YROW[i] = soff[512 + e] + POS[i];
        }
    }
    SEAM(19);
    if (IN(20)) {
        const int ntm = (int)ctl[CW_NT];
        { pg8::GatherProb S{X2B, STOK, WE_GU_T, TEXP, D, 2, ntm * 2, G, bx, (size_t)512 * D * 2}; pg8::EpiSwiGLU E{HH, EDIM}; pg8::gemm_phase(ldsl, S, E); }
        { pg8::DenseProb S{X2B, WS_GU_T, D, {}}; S.ord.init(NTOK, 512, G, bx); pg8::EpiSwiGLU E{HS, EDIM}; pg8::gemm_phase(ldsl, S, E); }
    }
    SEAM(20);
    if (IN(21)) {
        const int ntm = (int)ctl[CW_NT];
        { pg8::GroupedProb S{HH, WE_D_T, TEXP, EDIM, 4, ntm * 4, G, bx, (size_t)D * EDIM * 2}; pg8::EpiScaleY E{YY, SGATE, ctl + CW_OFF, ctl + CW_CNT, ctl + CW_CST}; pg8::gemm_phase(ldsl, S, E); }
        { pg8::DenseProb S{HS, WS_D_T, EDIM, {}}; S.ord.init(NTOK, D, G, bx); pg8::EpiF32ResB E{out, D, X2B, ALPHA}; pg8::gemm_phase(ldsl, S, E); }
    }
    SEAM(21);
    if (IN(22)) {
        for (int n = gw; n < NTOK; n += NGW) {
            float v[16];
            float* orow = out + (size_t)n * D;
#pragma unroll
            for (int j = 0; j < 2; ++j) { const f32x4 a = *(const f32x4*)(orow + 512 * j + 8 * lane), b = *(const f32x4*)(orow + 512 * j + 8 * lane + 4);
#pragma unroll
                for (int q = 0; q < 4; ++q) { v[8 * j + q] = a[q]; v[8 * j + 4 + q] = b[q]; } }
            int yr[8]; float gk[8];
#pragma unroll
            for (int k = 0; k < 8; ++k) { yr[k] = YROW[n * 8 + k]; gk[k] = GATE[n * 8 + k]; }
#pragma unroll
            for (int k = 0; k < 8; ++k) {
                const bf16_t* yrow = YY + (size_t)yr[k] * D;
#pragma unroll
                for (int j = 0; j < 2; ++j) { const u32x4 w = *(const u32x4*)(yrow + 512 * j + 8 * lane);
#pragma unroll
                    for (int q = 0; q < 4; ++q) { v[8 * j + 2 * q] += gk[k] * __builtin_bit_cast(float, w[q] << 16); v[8 * j + 2 * q + 1] += gk[k] * __builtin_bit_cast(float, w[q] & 0xffff0000u); } }
            }
            float s = 0.f;
#pragma unroll
            for (int i = 0; i < 16; ++i) s += v[i];
            const float mean = wave_sum(s) * (1.f / D); float s2 = 0.f;
#pragma unroll
            for (int i = 0; i < 16; ++i) { v[i] -= mean; s2 += v[i] * v[i]; }
            const float rstd = 1.f / sqrtf(wave_sum(s2) * (1.f / D) + LN_EPS);
#pragma unroll
            for (int j = 0; j < 2; ++j) {
                const f32x4 g0 = *(const f32x4*)(ln3_g + 512 * j + 8 * lane), g1 = *(const f32x4*)(ln3_g + 512 * j + 8 * lane + 4);
                const f32x4 b0 = *(const f32x4*)(ln3_b + 512 * j + 8 * lane), b1 = *(const f32x4*)(ln3_b + 512 * j + 8 * lane + 4);
                f32x4 o0, o1;
#pragma unroll
                for (int q = 0; q < 4; ++q) { o0[q] = v[8 * j + q] * rstd * g0[q] + b0[q]; o1[q] = v[8 * j + 4 + q] * rstd * g1[q] + b1[q]; }
                *(f32x4*)(orow + 512 * j + 8 * lane) = o0; *(f32x4*)(orow + 512 * j + 8 * lane + 4) = o1;
            }
        }
    }
#undef IN
#undef SEAM
}

#ifndef PHASE_MASK
#define PHASE_MASK 0x7FFFFFu
#endif
#ifndef ONE_LAUNCH
#define ONE_LAUNCH 1
#endif

extern "C" void kernel_launch(void* const* d_in, const int* in_sizes, int n_in, void* d_out, int out_size, void* d_ws, size_t ws_size, hipStream_t stream) {
    static int grid = 0;
    if (grid == 0) {
        if (n_in != 34 || out_size != NTOK * D || ws_size < WS_END) { fprintf(stderr, "kernel_launch: unexpected shapes (n_in %d out %d ws %zu)\n", n_in, out_size, ws_size); grid = -1; return; }
        int dev = 0, cus = 0;
        if (hipGetDevice(&dev) != hipSuccess || hipDeviceGetAttribute(&cus, hipDeviceAttributeMultiprocessorCount, dev) != hipSuccess) { grid = -1; return; }
        if (hipFuncSetAttribute((const void*)mega, hipFuncAttributeMaxDynamicSharedMemorySize, LDS_BYTES) != hipSuccess) { fprintf(stderr, "kernel_launch: hipFuncSetAttribute failed\n"); grid = -1; return; }
        (void)hipGetLastError();
        grid = cus;
    }
    if (grid < 0) return;
    (void)hipMemsetAsync((char*)d_ws + WS_CTL, 0, CTL_ZERO_BYTES, stream);
    Args a{};
    for (int i = 0; i < 34; ++i) a.in[i] = (const float*)d_in[i];
    a.out = (float*)d_out; a.ws = (unsigned char*)d_ws;
#if ONE_LAUNCH
    a.ph_lo = 0; a.ph_hi = NPHASES;
    hipLaunchKernelGGL(mega, dim3(grid), dim3(NTHREADS), LDS_BYTES, stream, a);
#else
    for (int p = 0; p < NPHASES; ++p) { if (!((PHASE_MASK >> p) & 1)) continue; a.ph_lo = p; a.ph_hi = p + 1; hipLaunchKernelGGL(mega, dim3(grid), dim3(NTHREADS), LDS_BYTES, stream, a); }
#endif
}
```

```cpp
#include <hip/hip_runtime.h>
#include <cstdio>
#include <cstdint>

constexpr int D = 1024, BATCH = 4, SEQ = 8192, NTOK = BATCH * SEQ;
constexpr int MEMT = 256;
constexpr int RW = 512, RCOLS = 1792, INCOLS = 2560;
constexpr int C_R = 0, C_K = 512, C_V = 1024, C_WD = 1536, C_AD = 1600, C_GD = 1664, C_Q = 1792, C_KS = 2304, C_VS = 2432;
constexpr int NEXP = 256, TOPK = 8, EDIM = 256;
constexpr int NK = NTOK * TOPK;
constexpr int CH = 128, NCH = SEQ / CH;
constexpr int MOE_TR = 256;
constexpr int PMAX = NK + NEXP * MOE_TR;
constexpr float LN_EPS = 1e-5f, GN_EPS = 64e-5f;
constexpr float ALPHA = 1.189207115002721f;

constexpr size_t MiB = 1u << 20;
constexpr size_t WS_CTL = 0, CTL_ZERO_BYTES = 64 * 1024;
constexpr size_t WS_TEXP = 512 * 1024;
constexpr size_t WS_ROPE = 1 * MiB;
constexpr size_t WS_EIDX = 9 * MiB, WS_GATE = 10 * MiB, WS_POS = 11 * MiB, WS_YROW = 12 * MiB;
constexpr size_t WS_STOK = 13 * MiB, WS_SGATE = 14 * MiB + 512 * 1024;
constexpr size_t WS_WIN = 16 * MiB, WS_WO = 21 * MiB, WS_WMQ = 23 * MiB, WS_WMKV = 25 * MiB, WS_WMO = 29 * MiB, WS_WSGU = 31 * MiB, WS_WSD = 32 * MiB;
constexpr size_t WS_MEMB = 36 * MiB;
constexpr size_t WS_WED = 40 * MiB;
constexpr size_t WS_WEGU = 168 * MiB;
constexpr size_t WS_XB = 424 * MiB;
constexpr size_t WS_U = 490 * MiB;
constexpr size_t WS_LRB = 650 * MiB;
constexpr size_t WS_DWAG = 666 * MiB;
constexpr size_t WS_YLOC = 762 * MiB;
constexpr size_t WS_ZB = 826 * MiB;
constexpr size_t WS_PT = 858 * MiB;
constexpr size_t WS_SLT = 424 * MiB;
constexpr size_t WS_SIN = 456 * MiB;
constexpr size_t WS_BONUS = 472 * MiB;
constexpr size_t WS_WLR = 33 * MiB;
constexpr size_t WS_MIX = 874 * MiB;
constexpr size_t WS_X1 = 424 * MiB;
constexpr size_t WS_X1B = 552 * MiB;
constexpr size_t WS_QM = 616 * MiB;
constexpr size_t WS_KVM = 744 * MiB;
constexpr size_t WS_SC = 752 * MiB;
constexpr size_t WS_OM = 880 * MiB;
constexpr size_t WS_X2B = 680 * MiB;
constexpr size_t WS_LOG = 490 * MiB;
constexpr size_t WS_H = 768 * MiB;
constexpr size_t WS_HS = 928 * MiB;
constexpr size_t WS_Y = 168 * MiB;
constexpr size_t WS_END = 944 * MiB;
constexpr int CW_CNT = 0, CW_OFF = 512, CW_NT = 1024, CW_CST = 1280, CW_BAR = 4096;

constexpr int NTHREADS = 512, NWAVES = 8;
constexpr int LDS_BYTES = 147456;
constexpr int MISC_OFF = 140 * 1024;

#define LAS __attribute__((address_space(3)))
typedef float f32x4 __attribute__((ext_vector_type(4)));
typedef float f32x16 __attribute__((ext_vector_type(16)));

#define XB_TMO      128
#define XB_XCNT(j)  (256  + 64 * (j))
#define XB_XSUB(j)  (1280 + 64 * (j))
#define XB_XGEN(j)  (2304 + 64 * (j))
#define XB_TOP      3328
#define XB_TOPGEN   3392
#define XCD_BAR_WORDS 3456
#define XB_SPIN_CAP (1u << 18)
__device__ __forceinline__ unsigned xb_ld(unsigned* p)              { return __hip_atomic_load(p, __ATOMIC_RELAXED, __HIP_MEMORY_SCOPE_AGENT); }
__device__ __forceinline__ unsigned xb_add(unsigned* p, unsigned v) { return __hip_atomic_fetch_add(p, v, __ATOMIC_RELAXED, __HIP_MEMORY_SCOPE_AGENT); }
__device__ __forceinline__ unsigned xb_xcc_id() { return (unsigned)__builtin_amdgcn_s_getreg((3 << 11) | 20) & 0xFu; }
#define XB_SPIN(cond, bar) do { unsigned _sp = 0; while (cond) { __builtin_amdgcn_s_sleep(1); \
    if ((++_sp & 255u) == 0u) { if (xb_ld(&(bar)[XB_TMO])) break; if (_sp > XB_SPIN_CAP) { atomicAdd(&(bar)[XB_TMO], 1u); break; } } } } while (0)
struct XcdBarrier { unsigned* bar; unsigned x; volatile LAS unsigned* st; };
__device__ __forceinline__ XcdBarrier xcd_barrier_post(unsigned* bar, volatile LAS unsigned* st) {
    XcdBarrier b; b.bar = bar; b.x = xb_xcc_id(); b.st = st;
    if (threadIdx.x == 0) (void)xb_add(&bar[XB_XCNT(b.x)], 1u);
    return b;
}
__device__ __forceinline__ void xcd_barrier_complete(unsigned* bar, unsigned x, unsigned& nloc, unsigned& nx) {
    const unsigned G = gridDim.x * gridDim.y * gridDim.z;
    unsigned sum, cnt, mine, sp = 0u;
    for (;;) {
        sum = 0u; cnt = 0u; mine = 0u;
#pragma unroll
        for (unsigned j = 0; j < 16; ++j) { const unsigned c = xb_ld(&bar[XB_XCNT(j)]); sum += c; cnt += (c > 0u) ? 1u : 0u; mine = (j == x) ? c : mine; }
        if (sum == G) break;
        __builtin_amdgcn_s_sleep(1);
        if ((++sp & 255u) == 0u) { if (xb_ld(&bar[XB_TMO])) break; if (sp > XB_SPIN_CAP) { atomicAdd(&bar[XB_TMO], 1u); break; } }
    }
    nloc = mine > 0u ? mine : 1u; nx = cnt > 0u ? cnt : 1u;
}
__device__ __forceinline__ void xcd_barrier(const XcdBarrier& b) {
    asm volatile("s_waitcnt vmcnt(0)" ::: "memory");
    __syncthreads();
    if (threadIdx.x == 0) {
        unsigned* bar = b.bar;
        __builtin_amdgcn_s_waitcnt(0);
        unsigned nloc = b.st[0], nx = b.st[1];
        if (nloc == 0u) { xcd_barrier_complete(bar, b.x, nloc, nx); b.st[0] = nloc; b.st[1] = nx; }
        const unsigned old = xb_add(&bar[XB_XSUB(b.x)], 1u);
        const unsigned gen = old / nloc;
        if (old + 1u == (gen + 1u) * nloc) {
            __builtin_amdgcn_fence(__ATOMIC_RELEASE, "agent");
            asm volatile("s_waitcnt vmcnt(0)" ::: "memory");
            const unsigned og = xb_add(&bar[XB_TOP], 1u);
            const unsigned tg = og / nx;
            if (og + 1u == (tg + 1u) * nx) xb_add(&bar[XB_TOPGEN], 1u);
            else XB_SPIN(xb_ld(&bar[XB_TOPGEN]) == tg, bar);
            __builtin_amdgcn_fence(__ATOMIC_ACQUIRE, "agent");
            xb_add(&bar[XB_XGEN(b.x)], 1u);
            asm volatile("s_waitcnt vmcnt(0)" ::: "memory");
        } else {
            XB_SPIN(xb_ld(&bar[XB_XGEN(b.x)]) == gen, bar);
            __builtin_amdgcn_fence(__ATOMIC_ACQUIRE, "agent");
            asm volatile("s_waitcnt vmcnt(0)" ::: "memory");
        }
    }
    __syncthreads();
}

namespace pg8 {
#define PG8_LAS __attribute__((address_space(3)))
typedef unsigned short bf16_t;
typedef short bf16x8 __attribute__((ext_vector_type(8)));
typedef float f32x4 __attribute__((ext_vector_type(4)));
typedef float f32x2 __attribute__((ext_vector_type(2)));
typedef unsigned u32x4 __attribute__((ext_vector_type(4)));
constexpr int BM = 256, BK = 64, HALF = 128, HTB = HALF * BK * 2, STAGE_BYTES = 8 * HTB, NXCD = 8, WGM = 8;
__host__ __device__ __forceinline__ int lds_byte(int r, int c) { const int st = (r >> 4) * 2 + (c >> 5), rr = r & 15, cc = c & 31, ob = rr * 64 + cc * 2; return st * 1024 + (ob ^ (((ob >> 9) & 1) << 5)); }
__host__ __device__ __forceinline__ void stage_rc(int b, int& R, int& C) { const int st = b / 1024, sb = b % 1024, swz = sb ^ (((sb >> 9) & 1) << 5); R = (st >> 1) * 16 + swz / 64; C = (st & 1) * 32 + (swz % 64) / 2; }
__host__ __device__ __forceinline__ int perm32(int rho) { const int n = rho >> 4, i = rho & 15; return 8 * (i >> 2) + 4 * n + (i & 3); }
__device__ __forceinline__ unsigned cvt_pk_bf16(float lo, float hi) { unsigned r; asm volatile("v_cvt_pk_bf16_f32 %0, %1, %2" : "=v"(r) : "v"(lo), "v"(hi)); return r; }

struct Unit { int pm, pn, e; };
struct StaticOrder {
    int nM, nN, nwg, G, c;
    __host__ __device__ void init(int M, int N, int G_, int c_) { nM = M / BM; nN = N / BM; nwg = nM * nN; G = G_; c = c_; }
    __host__ __device__ bool next(int i, Unit& u) const {
        const long L = (long)i * G + c; if (L >= nwg) return false;
        int wgid = (int)L; { const int q = nwg / NXCD, r = nwg % NXCD, xcd = wgid % NXCD, off = wgid / NXCD; wgid = (xcd < r ? xcd * (q + 1) : r * (q + 1) + (xcd - r) * q) + off; }
        const int nig = WGM * nN, gid = wgid / nig, fm = gid * WGM, gsz = (nM - fm) < WGM ? (nM - fm) : WGM;
        u.pm = fm + ((wgid % nig) % gsz); u.pn = (wgid % nig) / gsz; u.e = 0; return true;
    }
};
struct DenseProb {
    const bf16_t* A; const bf16_t* Bt; int K; StaticOrder ord;
    __device__ __forceinline__ bool next(int i, Unit& u) const { return ord.next(i, u); }
    __device__ __forceinline__ const char* a_base(const Unit& u) const { return (const char*)A + (size_t)u.pm * BM * K * 2; }
    __device__ __forceinline__ const char* b_base(const Unit& u) const { return (const char*)Bt + (size_t)u.pn * BM * K * 2; }
    __device__ __forceinline__ void a_offs(const Unit&, unsigned (&v)[2][2], const int (&R)[2], const int (&C)[2]) const {
#pragma unroll
        for (int h = 0; h < 2; ++h)
#pragma unroll
            for (int i = 0; i < 2; ++i) v[h][i] = (unsigned)((h * HALF + R[i]) * K + C[i]) * 2u;
    }
};
struct GatherProb {
    const bf16_t* X; const int* stok; const bf16_t* Bt; const int* texp; int K, nN, nunits, G, c; size_t estride;
    __device__ __forceinline__ bool next(int i, Unit& u) const {
        const int per = (nunits + G - 1) / G; const long L = (long)c * per + i; if (i >= per || L >= nunits) return false;
        u.pm = (int)(L / nN); u.pn = (int)(L % nN); u.e = texp[u.pm]; return true;
    }
    __device__ __forceinline__ const char* a_base(const Unit&) const { return (const char*)X; }
    __device__ __forceinline__ const char* b_base(const Unit& u) const { return (const char*)Bt + (size_t)u.e * estride + (size_t)u.pn * BM * K * 2; }
    __device__ __forceinline__ void a_offs(const Unit& u, unsigned (&v)[2][2], const int (&R)[2], const int (&C)[2]) const {
#pragma unroll
        for (int h = 0; h < 2; ++h)
#pragma unroll
            for (int i = 0; i < 2; ++i) { const int tok = stok[u.pm * BM + h * HALF + R[i]]; v[h][i] = (unsigned)(tok * K + C[i]) * 2u; }
    }
};
struct GroupedProb {
    const bf16_t* A; const bf16_t* Bt; const int* texp; int K, nN, nunits, G, c; size_t estride;
    __device__ __forceinline__ bool next(int i, Unit& u) const {
        const int per = (nunits + G - 1) / G; const long L = (long)c * per + i; if (i >= per || L >= nunits) return false;
        u.pm = (int)(L / nN); u.pn = (int)(L % nN); u.e = texp[u.pm]; return true;
    }
    __device__ __forceinline__ const char* a_base(const Unit& u) const { return (const char*)A + (size_t)u.pm * BM * K * 2; }
    __device__ __forceinline__ const char* b_base(const Unit& u) const { return (const char*)Bt + (size_t)u.e * estride + (size_t)u.pn * BM * K * 2; }
    __device__ __forceinline__ void a_offs(const Unit&, unsigned (&v)[2][2], const int (&R)[2], const int (&C)[2]) const {
#pragma unroll
        for (int h = 0; h < 2; ++h)
#pragma unroll
            for (int i = 0; i < 2; ++i) v[h][i] = (unsigned)((h * HALF + R[i]) * K + C[i]) * 2u;
    }
};

struct EpiBf16 {
    static constexpr bool PERM = true;
    bf16_t* O; int ldc;
    __device__ __forceinline__ void operator()(const f32x4 (&acc)[2][2][4][2], const Unit& u, int wr, int wc, int fr, int fq) const {
        const int row0 = u.pm * BM + wr * 64 + fr, col0 = u.pn * BM + wc * 32 + 8 * fq;
#pragma unroll
        for (int ai = 0; ai < 2; ++ai)
#pragma unroll
            for (int m = 0; m < 4; ++m) { bf16_t* rowp = O + (size_t)(row0 + ai * HALF + m * 16) * ldc + col0;
#pragma unroll
                for (int bj = 0; bj < 2; ++bj) { const f32x4 v0 = acc[ai][bj][m][0], v1 = acc[ai][bj][m][1];
                    u32x4 w; w.x = cvt_pk_bf16(v0[0], v0[1]); w.y = cvt_pk_bf16(v0[2], v0[3]); w.z = cvt_pk_bf16(v1[0], v1[1]); w.w = cvt_pk_bf16(v1[2], v1[3]);
                    *(u32x4*)(rowp + bj * HALF) = w; } }
    }
};
struct EpiF32Res {
    static constexpr bool PERM = false;
    float* C; int ldc; const float* base; float alpha;
    __device__ __forceinline__ void operator()(const f32x4 (&acc)[2][2][4][2], const Unit& u, int wr, int wc, int fr, int fq) const {
        const int row0 = u.pm * BM + wr * 64 + fr, col0 = u.pn * BM + wc * 32 + 4 * fq;
#pragma unroll
        for (int ai = 0; ai < 2; ++ai)
#pragma unroll
            for (int m = 0; m < 4; ++m) { const size_t off = (size_t)(row0 + ai * HALF + m * 16) * ldc + col0;
#pragma unroll
                for (int bj = 0; bj < 2; ++bj)
#pragma unroll
                    for (int n = 0; n < 2; ++n) { f32x4 o = acc[ai][bj][m][n];
                        if (base) o += *(const f32x4*)(base + off + bj * HALF + n * 16) * alpha;
                        *(f32x4*)(C + off + bj * HALF + n * 16) = o; } }
    }
};

struct EpiF32ResB {
    static constexpr bool PERM = false;
    float* C; int ldc; const bf16_t* base; float alpha;
    __device__ __forceinline__ void operator()(const f32x4 (&acc)[2][2][4][2], const Unit& u, int wr, int wc, int fr, int fq) const {
        typedef unsigned u32x2v __attribute__((ext_vector_type(2)));
        const int row0 = u.pm * BM + wr * 64 + fr, col0 = u.pn * BM + wc * 32 + 4 * fq;
#pragma unroll
        for (int ai = 0; ai < 2; ++ai)
#pragma unroll
            for (int m = 0; m < 4; ++m) { const size_t off = (size_t)(row0 + ai * HALF + m * 16) * ldc + col0;
#pragma unroll
                for (int bj = 0; bj < 2; ++bj)
#pragma unroll
                    for (int n = 0; n < 2; ++n) { f32x4 o = acc[ai][bj][m][n];
                        const u32x2v w = *(const u32x2v*)(base + off + bj * HALF + n * 16);
                        o[0] += alpha * __builtin_bit_cast(float, w.x << 16); o[1] += alpha * __builtin_bit_cast(float, w.x & 0xffff0000u);
                        o[2] += alpha * __builtin_bit_cast(float, w.y << 16); o[3] += alpha * __builtin_bit_cast(float, w.y & 0xffff0000u);
                        *(f32x4*)(C + off + bj * HALF + n * 16) = o; } }
    }
};
struct EpiSwiGLU {
    static constexpr bool PERM = true;
    bf16_t* O; int ldc;
    __device__ __forceinline__ void operator()(const f32x4 (&acc)[2][2][4][2], const Unit& u, int wr, int wc, int fr, int fq) const {
        const int row0 = u.pm * BM + wr * 64 + fr, col0 = u.pn * HALF + wc * 32 + 8 * fq;
#pragma unroll
        for (int ai = 0; ai < 2; ++ai)
#pragma unroll
            for (int m = 0; m < 4; ++m) { bf16_t* rowp = O + (size_t)(row0 + ai * HALF + m * 16) * ldc + col0;
                float h[8];
#pragma unroll
                for (int n = 0; n < 2; ++n)
#pragma unroll
                    for (int q = 0; q < 4; ++q) { const float g = acc[ai][0][m][n][q], up = acc[ai][1][m][n][q]; h[4 * n + q] = g * __builtin_amdgcn_rcpf(1.f + __expf(-g)) * up; }
                u32x4 w; w.x = cvt_pk_bf16(h[0], h[1]); w.y = cvt_pk_bf16(h[2], h[3]); w.z = cvt_pk_bf16(h[4], h[5]); w.w = cvt_pk_bf16(h[6], h[7]);
                *(u32x4*)rowp = w; }
    }
};
struct EpiScaleY {
    static constexpr bool PERM = true;
    bf16_t* Y; const float* sgate; const unsigned* off; const unsigned* cnt; const unsigned* cst;
    __device__ __forceinline__ void operator()(const f32x4 (&acc)[2][2][4][2], const Unit& u, int wr, int wc, int fr, int fq) const {
        const int o0 = (int)off[u.e], nreal = (int)cnt[u.e], c0 = (int)cst[u.e];
        const int row0 = u.pm * BM + wr * 64 + fr, col0 = u.pn * BM + wc * 32 + 8 * fq;
#pragma unroll
        for (int ai = 0; ai < 2; ++ai)
#pragma unroll
            for (int m = 0; m < 4; ++m) { const int p = row0 + ai * HALF + m * 16, rel = p - o0;
                if (rel < nreal) { bf16_t* rowp = Y + (size_t)(c0 + rel) * 1024 + col0;
#pragma unroll
                    for (int bj = 0; bj < 2; ++bj) { const f32x4 v0 = acc[ai][bj][m][0], v1 = acc[ai][bj][m][1];
                        u32x4 w; w.x = cvt_pk_bf16(v0[0], v0[1]); w.y = cvt_pk_bf16(v0[2], v0[3]); w.z = cvt_pk_bf16(v1[0], v1[1]); w.w = cvt_pk_bf16(v1[2], v1[3]);
                        *(u32x4*)(rowp + bj * HALF) = w; } } }
    }
};

template <class Epi, class Prob>
__device__ __forceinline__ void gemm_phase(PG8_LAS unsigned char* lds, const Prob& S, const Epi& E) {
    int tid = threadIdx.x; asm volatile("" : "+v"(tid));
    const int wid = __builtin_amdgcn_readfirstlane(tid >> 6), lane = tid & 63, wr = wid >> 2, wc = wid & 3, fr = lane & 15, fq = lane >> 4;
    const int K = S.K, nt = K / BK;
    int Rr[2], Cc[2]; unsigned voffB[2];
#pragma unroll
    for (int i = 0; i < 2; ++i) { int R, C; stage_rc(tid * 16 + i * 8192, R, C); const int Rb = Epi::PERM ? ((R & ~31) + perm32(R & 31)) : R;
        Rr[i] = R; Cc[i] = C; voffB[i] = (unsigned)(Rb * K + C) * 2u; }
    const size_t kstep = (size_t)(BK * 2);
    const size_t hstep = (size_t)HALF * K * 2;
    const unsigned ldsw = (unsigned)wid * 1024u;
    const int aoff = lds_byte(wr * 64 + fr, fq * 8), boff = lds_byte(wc * 32 + fr, fq * 8);
#define PG8_SA(b, h) (((b) * 2 + (h)) * HTB)
#define PG8_SB(b, h) ((4 + (b) * 2 + (h)) * HTB)
#define PG8_STAGE(bufoff, gbase, voff) do { _Pragma("unroll") for (int _i = 0; _i < 2; ++_i) \
        __builtin_amdgcn_global_load_lds((const unsigned*)((const char*)(gbase) + (voff)[_i]), (PG8_LAS unsigned*)(lds + (bufoff) + ldsw + _i * 8192), 16, 0, 0); } while (0)
#define PG8_LDA(dst, b, h) do { _Pragma("unroll") for (int m = 0; m < 4; ++m) _Pragma("unroll") for (int k = 0; k < 2; ++k) dst[m][k] = *(const PG8_LAS bf16x8*)(lds + PG8_SA(b, h) + aoff + m * 2048 + k * 1024); } while (0)
#define PG8_LDB(dst, b, h) do { _Pragma("unroll") for (int n = 0; n < 2; ++n) _Pragma("unroll") for (int k = 0; k < 2; ++k) dst[n][k] = *(const PG8_LAS bf16x8*)(lds + PG8_SB(b, h) + boff + n * 2048 + k * 1024); } while (0)
#define PG8_MMA(ai, bj, At, Bt) do { __builtin_amdgcn_s_setprio(1); _Pragma("unroll") for (int m = 0; m < 4; ++m) _Pragma("unroll") for (int n = 0; n < 2; ++n) _Pragma("unroll") for (int k = 0; k < 2; ++k) \
        acc[ai][bj][m][n] = __builtin_amdgcn_mfma_f32_16x16x32_bf16(Bt[n][k], At[m][k], acc[ai][bj][m][n], 0, 0, 0); __builtin_amdgcn_s_setprio(0); } while (0)
#define PG8_WAIT_V(n) asm volatile("s_waitcnt vmcnt(" #n ")" ::: "memory")
#define PG8_WAIT_L(n) asm volatile("s_waitcnt lgkmcnt(" #n ")" ::: "memory")
#define PG8_BAR __builtin_amdgcn_s_barrier()
#define PG8_SCHED __builtin_amdgcn_sched_barrier(0)
    Unit cur, nxt; int ui = 0;
    if (!S.next(0, cur)) return;
    f32x4 acc[2][2][4][2];
#pragma unroll
    for (int a = 0; a < 2; ++a)
#pragma unroll
        for (int b = 0; b < 2; ++b)
#pragma unroll
            for (int m = 0; m < 4; ++m)
#pragma unroll
                for (int n = 0; n < 2; ++n) acc[a][b][m][n] = (f32x4){0.f, 0.f, 0.f, 0.f};
    bf16x8 At[4][2], B0[2][2], B1[2][2];
    const char* cA = S.a_base(cur); const char* cB = S.b_base(cur);
    unsigned vA[2][2], nvA[2][2];
    S.a_offs(cur, vA, Rr, Cc);
    PG8_STAGE(PG8_SB(0, 0), cB, voffB); PG8_STAGE(PG8_SA(0, 0), cA, vA[0]); PG8_STAGE(PG8_SB(0, 1), cB + hstep, voffB); PG8_STAGE(PG8_SA(0, 1), cA, vA[1]);
    if (wr == 1) PG8_BAR;
    PG8_WAIT_V(4); PG8_BAR;
    PG8_STAGE(PG8_SB(1, 0), cB + kstep, voffB); PG8_STAGE(PG8_SA(1, 0), cA + kstep, vA[0]); PG8_STAGE(PG8_SB(1, 1), cB + hstep + kstep, voffB);
    PG8_WAIT_V(6); PG8_BAR;
    for (;;) {
        const bool has_next = S.next(ui + 1, nxt);
        const char* nA = has_next ? S.a_base(nxt) : cA; const char* nB = has_next ? S.b_base(nxt) : cB;
        if (has_next) S.a_offs(nxt, nvA, Rr, Cc);
        else {
#pragma unroll
            for (int h = 0; h < 2; ++h)
#pragma unroll
                for (int i = 0; i < 2; ++i) nvA[h][i] = vA[h][i];
        }
        for (int t = 0; t < nt; t += 2) {
            const bool last = (t == nt - 2);
            const char* a1 = cA + (size_t)(t + 1) * kstep;
            const char* a2 = last ? nA : cA + (size_t)(t + 2) * kstep; const char* b2 = last ? nB : cB + (size_t)(t + 2) * kstep;
            const char* a3 = a2 + kstep; const char* b3 = b2 + kstep;
            unsigned v2[2][2];
#pragma unroll
            for (int h = 0; h < 2; ++h)
#pragma unroll
                for (int i = 0; i < 2; ++i) v2[h][i] = last ? nvA[h][i] : vA[h][i];
            PG8_LDB(B0, 0, 0); PG8_SCHED; PG8_LDA(At, 0, 0); PG8_STAGE(PG8_SA(1, 1), a1, vA[1]);
            PG8_WAIT_L(8); PG8_BAR; PG8_WAIT_L(0); PG8_MMA(0, 0, At, B0); PG8_BAR; PG8_SCHED;
            PG8_LDB(B1, 0, 1); PG8_STAGE(PG8_SB(0, 0), b2, voffB);
            PG8_BAR; PG8_WAIT_L(0); PG8_MMA(0, 1, At, B1); PG8_BAR;
            PG8_LDA(At, 0, 1); PG8_STAGE(PG8_SA(0, 0), a2, v2[0]);
            PG8_BAR; PG8_WAIT_L(0); PG8_MMA(1, 0, At, B0); PG8_BAR; PG8_SCHED;
            PG8_STAGE(PG8_SB(0, 1), b2 + hstep, voffB);
            PG8_WAIT_V(6); PG8_BAR; PG8_MMA(1, 1, At, B1); PG8_BAR;
            PG8_LDB(B0, 1, 0); PG8_SCHED; PG8_LDA(At, 1, 0); PG8_STAGE(PG8_SA(0, 1), a2, v2[1]);
            PG8_WAIT_L(8); PG8_BAR; PG8_WAIT_L(0); PG8_MMA(0, 0, At, B0); PG8_BAR; PG8_SCHED;
            PG8_LDB(B1, 1, 1); PG8_STAGE(PG8_SB(1, 0), b3, voffB);
            PG8_BAR; PG8_WAIT_L(0); PG8_MMA(0, 1, At, B1); PG8_BAR;
            PG8_LDA(At, 1, 1); PG8_STAGE(PG8_SA(1, 0), a3, v2[0]);
            PG8_BAR; PG8_WAIT_L(0); PG8_MMA(1, 0, At, B0); PG8_BAR; PG8_SCHED;
            PG8_STAGE(PG8_SB(1, 1), b3 + hstep, voffB);
            PG8_WAIT_V(6); PG8_BAR; PG8_MMA(1, 1, At, B1); PG8_BAR;
        }
        E(acc, cur, wr, wc, fr, fq);
        if (!has_next) break;
#pragma unroll
        for (int a = 0; a < 2; ++a)
#pragma unroll
            for (int b = 0; b < 2; ++b)
#pragma unroll
                for (int m = 0; m < 4; ++m)
#pragma unroll
                    for (int n = 0; n < 2; ++n) acc[a][b][m][n] = (f32x4){0.f, 0.f, 0.f, 0.f};
        cur = nxt; cA = nA; cB = nB; ++ui;
#pragma unroll
        for (int h = 0; h < 2; ++h)
#pragma unroll
            for (int i = 0; i < 2; ++i) vA[h][i] = nvA[h][i];
    }
    PG8_WAIT_V(0);
    if (wr == 0) PG8_BAR;
    PG8_BAR;
#undef PG8_SA
#undef PG8_SB
#undef PG8_STAGE
#undef PG8_LDA
#undef PG8_LDB
#undef PG8_MMA
#undef PG8_WAIT_V
#undef PG8_WAIT_L
#undef PG8_BAR
#undef PG8_SCHED
}
}

__device__ __forceinline__ float wave_sum(float v) {
#pragma unroll
    for (int o = 1; o < 64; o <<= 1) v += __shfl_xor(v, o);
    return v;
}
__device__ __forceinline__ float sigmoidf_(float x) { return 1.0f / (1.0f + expf(-x)); }
__device__ __forceinline__ float wave_sum_dpp(float v) {
    v += __builtin_bit_cast(float, __builtin_amdgcn_update_dpp(0, __builtin_bit_cast(int, v), 0xB1, 0xF, 0xF, false));
    v += __builtin_bit_cast(float, __builtin_amdgcn_update_dpp(0, __builtin_bit_cast(int, v), 0x4E, 0xF, 0xF, false));
    v += __builtin_bit_cast(float, __builtin_amdgcn_update_dpp(0, __builtin_bit_cast(int, v), 0x124, 0xF, 0xF, false));
    v += __builtin_bit_cast(float, __builtin_amdgcn_update_dpp(0, __builtin_bit_cast(int, v), 0x128, 0xF, 0xF, false));
    const int vi = __builtin_bit_cast(int, v);
    const float r0 = __builtin_bit_cast(float, __builtin_amdgcn_readlane(vi, 0)), r1 = __builtin_bit_cast(float, __builtin_amdgcn_readlane(vi, 16));
    const float r2 = __builtin_bit_cast(float, __builtin_amdgcn_readlane(vi, 32)), r3 = __builtin_bit_cast(float, __builtin_amdgcn_readlane(vi, 48));
    return (r0 + r1) + (r2 + r3);
}
__device__ __forceinline__ float fma1(float a, float b, float c) { float d; asm("v_fma_f32 %0, %1, %2, %3" : "=v"(d) : "v"(a), "v"(b), "v"(c)); return d; }
__device__ __forceinline__ float mul1(float a, float b) { float d; asm("v_mul_f32 %0, %1, %2" : "=v"(d) : "v"(a), "v"(b)); return d; }
__device__ __forceinline__ void sa4(float& sa0, float& sa1, const float (&s0)[4], const float (&s1)[4], const f32x4 a) {
    asm("v_fmac_f32 %0, %2, %10\n\tv_fmac_f32 %1, %6, %10\n\tv_fmac_f32 %0, %3, %11\n\tv_fmac_f32 %1, %7, %11\n\tv_fmac_f32 %0, %4, %12\n\tv_fmac_f32 %1, %8, %12\n\tv_fmac_f32 %0, %5, %13\n\tv_fmac_f32 %1, %9, %13"
        : "+v"(sa0), "+v"(sa1) : "v"(s0[0]), "v"(s0[1]), "v"(s0[2]), "v"(s0[3]), "v"(s1[0]), "v"(s1[1]), "v"(s1[2]), "v"(s1[3]), "v"(a[0]), "v"(a[1]), "v"(a[2]), "v"(a[3]));
}
__device__ __forceinline__ void upd1(float& s0, float& s1, float& y0, float& y1, float w, float b, float k, float r, float sa0, float sa1, float vq) {
    float t0, t1;
    asm("v_mul_f32 %4, %11, %7\n\tv_mul_f32 %5, %10, %6\n\tv_fmac_f32 %4, %9, %6\n\tv_fma_f32 %1, %1, %12, %5\n\tv_fma_f32 %0, %0, %12, %4\n\tv_fmac_f32 %3, %1, %8\n\tv_fmac_f32 %2, %0, %8"
        : "+v"(s0), "+v"(s1), "+v"(y0), "+v"(y1), "=&v"(t0), "=&v"(t1) : "v"(b), "v"(k), "v"(r), "v"(sa0), "v"(sa1), "v"(vq), "v"(w));
}

typedef unsigned short bf16_t;
typedef unsigned u32x4 __attribute__((ext_vector_type(4)));
typedef unsigned u32x2 __attribute__((ext_vector_type(2)));
__device__ __forceinline__ float bf2f(bf16_t b) { return __builtin_bit_cast(float, (unsigned)b << 16); }
__device__ __forceinline__ bf16_t f2bf(float f) { return (bf16_t)(pg8::cvt_pk_bf16(f, 0.f) & 0xffffu); }
__device__ __forceinline__ void transpose_item(const float* W, int K, int N, bf16_t* WT, int k0, int n0, int drow0, float* scr, int lane) {
#pragma unroll 8
    for (int i = 0; i < 32; ++i) { const int kk = 2 * i + (lane >> 5); scr[kk * 33 + (lane & 31)] = W[(size_t)(k0 + kk) * N + n0 + (lane & 31)]; }
    __builtin_amdgcn_wave_barrier();
    const int c = lane & 7;
#pragma unroll
    for (int j = 0; j < 4; ++j) { const int n = (lane >> 3) + 8 * j; const float* s = scr + (8 * c) * 33 + n;
        u32x4 o; o.x = pg8::cvt_pk_bf16(s[0 * 33], s[1 * 33]); o.y = pg8::cvt_pk_bf16(s[2 * 33], s[3 * 33]); o.z = pg8::cvt_pk_bf16(s[4 * 33], s[5 * 33]); o.w = pg8::cvt_pk_bf16(s[6 * 33], s[7 * 33]);
        *(u32x4*)(WT + (size_t)(drow0 + n) * K + k0 + 8 * c) = o; }
    __builtin_amdgcn_wave_barrier();
}
namespace wk {
typedef pg8::bf16x8 bf16x8;
constexpr int IMG = 8192;
__device__ __forceinline__ int ia(int row, int col) { return row * 128 + ((((col >> 3) ^ ((row >> 1) & 7))) << 4) + (col & 7) * 2; }
template <int KS>
__device__ __forceinline__ f32x16 nt_tile(f32x16 acc, const unsigned char* A, int arow0, const unsigned char* B, int brow0, int k0, int lane) {
    const int r = lane & 31, h = lane >> 5;
#pragma unroll
    for (int s = 0; s < KS; ++s) {
        const bf16x8 a = *(const bf16x8*)(A + ia(arow0 + r, k0 + 16 * s + 8 * h));
        const bf16x8 b = *(const bf16x8*)(B + ia(brow0 + r, k0 + 16 * s + 8 * h));
        acc = __builtin_amdgcn_mfma_f32_32x32x16_bf16(a, b, acc, 0, 0, 0);
    }
    return acc;
}
__device__ __forceinline__ void st_rm(const f32x16& acc, unsigned char* img, int row0, int col0, int lane) {
    const int c = lane & 31, h = lane >> 5;
#pragma unroll
    for (int r = 0; r < 16; ++r) *(bf16_t*)(img + ia(row0 + (r & 3) + 8 * (r >> 2) + 4 * h, col0 + c)) = f2bf(acc[r]);
}
__device__ __forceinline__ void st_tr(const f32x16& acc, unsigned char* img, int row0, int col0, int lane) {
    const int c = lane & 31, h = lane >> 5;
#pragma unroll
    for (int q = 0; q < 4; ++q) { u32x2 w; w.x = pg8::cvt_pk_bf16(acc[4 * q], acc[4 * q + 1]); w.y = pg8::cvt_pk_bf16(acc[4 * q + 2], acc[4 * q + 3]);
        *(u32x2*)(img + ia(row0 + c, col0 + 8 * q + 4 * h)) = w; }
}
__device__ __forceinline__ f32x16 zero16() { f32x16 z;
#pragma unroll
    for (int i = 0; i < 16; ++i) z[i] = 0.f;
    return z; }
}

struct Args {
    const float* in[34]; float* out; unsigned char* ws;
    int ph_lo, ph_hi;
};

struct GF {
    const float* A; long lda; const int* arow; int arow_lim;
    const float* B; long ldb; int bmode;
    int K;
};
template <class Epi>
__device__ __forceinline__ void gemm_f32_tile(float* lds, const GF& g, int row0, int col0, Epi&& epi) {
    float* As = lds;
    float* Bs = lds + 16 * 132;
    const int tid = threadIdx.x, lane = tid & 63, w = tid >> 6, wm = w >> 1, wn = w & 1;
    f32x16 acc0, acc1;
#pragma unroll
    for (int i = 0; i < 16; ++i) { acc0[i] = 0.f; acc1[i] = 0.f; }
    const int ar = tid >> 2, ak = (tid & 3) * 4;
    long arow_idx = row0 + ar; bool avalid = true;
    if (g.arow) { const int t = g.arow[row0 + ar]; avalid = t < g.arow_lim; arow_idx = avalid ? t : 0; }
    const float* ap = g.A + arow_idx * g.lda + ak;
    const float* bp; int bk, bn;
    if (g.bmode == 0) { bk = tid >> 5; bn = (tid & 31) * 4; bp = g.B + (long)bk * g.ldb + col0 + bn; }
    else { bn = tid >> 2; bk = (tid & 3) * 4; bp = g.B + (long)(col0 + bn) * g.ldb + bk; }
    const int hl = lane >> 5, l31 = lane & 31;
    for (int k0 = 0; k0 < g.K; k0 += 16) {
        f32x4 av = (f32x4){0.f, 0.f, 0.f, 0.f};
        if (avalid) av = *(const f32x4*)(ap + k0);
        const f32x4 bv = g.bmode == 0 ? *(const f32x4*)(bp + (long)k0 * g.ldb) : *(const f32x4*)(bp + k0);
        __syncthreads();
        As[(ak + 0) * 132 + ar] = av[0]; As[(ak + 1) * 132 + ar] = av[1]; As[(ak + 2) * 132 + ar] = av[2]; As[(ak + 3) * 132 + ar] = av[3];
        if (g.bmode == 0) *(f32x4*)&Bs[bk * 132 + bn] = bv;
        else { Bs[(bk + 0) * 132 + bn] = bv[0]; Bs[(bk + 1) * 132 + bn] = bv[1]; Bs[(bk + 2) * 132 + bn] = bv[2]; Bs[(bk + 3) * 132 + bn] = bv[3]; }
        __syncthreads();
#pragma unroll
        for (int kk = 0; kk < 16; kk += 2) {
            const float a = As[(kk + hl) * 132 + wm * 32 + l31];
            const float b0 = Bs[(kk + hl) * 132 + wn * 64 + l31];
            const float b1 = Bs[(kk + hl) * 132 + wn * 64 + 32 + l31];
            acc0 = __builtin_amdgcn_mfma_f32_32x32x2f32(a, b0, acc0, 0, 0, 0);
            acc1 = __builtin_amdgcn_mfma_f32_32x32x2f32(a, b1, acc1, 0, 0, 0);
        }
    }
#pragma unroll
    for (int r = 0; r < 16; ++r) {
        const int row = row0 + wm * 32 + (r & 3) + 8 * (r >> 2) + 4 * hl;
        const int col = col0 + wn * 64 + l31;
        epi(row, col, acc0[r]);
        epi(row, col + 32, acc1[r]);
    }
    __syncthreads();
}

__device__ __forceinline__ void ln_row(const float* a, float alpha, const float* b, float* out, const float* gam, const float* bet, int lane, bf16_t* outb = nullptr) {
    f32x4 v[4]; float s = 0.f;
#pragma unroll
    for (int j = 0; j < 4; ++j) {
        v[j] = *(const f32x4*)(a + 4 * lane + 256 * j) * alpha;
        if (b) v[j] += *(const f32x4*)(b + 4 * lane + 256 * j);
        s += (v[j][0] + v[j][1]) + (v[j][2] + v[j][3]);
    }
    const float mean = wave_sum(s) * (1.f / D); float s2 = 0.f;
#pragma unroll
    for (int j = 0; j < 4; ++j) { v[j] = v[j] - mean; s2 += (v[j][0] * v[j][0] + v[j][1] * v[j][1]) + (v[j][2] * v[j][2] + v[j][3] * v[j][3]); }
    const float rstd = 1.f / sqrtf(wave_sum(s2) * (1.f / D) + LN_EPS);
#pragma unroll
    for (int j = 0; j < 4; ++j) {
        const f32x4 gg = *(const f32x4*)(gam + 4 * lane + 256 * j), bb = *(const f32x4*)(bet + 4 * lane + 256 * j);
        const f32x4 o = v[j] * rstd * gg + bb;
        if (out) *(f32x4*)(out + 4 * lane + 256 * j) = o;
        if (outb) { u32x2 w; w.x = pg8::cvt_pk_bf16(o[0], o[1]); w.y = pg8::cvt_pk_bf16(o[2], o[3]); *(u32x2*)(outb + 4 * lane + 256 * j) = w; }
    }
}

constexpr int NPHASES = 23;

__global__ void __launch_bounds__(NTHREADS, 2) mega(Args args) {
    extern __shared__ __attribute__((aligned(16))) unsigned char lds_raw[];
    float* ldsf = (float*)lds_raw;
    const int tid = threadIdx.x, lane = tid & 63, wave = tid >> 6;
    const int G = gridDim.x, bx = blockIdx.x;
    const int gw = bx * NWAVES + wave, NGW = G * NWAVES;
    unsigned char* ws = args.ws;
    unsigned* ctl = (unsigned*)(ws + WS_CTL);
    volatile LAS unsigned* misc = (volatile LAS unsigned*)((LAS unsigned char*)lds_raw + MISC_OFF);
    if (tid < 4) misc[tid] = 0u;
    __syncthreads();
    const int lo = args.ph_lo, hi = args.ph_hi;
    const bool multi = (hi - lo) > 1;
    XcdBarrier bar; bar.bar = ctl + CW_BAR; bar.x = 0; bar.st = nullptr;
    if (multi) bar = xcd_barrier_post(ctl + CW_BAR, misc);
#define IN(k) (lo <= (k) && (k) < hi)
#define SEAM(k) do { if (IN(k) && IN((k) + 1)) xcd_barrier(bar); } while (0)

    const float* x = args.in[0]; const float* mem = args.in[1]; const int* positions = (const int*)args.in[2];
    const float* w_in = args.in[3]; const float* mu_shift = args.in[4]; const float* w_decay_up = args.in[5]; const float* w0 = args.in[6];
    const float* a_up = args.in[7]; const float* a0 = args.in[8]; const float* g_up = args.in[9]; const float* k_k = args.in[10]; const float* k_a = args.in[11];
    const float* r_k = args.in[12]; const float* lnx_g = args.in[13]; const float* lnx_b = args.in[14]; const float* sinks = args.in[15];
    const float* w_o = args.in[16]; const float* ln1_g = args.in[17]; const float* ln1_b = args.in[18];
    const float* wm_q = args.in[19]; const float* wm_kv = args.in[20]; const float* wm_o = args.in[21]; const float* ln2_g = args.in[22]; const float* ln2_b = args.in[23];
    const float* w_router = args.in[24]; const float* router_bias = args.in[25];
    const float* we_gate = args.in[26]; const float* we_up = args.in[27]; const float* we_down = args.in[28];
    const float* ws_gate = args.in[29]; const float* ws_up = args.in[30]; const float* ws_down = args.in[31];
    const float* ln3_g = args.in[32]; const float* ln3_b = args.in[33];
    float* out = args.out;

    float* ROPE_C = (float*)(ws + WS_ROPE); float* ROPE_S = ROPE_C + (size_t)NTOK * 32;
    bf16_t* W_IN_T = (bf16_t*)(ws + WS_WIN); bf16_t* W_O_T = (bf16_t*)(ws + WS_WO); bf16_t* WM_Q_T = (bf16_t*)(ws + WS_WMQ); bf16_t* WM_KV_T = (bf16_t*)(ws + WS_WMKV); bf16_t* WM_O_T = (bf16_t*)(ws + WS_WMO);
    bf16_t* XB = (bf16_t*)(ws + WS_XB); bf16_t* MEMB = (bf16_t*)(ws + WS_MEMB);
    bf16_t* U = (bf16_t*)(ws + WS_U); bf16_t* LRB = (bf16_t*)(ws + WS_LRB); bf16_t* DWAG = (bf16_t*)(ws + WS_DWAG);
    float* YLOC = (float*)(ws + WS_YLOC); bf16_t* ZB = (bf16_t*)(ws + WS_ZB); bf16_t* PT = (bf16_t*)(ws + WS_PT); float* SLT = (float*)(ws + WS_SLT); bf16_t* SIN = (bf16_t*)(ws + WS_SIN);
    float* BONUS = (float*)(ws + WS_BONUS); bf16_t* WLR_T = (bf16_t*)(ws + WS_WLR); bf16_t* W_R_T = (bf16_t*)(ws + WS_WLR + MiB);
    bf16_t* MIX = (bf16_t*)(ws + WS_MIX); float* X1 = (float*)(ws + WS_X1); bf16_t* X1B = (bf16_t*)(ws + WS_X1B);
    bf16_t* QMB = (bf16_t*)(ws + WS_QM); bf16_t* KM = (bf16_t*)(ws + WS_KVM); bf16_t* VT = (bf16_t*)(ws + WS_KVM + 2 * MiB); bf16_t* OM = (bf16_t*)(ws + WS_OM);
    float* X2 = out; bf16_t* X2B = (bf16_t*)(ws + WS_X2B); float* LOG = (float*)(ws + WS_LOG);
    int* EIDX = (int*)(ws + WS_EIDX); float* GATE = (float*)(ws + WS_GATE); int* POS = (int*)(ws + WS_POS); int* YROW = (int*)(ws + WS_YROW);
    int* STOK = (int*)(ws + WS_STOK); float* SGATE = (float*)(ws + WS_SGATE);
    bf16_t* HH = (bf16_t*)(ws + WS_H); bf16_t* HS = (bf16_t*)(ws + WS_HS); bf16_t* YY = (bf16_t*)(ws + WS_Y);
    bf16_t* WS_GU_T = (bf16_t*)(ws + WS_WSGU); bf16_t* WS_D_T = (bf16_t*)(ws + WS_WSD); bf16_t* WE_GU_T = (bf16_t*)(ws + WS_WEGU); bf16_t* WE_D_T = (bf16_t*)(ws + WS_WED);
    int* TEXP = (int*)(ws + WS_TEXP);
    PG8_LAS unsigned char* ldsl = (PG8_LAS unsigned char*)lds_raw;

    if (IN(0)) {
        for (int i = bx * NTHREADS + tid; i < NTOK * 32; i += G * NTHREADS) {
            const int n = i >> 5, f = i & 31;
            const double inv = exp(-(double)(2 * f) / 64.0 * 9.210340371976184);
            const double ang = (double)positions[n] * inv;
            ROPE_C[i] = (float)cos(ang); ROPE_S[i] = (float)sin(ang);
        }
        {
            float* scr = ldsf + wave * 4096;
            constexpr int I_IN = 16 * (INCOLS / 32), I_SQ = 16 * (D / 32), I_KV = 16 * (2048 / 32);
            constexpr int I_R = 16 * (NEXP / 32); constexpr int NIT = I_IN + 3 * I_SQ + I_KV + I_R;
            for (int it = gw; it < NIT; it += NGW) {
                int r = it;
                if (r < I_IN) { const int nb = INCOLS / 32; transpose_item(w_in, D, INCOLS, W_IN_T, 64 * (r / nb), 32 * (r % nb), 32 * (r % nb), scr, lane); continue; } r -= I_IN;
                if (r < I_SQ) { const int nb = D / 32; transpose_item(w_o, D, D, W_O_T, 64 * (r / nb), 32 * (r % nb), 32 * (r % nb), scr, lane); continue; } r -= I_SQ;
                if (r < I_SQ) { const int nb = D / 32; transpose_item(wm_q, D, D, WM_Q_T, 64 * (r / nb), 32 * (r % nb), 32 * (r % nb), scr, lane); continue; } r -= I_SQ;
                if (r < I_SQ) { const int nb = D / 32; transpose_item(wm_o, D, D, WM_O_T, 64 * (r / nb), 32 * (r % nb), 32 * (r % nb), scr, lane); continue; } r -= I_SQ;
                if (r < I_KV) { const int nb = 2048 / 32; transpose_item(wm_kv, D, 2048, WM_KV_T, 64 * (r / nb), 32 * (r % nb), 32 * (r % nb), scr, lane); continue; } r -= I_KV;
                { const int nb = NEXP / 32; transpose_item(w_router, D, NEXP, W_R_T, 64 * (r / nb), 32 * (r % nb), 32 * (r % nb), scr, lane); }
            }
        }
        for (int i = bx * NTHREADS + tid; i < 1536 * 256; i += G * NTHREADS) {
            const int n = i >> 8, k = i & 255; float v = 0.f;
            if (n < 512) { if (k < 64) v = w_decay_up[k * RW + n]; }
            else if (n < 1024) { if (k >= 64 && k < 128) v = a_up[(k - 64) * RW + (n - 512)]; }
            else { if (k >= 128) v = g_up[(k - 128) * RW + (n - 1024)]; }
            WLR_T[i] = f2bf(v);
        }
        {
            float* scr = ldsf + wave * 4096;
            const int NITE = (NEXP + 1) * 384;
            for (int it = gw; it < NITE; it += NGW) {
                const int e = it / 384, r = it % 384;
                const float* wg = e < NEXP ? we_gate + (size_t)e * D * EDIM : ws_gate; const float* wu = e < NEXP ? we_up + (size_t)e * D * EDIM : ws_up;
                const float* wd = e < NEXP ? we_down + (size_t)e * EDIM * D : ws_down;
                bf16_t* gu = e < NEXP ? WE_GU_T + (size_t)e * 512 * D : WS_GU_T; bf16_t* dt = e < NEXP ? WE_D_T + (size_t)e * D * EDIM : WS_D_T;
                if (r < 256) { const int isup = r >> 7, rr = r & 127, kb = rr >> 3, nb = rr & 7, n0 = 32 * nb;
                    transpose_item(isup ? wu : wg, D, EDIM, gu, 64 * kb, n0, (n0 >> 7) * 256 + isup * 128 + (n0 & 127), scr, lane); }
                else { const int rr = r - 256, kb = rr >> 5, nb = rr & 31;
                    transpose_item(wd, EDIM, D, dt, 64 * kb, 32 * nb, 32 * nb, scr, lane); }
            }
        }
        for (size_t i = (size_t)bx * NTHREADS + tid; i < (size_t)NTOK * D / 8; i += (size_t)G * NTHREADS) {
            const f32x4 a = *(const f32x4*)(x + i * 8), b = *(const f32x4*)(x + i * 8 + 4);
            u32x4 o; o.x = pg8::cvt_pk_bf16(a[0], a[1]); o.y = pg8::cvt_pk_bf16(a[2], a[3]); o.z = pg8::cvt_pk_bf16(b[0], b[1]); o.w = pg8::cvt_pk_bf16(b[2], b[3]);
            *(u32x4*)(XB + i * 8) = o;
        }
        for (size_t i = (size_t)bx * NTHREADS + tid; i < (size_t)BATCH * MEMT * D / 8; i += (size_t)G * NTHREADS) {
            const f32x4 a = *(const f32x4*)(mem + i * 8), b = *(const f32x4*)(mem + i * 8 + 4);
            u32x4 o; o.x = pg8::cvt_pk_bf16(a[0], a[1]); o.y = pg8::cvt_pk_bf16(a[2], a[3]); o.z = pg8::cvt_pk_bf16(b[0], b[1]); o.w = pg8::cvt_pk_bf16(b[2], b[3]);
            *(u32x4*)(MEMB + i * 8) = o;
        }
    }
    SEAM(0);
    if (IN(1)) {
        pg8::DenseProb S{XB, W_IN_T, D, {}}; S.ord.init(NTOK, INCOLS, G, bx);
        pg8::EpiBf16 E{U, INCOLS};
        pg8::gemm_phase(ldsl, S, E);
    }
    SEAM(1);
    if (IN(2)) {
        for (size_t i = (size_t)bx * NTHREADS + tid; i < (size_t)NTOK * 256; i += (size_t)G * NTHREADS) {
            const int n = (int)(i >> 8), c = (int)(i & 255), col = C_WD + c;
            const float u = bf2f(U[(size_t)n * INCOLS + col]);
            const float p = (n % SEQ) ? bf2f(U[(size_t)(n - 1) * INCOLS + col]) : 0.f;
            const float v = u + (p - u) * mu_shift[col];
            LRB[i] = f2bf(c < 64 ? tanhf(v) : (c < 128 ? v : sigmoidf_(v)));
        }
    }
    SEAM(2);
    if (IN(3)) {
        pg8::DenseProb S{LRB, WLR_T, 256, {}}; S.ord.init(NTOK, 1536, G, bx);
        pg8::EpiBf16 E{DWAG, 1536};
        pg8::gemm_phase(ldsl, S, E);
    }
    SEAM(3);
    if (IN(4)) {
        using namespace wk;
        unsigned char* L = lds_raw;
        unsigned char* sA_TM = L + 0 * IMG; unsigned char* sB_TM = L + 1 * IMG; unsigned char* sK_TM = L + 2 * IMG; unsigned char* sR_TM = L + 3 * IMG;
        unsigned char* sA_CM = L + 4 * IMG; unsigned char* sB_CM = L + 5 * IMG; unsigned char* sK_CM = L + 6 * IMG; unsigned char* sV_CM = L + 7 * IMG;
        unsigned char* sN = L + 8 * IMG; unsigned char* sNT = L + 9 * IMG; unsigned char* sAakT = L + 10 * IMG; unsigned char* sAbrT = L + 11 * IMG; unsigned char* sAkrT = L + 12 * IMG;
        unsigned char* sX = L + 13 * IMG; unsigned char* sT1 = L + 14 * IMG; unsigned char* sP1 = L + 15 * IMG; unsigned char* sSl1 = L + 16 * IMG;
        unsigned char* sMB = sA_TM; unsigned char* sMTB = sB_TM; unsigned char* sW = sA_TM; unsigned char* sUl = sB_TM; unsigned char* sZ2 = sN; unsigned char* sPT2 = sNT;
        float* scr = (float*)sN;
        float* gLs = (float*)(L + 17 * IMG);
#define WK_IDS int tid_ = tid; asm volatile("" : "+v"(tid_)); const int lane = tid_ & 63, t_e = tid_ >> 3, jg = tid_ & 7, r31 = lane & 31, hh = lane >> 5; (void)t_e; (void)jg; (void)r31; (void)hh;
        for (int unit = bx; unit < BATCH * NCH * 8; unit += G) {
            const int b = unit / (NCH * 8), c = (unit % (NCH * 8)) >> 3, h = unit & 7;
            f32x16 accY = zero16(), accS = zero16();
#pragma unroll 1
            for (int half = 0; half < 2; ++half) {
                const int tok0 = c * CH + half * 64;
                const size_t n0 = (size_t)b * SEQ + tok0;
                float rr[8], kmv[8], vvv[8], av[8], bv_[8], lwv[8];
                { WK_IDS
                    const int t = tok0 + t_e; const size_t n = n0 + t_e; const int cb = h * 64 + jg * 8;
                    const u32x4 ur = *(const u32x4*)(U + n * INCOLS + C_R + cb), uk = *(const u32x4*)(U + n * INCOLS + C_K + cb), uv = *(const u32x4*)(U + n * INCOLS + C_V + cb);
                    u32x4 pr = (u32x4){0u, 0u, 0u, 0u}, pk = pr, pv = pr;
                    if (t) { pr = *(const u32x4*)(U + (n - 1) * INCOLS + C_R + cb); pk = *(const u32x4*)(U + (n - 1) * INCOLS + C_K + cb); pv = *(const u32x4*)(U + (n - 1) * INCOLS + C_V + cb); }
                    const u32x4 udw = *(const u32x4*)(DWAG + n * 1536 + cb), uda = *(const u32x4*)(DWAG + n * 1536 + 512 + cb);
                    float ssq = 0.f, sbon = 0.f, asg[8], kk8[8];
#pragma unroll
                    for (int e = 0; e < 8; ++e) {
                        const int w = e >> 1; const bool hi = e & 1;
#define BFE(v_) (hi ? __builtin_bit_cast(float, (v_)[w] & 0xffff0000u) : __builtin_bit_cast(float, (v_)[w] << 16))
                        const float r0 = BFE(ur), k0 = BFE(uk), v0 = BFE(uv), p_r = BFE(pr), p_k = BFE(pk), p_v = BFE(pv), dw = BFE(udw), da = BFE(uda);
#undef BFE
                        const int ch = cb + e;
                        const float r = r0 + (p_r - r0) * mu_shift[C_R + ch], k = k0 + (p_k - k0) * mu_shift[C_K + ch]; vvv[e] = v0 + (p_v - v0) * mu_shift[C_V + ch];
                        const float xx = -(w0[ch] + dw);
                        const float sp = fmaxf(xx, 0.f) + __logf(1.f + __expf(-fabsf(xx)));
                        lwv[e] = -__expf(-sp - 0.5f);
                        asg[e] = __builtin_amdgcn_rcpf(1.f + __expf(-(a0[ch] + da)));
                        kk8[e] = k * k_k[ch]; ssq += kk8[e] * kk8[e];
                        kmv[e] = k * (1.f + (asg[e] - 1.f) * k_a[ch]); rr[e] = r; sbon += r * kmv[e] * r_k[ch];
                    }
                    ssq += __shfl_xor(ssq, 1); ssq += __shfl_xor(ssq, 2); ssq += __shfl_xor(ssq, 4);
                    sbon += __shfl_xor(sbon, 1); sbon += __shfl_xor(sbon, 2); sbon += __shfl_xor(sbon, 4);
                    const float inv = __builtin_amdgcn_rcpf(fmaxf(sqrtf(ssq), 1e-12f));
#pragma unroll
                    for (int e = 0; e < 8; ++e) { const float kkn = kk8[e] * inv; av[e] = -kkn; bv_[e] = kkn * asg[e]; }
                    if (jg == 0) BONUS[n * 8 + h] = sbon;
                    __syncthreads();
                    *(f32x4*)&scr[t_e * 64 + jg * 8] = (f32x4){lwv[0], lwv[1], lwv[2], lwv[3]}; *(f32x4*)&scr[t_e * 64 + jg * 8 + 4] = (f32x4){lwv[4], lwv[5], lwv[6], lwv[7]};
                }
                __syncthreads();
                { WK_IDS const int ch = tid_ & 63, seg = tid_ >> 6; float run = 0.f;
#pragma unroll
                  for (int i = 0; i < 8; ++i) { run += scr[(seg * 8 + i) * 64 + ch]; scr[(seg * 8 + i) * 64 + ch] = run; }
                  scr[4096 + seg * 64 + ch] = run; }
                __syncthreads();
                { WK_IDS
                    float off[8];
#pragma unroll
                    for (int e = 0; e < 8; ++e) off[e] = 0.f;
                    for (int s = 0; s < (t_e >> 3); ++s) { const f32x4 o0 = *(const f32x4*)&scr[4096 + s * 64 + jg * 8], o1 = *(const f32x4*)&scr[4096 + s * 64 + jg * 8 + 4];
#pragma unroll
                        for (int q = 0; q < 4; ++q) { off[q] += o0[q]; off[4 + q] += o1[q]; } }
                    const f32x4 c0 = *(const f32x4*)&scr[t_e * 64 + jg * 8], c1 = *(const f32x4*)&scr[t_e * 64 + jg * 8 + 4];
                    float At[8], Bt[8], Kt[8], Rt[8];
#pragma unroll
                    for (int e = 0; e < 8; ++e) { const float cum = (e < 4 ? c0[e & 3] : c1[e & 3]) + off[e], cprev = cum - lwv[e];
                        const float eM = __expf(-cum); At[e] = av[e] * __expf(cprev); Bt[e] = bv_[e] * eM; Kt[e] = kmv[e] * eM; Rt[e] = rr[e] * __expf(cum);
                        if (t_e == 63) gLs[jg * 8 + e] = __expf(cum); }
#define PK8(x_) (u32x4){pg8::cvt_pk_bf16(x_[0], x_[1]), pg8::cvt_pk_bf16(x_[2], x_[3]), pg8::cvt_pk_bf16(x_[4], x_[5]), pg8::cvt_pk_bf16(x_[6], x_[7])}
                    *(u32x4*)(sA_TM + ia(t_e, jg * 8)) = PK8(At); *(u32x4*)(sB_TM + ia(t_e, jg * 8)) = PK8(Bt); *(u32x4*)(sK_TM + ia(t_e, jg * 8)) = PK8(Kt); *(u32x4*)(sR_TM + ia(t_e, jg * 8)) = PK8(Rt);
#undef PK8
#pragma unroll
                    for (int e = 0; e < 8; ++e) { const int ch = jg * 8 + e;
                        *(bf16_t*)(sA_CM + ia(ch, t_e)) = f2bf(At[e]); *(bf16_t*)(sB_CM + ia(ch, t_e)) = f2bf(Bt[e]); *(bf16_t*)(sK_CM + ia(ch, t_e)) = f2bf(Kt[e]); *(bf16_t*)(sV_CM + ia(ch, t_e)) = f2bf(vvv[e]); }
                }
                __syncthreads();
                { WK_IDS
                    const int p = wave >> 1, rb = wave & 1;
                    const unsigned char* Aop = (p < 2) ? sA_TM : sR_TM; const unsigned char* Bop = (p & 1) ? sK_TM : sB_TM;
                    unsigned char* dst = p == 0 ? sN : (p == 1 ? sAakT : (p == 2 ? sAbrT : sAkrT));
                    const bool strict = p < 2;
#pragma unroll
                    for (int cbk = 0; cbk < 2; ++cbk) {
                        f32x16 acc = zero16();
                        if (cbk <= rb) acc = nt_tile<4>(acc, Aop, 32 * rb, Bop, 32 * cbk, 0, lane);
#pragma unroll
                        for (int r = 0; r < 16; ++r) { const int row = 32 * rb + (r & 3) + 8 * (r >> 2) + 4 * hh, col = 32 * cbk + r31; const bool keep = strict ? (col < row) : (col <= row); acc[r] = keep ? acc[r] : 0.f; }
                        st_rm(acc, dst, 32 * rb, 32 * cbk, lane);
                        if (p == 0) st_tr(acc, sNT, 32 * cbk, 32 * rb, lane);
                        if (p == 0 && cbk == 1 && rb == 0) st_rm(acc, sX, 0, 32, lane);
                    }
                }
                __syncthreads();
                if (wave < 2) { WK_IDS
                    const int o = 32 * wave;
                    f32x16 X;
#pragma unroll
                    for (int r = 0; r < 16; ++r) { const int row = (r & 3) + 8 * (r >> 2) + 4 * hh; X[r] = bf2f(*(const bf16_t*)(sN + ia(o + row, o + r31))) + (row == r31 ? 1.f : 0.f); }
                    st_rm(X, sX, o, o, lane);
                    unsigned char* Mc = sN; unsigned char* MTc = sNT; unsigned char* Mn = sMB; unsigned char* MTn = sMTB;
#pragma unroll 1
                    for (int lvl = 0; lvl < 4; ++lvl) {
                        f32x16 M2 = zero16();
                        M2 = nt_tile<2>(M2, Mc, o, MTc, o, o, lane);
                        st_rm(M2, Mn, o, o, lane); st_tr(M2, MTn, o, o, lane);
                        X = nt_tile<2>(X, sX, o, MTn, o, o, lane);
                        st_rm(X, sX, o, o, lane);
                        unsigned char* t0 = Mc; Mc = Mn; Mn = t0; unsigned char* t1 = MTc; MTc = MTn; MTn = t1;
                    }
                    if (wave == 0) st_tr(X, sMB, 0, 0, lane);
                } else if (wave < 6) { WK_IDS
                    const int ti = wave - 2, rb = ti >> 1, cbk = ti & 1;
                    f32x16 acc = zero16();
                    acc = nt_tile<4>(acc, sV_CM, 32 * rb, sAakT, 32 * cbk, 0, lane);
                    st_rm(acc, sT1, 32 * rb, 32 * cbk, lane);
                }
                __syncthreads();
                if (wave == 0) { WK_IDS
                    f32x16 T = zero16();
                    T = nt_tile<2>(T, sX, 32, sNT, 0, 32, lane);
                    st_rm(T, sMTB, 0, 0, lane);
                    f32x16 X21 = zero16();
                    X21 = nt_tile<2>(X21, sMTB, 0, sMB, 0, 0, lane);
                    st_rm(X21, sX, 32, 0, lane);
                }
                __syncthreads();
                { WK_IDS
                    const int ti = wave & 3, rb = ti >> 1, cbk = ti & 1;
                    f32x16 acc = zero16();
                    acc = nt_tile<4>(acc, wave < 4 ? sA_CM : sT1, 32 * rb, sX, 32 * cbk, 0, lane);
                    st_rm(acc, wave < 4 ? sW : sUl, 32 * rb, 32 * cbk, lane);
                }
                __syncthreads();
                { WK_IDS
                    const int ti = wave & 3, rb = ti >> 1, cbk = ti & 1;
                    if (wave < 4) {
                        f32x16 z = zero16();
                        z = nt_tile<4>(z, sAbrT, 32 * rb, sW, 32 * cbk, 0, lane);
#pragma unroll
                        for (int r = 0; r < 16; ++r) { const int row = 32 * rb + (r & 3) + 8 * (r >> 2) + 4 * hh; z[r] += bf2f(*(const bf16_t*)(sR_TM + ia(row, 32 * cbk + r31))); }
                        f32x16 y = zero16();
                        y = nt_tile<4>(y, sAbrT, 32 * rb, sUl, 32 * cbk, 0, lane);
                        y = nt_tile<4>(y, sAkrT, 32 * rb, sV_CM, 32 * cbk, 0, lane);
                        if (half == 0) {
#pragma unroll
                            for (int r = 0; r < 16; ++r) { const size_t n = n0 + 32 * rb + (r & 3) + 8 * (r >> 2) + 4 * hh; const int col = h * 64 + 32 * cbk + r31;
                                ZB[n * RW + col] = f2bf(z[r]); YLOC[n * RW + col] = y[r]; }
                        } else { accY = y; st_rm(z, sZ2, 32 * rb, 32 * cbk, lane); }
                    } else {
                        f32x16 pt = zero16();
                        pt = nt_tile<4>(pt, sB_CM, 32 * rb, sW, 32 * cbk, 0, lane);
                        f32x16 st = zero16();
                        st = nt_tile<4>(st, sB_CM, 32 * rb, sUl, 32 * cbk, 0, lane);
                        st = nt_tile<4>(st, sK_CM, 32 * rb, sV_CM, 32 * cbk, 0, lane);
#pragma unroll
                        for (int r = 0; r < 16; ++r) { const int row = 32 * rb + (r & 3) + 8 * (r >> 2) + 4 * hh; const float gl = gLs[row];
                            pt[r] = (pt[r] + (row == 32 * cbk + r31 ? 1.f : 0.f)) * gl; st[r] *= gl; }
                        if (half == 0) { st_tr(pt, sP1, 32 * cbk, 32 * rb, lane); st_tr(st, sSl1, 32 * cbk, 32 * rb, lane); }
                        else { accS = st; st_rm(pt, sPT2, 32 * rb, 32 * cbk, lane); }
                    }
                }
            }
            __syncthreads();
            { WK_IDS
                const int ti = wave & 3, rb = ti >> 1, cbk = ti & 1;
                const size_t n0 = (size_t)b * SEQ + c * CH + 64;
                if (wave < 4) {
                    f32x16 z = zero16();
                    z = nt_tile<4>(z, sZ2, 32 * rb, sP1, 32 * cbk, 0, lane);
                    f32x16 y = accY;
                    y = nt_tile<4>(y, sZ2, 32 * rb, sSl1, 32 * cbk, 0, lane);
#pragma unroll
                    for (int r = 0; r < 16; ++r) { const size_t n = n0 + 32 * rb + (r & 3) + 8 * (r >> 2) + 4 * hh; const int col = h * 64 + 32 * cbk + r31;
                        ZB[n * RW + col] = f2bf(z[r]); YLOC[n * RW + col] = y[r]; }
                } else {
                    f32x16 pt = zero16();
                    pt = nt_tile<4>(pt, sPT2, 32 * rb, sP1, 32 * cbk, 0, lane);
                    f32x16 st = accS;
                    st = nt_tile<4>(st, sPT2, 32 * rb, sSl1, 32 * cbk, 0, lane);
#pragma unroll
                    for (int r = 0; r < 16; ++r) { const int row = 32 * rb + (r & 3) + 8 * (r >> 2) + 4 * hh, col = 32 * cbk + r31;
                        PT[(size_t)unit * 4096 + row * 64 + col] = f2bf(pt[r]); SLT[(size_t)unit * 4096 + row * 64 + col] = st[r]; }
                }
            }
        }
    }
#undef WK_IDS
    SEAM(4);
    if (IN(5)) {
        if (wave == 0 && bx < 128) {
            const int bh = bx >> 2, vs = bx & 3, b = bh >> 3, h = bh & 7, col = lane & 15, g = lane >> 4;
            pg8::f32x4 acc[4];
#pragma unroll
            for (int t = 0; t < 4; ++t) acc[t] = (pg8::f32x4){0.f, 0.f, 0.f, 0.f};
            u32x4 Aw[8], An[8]; pg8::f32x4 sl[4], sn[4];
#define P5_LOAD(c_, A_, s_) do { const int unit_ = (b * NCH + (c_)) * 8 + h; const bf16_t* pt_ = PT + (size_t)unit_ * 4096; const float* slp_ = SLT + (size_t)unit_ * 4096; \
                _Pragma("unroll") for (int jo = 0; jo < 4; ++jo) { \
                    _Pragma("unroll") for (int r = 0; r < 4; ++r) s_[jo][r] = slp_[(size_t)(16 * jo + 4 * g + r) * 64 + 16 * vs + col]; \
                    _Pragma("unroll") for (int sx = 0; sx < 2; ++sx) { const bf16_t* ap_ = pt_ + (size_t)(16 * jo + col) * 64 + 32 * sx + 4 * g; \
                        const u32x2 a0_ = *(const u32x2*)ap_, a1_ = *(const u32x2*)(ap_ + 16); u32x4 aw_; aw_.x = a0_.x; aw_.y = a0_.y; aw_.z = a1_.x; aw_.w = a1_.y; A_[jo * 2 + sx] = aw_; } } } while (0)
            P5_LOAD(0, Aw, sl);
            for (int c = 0; c < NCH; ++c) {
                const int unit = (b * NCH + c) * 8 + h;
                if (c + 2 < NCH) P5_LOAD(c + 1, An, sn);
                bf16_t* sdst = SIN + (size_t)unit * 4096 + (size_t)(16 * vs + col) * 64;
                unsigned pk[8];
#pragma unroll
                for (int t = 0; t < 4; ++t) { pk[2 * t] = pg8::cvt_pk_bf16(acc[t][0], acc[t][1]); pk[2 * t + 1] = pg8::cvt_pk_bf16(acc[t][2], acc[t][3]);
                    u32x2 w; w.x = pk[2 * t]; w.y = pk[2 * t + 1]; *(u32x2*)(sdst + 16 * t + 4 * g) = w; }
                if (c == NCH - 1) break;
                pg8::bf16x8 Bf[2];
#pragma unroll
                for (int s = 0; s < 2; ++s) { u32x4 w; w.x = pk[4 * s]; w.y = pk[4 * s + 1]; w.z = pk[4 * s + 2]; w.w = pk[4 * s + 3]; Bf[s] = __builtin_bit_cast(pg8::bf16x8, w); }
#pragma unroll
                for (int jo = 0; jo < 4; ++jo) {
                    pg8::f32x4 na = sl[jo];
#pragma unroll
                    for (int s = 0; s < 2; ++s) na = __builtin_amdgcn_mfma_f32_16x16x32_bf16(__builtin_bit_cast(pg8::bf16x8, Aw[jo * 2 + s]), Bf[s], na, 0, 0, 0);
                    acc[jo] = na;
                }
#pragma unroll
                for (int i = 0; i < 8; ++i) Aw[i] = An[i];
#pragma unroll
                for (int i = 0; i < 4; ++i) sl[i] = sn[i];
            }
#undef P5_LOAD
        }
    }
    SEAM(5);
    if (IN(6)) {
        const int col = lane & 31, hh = lane >> 5;
        for (int unit = gw; unit < BATCH * NCH * 8; unit += NGW) {
            const int b = unit / (NCH * 8), c = (unit % (NCH * 8)) >> 3, h = unit & 7;
            const bf16_t* sin = SIN + (size_t)unit * 4096;
            pg8::bf16x8 Bf[2][4];
#pragma unroll
            for (int ct = 0; ct < 2; ++ct)
#pragma unroll
                for (int s = 0; s < 4; ++s) Bf[ct][s] = *(const pg8::bf16x8*)(sin + (size_t)(32 * ct + col) * 64 + 16 * s + 8 * hh);
            float lg[2], lb[2], muv[2];
#pragma unroll
            for (int ct = 0; ct < 2; ++ct) { lg[ct] = lnx_g[h * 64 + 32 * ct + col]; lb[ct] = lnx_b[h * 64 + 32 * ct + col]; muv[ct] = mu_shift[C_V + h * 64 + 32 * ct + col]; }
            for (int rt = 0; rt < CH / 32; ++rt) {
                const size_t n0 = (size_t)b * SEQ + c * CH + rt * 32;
                f32x16 acc[2];
#pragma unroll
                for (int i = 0; i < 16; ++i) { acc[0][i] = 0.f; acc[1][i] = 0.f; }
#pragma unroll
                for (int s = 0; s < 4; ++s) {
                    const pg8::bf16x8 Af = *(const pg8::bf16x8*)(ZB + (n0 + col) * RW + h * 64 + 16 * s + 8 * hh);
                    acc[0] = __builtin_amdgcn_mfma_f32_32x32x16_bf16(Af, Bf[0][s], acc[0], 0, 0, 0);
                    acc[1] = __builtin_amdgcn_mfma_f32_32x32x16_bf16(Af, Bf[1][s], acc[1], 0, 0, 0);
                }
#pragma unroll
                for (int r = 0; r < 16; ++r) {
                    const int trow = (r & 3) + 8 * (r >> 2) + 4 * hh; const size_t n = n0 + trow; const int t = c * CH + rt * 32 + trow;
                    float y0 = acc[0][r] + YLOC[n * RW + h * 64 + col], y1 = acc[1][r] + YLOC[n * RW + h * 64 + 32 + col];
                    float sm = y0 + y1, sq = y0 * y0 + y1 * y1;
#pragma unroll
                    for (int o = 1; o < 32; o <<= 1) { sm += __shfl_xor(sm, o); sq += __shfl_xor(sq, o); }
                    const float mu = sm * (1.f / 64.f), var = fmaxf(sq * (1.f / 64.f) - mu * mu, 0.f), rs = 1.f / sqrtf(var + GN_EPS);
                    const float bon = BONUS[n * 8 + h];
#pragma unroll
                    for (int ct = 0; ct < 2; ++ct) {
                        const int hc = h * 64 + 32 * ct + col;
                        const float v0 = bf2f(U[n * INCOLS + C_V + hc]); const float pv = t ? bf2f(U[(n - 1) * INCOLS + C_V + hc]) : 0.f; const float vv = v0 + (pv - v0) * muv[ct];
                        const float gg = bf2f(DWAG[n * 1536 + 1024 + hc]);
                        const float yy = ct ? y1 : y0;
                        MIX[n * D + hc] = f2bf((((yy - mu) * rs) * lg[ct] + lb[ct] + bon * vv) * gg);
                    }
                }
            }
        }
    }
    SEAM(6);
    if (IN(7)) {
        const int qcol = lane & 15, g = lane >> 4;
        unsigned char* ldsK = lds_raw;
        unsigned char* ldsV = lds_raw + 32768;
        for (int unit = bx; unit < BATCH * 64 * 2; unit += G) {
            const int b = unit >> 7, blk = (unit & 127) >> 1, hk = unit & 1;
            const int s0 = blk * 128 - 128;
            __syncthreads();
            {
                const int key = tid >> 1, hf = tid & 1, s = s0 + key;
                u32x4 ko[4], vv[4];
                if (s >= 0) {
                    const size_t n = (size_t)b * SEQ + s;
                    const bf16_t* kp = U + n * INCOLS + C_KS + hk * 64 + 16 * hf;
                    const u32x4 a0 = *(const u32x4*)kp, a1 = *(const u32x4*)(kp + 8), b0 = *(const u32x4*)(kp + 32), b1 = *(const u32x4*)(kp + 40);
                    const unsigned k1w[8] = {a0.x, a0.y, a0.z, a0.w, a1.x, a1.y, a1.z, a1.w}, k2w[8] = {b0.x, b0.y, b0.z, b0.w, b1.x, b1.y, b1.z, b1.w};
                    unsigned o1[8], o2[8];
#pragma unroll
                    for (int q = 0; q < 8; ++q) {
                        const float c0 = ROPE_C[n * 32 + 16 * hf + 2 * q], c1 = ROPE_C[n * 32 + 16 * hf + 2 * q + 1], sn0 = ROPE_S[n * 32 + 16 * hf + 2 * q], sn1 = ROPE_S[n * 32 + 16 * hf + 2 * q + 1];
                        const float x1a = __builtin_bit_cast(float, k1w[q] << 16), x1b = __builtin_bit_cast(float, k1w[q] & 0xffff0000u), x2a = __builtin_bit_cast(float, k2w[q] << 16), x2b = __builtin_bit_cast(float, k2w[q] & 0xffff0000u);
                        o1[q] = pg8::cvt_pk_bf16(x1a * c0 - x2a * sn0, x1b * c1 - x2b * sn1); o2[q] = pg8::cvt_pk_bf16(x2a * c0 + x1a * sn0, x2b * c1 + x1b * sn1);
                    }
                    ko[0] = (u32x4){o1[0], o1[1], o1[2], o1[3]}; ko[1] = (u32x4){o1[4], o1[5], o1[6], o1[7]}; ko[2] = (u32x4){o2[0], o2[1], o2[2], o2[3]}; ko[3] = (u32x4){o2[4], o2[5], o2[6], o2[7]};
                    const bf16_t* vp = U + n * INCOLS + C_VS + hk * 64 + 32 * hf;
#pragma unroll
                    for (int q = 0; q < 4; ++q) vv[q] = *(const u32x4*)(vp + 8 * q);
                } else {
#pragma unroll
                    for (int q = 0; q < 4; ++q) { ko[q] = (u32x4){0u, 0u, 0u, 0u}; vv[q] = (u32x4){0u, 0u, 0u, 0u}; }
                }
                const int sw = (key >> 1) & 7;
                *(u32x4*)(ldsK + key * 128 + (((2 * hf) ^ sw) << 4)) = ko[0]; *(u32x4*)(ldsK + key * 128 + (((2 * hf + 1) ^ sw) << 4)) = ko[1];
                *(u32x4*)(ldsK + key * 128 + (((4 + 2 * hf) ^ sw) << 4)) = ko[2]; *(u32x4*)(ldsK + key * 128 + (((5 + 2 * hf) ^ sw) << 4)) = ko[3];
#pragma unroll
                for (int q = 0; q < 4; ++q)
#pragma unroll
                    for (int e2 = 0; e2 < 4; ++e2) {
                        const unsigned wv = vv[q][e2]; const int d0 = 32 * hf + 8 * q + 2 * e2;
                        *(bf16_t*)(ldsV + d0 * 512 + ((((key >> 2) ^ (2 * (d0 & 15)))) << 3) + (key & 3) * 2) = (bf16_t)(wv & 0xffffu);
                        *(bf16_t*)(ldsV + (d0 + 1) * 512 + ((((key >> 2) ^ (2 * ((d0 + 1) & 15)))) << 3) + (key & 3) * 2) = (bf16_t)(wv >> 16);
                    }
            }
            __syncthreads();
            const int i0 = 16 * wave, qi = i0 + qcol;
            const size_t nq = (size_t)b * SEQ + blk * 128 + qi;
#pragma unroll 1
            for (int gq = 0; gq < 4; ++gq) {
                const int hq = hk * 4 + gq;
                pg8::bf16x8 Qf[2];
                {
                    const bf16_t* qp = U + nq * INCOLS + C_Q + hq * 64 + 8 * g;
                    const u32x4 qa = *(const u32x4*)qp, qb = *(const u32x4*)(qp + 32);
                    const f32x4 c0 = *(const f32x4*)(ROPE_C + nq * 32 + 8 * g), c1 = *(const f32x4*)(ROPE_C + nq * 32 + 8 * g + 4), sn0 = *(const f32x4*)(ROPE_S + nq * 32 + 8 * g), sn1 = *(const f32x4*)(ROPE_S + nq * 32 + 8 * g + 4);
                    const float cc[8] = {c0[0], c0[1], c0[2], c0[3], c1[0], c1[1], c1[2], c1[3]}, ss[8] = {sn0[0], sn0[1], sn0[2], sn0[3], sn1[0], sn1[1], sn1[2], sn1[3]};
                    u32x4 w1, w2;
#pragma unroll
                    for (int q = 0; q < 4; ++q) {
                        const float x1a = __builtin_bit_cast(float, qa[q] << 16), x1b = __builtin_bit_cast(float, qa[q] & 0xffff0000u), x2a = __builtin_bit_cast(float, qb[q] << 16), x2b = __builtin_bit_cast(float, qb[q] & 0xffff0000u);
                        w1[q] = pg8::cvt_pk_bf16((x1a * cc[2 * q] - x2a * ss[2 * q]) * 0.125f, (x1b * cc[2 * q + 1] - x2b * ss[2 * q + 1]) * 0.125f);
                        w2[q] = pg8::cvt_pk_bf16((x2a * cc[2 * q] + x1a * ss[2 * q]) * 0.125f, (x2b * cc[2 * q + 1] + x1b * ss[2 * q + 1]) * 0.125f);
                    }
                    Qf[0] = __builtin_bit_cast(pg8::bf16x8, w1); Qf[1] = __builtin_bit_cast(pg8::bf16x8, w2);
                }
                const float sink = sinks[hq];
                pg8::f32x4 acc[10];
                float m = sink;
#pragma unroll
                for (int t = 0; t < 10; ++t) {
                    const int kt = wave + t, ktc = kt < 16 ? kt : 15, key = 16 * ktc + qcol, sw = (key >> 1) & 7;
                    pg8::f32x4 a = (pg8::f32x4){0.f, 0.f, 0.f, 0.f};
#pragma unroll
                    for (int ks = 0; ks < 2; ++ks) { const pg8::bf16x8 kf = *(const pg8::bf16x8*)(ldsK + key * 128 + (((4 * ks + g) ^ sw) << 4));
                        a = __builtin_amdgcn_mfma_f32_16x16x32_bf16(kf, Qf[ks], a, 0, 0, 0); }
#pragma unroll
                    for (int r = 0; r < 4; ++r) { const int kk = 16 * kt + 4 * g + r; const bool ok = (kk > qi) && (kk <= qi + 128) && (s0 + kk >= 0) && (kt < 16);
                        a[r] = ok ? a[r] : -INFINITY; m = fmaxf(m, a[r]); }
                    acc[t] = a;
                }
                m = fmaxf(m, __shfl_xor(m, 16)); m = fmaxf(m, __shfl_xor(m, 32));
                float lsum = 0.f;
#pragma unroll
                for (int t = 0; t < 10; ++t)
#pragma unroll
                    for (int r = 0; r < 4; ++r) { const float p = __expf(acc[t][r] - m); acc[t][r] = p; lsum += p; }
                lsum += __shfl_xor(lsum, 16); lsum += __shfl_xor(lsum, 32);
                lsum += __expf(sink - m);
                pg8::bf16x8 Pf[5];
#pragma unroll
                for (int ks = 0; ks < 5; ++ks) { u32x4 w; w.x = pg8::cvt_pk_bf16(acc[2 * ks][0], acc[2 * ks][1]); w.y = pg8::cvt_pk_bf16(acc[2 * ks][2], acc[2 * ks][3]);
                    w.z = pg8::cvt_pk_bf16(acc[2 * ks + 1][0], acc[2 * ks + 1][1]); w.w = pg8::cvt_pk_bf16(acc[2 * ks + 1][2], acc[2 * ks + 1][3]); Pf[ks] = __builtin_bit_cast(pg8::bf16x8, w); }
                float linv[4];
#pragma unroll
                for (int r = 0; r < 4; ++r) linv[r] = 1.f / __shfl(lsum, 4 * g + r);
#pragma unroll
                for (int dt = 0; dt < 4; ++dt) {
                    pg8::f32x4 o = (pg8::f32x4){0.f, 0.f, 0.f, 0.f};
                    const int dd = 16 * dt + qcol;
#pragma unroll
                    for (int ks = 0; ks < 5; ++ks) {
                        const int ka = wave + 2 * ks, kb = ka + 1, kac = ka < 16 ? ka : 15, kbc = kb < 16 ? kb : 15;
                        const u32x2 v0 = *(const u32x2*)(ldsV + dd * 512 + (((4 * kac + g) ^ (2 * (dd & 15))) << 3));
                        const u32x2 v1 = *(const u32x2*)(ldsV + dd * 512 + (((4 * kbc + g) ^ (2 * (dd & 15))) << 3));
                        u32x4 w; w.x = v0.x; w.y = v0.y; w.z = v1.x; w.w = v1.y;
                        o = __builtin_amdgcn_mfma_f32_16x16x32_bf16(Pf[ks], __builtin_bit_cast(pg8::bf16x8, w), o, 0, 0, 0);
                    }
#pragma unroll
                    for (int r = 0; r < 4; ++r) MIX[((size_t)b * SEQ + blk * 128 + i0 + 4 * g + r) * D + RW + hq * 64 + dd] = f2bf(o[r] * linv[r]);
                }
            }
        }
    }
    SEAM(7);
    if (IN(8)) {
        pg8::DenseProb S{MIX, W_O_T, D, {}}; S.ord.init(NTOK, D, G, bx);
        pg8::EpiF32Res E{X1, D, x, ALPHA};
        pg8::gemm_phase(ldsl, S, E);
    }
    SEAM(8);
    if (IN(9)) { for (int n = gw; n < NTOK; n += NGW) ln_row(X1 + (size_t)n * D, 1.f, nullptr, nullptr, ln1_g, ln1_b, lane, X1B + (size_t)n * D); }
    SEAM(9);
    if (IN(10)) {
        { pg8::DenseProb S{X1B, WM_Q_T, D, {}}; S.ord.init(NTOK, D, G, bx); pg8::EpiBf16 E{QMB, D}; pg8::gemm_phase(ldsl, S, E); }
        { pg8::DenseProb S{MEMB, WM_KV_T, D, {}}; S.ord.init(BATCH * MEMT, D, G, bx); pg8::EpiBf16 E{KM, D}; pg8::gemm_phase(ldsl, S, E); }
        { pg8::DenseProb S{WM_KV_T + (size_t)D * D, MEMB, D, {}}; S.ord.init(D, BATCH * MEMT, G, bx); pg8::EpiBf16 E{VT, BATCH * MEMT}; pg8::gemm_phase(ldsl, S, E); }
    }
    SEAM(10);
    if (IN(11)) {
        const int qcol = lane & 15, g = lane >> 4;
        unsigned char* ldsb = lds_raw;
        for (int unit = bx; unit < BATCH * 4 * (SEQ / 128); unit += G) {
            const int b = unit / (4 * (SEQ / 128)), h = (unit / (SEQ / 128)) & 3, qt = unit % (SEQ / 128);
            const size_t q0 = (size_t)b * SEQ + qt * 128 + wave * 16;
            pg8::bf16x8 Qf[8];
#pragma unroll
            for (int ks = 0; ks < 8; ++ks) Qf[ks] = *(const pg8::bf16x8*)(QMB + (q0 + qcol) * D + h * 256 + 32 * ks + 8 * g);
            __syncthreads();
#pragma unroll 4
            for (int i = 0; i < 16; ++i) { const int p = tid + NTHREADS * i, row = p >> 5, ch = p & 31;
                const u32x4 v = *(const u32x4*)(KM + (size_t)(b * MEMT + row) * D + h * 256 + ch * 8);
                *(u32x4*)(ldsb + row * 512 + ((ch ^ (row & 15)) << 4)) = v; }
            __syncthreads();
            pg8::f32x4 acc[16];
#pragma unroll
            for (int kt = 0; kt < 16; ++kt) { acc[kt] = (pg8::f32x4){0.f, 0.f, 0.f, 0.f};
                const int key = 16 * kt + qcol;
#pragma unroll
                for (int ks = 0; ks < 8; ++ks) { const pg8::bf16x8 a = *(const pg8::bf16x8*)(ldsb + key * 512 + (((4 * ks + g) ^ (key & 15)) << 4));
                    acc[kt] = __builtin_amdgcn_mfma_f32_16x16x32_bf16(a, Qf[ks], acc[kt], 0, 0, 0); } }
            float m = -INFINITY;
#pragma unroll
            for (int kt = 0; kt < 16; ++kt)
#pragma unroll
                for (int r = 0; r < 4; ++r) m = fmaxf(m, acc[kt][r]);
            m = fmaxf(m, __shfl_xor(m, 16)); m = fmaxf(m, __shfl_xor(m, 32));
            float lsum = 0.f;
#pragma unroll
            for (int kt = 0; kt < 16; ++kt)
#pragma unroll
                for (int r = 0; r < 4; ++r) { const float p = __expf((acc[kt][r] - m) * 0.0625f); acc[kt][r] = p; lsum += p; }
            lsum += __shfl_xor(lsum, 16); lsum += __shfl_xor(lsum, 32);
            pg8::bf16x8 Pf[8];
#pragma unroll
            for (int ks = 0; ks < 8; ++ks) { u32x4 w; w.x = pg8::cvt_pk_bf16(acc[2 * ks][0], acc[2 * ks][1]); w.y = pg8::cvt_pk_bf16(acc[2 * ks][2], acc[2 * ks][3]);
                w.z = pg8::cvt_pk_bf16(acc[2 * ks + 1][0], acc[2 * ks + 1][1]); w.w = pg8::cvt_pk_bf16(acc[2 * ks + 1][2], acc[2 * ks + 1][3]); Pf[ks] = __builtin_bit_cast(pg8::bf16x8, w); }
            __syncthreads();
#pragma unroll 4
            for (int i = 0; i < 16; ++i) { const int p = tid + NTHREADS * i, row = p >> 5, ch = p & 31;
                const u32x4 v = *(const u32x4*)(VT + (size_t)(h * 256 + row) * (BATCH * MEMT) + b * MEMT + ch * 8);
                *(u32x4*)(ldsb + row * 512 + ((ch ^ (row & 15)) << 4)) = v; }
            __syncthreads();
            float linv[4];
#pragma unroll
            for (int r = 0; r < 4; ++r) linv[r] = 1.f / __shfl(lsum, 4 * g + r);
#pragma unroll
            for (int dt = 0; dt < 16; ++dt) {
                pg8::f32x4 o = (pg8::f32x4){0.f, 0.f, 0.f, 0.f};
                const int dd = 16 * dt + qcol;
#pragma unroll
                for (int ks = 0; ks < 8; ++ks) {
                    const int c8 = 8 * ks + g;
                    const u32x2 v0 = *(const u32x2*)(ldsb + dd * 512 + ((c8 ^ (2 * (dd & 15))) << 3));
                    const u32x2 v1 = *(const u32x2*)(ldsb + dd * 512 + (((c8 + 4) ^ (2 * (dd & 15))) << 3));
                    u32x4 w; w.x = v0.x; w.y = v0.y; w.z = v1.x; w.w = v1.y;
                    o = __builtin_amdgcn_mfma_f32_16x16x32_bf16(Pf[ks], __builtin_bit_cast(pg8::bf16x8, w), o, 0, 0, 0);
                }
#pragma unroll
                for (int r = 0; r < 4; ++r) OM[(q0 + 4 * g + r) * D + h * 256 + dd] = f2bf(o[r] * linv[r]);
            }
        }
    }
    SEAM(11);
    if (IN(14)) {
        pg8::DenseProb S{OM, WM_O_T, D, {}}; S.ord.init(NTOK, D, G, bx);
        pg8::EpiF32ResB E{X2, D, X1B, ALPHA};
        pg8::gemm_phase(ldsl, S, E);
    }
    SEAM(14);
    if (IN(15)) {
        for (int n = gw; n < NTOK; n += NGW) ln_row(X2 + (size_t)n * D, 1.f, nullptr, nullptr, ln2_g, ln2_b, lane, X2B + (size_t)n * D);
        if (bx == 0 && tid < 128) *(u32x4*)(X2B + (size_t)NTOK * D + tid * 8) = (u32x4){0u, 0u, 0u, 0u};
    }
    SEAM(15);
    if (IN(16)) {
        pg8::DenseProb S{X2B, W_R_T, D, {}}; S.ord.init(NTOK, NEXP, G, bx);
        pg8::EpiF32Res E{LOG, NEXP, nullptr, 0.f};
        pg8::gemm_phase(ldsl, S, E);
    }
    SEAM(16);
    if (IN(17)) {
        const int hl = lane >> 5;
        for (int i = bx * NTHREADS + tid; i < PMAX; i += G * NTHREADS) { STOK[i] = NTOK; SGATE[i] = 0.f; }
        for (int n = gw; n < NTOK; n += NGW) {
            float sc[4], bi[4], gso[4];
#pragma unroll
            for (int j = 0; j < 4; ++j) { const int e = lane + 64 * j; sc[j] = sigmoidf_(LOG[(size_t)n * NEXP + e]); bi[j] = sc[j] + router_bias[e]; }
#pragma unroll
            for (int j = 0; j < 4; ++j) {
                float m1 = bi[j], m2 = -INFINITY;
#pragma unroll
                for (int o = 1; o < 32; o <<= 1) { const float o1 = __shfl_xor(m1, o), o2 = __shfl_xor(m2, o);
                    const float n1 = fmaxf(m1, o1), n2 = fmaxf(fminf(m1, o1), fmaxf(m2, o2)); m1 = n1; m2 = n2; }
                gso[j] = m1 + m2;
            }
            float g8[8];
#pragma unroll
            for (int j = 0; j < 4; ++j) { const float oth = __shfl_xor(gso[j], 32); g8[2 * j] = hl ? oth : gso[j]; g8[2 * j + 1] = hl ? gso[j] : oth; }
            bool gsel[8];
#pragma unroll
            for (int a = 0; a < 8; ++a) { int rank = 0;
#pragma unroll
                for (int c = 0; c < 8; ++c) rank += ((g8[c] > g8[a]) || (g8[c] == g8[a] && c < a)) ? 1 : 0;
                gsel[a] = rank < 4; }
            float cand[4];
#pragma unroll
            for (int j = 0; j < 4; ++j) { const bool s = hl ? gsel[2 * j + 1] : gsel[2 * j]; cand[j] = s ? bi[j] : -1e30f; }
            int eidx[8]; float sel[8]; float ssum = 0.f;
#pragma unroll
            for (int k = 0; k < 8; ++k) {
                float bv = cand[0]; int be = lane;
#pragma unroll
                for (int j = 1; j < 4; ++j) if (cand[j] > bv) { bv = cand[j]; be = lane + 64 * j; }
#pragma unroll
                for (int o = 1; o < 64; o <<= 1) { const float ov = __shfl_xor(bv, o); const int oe = __shfl_xor(be, o);
                    if (ov > bv || (ov == bv && oe < be)) { bv = ov; be = oe; } }
                eidx[k] = be;
                const int jw = be >> 6, lw = be & 63;
                const float mys = jw == 0 ? sc[0] : (jw == 1 ? sc[1] : (jw == 2 ? sc[2] : sc[3]));
                sel[k] = __shfl(mys, lw); ssum += sel[k];
#pragma unroll
                for (int j = 0; j < 4; ++j) if (lane == lw && j == jw) cand[j] = -INFINITY;
            }
#pragma unroll
            for (int k = 0; k < 8; ++k) {
                if (lane == k) {
                    const int e = eidx[k];
                    const int pos = (int)atomicAdd(&ctl[CW_CNT + e], 1u);
                    EIDX[n * 8 + k] = e; GATE[n * 8 + k] = sel[k] / ssum * 2.5f; POS[n * 8 + k] = pos;
                }
            }
        }
    }
    SEAM(17);
    if (IN(19)) {
        int* soff = (int*)ldsf;
        __syncthreads();
        if (tid < NEXP) soff[1024 + tid] = (int)ctl[CW_CNT + tid];
        __syncthreads();
        if (tid == 0) { int acc = 0, cacc = 0; for (int e = 0; e < NEXP; ++e) { soff[e] = acc; soff[512 + e] = cacc; const int c = soff[1024 + e]; acc += ((c + MOE_TR - 1) / MOE_TR) * MOE_TR; cacc += c; } soff[NEXP] = acc; }
        __syncthreads();
        if (bx == 0) {
            if (tid <= NEXP) ctl[CW_OFF + tid] = (unsigned)soff[tid];
            if (tid < NEXP) ctl[CW_CST + tid] = (unsigned)soff[512 + tid];
            if (tid == 0) ctl[CW_NT] = (unsigned)(soff[NEXP] / MOE_TR);
            if (tid < NEXP) { for (int t = soff[tid] / MOE_TR; t < soff[tid + 1] / MOE_TR; ++t) TEXP[t] = tid; }
        }
        for (int i = bx * NTHREADS + tid; i < NK; i += G * NTHREADS) {
            const int e = EIDX[i], p = soff[e] + POS[i];
            STOK[p] = i >> 3; YROW[i] = soff[512 + e] + POS[i];
        }
    }
    SEAM(19);
    if (IN(20)) {
        const int ntm = (int)ctl[CW_NT];
        { pg8::GatherProb S{X2B, STOK, WE_GU_T, TEXP, D, 2, ntm * 2, G, bx, (size_t)512 * D * 2}; pg8::EpiSwiGLU E{HH, EDIM}; pg8::gemm_phase(ldsl, S, E); }
        { pg8::DenseProb S{X2B, WS_GU_T, D, {}}; S.ord.init(NTOK, 512, G, bx); pg8::EpiSwiGLU E{HS, EDIM}; pg8::gemm_phase(ldsl, S, E); }
    }
    SEAM(20);
    if (IN(21)) {
        const int ntm = (int)ctl[CW_NT];
        { pg8::GroupedProb S{HH, WE_D_T, TEXP, EDIM, 4, ntm * 4, G, bx, (size_t)D * EDIM * 2}; pg8::EpiScaleY E{YY, SGATE, ctl + CW_OFF, ctl + CW_CNT, ctl + CW_CST}; pg8::gemm_phase(ldsl, S, E); }
        { pg8::DenseProb S{HS, WS_D_T, EDIM, {}}; S.ord.init(NTOK, D, G, bx); pg8::EpiF32ResB E{out, D, X2B, ALPHA}; pg8::gemm_phase(ldsl, S, E); }
    }
    SEAM(21);
    if (IN(22)) {
        for (int n = gw; n < NTOK; n += NGW) {
            float v[16];
            float* orow = out + (size_t)n * D;
#pragma unroll
            for (int j = 0; j < 2; ++j) { const f32x4 a = *(const f32x4*)(orow + 512 * j + 8 * lane), b = *(const f32x4*)(orow + 512 * j + 8 * lane + 4);
#pragma unroll
                for (int q = 0; q < 4; ++q) { v[8 * j + q] = a[q]; v[8 * j + 4 + q] = b[q]; } }
            int yr[8]; float gk[8];
#pragma unroll
            for (int k = 0; k < 8; ++k) { yr[k] = YROW[n * 8 + k]; gk[k] = GATE[n * 8 + k]; }
#pragma unroll
            for (int k = 0; k < 8; ++k) {
                const bf16_t* yrow = YY + (size_t)yr[k] * D;
#pragma unroll
                for (int j = 0; j < 2; ++j) { const u32x4 w = *(const u32x4*)(yrow + 512 * j + 8 * lane);
#pragma unroll
                    for (int q = 0; q < 4; ++q) { v[8 * j + 2 * q] += gk[k] * __builtin_bit_cast(float, w[q] << 16); v[8 * j + 2 * q + 1] += gk[k] * __builtin_bit_cast(float, w[q] & 0xffff0000u); } }
            }
            float s = 0.f;
#pragma unroll
            for (int i = 0; i < 16; ++i) s += v[i];
            const float mean = wave_sum(s) * (1.f / D); float s2 = 0.f;
#pragma unroll
            for (int i = 0; i < 16; ++i) { v[i] -= mean; s2 += v[i] * v[i]; }
            const float rstd = 1.f / sqrtf(wave_sum(s2) * (1.f / D) + LN_EPS);
#pragma unroll
            for (int j = 0; j < 2; ++j) {
                const f32x4 g0 = *(const f32x4*)(ln3_g + 512 * j + 8 * lane), g1 = *(const f32x4*)(ln3_g + 512 * j + 8 * lane + 4);
                const f32x4 b0 = *(const f32x4*)(ln3_b + 512 * j + 8 * lane), b1 = *(const f32x4*)(ln3_b + 512 * j + 8 * lane + 4);
                f32x4 o0, o1;
#pragma unroll
                for (int q = 0; q < 4; ++q) { o0[q] = v[8 * j + q] * rstd * g0[q] + b0[q]; o1[q] = v[8 * j + 4 + q] * rstd * g1[q] + b1[q]; }
                *(f32x4*)(orow + 512 * j + 8 * lane) = o0; *(f32x4*)(orow + 512 * j + 8 * lane + 4) = o1;
            }
        }
    }
#undef IN
#undef SEAM
}

#ifndef PHASE_MASK
#define PHASE_MASK 0x7FFFFFu
#endif
#ifndef ONE_LAUNCH
#define ONE_LAUNCH 1
#endif

extern "C" void kernel_launch(void* const* d_in, const int* in_sizes, int n_in, void* d_out, int out_size, void* d_ws, size_t ws_size, hipStream_t stream) {
    static int grid = 0;
    if (grid == 0) {
        if (n_in != 34 || out_size != NTOK * D || ws_size < WS_END) { fprintf(stderr, "kernel_launch: unexpected shapes (n_in %d out %d ws %zu)\n", n_in, out_size, ws_size); grid = -1; return; }
        int dev = 0, cus = 0;
        if (hipGetDevice(&dev) != hipSuccess || hipDeviceGetAttribute(&cus, hipDeviceAttributeMultiprocessorCount, dev) != hipSuccess) { grid = -1; return; }
        if (hipFuncSetAttribute((const void*)mega, hipFuncAttributeMaxDynamicSharedMemorySize, LDS_BYTES) != hipSuccess) { fprintf(stderr, "kernel_launch: hipFuncSetAttribute failed\n"); grid = -1; return; }
        (void)hipGetLastError();
        grid = cus;
    }
    if (grid < 0) return;
    (void)hipMemsetAsync((char*)d_ws + WS_CTL, 0, CTL_ZERO_BYTES, stream);
    Args a{};
    for (int i = 0; i < 34; ++i) a.in[i] = (const float*)d_in[i];
    a.out = (float*)d_out; a.ws = (unsigned char*)d_ws;
#if ONE_LAUNCH
    a.ph_lo = 0; a.ph_hi = NPHASES;
    hipLaunchKernelGGL(mega, dim3(grid), dim3(NTHREADS), LDS_BYTES, stream, a);
#else
    for (int p = 0; p < NPHASES; ++p) { if (!((PHASE_MASK >> p) & 1)) continue; a.ph_lo = p; a.ph_hi = p + 1; hipLaunchKernelGGL(mega, dim3(grid), dim3(NTHREADS), LDS_BYTES, stream, a); }
#endif
}
```
